# Optimizing an MI355X kernel written in HIP

```python
import jax
import jax.numpy as jnp
from jax import lax
import numpy as np

D_MODEL = 1024
BATCH = 2
SEQ = 8192
DEPTH = 2

RMS_EPS = 1e-6
MIX_W = D_MODEL
A_HEADS = 4
A_HEAD_K = 128
A_HEAD_V = MIX_W // 2 // A_HEADS
A_KW = A_HEADS * A_HEAD_K
A_W = A_HEADS * A_HEAD_V
HGRN_CHUNK = 64
B_GROUPS = 4
B_W = MIX_W // 2
B_GROUP_DIM = B_W // B_GROUPS
GMLP_CHUNK = 128
EVEN_IN = 2 * A_KW + 2 * A_W + 2 * B_W
C_HEADS = 4
Q_LORA = 256
KV_LORA = 128
C_NOPE = 128
C_ROPE = 64
C_QK = C_NOPE + C_ROPE
C_V = MIX_W // 2 // C_HEADS
C_W = C_HEADS * C_V
ROPE_THETA = 10000.0
ATTN_Q_BLOCK = 128
D_HEADS = 4
D_HEAD_DIM = MIX_W // 2 // D_HEADS
D_W = D_HEADS * D_HEAD_DIM
MOBA_BLOCK = 256
MOBA_TOPK = 3
MOBA_Q_CHUNK = 64
ODD_IN = Q_LORA + KV_LORA + C_ROPE + 3 * D_W
PEER_HEADS = 8
PEER_N_KEYS = 128
PEER_N_EXPERTS = PEER_N_KEYS * PEER_N_KEYS
PEER_TOPK = 16
PEER_HALF = 128
PEER_QDIM = 2 * PEER_HALF
PEER_CHUNK = 128

kernel_name = 'hybrid_hgrn2_gmlp_mla_moba_peer'


def rmsnorm(x, g):
    xf = x.astype(jnp.float32)
    y = xf * lax.rsqrt(jnp.mean(xf * xf, axis=-1, keepdims=True) + RMS_EPS)
    return y.astype(x.dtype) * g


def split_cols(z, sizes):
    cuts = [int(c) for c in np.cumsum(sizes)[:-1]]
    return jnp.split(z, cuts, axis=-1)


def rope(x, positions):
    half = x.shape[-1] // 2
    inv_freq = ROPE_THETA ** (-jnp.arange(half, dtype=jnp.float32) / half)
    ang = positions.astype(jnp.float32)[..., None] * inv_freq
    cos = jnp.cos(ang)[:, :, None, :]
    sin = jnp.sin(ang)[:, :, None, :]
    x1 = x[..., :half].astype(jnp.float32)
    x2 = x[..., half:].astype(jnp.float32)
    return jnp.concatenate([x1 * cos - x2 * sin, x2 * cos + x1 * sin], axis=-1).astype(x.dtype)


def hgrn_lower_bounds(lb_logits):
    p = jax.nn.softmax(lb_logits.astype(jnp.float32), axis=0)
    return jnp.cumsum(p, axis=0)[:DEPTH]


def hgrn2_recurrence(q, k, v, log_f):
    B, S, H, dk = q.shape
    dv = v.shape[-1]
    nc = S // HGRN_CHUNK

    def chunks(t):
        return t.reshape(B, nc, HGRN_CHUNK, H, t.shape[-1]).transpose(1, 0, 3, 2, 4)

    causal = jnp.tril(jnp.ones((HGRN_CHUNK, HGRN_CHUNK), dtype=bool))[:, :, None]

    def step(state, inp):
        qi, ki, vi, gi = inp
        b = jnp.cumsum(gi.astype(jnp.float32), axis=2)
        o_inter = jnp.einsum('bhtk,bhkv->bhtv', qi * jnp.exp(b), state)
        diff = b[:, :, :, None, :] - b[:, :, None, :, :]
        decay = jnp.exp(jnp.where(causal, diff, -jnp.inf))
        scores = jnp.einsum('bhtk,bhsk,bhtsk->bhts', qi, ki, decay)
        o = o_inter + jnp.einsum('bhts,bhsv->bhtv', scores, vi)
        b_last = b[:, :, -1:, :]
        k_dec = ki * jnp.exp(b_last - b)
        state = jnp.exp(b_last[:, :, 0, :])[..., None] * state + jnp.einsum('bhsk,bhsv->bhkv', k_dec, vi)
        return state, o

    state0 = jnp.zeros((B, H, dk, dv), jnp.float32)
    _, o = lax.scan(step, state0, (chunks(q), chunks(k), chunks(v), chunks(log_f)))
    return o.transpose(1, 0, 3, 2, 4).reshape(B, S, H, dv)


def causal_attention(q, k, v, scale):
    B, H, S, dqk = q.shape
    nq = S // ATTN_Q_BLOCK
    qb = q.reshape(B, H, nq, ATTN_Q_BLOCK, dqk).transpose(2, 0, 1, 3, 4)
    k_pos = jnp.arange(S)

    def block(args):
        i, qi = args
        s = jnp.einsum('bhqd,bhkd->bhqk', qi, k).astype(jnp.float32) * scale
        q_pos = i * ATTN_Q_BLOCK + jnp.arange(ATTN_Q_BLOCK)
        s = jnp.where(k_pos[None, :] <= q_pos[:, None], s, -jnp.inf)
        p = jax.nn.softmax(s, axis=-1).astype(v.dtype)
        return jnp.einsum('bhqk,bhkd->bhqd', p, v)

    o = lax.map(block, (jnp.arange(nq), qb))
    return o.transpose(1, 2, 0, 3, 4).reshape(B, H, S, v.shape[-1])


def moba_attention(q, k, v, scale):
    B, H, S, d = q.shape
    nb = -(-S // MOBA_BLOCK)
    sp = nb * MOBA_BLOCK
    pad = ((0, 0), (0, 0), (0, sp - S), (0, 0))
    q, k, v = jnp.pad(q, pad), jnp.pad(k, pad), jnp.pad(v, pad)
    kb = k.reshape(B, H, nb, MOBA_BLOCK, d)
    vb = v.reshape(B, H, nb, MOBA_BLOCK, d)
    k_mean = jnp.mean(kb.astype(jnp.float32), axis=3)
    gate = jnp.einsum('bhsd,bhnd->bhsn', q.astype(jnp.float32), k_mean)
    q_block = jnp.arange(sp) // MOBA_BLOCK
    past = jnp.arange(nb)[None, :] < q_block[:, None]
    gate = jnp.where(past, gate, -jnp.inf)
    topk = min(MOBA_TOPK, nb)
    _, sel = lax.top_k(gate, topk)
    valid = sel < q_block[:, None]
    nqc = sp // MOBA_Q_CHUNK

    def chunks(t):
        return t.reshape(B, H, nqc, MOBA_Q_CHUNK, t.shape[-1]).transpose(2, 0, 1, 3, 4)

    b_idx = jnp.arange(B)[:, None, None, None]
    h_idx = jnp.arange(H)[None, :, None, None]

    def chunk(args):
        i, qi, si, vi_ = args
        k_sel = kb[b_idx, h_idx, si]
        v_sel = vb[b_idx, h_idx, si]
        s_sel = jnp.einsum('bhqd,bhqnkd->bhqnk', qi, k_sel).astype(jnp.float32) * scale
        s_sel = jnp.where(vi_[..., None], s_sel, -jnp.inf).reshape(B, H, MOBA_Q_CHUNK, topk * MOBA_BLOCK)
        j = (i * MOBA_Q_CHUNK) // MOBA_BLOCK
        k_own = lax.dynamic_index_in_dim(kb, j, axis=2, keepdims=False)
        v_own = lax.dynamic_index_in_dim(vb, j, axis=2, keepdims=False)
        s_own = jnp.einsum('bhqd,bhkd->bhqk', qi, k_own).astype(jnp.float32) * scale
        q_pos = i * MOBA_Q_CHUNK + jnp.arange(MOBA_Q_CHUNK)
        k_pos = j * MOBA_BLOCK + jnp.arange(MOBA_BLOCK)
        s_own = jnp.where(k_pos[None, :] <= q_pos[:, None], s_own, -jnp.inf)
        p = jax.nn.softmax(jnp.concatenate([s_sel, s_own], axis=-1), axis=-1).astype(v.dtype)
        p_sel = p[..., :topk * MOBA_BLOCK].reshape(B, H, MOBA_Q_CHUNK, topk, MOBA_BLOCK)
        p_own = p[..., topk * MOBA_BLOCK:]
        return (jnp.einsum('bhqnk,bhqnkd->bhqd', p_sel, v_sel)
                + jnp.einsum('bhqk,bhkd->bhqd', p_own, v_own))

    o = lax.map(chunk, (jnp.arange(nqc), chunks(q), chunks(sel), chunks(valid)))
    return o.transpose(1, 2, 0, 3, 4).reshape(B, H, sp, d)[:, :, :S]


def hgrn_gmlp_mixer(x, lb, norm_mix, w_in, hgrn_out_norm, gmlp_v_norm, gmlp_w_s, gmlp_b_s, w_out):
    B, S, _ = x.shape
    xn = rmsnorm(x, norm_mix)
    q, fg, inp, og, u, v = split_cols(xn @ w_in, [A_KW, A_KW, A_W, A_W, B_W, B_W])
    f = lb + (1.0 - lb) * jax.nn.sigmoid(fg.astype(jnp.float32))
    o = hgrn2_recurrence(q.reshape(B, S, A_HEADS, A_HEAD_K),
                         (1.0 - f).reshape(B, S, A_HEADS, A_HEAD_K),
                         jax.nn.silu(inp).reshape(B, S, A_HEADS, A_HEAD_V),
                         jnp.log(f).reshape(B, S, A_HEADS, A_HEAD_K))
    o = rmsnorm(o.astype(x.dtype), hgrn_out_norm.reshape(A_HEADS, A_HEAD_V))
    out_a = o.reshape(B, S, A_W) * jax.nn.silu(og)
    u = jax.nn.gelu(u)
    v = rmsnorm(jax.nn.gelu(v).reshape(B, S, B_GROUPS, B_GROUP_DIM),
                gmlp_v_norm.reshape(B_GROUPS, B_GROUP_DIM))
    nc = S // GMLP_CHUNK
    w_causal = gmlp_w_s * jnp.tril(jnp.ones((GMLP_CHUNK, GMLP_CHUNK), gmlp_w_s.dtype))
    sv = jnp.einsum('gts,bnsgd->bntgd', w_causal, v.reshape(B, nc, GMLP_CHUNK, B_GROUPS, B_GROUP_DIM))
    sv = sv + gmlp_b_s.T[:, :, None]
    out_b = u * sv.reshape(B, S, B_W)
    return jnp.concatenate([out_a, out_b], axis=-1) @ w_out


def mla_moba_mixer(x, positions, norm_mix, w_in, cq_norm, ckv_norm, w_uq, w_ukv,
                   mla_q_norm, mla_k_norm, moba_q_norm, moba_k_norm, w_out):
    B, S, _ = x.shape
    xn = rmsnorm(x, norm_mix)
    c_q, c_kv, k_pe, q_d, k_d, v_d = split_cols(xn @ w_in, [Q_LORA, KV_LORA, C_ROPE, D_W, D_W, D_W])
    q_c = (rmsnorm(c_q, cq_norm) @ w_uq).reshape(B, S, C_HEADS, C_QK)
    kv_c = (rmsnorm(c_kv, ckv_norm) @ w_ukv).reshape(B, S, C_HEADS, C_NOPE + C_V)
    k_c = jnp.concatenate([kv_c[..., :C_NOPE],
                           jnp.broadcast_to(k_pe[:, :, None, :], (B, S, C_HEADS, C_ROPE))], axis=-1)
    v_c = kv_c[..., C_NOPE:]
    q_c = rmsnorm(q_c, mla_q_norm)
    k_c = rmsnorm(k_c, mla_k_norm)
    q_c = jnp.concatenate([q_c[..., :C_NOPE], rope(q_c[..., C_NOPE:], positions)], axis=-1)
    k_c = jnp.concatenate([k_c[..., :C_NOPE], rope(k_c[..., C_NOPE:], positions)], axis=-1)
    o_c = causal_attention(q_c.transpose(0, 2, 1, 3), k_c.transpose(0, 2, 1, 3),
                           v_c.transpose(0, 2, 1, 3), C_QK ** -0.5)
    out_c = o_c.transpose(0, 2, 1, 3).reshape(B, S, C_W)
    q_d = rmsnorm(q_d.reshape(B, S, D_HEADS, D_HEAD_DIM), moba_q_norm)
    k_d = rmsnorm(k_d.reshape(B, S, D_HEADS, D_HEAD_DIM), moba_k_norm)
    v_d = v_d.reshape(B, S, D_HEADS, D_HEAD_DIM)
    o_d = moba_attention(q_d.transpose(0, 2, 1, 3), k_d.transpose(0, 2, 1, 3),
                         v_d.transpose(0, 2, 1, 3), D_HEAD_DIM ** -0.5)
    out_d = o_d.transpose(0, 2, 1, 3).reshape(B, S, D_W)
    return jnp.concatenate([out_c, out_d], axis=-1) @ w_out


def peer_ffn(x, norm_ffn, w_query, sub_keys, expert_down, expert_up):
    B, S, D = x.shape
    xn = rmsnorm(x, norm_ffn)
    nt = S // PEER_CHUNK
    xc = xn.reshape(B, nt, PEER_CHUNK, D).transpose(1, 0, 2, 3)

    def chunk(xi):
        q = (xi @ w_query).reshape(B, PEER_CHUNK, PEER_HEADS, 2, PEER_HALF)
        s = jnp.einsum('bthpd,hpnd->bthpn', q, sub_keys)
        s1, i1 = lax.top_k(s[..., 0, :], PEER_TOPK)
        s2, i2 = lax.top_k(s[..., 1, :], PEER_TOPK)
        cand = (s1[..., :, None] + s2[..., None, :]).reshape(B, PEER_CHUNK, PEER_HEADS, PEER_TOPK * PEER_TOPK)
        top_s, top_c = lax.top_k(cand, PEER_TOPK)
        idx = (jnp.take_along_axis(i1, top_c // PEER_TOPK, axis=-1) * PEER_N_KEYS
               + jnp.take_along_axis(i2, top_c % PEER_TOPK, axis=-1))
        g = jax.nn.softmax(top_s.astype(jnp.float32), axis=-1)
        u = jnp.take(expert_down, idx, axis=0)
        act = jax.nn.gelu(jnp.einsum('btd,bthkd->bthk', xi, u).astype(jnp.float32))
        v_sel = jnp.take(expert_up, idx, axis=0)
        return jnp.einsum('bthk,bthkd->btd', (g * act).astype(xi.dtype), v_sel)

    out = lax.map(chunk, xc)
    return out.transpose(1, 0, 2, 3).reshape(B, S, D)


def setup_inputs(seed: int = 0) -> dict:
    key = jax.random.key(seed)
    ks = iter(jax.random.split(key, 64))

    def nrm(shape, scale):
        return jax.random.normal(next(ks), shape, jnp.float32) * scale

    def gain(n):
        return 1.0 + 0.1 * jax.random.normal(next(ks), (n,), jnp.float32)

    d = D_MODEL
    inp = {}
    inp['x'] = nrm((BATCH, SEQ, d), 1.0)
    inp['positions'] = jnp.broadcast_to(jnp.arange(SEQ, dtype=jnp.int32), (BATCH, SEQ))
    inp['lb_logits'] = nrm((DEPTH + 1, A_KW), 0.5)
    inp['l0_norm_mix'] = gain(d)
    inp['l0_w_in'] = nrm((d, EVEN_IN), d ** -0.5)
    inp['l0_hgrn_out_norm'] = gain(A_W)
    inp['l0_gmlp_v_norm'] = gain(B_W)
    inp['l0_gmlp_w_s'] = nrm((B_GROUPS, GMLP_CHUNK, GMLP_CHUNK), GMLP_CHUNK ** -0.5)
    inp['l0_gmlp_b_s'] = 1.0 + nrm((B_GROUPS, GMLP_CHUNK), 0.1)
    inp['l0_w_out'] = nrm((A_W + B_W, d), (A_W + B_W) ** -0.5)
    inp['l0_norm_ffn'] = gain(d)
    inp['l0_peer_w_query'] = nrm((d, PEER_HEADS * PEER_QDIM), d ** -0.5)
    inp['l0_peer_sub_keys'] = nrm((PEER_HEADS, 2, PEER_N_KEYS, PEER_HALF), PEER_HALF ** -0.5)
    inp['l0_peer_expert_down'] = nrm((PEER_N_EXPERTS, d), d ** -0.5)
    inp['l0_peer_expert_up'] = nrm((PEER_N_EXPERTS, d), 0.25)
    inp['l1_norm_mix'] = gain(d)
    inp['l1_w_in'] = nrm((d, ODD_IN), d ** -0.5)
    inp['l1_mla_cq_norm'] = gain(Q_LORA)
    inp['l1_mla_ckv_norm'] = gain(KV_LORA)
    inp['l1_mla_w_uq'] = nrm((Q_LORA, C_HEADS * C_QK), Q_LORA ** -0.5)
    inp['l1_mla_w_ukv'] = nrm((KV_LORA, C_HEADS * (C_NOPE + C_V)), KV_LORA ** -0.5)
    inp['l1_mla_q_norm'] = gain(C_QK)
    inp['l1_mla_k_norm'] = gain(C_QK)
    inp['l1_moba_q_norm'] = gain(D_HEAD_DIM)
    inp['l1_moba_k_norm'] = gain(D_HEAD_DIM)
    inp['l1_w_out'] = nrm((C_W + D_W, d), (C_W + D_W) ** -0.5)
    inp['l1_norm_ffn'] = gain(d)
    inp['l1_peer_w_query'] = nrm((d, PEER_HEADS * PEER_QDIM), d ** -0.5)
    inp['l1_peer_sub_keys'] = nrm((PEER_HEADS, 2, PEER_N_KEYS, PEER_HALF), PEER_HALF ** -0.5)
    inp['l1_peer_expert_down'] = nrm((PEER_N_EXPERTS, d), d ** -0.5)
    inp['l1_peer_expert_up'] = nrm((PEER_N_EXPERTS, d), 0.25)
    return inp


def reference(x, positions, lb_logits,
              l0_norm_mix, l0_w_in, l0_hgrn_out_norm, l0_gmlp_v_norm, l0_gmlp_w_s, l0_gmlp_b_s, l0_w_out,
              l0_norm_ffn, l0_peer_w_query, l0_peer_sub_keys, l0_peer_expert_down, l0_peer_expert_up,
              l1_norm_mix, l1_w_in, l1_mla_cq_norm, l1_mla_ckv_norm, l1_mla_w_uq, l1_mla_w_ukv,
              l1_mla_q_norm, l1_mla_k_norm, l1_moba_q_norm, l1_moba_k_norm, l1_w_out,
              l1_norm_ffn, l1_peer_w_query, l1_peer_sub_keys, l1_peer_expert_down, l1_peer_expert_up):
    lbs = hgrn_lower_bounds(lb_logits)
    mixer_params = [
        (lbs[0], l0_norm_mix, l0_w_in, l0_hgrn_out_norm, l0_gmlp_v_norm, l0_gmlp_w_s, l0_gmlp_b_s, l0_w_out),
        (positions, l1_norm_mix, l1_w_in, l1_mla_cq_norm, l1_mla_ckv_norm, l1_mla_w_uq, l1_mla_w_ukv,
         l1_mla_q_norm, l1_mla_k_norm, l1_moba_q_norm, l1_moba_k_norm, l1_w_out),
    ]
    ffn_params = [
        (l0_norm_ffn, l0_peer_w_query, l0_peer_sub_keys, l0_peer_expert_down, l0_peer_expert_up),
        (l1_norm_ffn, l1_peer_w_query, l1_peer_sub_keys, l1_peer_expert_down, l1_peer_expert_up),
    ]
    for layer in range(DEPTH):
        mixer = hgrn_gmlp_mixer if layer % 2 == 0 else mla_moba_mixer
        x = x + mixer(x, *mixer_params[layer])
        x = x + peer_ffn(x, *ffn_params[layer])
    return x
```

```cpp
#include <hip/hip_runtime.h>
#include <hip/hip_cooperative_groups.h>
#include <stdint.h>
#include <stdio.h>
#include <string.h>
namespace cg = cooperative_groups;

#ifndef ALPHA_P0
#define ALPHA_P0 1.0f
#endif
#ifndef ALPHA_P1
#define ALPHA_P1 1.0f
#endif
#ifndef ALPHA_M0
#define ALPHA_M0 1.0f
#endif
#ifndef ALPHA_M1
#define ALPHA_M1 1.0f
#endif
#ifndef N_LAUNCH_MODE
#define N_LAUNCH_MODE 0
#endif

typedef unsigned short bf16_t;
using bf16x8 = __attribute__((ext_vector_type(8))) short;
using f32x4  = __attribute__((ext_vector_type(4))) float;
using f32x16 = __attribute__((ext_vector_type(16))) float;
typedef float f32x4v __attribute__((ext_vector_type(4)));
typedef float f32x2_t __attribute__((ext_vector_type(2)));
typedef __bf16 bf16x2_t __attribute__((ext_vector_type(2)));
typedef unsigned u32x4 __attribute__((ext_vector_type(4)));

#define DEVI __device__ __forceinline__
#define NTHREADS 256
#define LDS_BYTES 81920

static constexpr size_t MB = 1024 * 1024;
static constexpr size_t OFF_W_IN0T  = 0;
static constexpr size_t OFF_W_OUT0T = OFF_W_IN0T  + 3072ull * 1024 * 2;
static constexpr size_t OFF_W_Q0T   = OFF_W_OUT0T + 1024ull * 1024 * 2;
static constexpr size_t OFF_SK0     = OFF_W_Q0T   + 2048ull * 1024 * 2;
static constexpr size_t OFF_WS0     = OFF_SK0     + 262144ull * 2;
static constexpr size_t OFF_W_IN1T  = OFF_WS0     + 65536ull * 2;
static constexpr size_t OFF_W_UQT   = OFF_W_IN1T  + 2048ull * 1024 * 2;
static constexpr size_t OFF_W_UKVT  = OFF_W_UQT   + 768ull * 256 * 2;
static constexpr size_t OFF_W_OUT1T = OFF_W_UKVT  + 1024ull * 128 * 2;
static constexpr size_t OFF_W_Q1T   = OFF_W_OUT1T + 1024ull * 1024 * 2;
static constexpr size_t OFF_SK1     = OFF_W_Q1T   + 2048ull * 1024 * 2;
static constexpr size_t OFF_LB      = OFF_SK1     + 262144ull * 2;
static constexpr size_t OFF_ED      = 26 * MB;
static constexpr size_t OFF_EU      = OFF_ED + 32 * MB;
static constexpr size_t OFF_ACT     = OFF_EU + 32 * MB;
static constexpr size_t OFF_Z0   = OFF_ACT;
static constexpr size_t OFF_G    = OFF_Z0  + 16384ull * 3072 * 2;
static constexpr size_t OFF_HST  = OFF_G   + 16384ull * 512 * 4;
static constexpr size_t OFF_DEC  = OFF_HST + 1024ull * 16384 * 4;
static constexpr size_t OFF_MIX0 = OFF_DEC + 1024ull * 128 * 4;
static constexpr size_t OFF_QP   = OFF_ACT;
static constexpr size_t OFF_IDX  = OFF_QP  + 16384ull * 2048 * 2;
static constexpr size_t OFF_GATE = OFF_IDX + 16384ull * 128 * 4;
static constexpr size_t OFF_Z1   = OFF_ACT;
static constexpr size_t OFF_MIX1 = OFF_ACT;
static constexpr size_t OFF_QC   = OFF_Z1  + 16384ull * 1984 * 2;
static constexpr size_t OFF_KV   = OFF_QC  + 16384ull * 768 * 2;
static constexpr size_t OFF_QD   = OFF_KV  + 16384ull * 1024 * 2;
static constexpr size_t OFF_KD   = OFF_QD  + 16384ull * 512 * 2;
static constexpr size_t OFF_VDT  = OFF_KD  + 16384ull * 512 * 2;
static constexpr size_t OFF_Q    = OFF_VDT + 16384ull * 512 * 2;
static constexpr size_t OFF_K    = OFF_Q   + 16384ull * 768 * 2;
static constexpr size_t OFF_VT   = OFF_K   + 16384ull * 768 * 2;
static constexpr size_t OFF_KMEAN= OFF_VT  + 16384ull * 512 * 2;
static constexpr size_t WS_END_L1 = OFF_KMEAN + 8ull * 32 * 128 * 4;
static constexpr size_t WS_END_L0 = OFF_MIX0 + 16384ull * 1024 * 2;
static constexpr size_t WS_NEED = (WS_END_L1 > WS_END_L0 ? WS_END_L1 : WS_END_L0);
static_assert(OFF_LB + 2048 <= OFF_ED, "weights overflow");

struct Params {
    const float* x; const int* pos; const float* lb_logits;
    const float *l0_norm_mix, *l0_w_in, *l0_hgrn_out_norm, *l0_gmlp_v_norm, *l0_gmlp_w_s, *l0_gmlp_b_s, *l0_w_out,
                *l0_norm_ffn, *l0_w_query, *l0_sub_keys, *l0_exp_down, *l0_exp_up;
    const float *l1_norm_mix, *l1_w_in, *l1_cq_norm, *l1_ckv_norm, *l1_w_uq, *l1_w_ukv, *l1_q_norm, *l1_k_norm,
                *l1_mq_norm, *l1_mk_norm, *l1_w_out, *l1_norm_ffn, *l1_w_query, *l1_sub_keys, *l1_exp_down, *l1_exp_up;
    float* out;
    char* ws;
    int ph_lo, ph_hi, coop, pad0;
};

DEVI unsigned pack2(float lo, float hi) { f32x2_t v = {lo, hi}; bf16x2_t b = __builtin_convertvector(v, bf16x2_t); return __builtin_bit_cast(unsigned, b); }
DEVI bf16_t f2bf(float f) { return (bf16_t)(pack2(f, 0.f) & 0xffffu); }
DEVI float bf2f(bf16_t h) { return __uint_as_float(((unsigned)h) << 16); }
DEVI float bflo(unsigned u) { return __uint_as_float(u << 16); }
DEVI float bfhi(unsigned u) { return __uint_as_float(u & 0xffff0000u); }
DEVI float sigm(float x) { return 1.f / (1.f + __expf(-x)); }
DEVI float gelu_tanh(float x) {
    float y = 0.7978845608028654f * (x + 0.044715f * x * x * x);
    float e = __expf(2.f * y);
    float t = 1.f - 2.f / (1.f + e);
    return 0.5f * x * (1.f + t);
}
DEVI char* opaque_ptr(char* q) { asm volatile("" : "+s"(q)); return q; }
DEVI f32x4  mfma16(bf16x8 a, bf16x8 b, f32x4 c)  { return __builtin_amdgcn_mfma_f32_16x16x32_bf16(a, b, c, 0, 0, 0); }
DEVI f32x16 mfma32(bf16x8 a, bf16x8 b, f32x16 c) { return __builtin_amdgcn_mfma_f32_32x32x16_bf16(a, b, c, 0, 0, 0); }

template <int KW> DEVI int swz_off(int row, int c) {
    if constexpr (KW == 128) return row * 256 + ((c ^ (row & 15)) << 4);
    else return row * (KW * 2) + ((c ^ ((row >> 1) & 7)) << 4);
}
template <int KW> DEVI int swz_elem(int row, int k) { return swz_off<KW>(row, k >> 3) + ((k & 7) << 1); }

template <int MT, int NT, int KWA, int KWB>
DEVI void mma_nt(f32x4 (&acc)[MT][NT], const char* A, int a_row0, const char* B, int b_row0, int kc0, int nks, int lane) {
    const int r = lane & 15, q = lane >> 4;
#pragma unroll 1
    for (int ks = 0; ks < nks; ++ks) {
        bf16x8 a[MT], b[NT];
#pragma unroll
        for (int i = 0; i < MT; ++i) a[i] = *(const bf16x8*)(A + swz_off<KWA>(a_row0 + 16 * i + r, kc0 + ks * 4 + q));
#pragma unroll
        for (int j = 0; j < NT; ++j) b[j] = *(const bf16x8*)(B + swz_off<KWB>(b_row0 + 16 * j + r, kc0 + ks * 4 + q));
#pragma unroll
        for (int i = 0; i < MT; ++i)
#pragma unroll
            for (int j = 0; j < NT; ++j) acc[i][j] = mfma16(a[i], b[j], acc[i][j]);
    }
}

DEVI void conv_transpose_tile(const float* __restrict__ src, int K, int N, bf16_t* __restrict__ dst, int kt, int nt, char* smem) {
    float* s = (float*)smem;
    const int tid = threadIdx.x;
    for (int e = tid; e < 4096; e += NTHREADS) {
        int kk = e >> 6, nn = e & 63;
        int n = nt * 64 + nn;
        s[kk * 65 + nn] = (n < N) ? src[(size_t)(kt * 64 + kk) * N + n] : 0.f;
    }
    __syncthreads();
    for (int e = tid; e < 2048; e += NTHREADS) {
        int nn = e >> 5, kp = e & 31;
        unsigned v = pack2(s[(2 * kp) * 65 + nn], s[(2 * kp + 1) * 65 + nn]);
        *(unsigned*)(dst + (size_t)(nt * 64 + nn) * K + kt * 64 + 2 * kp) = v;
    }
    __syncthreads();
}
DEVI void conv_plain_chunk(const float* __restrict__ src, bf16_t* __restrict__ dst, size_t chunk) {
    const int tid = threadIdx.x;
    size_t base = chunk * 4096 + (size_t)tid * 16;
    const float4* s4 = (const float4*)(src + base);
    float4 a = s4[0], b = s4[1], c = s4[2], d = s4[3];
    uint4 o0, o1;
    o0.x = pack2(a.x, a.y); o0.y = pack2(a.z, a.w); o0.z = pack2(b.x, b.y); o0.w = pack2(b.z, b.w);
    o1.x = pack2(c.x, c.y); o1.y = pack2(c.z, c.w); o1.z = pack2(d.x, d.y); o1.w = pack2(d.z, d.w);
    uint4* d4 = (uint4*)(dst + base);
    d4[0] = o0; d4[1] = o1;
}
DEVI void conv_experts(const float* down, const float* up, char* ws, int it  ) {
    if (it < 4096) conv_plain_chunk(down, (bf16_t*)(ws + OFF_ED), it);
    else conv_plain_chunk(up, (bf16_t*)(ws + OFF_EU), it - 4096);
}

DEVI void phase_convert(const Params& p, char* smem) {
    const int T0 = 768, T1 = T0 + 256, T2 = T1 + 512, T3 = T2 + 512, T4 = T3 + 48, T5 = T4 + 32, T6 = T5 + 256, T7 = T6 + 512;
    const int P0 = T7 + 64, P1 = P0 + 64, P2 = P1 + 16, P3 = P2 + 1;
    const int P4 = P3 + 8192;
    char* ws = p.ws;
    for (int it = blockIdx.x; it < P4; it += gridDim.x) {
        if (it < T0)      { int t = it;      conv_transpose_tile(p.l0_w_in,   1024, 3072, (bf16_t*)(ws + OFF_W_IN0T),  t / 48, t % 48, smem); }
        else if (it < T1) { int t = it - T0; conv_transpose_tile(p.l0_w_out,  1024, 1024, (bf16_t*)(ws + OFF_W_OUT0T), t / 16, t % 16, smem); }
        else if (it < T2) { int t = it - T1; conv_transpose_tile(p.l0_w_query,1024, 2048, (bf16_t*)(ws + OFF_W_Q0T),   t / 32, t % 32, smem); }
        else if (it < T3) { int t = it - T2; conv_transpose_tile(p.l1_w_in,   1024, 1984, (bf16_t*)(ws + OFF_W_IN1T),  t / 32, t % 32, smem); }
        else if (it < T4) { int t = it - T3; conv_transpose_tile(p.l1_w_uq,    256,  768, (bf16_t*)(ws + OFF_W_UQT),   t / 12, t % 12, smem); }
        else if (it < T5) { int t = it - T4; conv_transpose_tile(p.l1_w_ukv,   128, 1024, (bf16_t*)(ws + OFF_W_UKVT),  t / 16, t % 16, smem); }
        else if (it < T6) { int t = it - T5; conv_transpose_tile(p.l1_w_out,  1024, 1024, (bf16_t*)(ws + OFF_W_OUT1T), t / 16, t % 16, smem); }
        else if (it < T7) { int t = it - T6; conv_transpose_tile(p.l1_w_query,1024, 2048, (bf16_t*)(ws + OFF_W_Q1T),   t / 32, t % 32, smem); }
        else if (it < P0) conv_plain_chunk(p.l0_sub_keys, (bf16_t*)(ws + OFF_SK0), it - T7);
        else if (it < P1) conv_plain_chunk(p.l1_sub_keys, (bf16_t*)(ws + OFF_SK1), it - P0);
        else if (it < P2) {
            int chunk = it - P1; bf16_t* dst = (bf16_t*)(ws + OFF_WS0);
            for (int e = threadIdx.x; e < 4096; e += NTHREADS) {
                int idx = chunk * 4096 + e; int t = (idx >> 7) & 127, s = idx & 127;
                dst[idx] = f2bf(s <= t ? p.l0_gmlp_w_s[idx] : 0.f);
            }
        }
        else if (it < P3) {
            float* lb = (float*)(ws + OFF_LB);
            for (int c = threadIdx.x; c < 512; c += NTHREADS) {
                float a0 = p.lb_logits[c], a1 = p.lb_logits[512 + c], a2 = p.lb_logits[1024 + c];
                float m = fmaxf(a0, fmaxf(a1, a2));
                float e0 = __expf(a0 - m), e1 = __expf(a1 - m), e2 = __expf(a2 - m);
                lb[c] = e0 / (e0 + e1 + e2);
            }
        }
        else conv_experts(p.l0_exp_down, p.l0_exp_up, ws, it - P3);
    }
}

template <int AMODE, class Epi>
DEVI void gemm_phase(const void* __restrict__ Aptr, int lda, const float* __restrict__ gain, const bf16_t* __restrict__ Bt,
                           int M, int Npad, int K, Epi epi, char* smem, int blk0, int nblk) {
    const int tid = threadIdx.x, lane = tid & 63, wave = tid >> 6;
    const int wm = wave >> 1, wn = wave & 1;
    const int tn = Npad / 128, tm = M / 128, nkt = K / 64;
    float* sRstd = (float*)(smem + 65536);
    const int crow = tid >> 3, cc = tid & 7;
    for (int tile = blk0; tile < tm * tn; tile += nblk) {
        const int m0 = (tile / tn) * 128, n0 = (tile % tn) * 128;
        f32x4 acc[4][4];
#pragma unroll
        for (int i = 0; i < 4; ++i)
#pragma unroll
            for (int j = 0; j < 4; ++j) acc[i][j] = f32x4{0.f, 0.f, 0.f, 0.f};
        float ss[4] = {0.f, 0.f, 0.f, 0.f};
        f32x4v ra[4][2]; u32x4 rab[4]; u32x4 rb[4]; f32x4v g0, g1;
        auto gload = [&](int kt) {
            const int k0 = kt * 64 + cc * 8;
#pragma unroll
            for (int i = 0; i < 4; ++i) {
                const int row = crow + 32 * i;
                if constexpr (AMODE == 0) {
                    const float* pa = (const float*)Aptr + (size_t)(m0 + row) * lda + k0;
                    ra[i][0] = *(const f32x4v*)pa; ra[i][1] = *(const f32x4v*)(pa + 4);
                } else {
                    const bf16_t* pa = (const bf16_t*)Aptr + (size_t)(m0 + row) * lda + k0;
                    rab[i] = *(const u32x4*)pa;
                }
                rb[i] = *(const u32x4*)(Bt + (size_t)(n0 + row) * K + k0);
            }
            if constexpr (AMODE != 1) { g0 = *(const f32x4v*)(gain + k0); g1 = *(const f32x4v*)(gain + k0 + 4); }
        };
        auto lstore = [&](int buf) {
            char* sA = smem + buf * 32768; char* sB = sA + 16384;
#pragma unroll
            for (int i = 0; i < 4; ++i) {
                const int row = crow + 32 * i;
                u32x4 o;
                if constexpr (AMODE == 0) {
                    f32x4v a = ra[i][0], b = ra[i][1];
                    ss[i] += a.x * a.x + a.y * a.y + a.z * a.z + a.w * a.w + b.x * b.x + b.y * b.y + b.z * b.z + b.w * b.w;
                    o.x = pack2(a.x * g0.x, a.y * g0.y); o.y = pack2(a.z * g0.z, a.w * g0.w);
                    o.z = pack2(b.x * g1.x, b.y * g1.y); o.w = pack2(b.z * g1.z, b.w * g1.w);
                } else if constexpr (AMODE == 2) {
                    u32x4 u = rab[i];
                    float a0 = bflo(u.x), a1 = bfhi(u.x), a2 = bflo(u.y), a3 = bfhi(u.y), a4 = bflo(u.z), a5 = bfhi(u.z), a6 = bflo(u.w), a7 = bfhi(u.w);
                    ss[i] += a0 * a0 + a1 * a1 + a2 * a2 + a3 * a3 + a4 * a4 + a5 * a5 + a6 * a6 + a7 * a7;
                    o.x = pack2(a0 * g0.x, a1 * g0.y); o.y = pack2(a2 * g0.z, a3 * g0.w);
                    o.z = pack2(a4 * g1.x, a5 * g1.y); o.w = pack2(a6 * g1.z, a7 * g1.w);
                } else o = rab[i];
                *(u32x4*)(sA + swz_off<64>(row, cc)) = o;
                *(u32x4*)(sB + swz_off<64>(row, cc)) = rb[i];
            }
        };
        gload(0); lstore(0); __syncthreads();
#pragma unroll 1
        for (int kt = 0; kt < nkt; ++kt) {
            if (kt + 1 < nkt) gload(kt + 1);
            const char* sA = smem + (kt & 1) * 32768; const char* sB = sA + 16384;
            mma_nt<4, 4, 64, 64>(acc, sA, wm * 64, sB, wn * 64, 0, 2, lane);
            if (kt + 1 < nkt) lstore((kt + 1) & 1);
            __syncthreads();
        }
        if constexpr (AMODE != 1) {
#pragma unroll
            for (int i = 0; i < 4; ++i) {
                float s = ss[i];
                s += __shfl_xor(s, 1); s += __shfl_xor(s, 2); s += __shfl_xor(s, 4);
                if (cc == 0) sRstd[crow + 32 * i] = rsqrtf(s / (float)K + 1e-6f);
            }
            __syncthreads();
        }
#pragma unroll
        for (int i = 0; i < 4; ++i)
#pragma unroll
            for (int r = 0; r < 4; ++r) {
                const int rl = wm * 64 + i * 16 + (lane >> 4) * 4 + r;
                const float rs = (AMODE != 1) ? sRstd[rl] : 1.f;
#pragma unroll
                for (int j = 0; j < 4; ++j) epi(m0 + rl, n0 + wn * 64 + j * 16 + (lane & 15), acc[i][j][r] * rs);
                __builtin_amdgcn_sched_barrier(0);
            }
    }
}

struct EpiIn0 {
    bf16_t* Z0; float* G; const float* lb;
    DEVI void operator()(int m, int n, float v) const {
        const int blk = n >> 9;
        if (blk == 1) { const int c = n - 512; const float l = lb[c]; const float f = l + (1.f - l) * sigm(v); G[(size_t)m * 512 + c] = logf(f); }
        else {
            float o = v;
            if (blk == 2 || blk == 3) o = v * sigm(v);
            else if (blk >= 4) o = gelu_tanh(v);
            Z0[(size_t)m * 3072 + n] = f2bf(o);
        }
    }
};
struct EpiResid { const float* R; float* X; float alpha; DEVI void operator()(int m, int n, float v) const { X[(size_t)m * 1024 + n] = R[(size_t)m * 1024 + n] + alpha * v; } };
struct EpiBf16 { bf16_t* D; int ldd; int N; DEVI void operator()(int m, int n, float v) const { if (n < N) D[(size_t)m * ldd + n] = f2bf(v); } };

DEVI void hgrn_local_item(const Params& p, int item, char* smem) {
    const int tid = threadIdx.x, lane = tid & 63, wave = tid >> 6;
    const int bh = item >> 7, c = item & 127, b = bh >> 2, h = bh & 3;
    const size_t m0 = (size_t)b * 8192 + c * 64;
    const float* G = (const float*)(p.ws + OFF_G) + m0 * 512 + h * 128;
    const bf16_t* Zv = (const bf16_t*)(p.ws + OFF_Z0) + m0 * 3072 + 1024 + h * 128;
    char* sVT = smem; char* sKd = smem + 16384;
    const int k = tid & 127, hf = tid >> 7;
    float bl = 0.f, bmid = 0.f;
#pragma unroll 8
    for (int t = 0; t < 64; ++t) { bl += G[t * 512 + k]; if (t == 31) bmid = bl; }
    float bcur = hf ? bmid : 0.f;
#pragma unroll 1
    for (int ch = 0; ch < 4; ++ch) {
        float kd[8], vv[8];
#pragma unroll
        for (int j = 0; j < 8; ++j) {
            const int t = 32 * hf + 8 * ch + j;
            const float g = G[t * 512 + k];
            bcur += g;
            kd[j] = (1.f - __expf(g)) * __expf(bl - bcur);
            vv[j] = bf2f(Zv[(size_t)t * 3072 + k]);
        }
        uint4 o; o.x = pack2(kd[0], kd[1]); o.y = pack2(kd[2], kd[3]); o.z = pack2(kd[4], kd[5]); o.w = pack2(kd[6], kd[7]);
        *(uint4*)(sKd + swz_off<64>(k, 4 * hf + ch)) = o;
        uint4 w; w.x = pack2(vv[0], vv[1]); w.y = pack2(vv[2], vv[3]); w.z = pack2(vv[4], vv[5]); w.w = pack2(vv[6], vv[7]);
        *(uint4*)(sVT + swz_off<64>(k, 4 * hf + ch)) = w;
    }
    if (hf == 0) ((float*)(p.ws + OFF_DEC))[item * 128 + k] = __expf(bl);
    __syncthreads();
    f32x4 acc[2][8];
#pragma unroll
    for (int i = 0; i < 2; ++i)
#pragma unroll
        for (int j = 0; j < 8; ++j) acc[i][j] = f32x4{0.f, 0.f, 0.f, 0.f};
    mma_nt<2, 8, 64, 64>(acc, sVT, 32 * wave, sKd, 0, 0, 2, lane);
    float* H = (float*)(p.ws + OFF_HST) + (size_t)item * 16384;
#pragma unroll
    for (int i = 0; i < 2; ++i)
#pragma unroll
        for (int j = 0; j < 8; ++j)
#pragma unroll
            for (int r = 0; r < 4; ++r) {
                const int v = 32 * wave + 16 * i + (lane >> 4) * 4 + r, kk = 16 * j + (lane & 15);
                H[v * 128 + kk] = acc[i][j][r];
                if (r == 3) __builtin_amdgcn_sched_barrier(0);
            }
    __syncthreads();
}

DEVI void gmlp_item(const Params& p, int item, char* smem) {
    const int tid = threadIdx.x, lane = tid & 63, wave = tid >> 6;
    const int g = item & 3, chunk = item >> 2;
    const size_t m0 = (size_t)chunk * 128;
    const bf16_t* Z0 = (const bf16_t*)(p.ws + OFF_Z0);
    const bf16_t* Wc = (const bf16_t*)(p.ws + OFF_WS0) + g * 16384;
    char* sW = smem; char* sV = smem + 32768;
#pragma unroll
    for (int i = 0; i < 8; ++i) {
        const int e = tid + 256 * i, row = e >> 4, cc = e & 15;
        *(uint4*)(sW + swz_off<128>(row, cc)) = *(const uint4*)(Wc + row * 128 + cc * 8);
    }
    {
        const int t = tid >> 1, hf = tid & 1;
        const bf16_t* src = Z0 + (m0 + t) * 3072 + 2560 + g * 128 + 64 * hf;
        float vals[64]; float ss = 0.f;
#pragma unroll
        for (int i = 0; i < 8; ++i) {
            uint4 u = *(const uint4*)(src + 8 * i);
            vals[8 * i + 0] = bflo(u.x); vals[8 * i + 1] = bfhi(u.x); vals[8 * i + 2] = bflo(u.y); vals[8 * i + 3] = bfhi(u.y);
            vals[8 * i + 4] = bflo(u.z); vals[8 * i + 5] = bfhi(u.z); vals[8 * i + 6] = bflo(u.w); vals[8 * i + 7] = bfhi(u.w);
        }
#pragma unroll
        for (int i = 0; i < 64; ++i) ss += vals[i] * vals[i];
        ss += __shfl_xor(ss, 1);
        const float rstd = rsqrtf(ss * (1.f / 128.f) + 1e-6f);
        const float* gn = p.l0_gmlp_v_norm + g * 128 + 64 * hf;
#pragma unroll
        for (int i = 0; i < 64; ++i) {
            const int d = 64 * hf + i;
            *(bf16_t*)(sV + swz_elem<128>(d, t)) = f2bf(vals[i] * rstd * gn[i]);
        }
    }
    __syncthreads();
    const int wm = wave >> 1, wn = wave & 1;
    f32x4 acc[4][4];
#pragma unroll
    for (int i = 0; i < 4; ++i)
#pragma unroll
        for (int j = 0; j < 4; ++j) acc[i][j] = f32x4{0.f, 0.f, 0.f, 0.f};
    mma_nt<4, 4, 128, 128>(acc, sW, wm * 64, sV, wn * 64, 0, 4, lane);
    bf16_t* MIX = (bf16_t*)(p.ws + OFF_MIX0);
#pragma unroll
    for (int i = 0; i < 4; ++i)
#pragma unroll
        for (int r = 0; r < 4; ++r) {
            const int t = wm * 64 + i * 16 + (lane >> 4) * 4 + r;
            const float bias = p.l0_gmlp_b_s[g * 128 + t];
#pragma unroll
            for (int j = 0; j < 4; ++j) {
                const int d = wn * 64 + j * 16 + (lane & 15);
                const float u = bf2f(Z0[(m0 + t) * 3072 + 2048 + g * 128 + d]);
                MIX[(m0 + t) * 1024 + 512 + g * 128 + d] = f2bf(u * (acc[i][j][r] + bias));
            }
        }
    __syncthreads();
}

DEVI void hgrn_scan_phase(const Params& p) {
    float* H = (float*)(p.ws + OFF_HST);
    const float* D = (const float*)(p.ws + OFF_DEC);
    for (int e = blockIdx.x * NTHREADS + threadIdx.x; e < 8 * 16384; e += gridDim.x * NTHREADS) {
        const int bh = e >> 14, idx = e & 16383, k = idx & 127;
        float run = 0.f;
        for (int c0 = 0; c0 < 128; c0 += 8) {
            float L[8], d[8];
#pragma unroll
            for (int u = 0; u < 8; ++u) { L[u] = H[((size_t)(bh * 128 + c0 + u)) * 16384 + idx]; d[u] = D[(bh * 128 + c0 + u) * 128 + k]; }
#pragma unroll
            for (int u = 0; u < 8; ++u) { H[((size_t)(bh * 128 + c0 + u)) * 16384 + idx] = run; run = d[u] * run + L[u]; }
        }
    }
}

DEVI void hgrn_out_item(const Params& p, int item, char* smem) {
    const int tid = threadIdx.x, lane = tid & 63, wave = tid >> 6;
    const int bh = item >> 7, c = item & 127, b = bh >> 2, h = bh & 3;
    const size_t m0 = (size_t)b * 8192 + c * 64;
    const float* G = (const float*)(p.ws + OFF_G) + m0 * 512 + h * 128;
    const bf16_t* Z0 = (const bf16_t*)(p.ws + OFF_Z0) + m0 * 3072;
    float* sB  = (float*)smem;
    char*  sHT = smem;
    char*  sQe = smem + 32768;
    char*  sP  = smem + 49152;
    char*  sU  = smem + 57344;
    char*  sQs = sU; char* sKh = sU + 4096; char* sVT = sU;
    float* sRed = (float*)(smem + 77824);
    const int k = tid & 127, hf = tid >> 7;
    if (hf == 0) { float bc = 0.f;
#pragma unroll 8
        for (int t = 0; t < 64; ++t) { bc += G[t * 512 + k]; sB[t * 128 + k] = bc; } }
    __syncthreads();
#pragma unroll 4
    for (int t = 32 * hf; t < 32 * hf + 32; ++t) {
        const float q = bf2f(Z0[(size_t)t * 3072 + h * 128 + k]);
        *(bf16_t*)(sQe + swz_elem<128>(t, k)) = f2bf(q * __expf(sB[t * 128 + k]));
    }
#pragma unroll 1
    for (int i = 0; i < 4; ++i) {
        const float ri = (i == 0) ? 0.f : sB[(16 * i - 1) * 128 + k];
#pragma unroll 4
        for (int tt = 8 * hf; tt < 8 * hf + 8; ++tt) {
            const int t = 16 * i + tt;
            const float q = bf2f(Z0[(size_t)t * 3072 + h * 128 + k]);
            *(bf16_t*)(sQs + swz_elem<128>(tt, k)) = f2bf(q * __expf(sB[t * 128 + k] - ri));
        }
        const int ns = 16 * (i + 1), half = ns >> 1;
#pragma unroll 4
        for (int s = hf * half; s < hf * half + half; ++s) {
            const float bs = sB[s * 128 + k];
            const float gs = bs - (s ? sB[(s - 1) * 128 + k] : 0.f);
            const float kk = 1.f - __expf(gs);
            *(bf16_t*)(sKh + swz_elem<128>(s, k)) = f2bf(kk * __expf(fminf(ri - bs, 80.f)));
        }
        __syncthreads();
        {
            f32x4 acc[1][1]; acc[0][0] = f32x4{0.f, 0.f, 0.f, 0.f};
            if (wave <= i) mma_nt<1, 1, 128, 128>(acc, sQs, 0, sKh, 16 * wave, 0, 4, lane);
#pragma unroll
            for (int r = 0; r < 4; ++r) {
                const int row = (lane >> 4) * 4 + r, col = lane & 15;
                float v = acc[0][0][r];
                if (wave > i || (wave == i && col > row)) v = 0.f;
                *(bf16_t*)(sP + swz_elem<64>(16 * i + row, 16 * wave + col)) = f2bf(v);
            }
        }
        __syncthreads();
    }
    {
        const bf16_t* Zv = Z0 + 1024 + h * 128;
#pragma unroll 1
        for (int ch = 0; ch < 4; ++ch) {
            float vv[8];
#pragma unroll
            for (int j = 0; j < 8; ++j) vv[j] = bf2f(Zv[(size_t)(32 * hf + 8 * ch + j) * 3072 + k]);
            uint4 w; w.x = pack2(vv[0], vv[1]); w.y = pack2(vv[2], vv[3]); w.z = pack2(vv[4], vv[5]); w.w = pack2(vv[6], vv[7]);
            *(uint4*)(sVT + swz_off<64>(k, 4 * hf + ch)) = w;
        }
        const float* H = (const float*)(p.ws + OFF_HST) + (size_t)item * 16384;
#pragma unroll 2
        for (int i = 0; i < 8; ++i) {
            const int e = tid + 256 * i, row = e >> 4, cc = e & 15;
            const float4 a = *(const float4*)(H + row * 128 + cc * 8), bq = *(const float4*)(H + row * 128 + cc * 8 + 4);
            uint4 o; o.x = pack2(a.x, a.y); o.y = pack2(a.z, a.w); o.z = pack2(bq.x, bq.y); o.w = pack2(bq.z, bq.w);
            *(uint4*)(sHT + swz_off<128>(row, cc)) = o;
        }
    }
    __syncthreads();
    f32x4 acc[4][2];
#pragma unroll
    for (int i = 0; i < 4; ++i)
#pragma unroll
        for (int j = 0; j < 2; ++j) acc[i][j] = f32x4{0.f, 0.f, 0.f, 0.f};
    mma_nt<4, 2, 128, 128>(acc, sQe, 0, sHT, 32 * wave, 0, 4, lane);
    mma_nt<4, 2, 64, 64>(acc, sP, 0, sVT, 32 * wave, 0, 2, lane);
#pragma unroll
    for (int i = 0; i < 4; ++i)
#pragma unroll
        for (int r = 0; r < 4; ++r) {
            float s = acc[i][0][r] * acc[i][0][r] + acc[i][1][r] * acc[i][1][r];
            s += __shfl_xor(s, 1); s += __shfl_xor(s, 2); s += __shfl_xor(s, 4); s += __shfl_xor(s, 8);
            if ((lane & 15) == 0) sRed[wave * 64 + i * 16 + (lane >> 4) * 4 + r] = s;
        }
    __syncthreads();
    bf16_t* MIX = (bf16_t*)(p.ws + OFF_MIX0);
#pragma unroll
    for (int i = 0; i < 4; ++i)
#pragma unroll
        for (int r = 0; r < 4; ++r) {
            const int t = i * 16 + (lane >> 4) * 4 + r;
            const float tot = sRed[t] + sRed[64 + t] + sRed[128 + t] + sRed[192 + t];
            const float rstd = rsqrtf(tot * (1.f / 128.f) + 1e-6f);
#pragma unroll
            for (int j = 0; j < 2; ++j) {
                const int v = 32 * wave + 16 * j + (lane & 15);
                const float og = bf2f(Z0[(size_t)t * 3072 + 1536 + h * 128 + v]);
                MIX[(m0 + t) * 1024 + h * 128 + v] = f2bf(acc[i][j][r] * rstd * p.l0_hgrn_out_norm[h * 128 + v] * og);
            }
        }
    __syncthreads();
}

DEVI unsigned f2key(float f) { unsigned u = __float_as_uint(f); return (u & 0x80000000u) ? ~u : (u | 0x80000000u); }
DEVI float key2f(unsigned k) { unsigned u = (k & 0x80000000u) ? (k ^ 0x80000000u) : ~k; return __uint_as_float(u); }
#define CE_DESC(a, b) { unsigned _x = max(a, b), _y = min(a, b); a = _x; b = _y; }
DEVI void sort16_desc(unsigned (&a)[16]) {
#pragma unroll
    for (int k = 2; k <= 16; k <<= 1)
#pragma unroll
        for (int j = k >> 1; j > 0; j >>= 1)
#pragma unroll
            for (int i = 0; i < 16; ++i) {
                const int l = i ^ j;
                if (l > i) {
                    if ((i & k) == 0) { CE_DESC(a[i], a[l]); } else { CE_DESC(a[l], a[i]); }
                }
            }
}
DEVI void merge16_desc(unsigned (&a)[16], const unsigned (&b)[16]) {
#pragma unroll
    for (int i = 0; i < 16; ++i) a[i] = max(a[i], b[15 - i]);
#pragma unroll
    for (int j = 8; j > 0; j >>= 1)
#pragma unroll
        for (int i = 0; i < 16; ++i) { const int l = i ^ j; if (l > i) { CE_DESC(a[i], a[l]); } }
}

DEVI void peer_topk_phase(const Params& p, const bf16_t* __restrict__ SK, int blk0, int nblk) {
    const int tid = threadIdx.x, lane = tid & 63, wave = tid >> 6;
    const int r = lane & 31, hh = lane >> 5;
    const bf16_t* QP = (const bf16_t*)(p.ws + OFF_QP);
    int* IDX = (int*)(p.ws + OFF_IDX); float* GATE = (float*)(p.ws + OFF_GATE);
    for (int item = blk0; item < 1024; item += nblk) {
        const int tile = item >> 1, h = (item & 1) * 4 + wave;
        const size_t tok = (size_t)tile * 32 + r;
        unsigned top[2][16];
#pragma unroll
        for (int ph = 0; ph < 2; ++ph) {
            f32x16 acc[4];
#pragma unroll
            for (int rt = 0; rt < 4; ++rt)
#pragma unroll
                for (int e = 0; e < 16; ++e) acc[rt][e] = 0.f;
            const bf16_t* qsrc = QP + tok * 2048 + h * 256 + ph * 128 + hh * 8;
            const bf16_t* ksrc = SK + ((size_t)(h * 2 + ph) * 128 + r) * 128 + hh * 8;
#pragma unroll
            for (int ks = 0; ks < 8; ++ks) {
                const bf16x8 qf = *(const bf16x8*)(qsrc + ks * 16);
#pragma unroll
                for (int rt = 0; rt < 4; ++rt) {
                    const bf16x8 kf = *(const bf16x8*)(ksrc + (size_t)rt * 32 * 128 + ks * 16);
                    acc[rt] = mfma32(kf, qf, acc[rt]);
                }
            }
#pragma unroll
            for (int rt = 0; rt < 4; ++rt) {
                unsigned kk[16];
#pragma unroll
                for (int e = 0; e < 16; ++e) {
                    const unsigned n = 32 * rt + (e & 3) + 8 * (e >> 2) + 4 * hh;
                    kk[e] = (f2key(acc[rt][e]) & ~127u) | n;
                }
                sort16_desc(kk);
                if (rt == 0) {
#pragma unroll
                    for (int e = 0; e < 16; ++e) top[ph][e] = kk[e];
                } else merge16_desc(top[ph], kk);
            }
            unsigned other[16];
#pragma unroll
            for (int e = 0; e < 16; ++e) other[e] = (unsigned)__shfl_xor((int)top[ph][e], 32);
            merge16_desc(top[ph], other);
        }
        unsigned best[16];
        {
            float s1[16], s2[16];
#pragma unroll
            for (int e = 0; e < 16; ++e) { s1[e] = key2f(top[0][e] & ~127u); s2[e] = key2f(top[1][e] & ~127u); }
            unsigned cand[64];
            int n = 0;
#pragma unroll
            for (int i = 0; i < 16; ++i)
#pragma unroll
                for (int j = 0; j < 16; ++j)
                    if ((i + 1) * (j + 1) <= 16) { cand[n] = (f2key(s1[i] + s2[j]) & ~255u) | (unsigned)(i * 16 + j); ++n; }
#pragma unroll
            for (int e = 50; e < 64; ++e) cand[e] = 0u;
#pragma unroll
            for (int g = 0; g < 4; ++g) {
                unsigned kk[16];
#pragma unroll
                for (int e = 0; e < 16; ++e) kk[e] = cand[16 * g + e];
                sort16_desc(kk);
                if (g == 0) {
#pragma unroll
                    for (int e = 0; e < 16; ++e) best[e] = kk[e];
                } else merge16_desc(best, kk);
            }
        }
        float sv[16]; int id[16];
#pragma unroll
        for (int e = 0; e < 16; ++e) {
            const unsigned code = best[e] & 255u, ci = code >> 4, cj = code & 15u;
            sv[e] = key2f(best[e] & ~255u);
            unsigned i1 = 0, i2 = 0;
#pragma unroll
            for (int a = 0; a < 16; ++a) { i1 = (ci == (unsigned)a) ? (top[0][a] & 127u) : i1; i2 = (cj == (unsigned)a) ? (top[1][a] & 127u) : i2; }
            id[e] = (int)(i1 * 128u + i2);
        }
        float den = 0.f; const float smax = sv[0];
#pragma unroll
        for (int e = 0; e < 16; ++e) { sv[e] = __expf(sv[e] - smax); den += sv[e]; }
        const float inv = 1.f / den;
        if (hh == 0) {
            int4* dst = (int4*)(IDX + tok * 128 + h * 16);
#pragma unroll
            for (int e = 0; e < 4; ++e) dst[e] = int4{id[4 * e], id[4 * e + 1], id[4 * e + 2], id[4 * e + 3]};
        } else {
            float4* dst = (float4*)(GATE + tok * 128 + h * 16);
#pragma unroll
            for (int e = 0; e < 4; ++e) dst[e] = float4{sv[4 * e] * inv, sv[4 * e + 1] * inv, sv[4 * e + 2] * inv, sv[4 * e + 3] * inv};
        }
    }
}

typedef __bf16 bf16x2v __attribute__((ext_vector_type(2)));
DEVI float dot2bf(unsigned a, unsigned b, float acc) { return __builtin_amdgcn_fdot2_f32_bf16(__builtin_bit_cast(bf16x2v, a), __builtin_bit_cast(bf16x2v, b), acc, false); }

DEVI void peer_gather_phase(const Params& p, const float* __restrict__ gain, float* X, float alpha, int blk0, int nblk) {
    const int tid = threadIdx.x, lane = tid & 63, wave = tid >> 6;
    const bf16_t* ED = (const bf16_t*)(p.ws + OFF_ED);
    const bf16_t* EU = (const bf16_t*)(p.ws + OFF_EU);
    const int* IDX = (const int*)(p.ws + OFF_IDX); const float* GATE = (const float*)(p.ws + OFF_GATE);
    for (int it = blk0; it < 4096; it += nblk) {
        const size_t tok = (size_t)it * 4 + wave;
        float* xr = X + tok * 1024;
        float4 x0 = *(const float4*)(xr + 8 * lane), x1 = *(const float4*)(xr + 8 * lane + 4);
        float4 x2 = *(const float4*)(xr + 512 + 8 * lane), x3 = *(const float4*)(xr + 512 + 8 * lane + 4);
        float ss = x0.x * x0.x + x0.y * x0.y + x0.z * x0.z + x0.w * x0.w + x1.x * x1.x + x1.y * x1.y + x1.z * x1.z + x1.w * x1.w
                 + x2.x * x2.x + x2.y * x2.y + x2.z * x2.z + x2.w * x2.w + x3.x * x3.x + x3.y * x3.y + x3.z * x3.z + x3.w * x3.w;
#pragma unroll
        for (int o = 1; o < 64; o <<= 1) ss += __shfl_xor(ss, o);
        const float rstd = rsqrtf(ss * (1.f / 1024.f) + 1e-6f);
        const float4 g0 = *(const float4*)(gain + 8 * lane), g1 = *(const float4*)(gain + 8 * lane + 4);
        const float4 g2 = *(const float4*)(gain + 512 + 8 * lane), g3 = *(const float4*)(gain + 512 + 8 * lane + 4);
        unsigned xn[8];
        xn[0] = pack2(x0.x * rstd * g0.x, x0.y * rstd * g0.y); xn[1] = pack2(x0.z * rstd * g0.z, x0.w * rstd * g0.w);
        xn[2] = pack2(x1.x * rstd * g1.x, x1.y * rstd * g1.y); xn[3] = pack2(x1.z * rstd * g1.z, x1.w * rstd * g1.w);
        xn[4] = pack2(x2.x * rstd * g2.x, x2.y * rstd * g2.y); xn[5] = pack2(x2.z * rstd * g2.z, x2.w * rstd * g2.w);
        xn[6] = pack2(x3.x * rstd * g3.x, x3.y * rstd * g3.y); xn[7] = pack2(x3.z * rstd * g3.z, x3.w * rstd * g3.w);
        const int id0 = IDX[tok * 128 + lane], id1 = IDX[tok * 128 + 64 + lane];
        const float gt0 = GATE[tok * 128 + lane], gt1 = GATE[tok * 128 + 64 + lane];
        float acc[16];
#pragma unroll
        for (int i = 0; i < 16; ++i) acc[i] = 0.f;
        for (int n0 = 0; n0 < 128; n0 += 4) {
            uint4 d[4][2], u[4][2]; float gg[4];
#pragma unroll
            for (int j = 0; j < 4; ++j) {
                const int n = n0 + j;
                const int e = __builtin_amdgcn_readlane((n0 < 64) ? id0 : id1, n & 63);
                gg[j] = __builtin_bit_cast(float, __builtin_amdgcn_readlane(__builtin_bit_cast(int, (n0 < 64) ? gt0 : gt1), n & 63));
                const bf16_t* dr = ED + (size_t)e * 1024 + 8 * lane;
                const bf16_t* ur = EU + (size_t)e * 1024 + 8 * lane;
                d[j][0] = *(const uint4*)dr; d[j][1] = *(const uint4*)(dr + 512);
                u[j][0] = *(const uint4*)ur; u[j][1] = *(const uint4*)(ur + 512);
            }
#pragma unroll
            for (int j = 0; j < 4; ++j) {
                float s = 0.f;
                s = dot2bf(d[j][0].x, xn[0], s); s = dot2bf(d[j][0].y, xn[1], s); s = dot2bf(d[j][0].z, xn[2], s); s = dot2bf(d[j][0].w, xn[3], s);
                s = dot2bf(d[j][1].x, xn[4], s); s = dot2bf(d[j][1].y, xn[5], s); s = dot2bf(d[j][1].z, xn[6], s); s = dot2bf(d[j][1].w, xn[7], s);
#pragma unroll
                for (int o = 1; o < 64; o <<= 1) s += __shfl_xor(s, o);
                const float w = alpha * gg[j] * gelu_tanh(s);
                acc[0] += w * bflo(u[j][0].x); acc[1] += w * bfhi(u[j][0].x); acc[2] += w * bflo(u[j][0].y); acc[3] += w * bfhi(u[j][0].y);
                acc[4] += w * bflo(u[j][0].z); acc[5] += w * bfhi(u[j][0].z); acc[6] += w * bflo(u[j][0].w); acc[7] += w * bfhi(u[j][0].w);
                acc[8] += w * bflo(u[j][1].x); acc[9] += w * bfhi(u[j][1].x); acc[10] += w * bflo(u[j][1].y); acc[11] += w * bfhi(u[j][1].y);
                acc[12] += w * bflo(u[j][1].z); acc[13] += w * bfhi(u[j][1].z); acc[14] += w * bflo(u[j][1].w); acc[15] += w * bfhi(u[j][1].w);
            }
        }
        *(float4*)(xr + 8 * lane)           = float4{x0.x + acc[0], x0.y + acc[1], x0.z + acc[2], x0.w + acc[3]};
        *(float4*)(xr + 8 * lane + 4)       = float4{x1.x + acc[4], x1.y + acc[5], x1.z + acc[6], x1.w + acc[7]};
        *(float4*)(xr + 512 + 8 * lane)     = float4{x2.x + acc[8], x2.y + acc[9], x2.z + acc[10], x2.w + acc[11]};
        *(float4*)(xr + 512 + 8 * lane + 4) = float4{x3.x + acc[12], x3.y + acc[13], x3.z + acc[14], x3.w + acc[15]};
    }
}

DEVI void rope_cs(float pos, int i, float& c, float& s) {
    const float inv = exp2f(-(float)i * (13.287712379549449f / 32.f));
    const float ang = pos * inv;
    const float kf = rintf(ang * 0.15915494309189535f);
    float rr = fmaf(-kf, 6.2831854820251465f, ang);
    rr = fmaf(-kf, -1.7484555e-7f, rr);
    c = __cosf(rr); s = __sinf(rr);
}
#define QSCALE_MLA  (0.07216878364870322f * 1.4426950408889634f)
#define QSCALE_MOBA (0.08838834764831845f * 1.4426950408889634f)

DEVI void moba_prep_item(const Params& p, int item, char* smem) {
    const int tid = threadIdx.x;
    const int h = item & 3, tt = item >> 2;
    const size_t m0 = (size_t)tt * 64;
    const int b = (int)(m0 >> 13), s0 = (int)(m0 & 8191), bh = b * 4 + h;
    const bf16_t* Z1 = (const bf16_t*)(p.ws + OFF_Z1);
    bf16_t* Qd = (bf16_t*)(p.ws + OFF_QD); bf16_t* Kd = (bf16_t*)(p.ws + OFF_KD); bf16_t* VdT = (bf16_t*)(p.ws + OFF_VDT);
    const int row = tid >> 2, j = tid & 3;
    const bf16_t* zr = Z1 + (m0 + row) * 1984;
#pragma unroll
    for (int which = 0; which < 2; ++which) {
        const bf16_t* src = zr + (which ? 960 : 448) + h * 128 + 32 * j;
        const float* gn = (which ? p.l1_mk_norm : p.l1_mq_norm) + 32 * j;
        float v[32]; float ss = 0.f;
#pragma unroll
        for (int i = 0; i < 4; ++i) {
            uint4 u = *(const uint4*)(src + 8 * i);
            v[8 * i] = bflo(u.x); v[8 * i + 1] = bfhi(u.x); v[8 * i + 2] = bflo(u.y); v[8 * i + 3] = bfhi(u.y);
            v[8 * i + 4] = bflo(u.z); v[8 * i + 5] = bfhi(u.z); v[8 * i + 6] = bflo(u.w); v[8 * i + 7] = bfhi(u.w);
        }
#pragma unroll
        for (int i = 0; i < 32; ++i) ss += v[i] * v[i];
        ss += __shfl_xor(ss, 1); ss += __shfl_xor(ss, 2);
        const float sc = rsqrtf(ss * (1.f / 128.f) + 1e-6f) * (which ? 1.f : QSCALE_MOBA);
        bf16_t* dst = (which ? Kd : Qd) + ((size_t)bh * 8192 + s0 + row) * 128 + 32 * j;
#pragma unroll
        for (int i = 0; i < 4; ++i) {
            uint4 o;
            o.x = pack2(v[8 * i] * sc * gn[8 * i], v[8 * i + 1] * sc * gn[8 * i + 1]); o.y = pack2(v[8 * i + 2] * sc * gn[8 * i + 2], v[8 * i + 3] * sc * gn[8 * i + 3]);
            o.z = pack2(v[8 * i + 4] * sc * gn[8 * i + 4], v[8 * i + 5] * sc * gn[8 * i + 5]); o.w = pack2(v[8 * i + 6] * sc * gn[8 * i + 6], v[8 * i + 7] * sc * gn[8 * i + 7]);
            *(uint4*)(dst + 8 * i) = o;
        }
    }
    bf16_t* sT = (bf16_t*)smem;
    {
        const bf16_t* src = zr + 1472 + h * 128 + 32 * j;
#pragma unroll
        for (int i = 0; i < 4; ++i) {
            uint4 u = *(const uint4*)(src + 8 * i);
            const int d0 = 32 * j + 8 * i;
            sT[(d0 + 0) * 66 + row] = (bf16_t)(u.x & 0xffff); sT[(d0 + 1) * 66 + row] = (bf16_t)(u.x >> 16);
            sT[(d0 + 2) * 66 + row] = (bf16_t)(u.y & 0xffff); sT[(d0 + 3) * 66 + row] = (bf16_t)(u.y >> 16);
            sT[(d0 + 4) * 66 + row] = (bf16_t)(u.z & 0xffff); sT[(d0 + 5) * 66 + row] = (bf16_t)(u.z >> 16);
            sT[(d0 + 6) * 66 + row] = (bf16_t)(u.w & 0xffff); sT[(d0 + 7) * 66 + row] = (bf16_t)(u.w >> 16);
        }
    }
    __syncthreads();
    for (int e = tid; e < 128 * 32; e += NTHREADS) {
        const int d = e >> 5, tp = e & 31;
        const unsigned v = (unsigned)sT[d * 66 + 2 * tp] | ((unsigned)sT[d * 66 + 2 * tp + 1] << 16);
        *(unsigned*)(VdT + ((size_t)bh * 128 + d) * 8192 + s0 + 2 * tp) = v;
    }
    __syncthreads();
}

DEVI void moba_kmean_item(const Params& p, int item, char* smem) {
    const int tid = threadIdx.x;
    const int bh = item >> 5, blk = item & 31, b = bh >> 2, h = bh & 3;
    const bf16_t* Z1 = (const bf16_t*)(p.ws + OFF_Z1) + ((size_t)b * 8192 + blk * 256) * 1984 + 960 + h * 128;
    const int cc = tid & 15, rg = tid >> 4;
    float col[8];
#pragma unroll
    for (int i = 0; i < 8; ++i) col[i] = 0.f;
    for (int i = 0; i < 16; ++i) {
        const int row = rg * 16 + i;
        uint4 u = *(const uint4*)(Z1 + (size_t)row * 1984 + cc * 8);
        float v[8] = {bflo(u.x), bfhi(u.x), bflo(u.y), bfhi(u.y), bflo(u.z), bfhi(u.z), bflo(u.w), bfhi(u.w)};
        float ss = 0.f;
#pragma unroll
        for (int e = 0; e < 8; ++e) ss += v[e] * v[e];
        ss += __shfl_xor(ss, 1); ss += __shfl_xor(ss, 2); ss += __shfl_xor(ss, 4); ss += __shfl_xor(ss, 8);
        const float rstd = rsqrtf(ss * (1.f / 128.f) + 1e-6f);
#pragma unroll
        for (int e = 0; e < 8; ++e) col[e] += v[e] * rstd;
    }
    float* sR = (float*)smem;
#pragma unroll
    for (int e = 0; e < 8; ++e) sR[rg * 128 + cc * 8 + e] = col[e];
    __syncthreads();
    if (tid < 128) {
        float s = 0.f;
#pragma unroll
        for (int g = 0; g < 16; ++g) s += sR[g * 128 + tid];
        ((float*)(p.ws + OFF_KMEAN))[((size_t)bh * 32 + blk) * 128 + tid] = s * (1.f / 256.f) * p.l1_mk_norm[tid];
    }
    __syncthreads();
}

DEVI void mla_prep_item(const Params& p, int item, char* smem) {
    const int tid = threadIdx.x;
    const int h = item & 3, tt = item >> 2;
    const size_t m0 = (size_t)tt * 64;
    const int b = (int)(m0 >> 13), s0 = (int)(m0 & 8191), bh = b * 4 + h;
    const bf16_t* Z1 = (const bf16_t*)(p.ws + OFF_Z1);
    const bf16_t* QC = (const bf16_t*)(p.ws + OFF_QC);
    const bf16_t* KV = (const bf16_t*)(p.ws + OFF_KV);
    bf16_t* Q = (bf16_t*)(p.ws + OFF_Q); bf16_t* K = (bf16_t*)(p.ws + OFF_K); bf16_t* VT = (bf16_t*)(p.ws + OFF_VT);
    const int row = tid >> 2, j = tid & 3;
    const size_t m = m0 + row;
    const float pos = (float)p.pos[m];
#pragma unroll
    for (int which = 0; which < 2; ++which) {
        const bf16_t* nsrc = which ? (KV + m * 1024 + h * 256 + 32 * j) : (QC + m * 768 + h * 192 + 32 * j);
        const bf16_t* r1 = which ? (Z1 + m * 1984 + 384 + 8 * j) : (QC + m * 768 + h * 192 + 128 + 8 * j);
        const bf16_t* r2 = r1 + 32;
        const float* gn = which ? p.l1_k_norm : p.l1_q_norm;
        float v[32], a1[8], a2[8]; float ss = 0.f;
#pragma unroll
        for (int i = 0; i < 4; ++i) {
            uint4 u = *(const uint4*)(nsrc + 8 * i);
            v[8 * i] = bflo(u.x); v[8 * i + 1] = bfhi(u.x); v[8 * i + 2] = bflo(u.y); v[8 * i + 3] = bfhi(u.y);
            v[8 * i + 4] = bflo(u.z); v[8 * i + 5] = bfhi(u.z); v[8 * i + 6] = bflo(u.w); v[8 * i + 7] = bfhi(u.w);
        }
        { uint4 u = *(const uint4*)r1; a1[0] = bflo(u.x); a1[1] = bfhi(u.x); a1[2] = bflo(u.y); a1[3] = bfhi(u.y); a1[4] = bflo(u.z); a1[5] = bfhi(u.z); a1[6] = bflo(u.w); a1[7] = bfhi(u.w); }
        { uint4 u = *(const uint4*)r2; a2[0] = bflo(u.x); a2[1] = bfhi(u.x); a2[2] = bflo(u.y); a2[3] = bfhi(u.y); a2[4] = bflo(u.z); a2[5] = bfhi(u.z); a2[6] = bflo(u.w); a2[7] = bfhi(u.w); }
#pragma unroll
        for (int i = 0; i < 32; ++i) ss += v[i] * v[i];
#pragma unroll
        for (int i = 0; i < 8; ++i) ss += a1[i] * a1[i] + a2[i] * a2[i];
        ss += __shfl_xor(ss, 1); ss += __shfl_xor(ss, 2);
        const float rstd = rsqrtf(ss * (1.f / 192.f) + 1e-6f);
        const float sc = which ? 1.f : QSCALE_MLA;
        bf16_t* dst = (which ? K : Q) + ((size_t)bh * 8192 + s0 + row) * 192;
#pragma unroll
        for (int i = 0; i < 4; ++i) {
            const float* g = gn + 32 * j + 8 * i;
            uint4 o;
            o.x = pack2(v[8 * i] * rstd * g[0] * sc, v[8 * i + 1] * rstd * g[1] * sc); o.y = pack2(v[8 * i + 2] * rstd * g[2] * sc, v[8 * i + 3] * rstd * g[3] * sc);
            o.z = pack2(v[8 * i + 4] * rstd * g[4] * sc, v[8 * i + 5] * rstd * g[5] * sc); o.w = pack2(v[8 * i + 6] * rstd * g[6] * sc, v[8 * i + 7] * rstd * g[7] * sc);
            *(uint4*)(dst + 32 * j + 8 * i) = o;
        }
        float o1[8], o2[8];
#pragma unroll
        for (int i = 0; i < 8; ++i) {
            float c, s; rope_cs(pos, 8 * j + i, c, s);
            const float y1 = a1[i] * rstd * gn[128 + 8 * j + i], y2 = a2[i] * rstd * gn[160 + 8 * j + i];
            o1[i] = (y1 * c - y2 * s) * sc; o2[i] = (y2 * c + y1 * s) * sc;
        }
        uint4 w1, w2;
        w1.x = pack2(o1[0], o1[1]); w1.y = pack2(o1[2], o1[3]); w1.z = pack2(o1[4], o1[5]); w1.w = pack2(o1[6], o1[7]);
        w2.x = pack2(o2[0], o2[1]); w2.y = pack2(o2[2], o2[3]); w2.z = pack2(o2[4], o2[5]); w2.w = pack2(o2[6], o2[7]);
        *(uint4*)(dst + 128 + 8 * j) = w1; *(uint4*)(dst + 160 + 8 * j) = w2;
    }
    bf16_t* sT = (bf16_t*)smem;
    {
        const bf16_t* src = KV + m * 1024 + h * 256 + 128 + 32 * j;
#pragma unroll
        for (int i = 0; i < 4; ++i) {
            uint4 u = *(const uint4*)(src + 8 * i);
            const int d0 = 32 * j + 8 * i;
            sT[(d0 + 0) * 66 + row] = (bf16_t)(u.x & 0xffff); sT[(d0 + 1) * 66 + row] = (bf16_t)(u.x >> 16);
            sT[(d0 + 2) * 66 + row] = (bf16_t)(u.y & 0xffff); sT[(d0 + 3) * 66 + row] = (bf16_t)(u.y >> 16);
            sT[(d0 + 4) * 66 + row] = (bf16_t)(u.z & 0xffff); sT[(d0 + 5) * 66 + row] = (bf16_t)(u.z >> 16);
            sT[(d0 + 6) * 66 + row] = (bf16_t)(u.w & 0xffff); sT[(d0 + 7) * 66 + row] = (bf16_t)(u.w >> 16);
        }
    }
    __syncthreads();
    for (int e = tid; e < 128 * 32; e += NTHREADS) {
        const int d = e >> 5, tp = e & 31;
        const unsigned v = (unsigned)sT[d * 66 + 2 * tp] | ((unsigned)sT[d * 66 + 2 * tp + 1] << 16);
        *(unsigned*)(VT + ((size_t)bh * 128 + d) * 8192 + s0 + 2 * tp) = v;
    }
    __syncthreads();
}

template <int DQK, bool MOBA>
DEVI void attn_item(const Params& p, int bh, int qt, char* smem) {
    constexpr int NKS = DQK / 16, KCH = DQK / 8;
    constexpr int KPT = 64 * KCH / NTHREADS;
    const int tid = threadIdx.x, lane = tid & 63, wave = tid >> 6;
    const int r = lane & 31, hh = lane >> 5;
    char* const ws = opaque_ptr(p.ws);
    const bf16_t* Q  = (const bf16_t*)(ws + (MOBA ? OFF_QD : OFF_Q)) + (size_t)bh * 8192 * DQK;
    const bf16_t* Kg = (const bf16_t*)(ws + (MOBA ? OFF_KD : OFF_K)) + (size_t)bh * 8192 * DQK;
    const bf16_t* Vg = (const bf16_t*)(ws + (MOBA ? OFF_VDT : OFF_VT)) + (size_t)bh * 128 * 8192;
    const int q0 = qt * 128;
    const int qpos = q0 + wave * 32 + r;
    char* sK = smem;
    char* sV = smem + 24576;
    int*  sList = (int*)(smem + 40960);
    unsigned* sSel = (unsigned*)(smem + 41472);
    float* sTop = (float*)(smem + 42240);
    int ntiles;
    unsigned mysel = 0xffffffffu;
    if constexpr (MOBA) {
        const int jblk = q0 >> 8;
        float* sKm = (float*)smem;
        const float* km = (const float*)(ws + OFF_KMEAN) + (size_t)bh * 32 * 128;
        for (int e = tid; e < 1024; e += NTHREADS) ((float4*)sKm)[e] = ((const float4*)km)[e];
        unsigned* sAny = (unsigned*)(smem + 41984);
        if (tid < 32) sAny[tid] = 0u;
        __syncthreads();
        const int qq = tid & 127, par = tid >> 7;
        float ga[16];
#pragma unroll
        for (int i = 0; i < 16; ++i) ga[i] = 0.f;
        const bf16_t* qrow = Q + (size_t)(q0 + qq) * 128;
        for (int d0 = 0; d0 < 128; d0 += 8) {
            uint4 u = *(const uint4*)(qrow + d0);
            float qv[8] = {bflo(u.x), bfhi(u.x), bflo(u.y), bfhi(u.y), bflo(u.z), bfhi(u.z), bflo(u.w), bfhi(u.w)};
#pragma unroll
            for (int i = 0; i < 16; ++i) {
                const float4 ka = *(const float4*)(sKm + (2 * i + par) * 128 + d0), kb = *(const float4*)(sKm + (2 * i + par) * 128 + d0 + 4);
                ga[i] += qv[0] * ka.x + qv[1] * ka.y + qv[2] * ka.z + qv[3] * ka.w + qv[4] * kb.x + qv[5] * kb.y + qv[6] * kb.z + qv[7] * kb.w;
            }
        }
        float tv[3] = {-3e38f, -3e38f, -3e38f}; int ti[3] = {-1, -1, -1};
#pragma unroll
        for (int i = 0; i < 16; ++i) {
            const int n = 2 * i + par;
            if (n < jblk) {
                const float v = ga[i];
                if (v > tv[0]) { tv[2] = tv[1]; ti[2] = ti[1]; tv[1] = tv[0]; ti[1] = ti[0]; tv[0] = v; ti[0] = n; }
                else if (v > tv[1]) { tv[2] = tv[1]; ti[2] = ti[1]; tv[1] = v; ti[1] = n; }
                else if (v > tv[2]) { tv[2] = v; ti[2] = n; }
            }
        }
#pragma unroll
        for (int i = 0; i < 3; ++i) { sTop[tid * 6 + 2 * i] = tv[i]; sTop[tid * 6 + 2 * i + 1] = __int_as_float(ti[i]); }
        __syncthreads();
        if (par == 0) {
#pragma unroll
            for (int i = 0; i < 3; ++i) {
                const float v = sTop[(tid + 128) * 6 + 2 * i]; const int n = __float_as_int(sTop[(tid + 128) * 6 + 2 * i + 1]);
                if (n >= 0) {
                    if (v > tv[0]) { tv[2] = tv[1]; ti[2] = ti[1]; tv[1] = tv[0]; ti[1] = ti[0]; tv[0] = v; ti[0] = n; }
                    else if (v > tv[1]) { tv[2] = tv[1]; ti[2] = ti[1]; tv[1] = v; ti[1] = n; }
                    else if (v > tv[2]) { tv[2] = v; ti[2] = n; }
                }
            }
            unsigned m = 1u << jblk;
#pragma unroll
            for (int i = 0; i < 3; ++i) if (ti[i] >= 0) { m |= 1u << ti[i]; sAny[ti[i]] = 1u; }
            sSel[qq] = m;
        }
        __syncthreads();
        if (tid == 0) {
            int n = 0;
            for (int blk = 0; blk < jblk; ++blk) if (sAny[blk]) { for (int t = 0; t < 4; ++t) sList[n++] = blk * 4 + t; }
            for (int t = jblk * 4; t < (q0 + 128) / 64; ++t) sList[n++] = t;
            sList[127] = n;
        }
        __syncthreads();
        ntiles = sList[127];
        mysel = sSel[wave * 32 + r];
        __syncthreads();
    } else {
        ntiles = 2 * qt + 2;
    }
    bf16x8 qf[NKS];
#pragma unroll
    for (int ks = 0; ks < NKS; ++ks) qf[ks] = *(const bf16x8*)(Q + (size_t)qpos * DQK + ks * 16 + hh * 8);
    f32x16 o[4];
#pragma unroll
    for (int dt = 0; dt < 4; ++dt)
#pragma unroll
        for (int e = 0; e < 16; ++e) o[dt][e] = 0.f;
    float lsum = 0.f;
    u32x4 rk[KPT], rv[4];
#define ATT_GLOAD(TILE) { const int key0_ = (TILE) * 64; \
        _Pragma("unroll") for (int i = 0; i < KPT; ++i) { const int e = tid + NTHREADS * i, row = e / KCH, cc = e % KCH; rk[i] = *(const u32x4*)(Kg + (size_t)(key0_ + row) * DQK + cc * 8); } \
        _Pragma("unroll") for (int i = 0; i < 4; ++i) { const int e = tid + NTHREADS * i, row = e >> 3, cc = e & 7; rv[i] = *(const u32x4*)(Vg + (size_t)row * 8192 + key0_ + cc * 8); } }
#define ATT_LSTORE() { \
        _Pragma("unroll") for (int i = 0; i < KPT; ++i) { const int e = tid + NTHREADS * i, row = e / KCH, cc = e % KCH; *(u32x4*)(sK + swz_off<DQK>(row, cc)) = rk[i]; } \
        _Pragma("unroll") for (int i = 0; i < 4; ++i) { const int e = tid + NTHREADS * i, row = e >> 3, cc = e & 7; *(u32x4*)(sV + swz_off<64>(row, cc)) = rv[i]; } }
    auto tile_id = [&](int li) -> int { if constexpr (MOBA) return sList[li]; else return li; };
    if (ntiles > 0) { ATT_GLOAD(tile_id(0)); ATT_LSTORE(); }
    __syncthreads();
    for (int li = 0; li < ntiles; ++li) {
        const int tile = tile_id(li);
        if constexpr (MOBA) { if (li + 1 < ntiles) ATT_GLOAD(tile_id(li + 1)); }
        const int key0 = tile * 64;
        int xk = ((DQK == 128) ? (r & 15) : ((r >> 1) & 7)) ^ hh, xv = (r >> 1) & 7;
        asm volatile("" : "+v"(xk), "+v"(xv));
        const char* kbase_l = sK + r * (DQK * 2);
        const char* vbase_l = sV + r * 128 + 8 * hh;
        bool allowed = true;
        if constexpr (MOBA) allowed = (mysel >> (tile >> 2)) & 1u;
#pragma unroll 1
        for (int kt2 = 0; kt2 < 2; ++kt2) {
            const int kbase = key0 + 32 * kt2;
            if (kbase <= q0 + wave * 32 + 31) {
                f32x16 s;
#pragma unroll
                for (int e = 0; e < 16; ++e) s[e] = 0.f;
#pragma unroll
                for (int ks = 0; ks < NKS; ++ks) {
                    const bf16x8 a = *(const bf16x8*)(kbase_l + kt2 * (32 * DQK * 2) + (((2 * ks) ^ xk) << 4));
                    s = mfma32(a, qf[ks], s);
                }
                const bool need_mask = (kbase + 31 > q0 + wave * 32);
                float pr[16];
#pragma unroll
                for (int e = 0; e < 16; ++e) {
                    const int key = kbase + (e & 3) + 8 * (e >> 2) + 4 * hh;
                    float pv = exp2f(s[e]);
                    if (need_mask && key > qpos) pv = 0.f;
                    if (!allowed) pv = 0.f;
                    pr[e] = pv; lsum += pv;
                }
#pragma unroll
                for (int s2 = 0; s2 < 2; ++s2) {
                    const u32x4 pbu = {pack2(pr[8 * s2 + 0], pr[8 * s2 + 1]), pack2(pr[8 * s2 + 2], pr[8 * s2 + 3]),
                                       pack2(pr[8 * s2 + 4], pr[8 * s2 + 5]), pack2(pr[8 * s2 + 6], pr[8 * s2 + 7])};
                    const bf16x8 pbv = __builtin_bit_cast(bf16x8, pbu);
#pragma unroll
                    for (int dt = 0; dt < 4; ++dt) {
                        const char* vb = vbase_l + dt * (32 * 128);
                        const uint2 vlo = *(const uint2*)(vb + (((4 * kt2 + 2 * s2) ^ xv) << 4));
                        const uint2 vhi = *(const uint2*)(vb + (((4 * kt2 + 2 * s2 + 1) ^ xv) << 4));
                        const u32x4 vau = {vlo.x, vlo.y, vhi.x, vhi.y};
                        o[dt] = mfma32(__builtin_bit_cast(bf16x8, vau), pbv, o[dt]);
                    }
                }
            }
        }
        __syncthreads();
        if (li + 1 < ntiles) { if constexpr (!MOBA) { ATT_GLOAD(tile_id(li + 1)); } ATT_LSTORE(); }
        __syncthreads();
    }
#undef ATT_GLOAD
#undef ATT_LSTORE
    lsum += __shfl_xor(lsum, 32);
    const float inv = 1.f / lsum;
    char* sO = smem + wave * 8704;
#pragma unroll
    for (int dt = 0; dt < 4; ++dt)
#pragma unroll
        for (int e = 0; e < 16; e += 2) {
            const int dv = 32 * dt + (e & 3) + 8 * (e >> 2) + 4 * hh;
            *(unsigned*)(sO + r * 272 + dv * 2) = pack2(o[dt][e] * inv, o[dt][e + 1] * inv);
        }
    __builtin_amdgcn_s_waitcnt(0xc07f);
    __builtin_amdgcn_wave_barrier();
    bf16_t* MIX = (bf16_t*)(ws + OFF_MIX1);
    const int b = bh >> 2, h = bh & 3;
#pragma unroll
    for (int i = 0; i < 8; ++i) {
        const int id = lane + 64 * i, row = id >> 4, cc = id & 15;
        const uint4 v = *(const uint4*)(sO + row * 272 + cc * 16);
        *(uint4*)(MIX + ((size_t)b * 8192 + q0 + wave * 32 + row) * 1024 + (MOBA ? 512 : 0) + h * 128 + cc * 8) = v;
    }
    __syncthreads();
}

template <int DQK, bool MOBA>
DEVI void attn_phase(const Params& p, char* smem) {
    const int G = gridDim.x;
#pragma unroll 1
    for (int round = 0; round * G < 512; ++round) {
        const int v = round * G + ((round & 1) ? (G - 1 - (int)blockIdx.x) : (int)blockIdx.x);
        if (v < 512) attn_item<DQK, MOBA>(p, v & 7, 63 - (v >> 3), smem);
    }
}

#define N_PHASES 18
DEVI void run_phase(const Params& p, int ph, char* smem) {
    char* ws = p.ws;
    const int bid = blockIdx.x, nb = gridDim.x;
    switch (ph) {
    case 0: phase_convert(p, smem); break;
    case 1: gemm_phase<0>(p.x, 1024, p.l0_norm_mix, (const bf16_t*)(ws + OFF_W_IN0T), 16384, 3072, 1024,
                          EpiIn0{(bf16_t*)(ws + OFF_Z0), (float*)(ws + OFF_G), (const float*)(ws + OFF_LB)}, smem, bid, nb); break;
    case 2: for (int it = bid; it < 1024; it += nb) hgrn_local_item(p, it, smem);
            for (int it = nb - 1 - bid; it < 512; it += nb) gmlp_item(p, it, smem);
            break;
    case 3: hgrn_scan_phase(p); break;
    case 4: for (int it = bid; it < 1024; it += nb) hgrn_out_item(p, it, smem); break;
    case 5: case 14: {
        const bool l1 = (ph == 14);
        gemm_phase<1>(ws + (l1 ? OFF_MIX1 : OFF_MIX0), 1024, nullptr, (const bf16_t*)(ws + (l1 ? OFF_W_OUT1T : OFF_W_OUT0T)), 16384, 1024, 1024, EpiResid{l1 ? (const float*)p.out : p.x, p.out, l1 ? ALPHA_M1 : ALPHA_M0}, smem, bid, nb);
    } break;
    case 6: case 15: {
        const bool l1 = (ph == 15);
        gemm_phase<0>(p.out, 1024, l1 ? p.l1_norm_ffn : p.l0_norm_ffn, (const bf16_t*)(ws + (l1 ? OFF_W_Q1T : OFF_W_Q0T)), 16384, 2048, 1024, EpiBf16{(bf16_t*)(ws + OFF_QP), 2048, 2048}, smem, bid, nb);
    } break;
    case 7: case 16: peer_topk_phase(p, (const bf16_t*)(ws + (ph == 16 ? OFF_SK1 : OFF_SK0)), bid, nb); break;
    case 8: case 17: peer_gather_phase(p, (ph == 17) ? p.l1_norm_ffn : p.l0_norm_ffn, p.out, (ph == 17) ? ALPHA_P1 : ALPHA_P0, bid, nb); break;
    case 9: gemm_phase<0>(p.out, 1024, p.l1_norm_mix, (const bf16_t*)(ws + OFF_W_IN1T), 16384, 2048, 1024, EpiBf16{(bf16_t*)(ws + OFF_Z1), 1984, 1984}, smem, bid, nb);
            for (int it = bid; it < 8192; it += nb) conv_experts(p.l1_exp_down, p.l1_exp_up, ws, it);
            break;
    case 10: {
        const int g1 = (nb * 3) / 5 > 0 ? (nb * 3) / 5 : 1;
        gemm_phase<2>(ws + OFF_Z1, 1984, p.l1_cq_norm, (const bf16_t*)(ws + OFF_W_UQT), 16384, 768, 256, EpiBf16{(bf16_t*)(ws + OFF_QC), 768, 768}, smem, bid, nb);
        gemm_phase<2>((const bf16_t*)(ws + OFF_Z1) + 256, 1984, p.l1_ckv_norm, (const bf16_t*)(ws + OFF_W_UKVT), 16384, 1024, 128, EpiBf16{(bf16_t*)(ws + OFF_KV), 1024, 1024}, smem, bid, nb);
        (void)g1;
        for (int it = bid; it < 1024 + 256; it += nb) { if (it < 1024) moba_prep_item(p, it, smem); else moba_kmean_item(p, it - 1024, smem); }
    } break;
    case 11: for (int it = bid; it < 1024; it += nb) mla_prep_item(p, it, smem); break;
    case 12: attn_phase<192, false>(p, smem); break;
    case 13: attn_phase<128, true>(p, smem); break;
#ifdef PHASE_PROBE
    case 20: for (int it = bid; it < 1024; it += nb) hgrn_local_item(p, it, smem); break;
    case 21: for (int it = bid; it < 512; it += nb) gmlp_item(p, it, smem); break;
    case 22: for (int it = bid; it < 1024; it += nb) moba_prep_item(p, it, smem); break;
    case 23: for (int it = bid; it < 256; it += nb) moba_kmean_item(p, it, smem); break;
    case 24: gemm_phase<2>(ws + OFF_Z1, 1984, p.l1_cq_norm, (const bf16_t*)(ws + OFF_W_UQT), 16384, 768, 256, EpiBf16{(bf16_t*)(ws + OFF_QC), 768, 768}, smem, bid, nb); break;
    case 25: for (int it = bid; it < 512; it += nb) attn_item<192, false>(p, it & 7, it >> 3, smem); break;
    case 26: for (int it = bid; it < 512; it += nb) attn_item<128, true>(p, it & 7, it >> 3, smem); break;
#endif
    default: break;
    }
}

extern "C" __global__ void __launch_bounds__(NTHREADS, 2) fwd_kernel(Params p) {
    extern __shared__ __attribute__((aligned(16))) char smem[];
#define RUN_PH(PH) if (p.ph_lo <= PH && PH < p.ph_hi) { run_phase(p, PH, smem); if (p.coop && PH + 1 < p.ph_hi) cg::this_grid().sync(); }
    RUN_PH(0) RUN_PH(1) RUN_PH(2) RUN_PH(3) RUN_PH(4) RUN_PH(5) RUN_PH(6) RUN_PH(7) RUN_PH(8)
    RUN_PH(9) RUN_PH(10) RUN_PH(11) RUN_PH(12) RUN_PH(13) RUN_PH(14) RUN_PH(15) RUN_PH(16) RUN_PH(17)
}

extern "C" void kernel_launch(void* const* d_in, const int* in_sizes, int n_in, void* d_out, int out_size, void* d_ws, size_t ws_size, hipStream_t stream) {
    static int grid = 0;
    if (grid == 0) {
        if (n_in != 31 || out_size != 16384 * 1024 || ws_size < WS_NEED) { fprintf(stderr, "kernel_launch: unexpected shapes (n_in %d out %d ws %zu need %zu)\n", n_in, out_size, ws_size, (size_t)WS_NEED); grid = -1; return; }
        int dev = 0, cus = 0, per_cu = 0;
        hipGetDevice(&dev);
        hipDeviceGetAttribute(&cus, hipDeviceAttributeMultiprocessorCount, dev);
        if (hipFuncSetAttribute((const void*)fwd_kernel, hipFuncAttributeMaxDynamicSharedMemorySize, LDS_BYTES) != hipSuccess) { fprintf(stderr, "kernel_launch: hipFuncSetAttribute failed\n"); grid = -1; return; }
        if (hipOccupancyMaxActiveBlocksPerMultiprocessor(&per_cu, (const void*)fwd_kernel, NTHREADS, LDS_BYTES) != hipSuccess || per_cu < 1) { fprintf(stderr, "kernel_launch: occupancy query failed (%d)\n", per_cu); per_cu = 1; }
        (void)hipGetLastError();
        if (per_cu > 2) per_cu = 2;
        grid = cus * per_cu;
        fprintf(stderr, "kernel_launch: grid %d (%d CUs x %d)\n", grid, cus, per_cu);
    }
    if (grid < 0) return;
    Params p; memset(&p, 0, sizeof(p));
    const float* const* f = (const float* const*)d_in;
    p.x = f[0]; p.pos = (const int*)d_in[1]; p.lb_logits = f[2];
    p.l0_norm_mix = f[3]; p.l0_w_in = f[4]; p.l0_hgrn_out_norm = f[5]; p.l0_gmlp_v_norm = f[6]; p.l0_gmlp_w_s = f[7]; p.l0_gmlp_b_s = f[8]; p.l0_w_out = f[9];
    p.l0_norm_ffn = f[10]; p.l0_w_query = f[11]; p.l0_sub_keys = f[12]; p.l0_exp_down = f[13]; p.l0_exp_up = f[14];
    p.l1_norm_mix = f[15]; p.l1_w_in = f[16]; p.l1_cq_norm = f[17]; p.l1_ckv_norm = f[18]; p.l1_w_uq = f[19]; p.l1_w_ukv = f[20];
    p.l1_q_norm = f[21]; p.l1_k_norm = f[22]; p.l1_mq_norm = f[23]; p.l1_mk_norm = f[24]; p.l1_w_out = f[25];
    p.l1_norm_ffn = f[26]; p.l1_w_query = f[27]; p.l1_sub_keys = f[28]; p.l1_exp_down = f[29]; p.l1_exp_up = f[30];
    p.out = (float*)d_out; p.ws = (char*)d_ws;
#if N_LAUNCH_MODE == 1
    p.ph_lo = 0; p.ph_hi = N_PHASES; p.coop = 1;
    void* args[] = {&p};
    hipError_t e = hipLaunchCooperativeKernel((const void*)fwd_kernel, dim3(grid), dim3(NTHREADS), args, LDS_BYTES, stream);
    if (e != hipSuccess) fprintf(stderr, "cooperative launch failed: %s (grid %d)\n", hipGetErrorString(e), grid);
#else
    for (int ph = 0; ph < N_PHASES; ++ph) {
#ifdef ABLATE_M1
        if (ph >= 10 && ph <= 14) continue;
#endif
        p.ph_lo = ph; p.ph_hi = ph + 1; p.coop = 0;
        hipLaunchKernelGGL(fwd_kernel, dim3(grid), dim3(NTHREADS), LDS_BYTES, stream, p);
    }
#endif
}

#ifdef PHASE_PROBE
template <int PH> __global__ void __launch_bounds__(NTHREADS, 2) probe_kernel(Params p) {
    extern __shared__ __attribute__((aligned(16))) char smem[];
    run_phase(p, PH, smem);
}
template __global__ void probe_kernel<0>(Params);
template __global__ void probe_kernel<1>(Params);
template __global__ void probe_kernel<2>(Params);
template __global__ void probe_kernel<3>(Params);
template __global__ void probe_kernel<4>(Params);
template __global__ void probe_kernel<5>(Params);
template __global__ void probe_kernel<7>(Params);
template __global__ void probe_kernel<8>(Params);
template __global__ void probe_kernel<10>(Params);
template __global__ void probe_kernel<11>(Params);
template __global__ void probe_kernel<12>(Params);
template __global__ void probe_kernel<13>(Params);
template __global__ void probe_kernel<20>(Params);
template __global__ void probe_kernel<21>(Params);
template __global__ void probe_kernel<22>(Params);
template __global__ void probe_kernel<23>(Params);
template __global__ void probe_kernel<24>(Params);
template __global__ void probe_kernel<25>(Params);
template __global__ void probe_kernel<26>(Params);
#endif
```

```cpp
#include <hip/hip_runtime.h>
#include <hip/hip_cooperative_groups.h>
#include <stdint.h>
#include <stdio.h>
#include <string.h>
namespace cg = cooperative_groups;

#ifndef ALPHA_P0
#define ALPHA_P0 1.0f
#endif
#ifndef ALPHA_P1
#define ALPHA_P1 1.0f
#endif
#ifndef ALPHA_M0
#define ALPHA_M0 1.0f
#endif
#ifndef ALPHA_M1
#define ALPHA_M1 1.0f
#endif
#ifndef PROBE_DUP
#define PROBE_DUP -1
#endif
#ifndef N_LAUNCH_MODE
#define N_LAUNCH_MODE 1
#endif

typedef unsigned short bf16_t;
using bf16x8 = __attribute__((ext_vector_type(8))) short;
using f32x4  = __attribute__((ext_vector_type(4))) float;
using f32x16 = __attribute__((ext_vector_type(16))) float;
typedef float f32x4v __attribute__((ext_vector_type(4)));
typedef float f32x2_t __attribute__((ext_vector_type(2)));
typedef __bf16 bf16x2_t __attribute__((ext_vector_type(2)));
typedef unsigned u32x4 __attribute__((ext_vector_type(4)));

#define DEVI __device__ __forceinline__
#define NTHREADS 256
#define LDS_BYTES 80896

static constexpr size_t MB = 1024 * 1024;
static constexpr size_t OFF_W_IN0T  = 0;
static constexpr size_t OFF_W_OUT0T = OFF_W_IN0T  + 3072ull * 1024 * 2;
static constexpr size_t OFF_W_Q0T   = OFF_W_OUT0T + 1024ull * 1024 * 2;
static constexpr size_t OFF_SK0     = OFF_W_Q0T   + 2048ull * 1024 * 2;
static constexpr size_t OFF_WS0     = OFF_SK0     + 262144ull * 2;
static constexpr size_t OFF_W_IN1T  = OFF_WS0     + 65536ull * 2;
static constexpr size_t OFF_W_UQT   = OFF_W_IN1T  + 2048ull * 1024 * 2;
static constexpr size_t OFF_W_UKVT  = OFF_W_UQT   + 768ull * 256 * 2;
static constexpr size_t OFF_W_OUT1T = OFF_W_UKVT  + 1024ull * 128 * 2;
static constexpr size_t OFF_W_Q1T   = OFF_W_OUT1T + 1024ull * 1024 * 2;
static constexpr size_t OFF_SK1     = OFF_W_Q1T   + 2048ull * 1024 * 2;
static constexpr size_t OFF_LB      = OFF_SK1     + 262144ull * 2;
static constexpr size_t OFF_INVD    = OFF_LB + 4096;
static constexpr size_t OFF_INVU    = OFF_INVD + 65536;
static constexpr size_t OFF_BAR     = OFF_INVU + 65536;
static constexpr size_t OFF_QCNT    = OFF_BAR + 14336;
static constexpr size_t OFF_ED      = 26 * MB;
static constexpr size_t OFF_EU      = OFF_ED + 32 * MB;
static constexpr size_t OFF_ACT     = OFF_EU + 32 * MB;
static constexpr size_t OFF_Z0   = OFF_ACT;
static constexpr size_t OFF_G    = OFF_Z0  + 16384ull * 3072 * 2;
static constexpr size_t OFF_HST  = OFF_G   + 16384ull * 512 * 4;
static constexpr size_t OFF_DEC  = OFF_HST + 1024ull * 16384 * 4;
static constexpr size_t OFF_MIX0 = OFF_DEC + 1024ull * 128 * 4;
static constexpr size_t OFF_QP   = OFF_ACT;
static constexpr size_t OFF_IDX  = OFF_QP  + 16384ull * 2048 * 2;
static constexpr size_t OFF_GATE = OFF_IDX + 16384ull * 128 * 4;
static constexpr size_t OFF_ACTW = OFF_GATE + 16384ull * 128 * 4;
static constexpr size_t OFF_PART = OFF_QP;
static constexpr size_t OFF_SDN  = OFF_ACTW + 16384ull * 128 * 4;
static constexpr size_t OFF_Z1   = OFF_ACT;
static constexpr size_t OFF_MIX1 = OFF_ACT;
static constexpr size_t OFF_QC   = OFF_Z1  + 16384ull * 1984 * 2;
static constexpr size_t OFF_KV   = OFF_QC  + 16384ull * 768 * 2;
static constexpr size_t OFF_QD   = OFF_KV  + 16384ull * 1024 * 2;
static constexpr size_t OFF_KD   = OFF_QD  + 16384ull * 512 * 2;
static constexpr size_t OFF_VDT  = OFF_KD  + 16384ull * 512 * 2;
static constexpr size_t OFF_Q    = OFF_VDT + 16384ull * 512 * 2;
static constexpr size_t OFF_K    = OFF_Q   + 16384ull * 768 * 2;
static constexpr size_t OFF_VT   = OFF_K   + 16384ull * 768 * 2;
static constexpr size_t OFF_KMEAN= OFF_VT  + 16384ull * 512 * 2;
static constexpr size_t WS_END_L1 = OFF_KMEAN + 8ull * 32 * 128 * 4;
static constexpr size_t WS_END_L0 = OFF_MIX0 + 16384ull * 1024 * 2;
static constexpr size_t WS_END_ACT = (WS_END_L1 > WS_END_L0 ? WS_END_L1 : WS_END_L0);
static constexpr size_t OFF_XB    = (WS_END_ACT + 255) / 256 * 256;
static constexpr size_t OFF_SSQ1  = OFF_XB + 16384ull * 1024 * 2;
static constexpr size_t OFF_SSQ16 = OFF_SSQ1 + 16384ull * 4;
static constexpr size_t OFF_SSQ8  = OFF_SSQ16 + 16384ull * 16 * 4;
static constexpr size_t OFF_XB8   = OFF_ED + 16 * MB;
static constexpr size_t OFF_SSQCQ = OFF_SSQ8 + 16384ull * 8 * 4;
static constexpr size_t OFF_SSQCKV = OFF_SSQCQ + 16384ull * 4;
static constexpr size_t WS_NEED = OFF_SSQCKV + 16384ull * 4;
static_assert(OFF_BAR + 16384 + 4096 <= OFF_ED, "weights overflow");

struct Params {
    const float* x; const int* pos; const float* lb_logits;
    const float *l0_norm_mix, *l0_w_in, *l0_hgrn_out_norm, *l0_gmlp_v_norm, *l0_gmlp_w_s, *l0_gmlp_b_s, *l0_w_out,
                *l0_norm_ffn, *l0_w_query, *l0_sub_keys, *l0_exp_down, *l0_exp_up;
    const float *l1_norm_mix, *l1_w_in, *l1_cq_norm, *l1_ckv_norm, *l1_w_uq, *l1_w_ukv, *l1_q_norm, *l1_k_norm,
                *l1_mq_norm, *l1_mk_norm, *l1_w_out, *l1_norm_ffn, *l1_w_query, *l1_sub_keys, *l1_exp_down, *l1_exp_up;
    float* out;
    char* ws;
    int ph_lo, ph_hi, coop, pad0;
};

DEVI unsigned pack2(float lo, float hi) { f32x2_t v = {lo, hi}; bf16x2_t b = __builtin_convertvector(v, bf16x2_t); return __builtin_bit_cast(unsigned, b); }
DEVI bf16_t f2bf(float f) { return (bf16_t)(pack2(f, 0.f) & 0xffffu); }
DEVI float bf2f(bf16_t h) { return __uint_as_float(((unsigned)h) << 16); }
DEVI float bflo(unsigned u) { return __uint_as_float(u << 16); }
DEVI float bfhi(unsigned u) { return __uint_as_float(u & 0xffff0000u); }
DEVI float sigm(float x) { return 1.f / (1.f + __expf(-x)); }
DEVI float gelu_tanh(float x) {
    float y = 0.7978845608028654f * (x + 0.044715f * x * x * x);
    float e = __expf(2.f * y);
    float t = 1.f - 2.f / (1.f + e);
    return 0.5f * x * (1.f + t);
}
DEVI char* opaque_ptr(char* q) { asm volatile("" : "+s"(q)); return q; }
DEVI f32x4  mfma16(bf16x8 a, bf16x8 b, f32x4 c)  { return __builtin_amdgcn_mfma_f32_16x16x32_bf16(a, b, c, 0, 0, 0); }
DEVI f32x16 mfma32(bf16x8 a, bf16x8 b, f32x16 c) { return __builtin_amdgcn_mfma_f32_32x32x16_bf16(a, b, c, 0, 0, 0); }

template <int KW> DEVI int swz_off(int row, int c) {
    if constexpr (KW == 128) return row * 256 + ((c ^ (row & 15)) << 4);
    else return row * (KW * 2) + ((c ^ ((row >> 1) & 7)) << 4);
}
template <int KW> DEVI int swz_elem(int row, int k) { return swz_off<KW>(row, k >> 3) + ((k & 7) << 1); }

template <int MT, int NT, int KWA, int KWB>
DEVI void mma_nt(f32x4 (&acc)[MT][NT], const char* A, int a_row0, const char* B, int b_row0, int kc0, int nks, int lane) {
    const int r = lane & 15, q = lane >> 4;
#pragma unroll 1
    for (int ks = 0; ks < nks; ++ks) {
        bf16x8 a[MT], b[NT];
#pragma unroll
        for (int i = 0; i < MT; ++i) a[i] = *(const bf16x8*)(A + swz_off<KWA>(a_row0 + 16 * i + r, kc0 + ks * 4 + q));
#pragma unroll
        for (int j = 0; j < NT; ++j) b[j] = *(const bf16x8*)(B + swz_off<KWB>(b_row0 + 16 * j + r, kc0 + ks * 4 + q));
#pragma unroll
        for (int i = 0; i < MT; ++i)
#pragma unroll
            for (int j = 0; j < NT; ++j) acc[i][j] = mfma16(a[i], b[j], acc[i][j]);
    }
}

DEVI void conv_transpose_tile(const float* __restrict__ src, int K, int N, bf16_t* __restrict__ dst, int kt, int nt, char* smem, const float* __restrict__ kgain = nullptr) {
    float* s = (float*)smem;
    const int tid = threadIdx.x;
    for (int e = tid; e < 4096; e += NTHREADS) {
        int kk = e >> 6, nn = e & 63;
        int n = nt * 64 + nn;
        const float gk = kgain ? kgain[kt * 64 + kk] : 1.f;
        s[kk * 65 + nn] = (n < N) ? src[(size_t)(kt * 64 + kk) * N + n] * gk : 0.f;
    }
    __syncthreads();
    for (int e = tid; e < 2048; e += NTHREADS) {
        int nn = e >> 5, kp = e & 31;
        unsigned v = pack2(s[(2 * kp) * 65 + nn], s[(2 * kp + 1) * 65 + nn]);
        *(unsigned*)(dst + (size_t)(nt * 64 + nn) * K + kt * 64 + 2 * kp) = v;
    }
    __syncthreads();
}
DEVI void conv_plain_chunk(const float* __restrict__ src, bf16_t* __restrict__ dst, size_t chunk) {
    const int tid = threadIdx.x;
    size_t base = chunk * 4096 + (size_t)tid * 16;
    const float4* s4 = (const float4*)(src + base);
    float4 a = s4[0], b = s4[1], c = s4[2], d = s4[3];
    uint4 o0, o1;
    o0.x = pack2(a.x, a.y); o0.y = pack2(a.z, a.w); o0.z = pack2(b.x, b.y); o0.w = pack2(b.z, b.w);
    o1.x = pack2(c.x, c.y); o1.y = pack2(c.z, c.w); o1.z = pack2(d.x, d.y); o1.w = pack2(d.z, d.w);
    uint4* d4 = (uint4*)(dst + base);
    d4[0] = o0; d4[1] = o1;
}
DEVI void conv_experts(const float* down, const float* up, const float* __restrict__ dgain, char* ws, int it  ) {
    const int lane = threadIdx.x & 63, wave = threadIdx.x >> 6;
    const bool isup = it >= 4096;
    const int row = (isup ? it - 4096 : it) * 4 + wave;
    const float* src = (isup ? up : down) + (size_t)row * 1024 + 16 * lane;
    float4 a = *(const float4*)src, b = *(const float4*)(src + 4), c = *(const float4*)(src + 8), d = *(const float4*)(src + 12);
    if (!isup) {
        const float4 ga = *(const float4*)(dgain + 16 * lane), gb = *(const float4*)(dgain + 16 * lane + 4), gc = *(const float4*)(dgain + 16 * lane + 8), gd = *(const float4*)(dgain + 16 * lane + 12);
        a.x *= ga.x; a.y *= ga.y; a.z *= ga.z; a.w *= ga.w; b.x *= gb.x; b.y *= gb.y; b.z *= gb.z; b.w *= gb.w;
        c.x *= gc.x; c.y *= gc.y; c.z *= gc.z; c.w *= gc.w; d.x *= gd.x; d.y *= gd.y; d.z *= gd.z; d.w *= gd.w;
    }
    float mx = fmaxf(fmaxf(fmaxf(fabsf(a.x), fabsf(a.y)), fmaxf(fabsf(a.z), fabsf(a.w))), fmaxf(fmaxf(fabsf(b.x), fabsf(b.y)), fmaxf(fabsf(b.z), fabsf(b.w))));
    mx = fmaxf(mx, fmaxf(fmaxf(fmaxf(fabsf(c.x), fabsf(c.y)), fmaxf(fabsf(c.z), fabsf(c.w))), fmaxf(fmaxf(fabsf(d.x), fabsf(d.y)), fmaxf(fabsf(d.z), fabsf(d.w)))));
#pragma unroll
    for (int o = 1; o < 64; o <<= 1) mx = fmaxf(mx, __shfl_xor(mx, o));
    const float sc = (mx > 0.f) ? 416.f / mx : 1.f;
    const float inv = (mx > 0.f) ? mx / 416.f : 1.f;
    int w0 = 0, w1 = 0, w2 = 0, w3 = 0;
    w0 = __builtin_amdgcn_cvt_pk_fp8_f32(a.x * sc, a.y * sc, w0, false); w0 = __builtin_amdgcn_cvt_pk_fp8_f32(a.z * sc, a.w * sc, w0, true);
    w1 = __builtin_amdgcn_cvt_pk_fp8_f32(b.x * sc, b.y * sc, w1, false); w1 = __builtin_amdgcn_cvt_pk_fp8_f32(b.z * sc, b.w * sc, w1, true);
    w2 = __builtin_amdgcn_cvt_pk_fp8_f32(c.x * sc, c.y * sc, w2, false); w2 = __builtin_amdgcn_cvt_pk_fp8_f32(c.z * sc, c.w * sc, w2, true);
    w3 = __builtin_amdgcn_cvt_pk_fp8_f32(d.x * sc, d.y * sc, w3, false); w3 = __builtin_amdgcn_cvt_pk_fp8_f32(d.z * sc, d.w * sc, w3, true);
    *(int4*)(ws + (isup ? OFF_EU : OFF_ED) + ((size_t)(lane >> 3) * 16384 + row) * 128 + 16 * (lane & 7)) = int4{w0, w1, w2, w3};
    if (lane == 0) ((float*)(ws + (isup ? OFF_INVU : OFF_INVD)))[row] = inv;
}

DEVI void phase_convert(const Params& p, char* smem) {
    char* ws = p.ws;
    const int bid = blockIdx.x, nb = gridDim.x;
    for (int t = bid; t < 768; t += nb) conv_transpose_tile(p.l0_w_in,    1024, 3072, (bf16_t*)(ws + OFF_W_IN0T),  t / 48, t % 48, smem, p.l0_norm_mix);
    for (int t = (bid + nb - 256 % nb) % nb; t < 256; t += nb) conv_transpose_tile(p.l0_w_out,   1024, 1024, (bf16_t*)(ws + OFF_W_OUT0T), t / 16, t % 16, smem);
    for (int t = bid; t < 512; t += nb) conv_transpose_tile(p.l0_w_query, 1024, 2048, (bf16_t*)(ws + OFF_W_Q0T),   t / 32, t % 32, smem, p.l0_norm_ffn);
    for (int t = bid; t < 512; t += nb) conv_transpose_tile(p.l1_w_in,    1024, 1984, (bf16_t*)(ws + OFF_W_IN1T),  t / 32, t % 32, smem, p.l1_norm_mix);
    for (int t = bid; t < 48; t += nb)  conv_transpose_tile(p.l1_w_uq,     256,  768, (bf16_t*)(ws + OFF_W_UQT),   t / 12, t % 12, smem, p.l1_cq_norm);
    for (int t = nb - 1 - bid; t < 32; t += nb)  conv_transpose_tile(p.l1_w_ukv,    128, 1024, (bf16_t*)(ws + OFF_W_UKVT),  t / 16, t % 16, smem, p.l1_ckv_norm);
    for (int t = (bid + nb - 256 % nb) % nb; t < 256; t += nb) conv_transpose_tile(p.l1_w_out,   1024, 1024, (bf16_t*)(ws + OFF_W_OUT1T), t / 16, t % 16, smem);
    for (int t = bid; t < 512; t += nb) conv_transpose_tile(p.l1_w_query, 1024, 2048, (bf16_t*)(ws + OFF_W_Q1T),   t / 32, t % 32, smem, p.l1_norm_ffn);
    for (int t = bid - 64; t < 64; t += nb) if (t >= 0) conv_plain_chunk(p.l0_sub_keys, (bf16_t*)(ws + OFF_SK0), t);
    for (int t = bid - 128; t < 64; t += nb) if (t >= 0) conv_plain_chunk(p.l1_sub_keys, (bf16_t*)(ws + OFF_SK1), t);
    for (int chunk = bid - 192; chunk < 16; chunk += nb) if (chunk >= 0) {
        bf16_t* dst = (bf16_t*)(ws + OFF_WS0);
        for (int e = threadIdx.x; e < 4096; e += NTHREADS) {
            int idx = chunk * 4096 + e; int t = (idx >> 7) & 127, sI = idx & 127;
            dst[idx] = f2bf(sI <= t ? p.l0_gmlp_w_s[idx] : 0.f);
        }
    }
    if (bid == nb - 1) {
        float* lb = (float*)(ws + OFF_LB);
        for (int c = threadIdx.x; c < 512; c += NTHREADS) {
            float a0 = p.lb_logits[c], a1 = p.lb_logits[512 + c], a2 = p.lb_logits[1024 + c];
            float m = fmaxf(a0, fmaxf(a1, a2));
            float e0 = __expf(a0 - m), e1 = __expf(a1 - m), e2 = __expf(a2 - m);
            lb[c] = e0 / (e0 + e1 + e2);
        }
    }
    for (int it = bid; it < 8192; it += nb) conv_experts(p.l0_exp_down, p.l0_exp_up, p.l0_norm_ffn, ws, it);
    {
        const int lane = threadIdx.x & 63, wave = threadIdx.x >> 6;
        for (int it = bid; it < 4096; it += nb) {
            const size_t row = (size_t)it * 4 + wave;
            const float* xr = p.x + row * 1024 + 16 * lane;
            const float4 a = *(const float4*)xr, b = *(const float4*)(xr + 4), c = *(const float4*)(xr + 8), d = *(const float4*)(xr + 12);
            float ss = a.x * a.x + a.y * a.y + a.z * a.z + a.w * a.w + b.x * b.x + b.y * b.y + b.z * b.z + b.w * b.w
                     + c.x * c.x + c.y * c.y + c.z * c.z + c.w * c.w + d.x * d.x + d.y * d.y + d.z * d.z + d.w * d.w;
#pragma unroll
            for (int o = 1; o < 64; o <<= 1) ss += __shfl_xor(ss, o);
            uint4 o0, o1;
            o0.x = pack2(a.x, a.y); o0.y = pack2(a.z, a.w); o0.z = pack2(b.x, b.y); o0.w = pack2(b.z, b.w);
            o1.x = pack2(c.x, c.y); o1.y = pack2(c.z, c.w); o1.z = pack2(d.x, d.y); o1.w = pack2(d.z, d.w);
            bf16_t* xb = (bf16_t*)(ws + OFF_XB) + row * 1024 + 16 * lane;
            *(uint4*)xb = o0; *(uint4*)(xb + 8) = o1;
            if (lane == 0) ((float*)(ws + OFF_SSQ1))[row] = ss;
        }
    }
}

template <int AMODE, class Epi>
DEVI void gemm_phase(const void* __restrict__ Aptr, int lda, const float* __restrict__ gain, const bf16_t* __restrict__ Bt,
                           int M, int Npad, int K, Epi epi, char* smem, int blk0, int nblk) {
    const int tid = threadIdx.x, lane = tid & 63, wave = tid >> 6;
    const int wm = wave >> 1, wn = wave & 1;
    const int tn = Npad / 128, tm = M / 128, nkt = K / 64;
    float* sRstd = (float*)(smem + 65536);
    const int crow = tid >> 3, cc = tid & 7;
    for (int tile = blk0; tile < tm * tn; tile += nblk) {
        const int m0 = (tile / tn) * 128, n0 = (tile % tn) * 128;
        f32x4 acc[4][4];
#pragma unroll
        for (int i = 0; i < 4; ++i)
#pragma unroll
            for (int j = 0; j < 4; ++j) acc[i][j] = f32x4{0.f, 0.f, 0.f, 0.f};
        float ss[4] = {0.f, 0.f, 0.f, 0.f};
        f32x4v ra[4][2]; u32x4 rab[4]; u32x4 rb[4]; f32x4v g0, g1;
        auto gload = [&](int kt) {
            const int k0 = kt * 64 + cc * 8;
#pragma unroll
            for (int i = 0; i < 4; ++i) {
                const int row = crow + 32 * i;
                if constexpr (AMODE == 0) {
                    const float* pa = (const float*)Aptr + (size_t)(m0 + row) * lda + k0;
                    ra[i][0] = *(const f32x4v*)pa; ra[i][1] = *(const f32x4v*)(pa + 4);
                } else {
                    const bf16_t* pa = (const bf16_t*)Aptr + (size_t)(m0 + row) * lda + k0;
                    rab[i] = *(const u32x4*)pa;
                }
                rb[i] = *(const u32x4*)(Bt + (size_t)(n0 + row) * K + k0);
            }
            if constexpr (AMODE != 1) { g0 = *(const f32x4v*)(gain + k0); g1 = *(const f32x4v*)(gain + k0 + 4); }
        };
        auto lstore = [&](int buf) {
            char* sA = smem + buf * 32768; char* sB = sA + 16384;
#pragma unroll
            for (int i = 0; i < 4; ++i) {
                const int row = crow + 32 * i;
                u32x4 o;
                if constexpr (AMODE == 0) {
                    f32x4v a = ra[i][0], b = ra[i][1];
                    ss[i] += a.x * a.x + a.y * a.y + a.z * a.z + a.w * a.w + b.x * b.x + b.y * b.y + b.z * b.z + b.w * b.w;
                    o.x = pack2(a.x * g0.x, a.y * g0.y); o.y = pack2(a.z * g0.z, a.w * g0.w);
                    o.z = pack2(b.x * g1.x, b.y * g1.y); o.w = pack2(b.z * g1.z, b.w * g1.w);
                } else if constexpr (AMODE == 2) {
                    u32x4 u = rab[i];
                    float a0 = bflo(u.x), a1 = bfhi(u.x), a2 = bflo(u.y), a3 = bfhi(u.y), a4 = bflo(u.z), a5 = bfhi(u.z), a6 = bflo(u.w), a7 = bfhi(u.w);
                    ss[i] += a0 * a0 + a1 * a1 + a2 * a2 + a3 * a3 + a4 * a4 + a5 * a5 + a6 * a6 + a7 * a7;
                    o.x = pack2(a0 * g0.x, a1 * g0.y); o.y = pack2(a2 * g0.z, a3 * g0.w);
                    o.z = pack2(a4 * g1.x, a5 * g1.y); o.w = pack2(a6 * g1.z, a7 * g1.w);
                } else o = rab[i];
                *(u32x4*)(sA + swz_off<64>(row, cc)) = o;
                *(u32x4*)(sB + swz_off<64>(row, cc)) = rb[i];
            }
        };
        gload(0); lstore(0); __syncthreads();
#pragma unroll 1
        for (int kt = 0; kt < nkt; ++kt) {
            if (kt + 1 < nkt) gload(kt + 1);
            const char* sA = smem + (kt & 1) * 32768; const char* sB = sA + 16384;
            mma_nt<4, 4, 64, 64>(acc, sA, wm * 64, sB, wn * 64, 0, 2, lane);
            if (kt + 1 < nkt) lstore((kt + 1) & 1);
            __syncthreads();
        }
        if constexpr (AMODE != 1) {
#pragma unroll
            for (int i = 0; i < 4; ++i) {
                float s = ss[i];
                s += __shfl_xor(s, 1); s += __shfl_xor(s, 2); s += __shfl_xor(s, 4);
                if (cc == 0) sRstd[crow + 32 * i] = rsqrtf(s / (float)K + 1e-6f);
            }
            __syncthreads();
        }
#pragma unroll
        for (int i = 0; i < 4; ++i)
#pragma unroll
            for (int r = 0; r < 4; ++r) {
                const int rl = wm * 64 + i * 16 + (lane >> 4) * 4 + r;
                const float rs = (AMODE != 1) ? sRstd[rl] : 1.f;
#pragma unroll
                for (int j = 0; j < 4; ++j) epi(m0 + rl, n0 + wn * 64 + j * 16 + (lane & 15), acc[i][j][r] * rs);
                __builtin_amdgcn_sched_barrier(0);
            }
    }
}

struct Placement { int xcc, rank, nloc, nx; };
#define G2_RAW_BARRIER() do { asm volatile("s_waitcnt lgkmcnt(0)" ::: "memory"); __builtin_amdgcn_s_barrier(); } while (0)
template <class Epi>
DEVI void gemm2_phase(const bf16_t* __restrict__ A, int lda, const bf16_t* __restrict__ Bt, int tm, int tn, int K,
                      const float* __restrict__ ssq, int nss, Epi epi, char* smem, Placement pl) {
    const int tid = threadIdx.x, lane = tid & 63;
    const int wave = __builtin_amdgcn_readfirstlane(tid >> 6);
    const int wm = wave >> 1, wn = wave & 1;
    const int nkt = K / 32;
    constexpr int STG = 24576;
    float* sRstd = (float*)(smem + 3 * STG);
    int xcd = blockIdx.x & 7, slot = blockIdx.x >> 3, nslots = gridDim.x >> 3, nxc = 8;
    if (pl.nloc > 0) { xcd = pl.xcc; slot = pl.rank; nslots = pl.nloc; nxc = pl.nx; }
    const int np = (tm + nxc - 1) / nxc;
    const int per_xcd = ((np + 7) >> 3) * tn * 8;
    const int Rl = (lane >> 4) & 3, gl = (((Rl ^ (Rl >> 1)) & 1) << 1) | (Rl >> 1);
    const int Rr = (lane >> 2) & 3, gr = (((Rr ^ (Rr >> 1)) & 1) << 1) | (Rr >> 1);
    const int ld_row = lane >> 2, ld_c = (lane & 3) ^ gl;
    const int rd_off = (lane & 15) * 64 + (((lane >> 4) ^ gr) << 4);
    for (int t = slot; t < per_xcd; t += nslots) {
        const int mi = t & 7, rest = t >> 3, nt_ = rest % tn, mg = rest / tn;
        const int pidx = mg * 8 + mi, panel = xcd + nxc * pidx;
        if (pidx >= np || panel >= tm) continue;
        const int m0 = panel * 128, n0 = nt_ * 256;
        if (ssq) { if (tid < 128) { float sacc = 0.f; for (int i = 0; i < nss; ++i) sacc += ssq[(size_t)(m0 + tid) * nss + i]; sRstd[tid] = rsqrtf(sacc / (float)K + 1e-6f); } }
        else if (tid < 128) sRstd[tid] = 1.f;
        const bf16_t* ga = A  + (size_t)(m0 + 32 * wave + ld_row) * lda + ld_c * 8;
        const bf16_t* gb = Bt + (size_t)(n0 + 64 * wave + ld_row) * K   + ld_c * 8;
        f32x4 acc[4][8];
#pragma unroll
        for (int i = 0; i < 4; ++i)
#pragma unroll
            for (int j = 0; j < 8; ++j) acc[i][j] = f32x4{0.f, 0.f, 0.f, 0.f};
#define G2_ISSUE(KT) { char* st_ = smem + ((KT) % 3) * STG; const int ko_ = (KT) * 32; \
            __builtin_amdgcn_global_load_lds((const unsigned*)(ga + ko_),                    (unsigned*)(st_ + wave * 2048),               16, 0, 0); \
            __builtin_amdgcn_global_load_lds((const unsigned*)(ga + (size_t)16 * lda + ko_), (unsigned*)(st_ + wave * 2048 + 1024),        16, 0, 0); \
            __builtin_amdgcn_global_load_lds((const unsigned*)(gb + ko_),                    (unsigned*)(st_ + 8192 + wave * 4096),        16, 0, 0); \
            __builtin_amdgcn_global_load_lds((const unsigned*)(gb + (size_t)16 * K + ko_),   (unsigned*)(st_ + 8192 + wave * 4096 + 1024), 16, 0, 0); \
            __builtin_amdgcn_global_load_lds((const unsigned*)(gb + (size_t)32 * K + ko_),   (unsigned*)(st_ + 8192 + wave * 4096 + 2048), 16, 0, 0); \
            __builtin_amdgcn_global_load_lds((const unsigned*)(gb + (size_t)48 * K + ko_),   (unsigned*)(st_ + 8192 + wave * 4096 + 3072), 16, 0, 0); }
        G2_ISSUE(0) G2_ISSUE(1)
#pragma unroll 1
        for (int kt = 0; kt < nkt; ++kt) {
            if (kt + 1 < nkt) asm volatile("s_waitcnt vmcnt(6)" ::: "memory");
            else asm volatile("s_waitcnt vmcnt(0)" ::: "memory");
            G2_RAW_BARRIER();
            if (kt + 2 < nkt) G2_ISSUE(kt + 2)
            const char* sA = smem + (kt % 3) * STG + rd_off; const char* sB = sA + 8192;
            bf16x8 a[4], b[8];
#pragma unroll
            for (int i = 0; i < 4; ++i) a[i] = *(const bf16x8*)(sA + (wm * 64 + 16 * i) * 64);
#pragma unroll
            for (int j = 0; j < 8; ++j) b[j] = *(const bf16x8*)(sB + (wn * 128 + 16 * j) * 64);
#pragma unroll
            for (int i = 0; i < 4; ++i)
#pragma unroll
                for (int j = 0; j < 8; ++j) acc[i][j] = mfma16(b[j], a[i], acc[i][j]);
        }
#undef G2_ISSUE
        if (epi.staged(n0)) {
            G2_RAW_BARRIER();
#pragma unroll
            for (int i = 0; i < 4; ++i) {
                const int rl = wm * 64 + i * 16 + (lane & 15);
                const float rs = sRstd[rl];
                char* trow = smem + rl * 528 + (wn * 128 + 4 * (lane >> 4)) * 2;
#pragma unroll
                for (int j = 0; j < 8; ++j) {
                    const int nc = n0 + wn * 128 + 16 * j + 4 * (lane >> 4);
                    *(uint2*)(trow + 32 * j) = uint2{pack2(epi.map(nc, acc[i][j][0] * rs), epi.map(nc + 1, acc[i][j][1] * rs)), pack2(epi.map(nc + 2, acc[i][j][2] * rs), epi.map(nc + 3, acc[i][j][3] * rs))};
                }
            }
            __syncthreads();
            float* const sqp = (n0 == 0) ? epi.SQ0 : ((n0 == 256) ? epi.SQ1 : nullptr);
#pragma unroll 4
            for (int i = 0; i < 16; ++i) {
                const int e = tid + 256 * i, row = e >> 5, cc = e & 31;
                const uint4 v = *(const uint4*)(smem + row * 528 + cc * 16);
                if (n0 + cc * 8 < epi.N) *(uint4*)(epi.D + (size_t)(m0 + row) * epi.ldd + n0 + cc * 8) = v;
                if (sqp) {
                    float q = bflo(v.x) * bflo(v.x) + bfhi(v.x) * bfhi(v.x) + bflo(v.y) * bflo(v.y) + bfhi(v.y) * bfhi(v.y)
                            + bflo(v.z) * bflo(v.z) + bfhi(v.z) * bfhi(v.z) + bflo(v.w) * bflo(v.w) + bfhi(v.w) * bfhi(v.w);
                    if (n0 == 256 && cc >= 16) q = 0.f;
                    q += __shfl_xor(q, 1); q += __shfl_xor(q, 2); q += __shfl_xor(q, 4); q += __shfl_xor(q, 8); q += __shfl_xor(q, 16);
                    if (cc == 0) sqp[m0 + row] = q;
                }
            }
        } else {
#pragma unroll
            for (int i = 0; i < 4; ++i) {
                const int rl = wm * 64 + i * 16 + (lane & 15);
                const float rs = sRstd[rl];
                epi.row(m0 + rl, n0 + wn * 128 + 4 * (lane >> 4), acc[i], rs, lane);
                __builtin_amdgcn_sched_barrier(0);
            }
        }
        __syncthreads();
    }
}

struct Epi2In0 {
    bf16_t* Z0; float* G; const float* lb; bf16_t* D; int ldd; int N; float* SQ0; float* SQ1;
    DEVI bool staged(int n0) const { return (n0 >> 9) != 1; }
    DEVI float map(int n, float v) const { const int blk = n >> 9; return (blk == 0) ? v : ((blk <= 3) ? v * sigm(v) : gelu_tanh(v)); }
    DEVI void row(int m, int n, const f32x4 (&a)[8], float rs, int) const {
#pragma unroll
        for (int j = 0; j < 8; ++j) {
            const int c = n + 16 * j - 512;
            const float4 l4 = *(const float4*)(lb + c);
            float4 o;
            o.x = logf(l4.x + (1.f - l4.x) * sigm(a[j][0] * rs)); o.y = logf(l4.y + (1.f - l4.y) * sigm(a[j][1] * rs));
            o.z = logf(l4.z + (1.f - l4.z) * sigm(a[j][2] * rs)); o.w = logf(l4.w + (1.f - l4.w) * sigm(a[j][3] * rs));
            *(float4*)(G + (size_t)m * 512 + c) = o;
        }
    }
};
struct Epi2Bf16 {
    bf16_t* D; int ldd; int N; float* SQ0; float* SQ1;
    DEVI bool staged(int) const { return true; }
    DEVI float map(int, float v) const { return v; }
    DEVI void row(int, int, const f32x4 (&)[8], float, int) const {}
};
struct Epi2Resid {
    bf16_t* XB; float* SSQ16; float alpha; bf16_t* D; int ldd; int N; float* SQ0; float* SQ1;
    DEVI bool staged(int) const { return false; }
    DEVI float map(int, float v) const { return v; }
    DEVI void row(int m, int n, const f32x4 (&a)[8], float, int lane) const {
        float sq[2] = {0.f, 0.f};
#pragma unroll
        for (int j = 0; j < 8; ++j) {
            bf16_t* px = XB + (size_t)m * 1024 + n + 16 * j;
            const uint2 r = *(const uint2*)px;
            const unsigned w0 = pack2(bflo(r.x) + alpha * a[j][0], bfhi(r.x) + alpha * a[j][1]), w1 = pack2(bflo(r.y) + alpha * a[j][2], bfhi(r.y) + alpha * a[j][3]);
            *(uint2*)px = uint2{w0, w1};
            sq[j >> 2] += bflo(w0) * bflo(w0) + bfhi(w0) * bfhi(w0) + bflo(w1) * bflo(w1) + bfhi(w1) * bfhi(w1);
        }
#pragma unroll
        for (int g = 0; g < 2; ++g) {
            float v = sq[g];
            v += __shfl_xor(v, 16); v += __shfl_xor(v, 32);
            if ((lane >> 4) == 0) SSQ16[(size_t)m * 16 + ((n + 64 * g) >> 6)] = v;
        }
    }
};

struct EpiBf16 { bf16_t* D; int ldd; int N; DEVI void operator()(int m, int n, float v) const { if (n < N) D[(size_t)m * ldd + n] = f2bf(v); } };

DEVI void hgrn_local_item(const Params& p, int item, char* smem) {
    const int tid = threadIdx.x, lane = tid & 63, wave = tid >> 6;
    const int bh = item >> 7, c = item & 127, b = bh >> 2, h = bh & 3;
    const size_t m0 = (size_t)b * 8192 + c * 64;
    const float* G = (const float*)(p.ws + OFF_G) + m0 * 512 + h * 128;
    const bf16_t* Zv = (const bf16_t*)(p.ws + OFF_Z0) + m0 * 3072 + 1024 + h * 128;
    char* sVT = smem; char* sKd = smem + 16384;
    const int k = tid & 127, hf = tid >> 7;
    float bl = 0.f, bmid = 0.f;
#pragma unroll 8
    for (int t = 0; t < 64; ++t) { bl += G[t * 512 + k]; if (t == 31) bmid = bl; }
    float bcur = hf ? bmid : 0.f;
#pragma unroll 1
    for (int ch = 0; ch < 4; ++ch) {
        float kd[8], vv[8];
#pragma unroll
        for (int j = 0; j < 8; ++j) {
            const int t = 32 * hf + 8 * ch + j;
            const float g = G[t * 512 + k];
            bcur += g;
            kd[j] = (1.f - __expf(g)) * __expf(bl - bcur);
            vv[j] = bf2f(Zv[(size_t)t * 3072 + k]);
        }
        uint4 o; o.x = pack2(kd[0], kd[1]); o.y = pack2(kd[2], kd[3]); o.z = pack2(kd[4], kd[5]); o.w = pack2(kd[6], kd[7]);
        *(uint4*)(sKd + swz_off<64>(k, 4 * hf + ch)) = o;
        uint4 w; w.x = pack2(vv[0], vv[1]); w.y = pack2(vv[2], vv[3]); w.z = pack2(vv[4], vv[5]); w.w = pack2(vv[6], vv[7]);
        *(uint4*)(sVT + swz_off<64>(k, 4 * hf + ch)) = w;
    }
    if (hf == 0) ((float*)(p.ws + OFF_DEC))[item * 128 + k] = __expf(bl);
    __syncthreads();
    f32x4 acc[2][8];
#pragma unroll
    for (int i = 0; i < 2; ++i)
#pragma unroll
        for (int j = 0; j < 8; ++j) acc[i][j] = f32x4{0.f, 0.f, 0.f, 0.f};
    mma_nt<2, 8, 64, 64>(acc, sVT, 32 * wave, sKd, 0, 0, 2, lane);
    float* H = (float*)(p.ws + OFF_HST) + (size_t)item * 16384;
#pragma unroll
    for (int i = 0; i < 2; ++i)
#pragma unroll
        for (int j = 0; j < 8; ++j)
#pragma unroll
            for (int r = 0; r < 4; ++r) {
                const int v = 32 * wave + 16 * i + (lane >> 4) * 4 + r, kk = 16 * j + (lane & 15);
                H[v * 128 + kk] = acc[i][j][r];
                if (r == 3) __builtin_amdgcn_sched_barrier(0);
            }
    __syncthreads();
}

DEVI void gmlp_item(const Params& p, int item, char* smem) {
    const int tid = threadIdx.x, lane = tid & 63, wave = tid >> 6;
    const int g = item & 3, chunk = item >> 2;
    const size_t m0 = (size_t)chunk * 128;
    const bf16_t* Z0 = (const bf16_t*)(p.ws + OFF_Z0);
    const bf16_t* Wc = (const bf16_t*)(p.ws + OFF_WS0) + g * 16384;
    char* sW = smem; char* sV = smem + 32768;
#pragma unroll
    for (int i = 0; i < 8; ++i) {
        const int e = tid + 256 * i, row = e >> 4, cc = e & 15;
        *(uint4*)(sW + swz_off<128>(row, cc)) = *(const uint4*)(Wc + row * 128 + cc * 8);
    }
    {
        const int t = tid >> 1, hf = tid & 1;
        const bf16_t* src = Z0 + (m0 + t) * 3072 + 2560 + g * 128 + 64 * hf;
        float vals[64]; float ss = 0.f;
#pragma unroll
        for (int i = 0; i < 8; ++i) {
            uint4 u = *(const uint4*)(src + 8 * i);
            vals[8 * i + 0] = bflo(u.x); vals[8 * i + 1] = bfhi(u.x); vals[8 * i + 2] = bflo(u.y); vals[8 * i + 3] = bfhi(u.y);
            vals[8 * i + 4] = bflo(u.z); vals[8 * i + 5] = bfhi(u.z); vals[8 * i + 6] = bflo(u.w); vals[8 * i + 7] = bfhi(u.w);
        }
#pragma unroll
        for (int i = 0; i < 64; ++i) ss += vals[i] * vals[i];
        ss += __shfl_xor(ss, 1);
        const float rstd = rsqrtf(ss * (1.f / 128.f) + 1e-6f);
        const float* gn = p.l0_gmlp_v_norm + g * 128 + 64 * hf;
#pragma unroll
        for (int i = 0; i < 64; ++i) {
            const int d = 64 * hf + i;
            *(bf16_t*)(sV + swz_elem<128>(d, t)) = f2bf(vals[i] * rstd * gn[i]);
        }
    }
    __syncthreads();
    const int wm = wave >> 1, wn = wave & 1;
    f32x4 acc[4][4];
#pragma unroll
    for (int i = 0; i < 4; ++i)
#pragma unroll
        for (int j = 0; j < 4; ++j) acc[i][j] = f32x4{0.f, 0.f, 0.f, 0.f};
    mma_nt<4, 4, 128, 128>(acc, sW, wm * 64, sV, wn * 64, 0, 4, lane);
    bf16_t* MIX = (bf16_t*)(p.ws + OFF_MIX0);
#pragma unroll
    for (int i = 0; i < 4; ++i)
#pragma unroll
        for (int r = 0; r < 4; ++r) {
            const int t = wm * 64 + i * 16 + (lane >> 4) * 4 + r;
            const float bias = p.l0_gmlp_b_s[g * 128 + t];
#pragma unroll
            for (int j = 0; j < 4; ++j) {
                const int d = wn * 64 + j * 16 + (lane & 15);
                const float u = bf2f(Z0[(m0 + t) * 3072 + 2048 + g * 128 + d]);
                MIX[(m0 + t) * 1024 + 512 + g * 128 + d] = f2bf(u * (acc[i][j][r] + bias));
            }
        }
    __syncthreads();
}

DEVI void hgrn_scan_phase(const Params& p) {
    float* H = (float*)(p.ws + OFF_HST);
    const float* D = (const float*)(p.ws + OFF_DEC);
    for (int e = blockIdx.x * NTHREADS + threadIdx.x; e < 8 * 16384; e += gridDim.x * NTHREADS) {
        const int bh = e >> 14, idx = e & 16383, k = idx & 127;
        float run = 0.f;
        for (int c0 = 0; c0 < 128; c0 += 8) {
            float L[8], d[8];
#pragma unroll
            for (int u = 0; u < 8; ++u) { L[u] = H[((size_t)(bh * 128 + c0 + u)) * 16384 + idx]; d[u] = D[(bh * 128 + c0 + u) * 128 + k]; }
#pragma unroll
            for (int u = 0; u < 8; ++u) { H[((size_t)(bh * 128 + c0 + u)) * 16384 + idx] = run; run = d[u] * run + L[u]; }
        }
    }
}

DEVI void hgrn_out_item(const Params& p, int item, char* smem) {
    const int tid = threadIdx.x, lane = tid & 63, wave = tid >> 6;
    const int bh = item >> 7, c = item & 127, b = bh >> 2, h = bh & 3;
    const size_t m0 = (size_t)b * 8192 + c * 64;
    const float* G = (const float*)(p.ws + OFF_G) + m0 * 512 + h * 128;
    const bf16_t* Z0 = (const bf16_t*)(p.ws + OFF_Z0) + m0 * 3072;
    float* sB  = (float*)smem;
    char*  sHT = smem;
    char*  sQe = smem + 32768;
    char*  sP  = smem + 49152;
    char*  sU  = smem + 57344;
    char*  sQs = sU; char* sKh = sU + 4096; char* sVT = sU;
    float* sRed = (float*)(smem + 77824);
    const int k = tid & 127, hf = tid >> 7;
    if (hf == 0) { float bc = 0.f;
#pragma unroll 8
        for (int t = 0; t < 64; ++t) { bc += G[t * 512 + k]; sB[t * 128 + k] = bc; } }
    __syncthreads();
#pragma unroll 4
    for (int t = 32 * hf; t < 32 * hf + 32; ++t) {
        const float q = bf2f(Z0[(size_t)t * 3072 + h * 128 + k]);
        *(bf16_t*)(sQe + swz_elem<128>(t, k)) = f2bf(q * __expf(sB[t * 128 + k]));
    }
#pragma unroll 1
    for (int i = 0; i < 4; ++i) {
        const float ri = (i == 0) ? 0.f : sB[(16 * i - 1) * 128 + k];
#pragma unroll 4
        for (int tt = 8 * hf; tt < 8 * hf + 8; ++tt) {
            const int t = 16 * i + tt;
            const float q = bf2f(Z0[(size_t)t * 3072 + h * 128 + k]);
            *(bf16_t*)(sQs + swz_elem<128>(tt, k)) = f2bf(q * __expf(sB[t * 128 + k] - ri));
        }
        const int ns = 16 * (i + 1), half = ns >> 1;
#pragma unroll 4
        for (int s = hf * half; s < hf * half + half; ++s) {
            const float bs = sB[s * 128 + k];
            const float gs = bs - (s ? sB[(s - 1) * 128 + k] : 0.f);
            const float kk = 1.f - __expf(gs);
            *(bf16_t*)(sKh + swz_elem<128>(s, k)) = f2bf(kk * __expf(fminf(ri - bs, 80.f)));
        }
        __syncthreads();
        {
            f32x4 acc[1][1]; acc[0][0] = f32x4{0.f, 0.f, 0.f, 0.f};
            if (wave <= i) mma_nt<1, 1, 128, 128>(acc, sQs, 0, sKh, 16 * wave, 0, 4, lane);
#pragma unroll
            for (int r = 0; r < 4; ++r) {
                const int row = (lane >> 4) * 4 + r, col = lane & 15;
                float v = acc[0][0][r];
                if (wave > i || (wave == i && col > row)) v = 0.f;
                *(bf16_t*)(sP + swz_elem<64>(16 * i + row, 16 * wave + col)) = f2bf(v);
            }
        }
        __syncthreads();
    }
    {
        const bf16_t* Zv = Z0 + 1024 + h * 128;
#pragma unroll 1
        for (int ch = 0; ch < 4; ++ch) {
            float vv[8];
#pragma unroll
            for (int j = 0; j < 8; ++j) vv[j] = bf2f(Zv[(size_t)(32 * hf + 8 * ch + j) * 3072 + k]);
            uint4 w; w.x = pack2(vv[0], vv[1]); w.y = pack2(vv[2], vv[3]); w.z = pack2(vv[4], vv[5]); w.w = pack2(vv[6], vv[7]);
            *(uint4*)(sVT + swz_off<64>(k, 4 * hf + ch)) = w;
        }
        const float* H = (const float*)(p.ws + OFF_HST) + (size_t)item * 16384;
#pragma unroll 2
        for (int i = 0; i < 8; ++i) {
            const int e = tid + 256 * i, row = e >> 4, cc = e & 15;
            const float4 a = *(const float4*)(H + row * 128 + cc * 8), bq = *(const float4*)(H + row * 128 + cc * 8 + 4);
            uint4 o; o.x = pack2(a.x, a.y); o.y = pack2(a.z, a.w); o.z = pack2(bq.x, bq.y); o.w = pack2(bq.z, bq.w);
            *(uint4*)(sHT + swz_off<128>(row, cc)) = o;
        }
    }
    __syncthreads();
    f32x4 acc[4][2];
#pragma unroll
    for (int i = 0; i < 4; ++i)
#pragma unroll
        for (int j = 0; j < 2; ++j) acc[i][j] = f32x4{0.f, 0.f, 0.f, 0.f};
    mma_nt<4, 2, 128, 128>(acc, sQe, 0, sHT, 32 * wave, 0, 4, lane);
    mma_nt<4, 2, 64, 64>(acc, sP, 0, sVT, 32 * wave, 0, 2, lane);
#pragma unroll
    for (int i = 0; i < 4; ++i)
#pragma unroll
        for (int r = 0; r < 4; ++r) {
            float s = acc[i][0][r] * acc[i][0][r] + acc[i][1][r] * acc[i][1][r];
            s += __shfl_xor(s, 1); s += __shfl_xor(s, 2); s += __shfl_xor(s, 4); s += __shfl_xor(s, 8);
            if ((lane & 15) == 0) sRed[wave * 64 + i * 16 + (lane >> 4) * 4 + r] = s;
        }
    __syncthreads();
    bf16_t* MIX = (bf16_t*)(p.ws + OFF_MIX0);
#pragma unroll
    for (int i = 0; i < 4; ++i)
#pragma unroll
        for (int r = 0; r < 4; ++r) {
            const int t = i * 16 + (lane >> 4) * 4 + r;
            const float tot = sRed[t] + sRed[64 + t] + sRed[128 + t] + sRed[192 + t];
            const float rstd = rsqrtf(tot * (1.f / 128.f) + 1e-6f);
#pragma unroll
            for (int j = 0; j < 2; ++j) {
                const int v = 32 * wave + 16 * j + (lane & 15);
                const float og = bf2f(Z0[(size_t)t * 3072 + 1536 + h * 128 + v]);
                MIX[(m0 + t) * 1024 + h * 128 + v] = f2bf(acc[i][j][r] * rstd * p.l0_hgrn_out_norm[h * 128 + v] * og);
            }
        }
    __syncthreads();
}

DEVI unsigned f2key(float f) { unsigned u = __float_as_uint(f); return (u & 0x80000000u) ? ~u : (u | 0x80000000u); }
DEVI float key2f(unsigned k) { unsigned u = (k & 0x80000000u) ? (k ^ 0x80000000u) : ~k; return __uint_as_float(u); }
#define CE_DESC(a, b) { unsigned _x = max(a, b), _y = min(a, b); a = _x; b = _y; }
DEVI void sort16_desc(unsigned (&a)[16]) {
#pragma unroll
    for (int k = 2; k <= 16; k <<= 1)
#pragma unroll
        for (int j = k >> 1; j > 0; j >>= 1)
#pragma unroll
            for (int i = 0; i < 16; ++i) {
                const int l = i ^ j;
                if (l > i) {
                    if ((i & k) == 0) { CE_DESC(a[i], a[l]); } else { CE_DESC(a[l], a[i]); }
                }
            }
}
DEVI void merge16_desc(unsigned (&a)[16], const unsigned (&b)[16]) {
#pragma unroll
    for (int i = 0; i < 16; ++i) a[i] = max(a[i], b[15 - i]);
#pragma unroll
    for (int j = 8; j > 0; j >>= 1)
#pragma unroll
        for (int i = 0; i < 16; ++i) { const int l = i ^ j; if (l > i) { CE_DESC(a[i], a[l]); } }
}

DEVI void peer_topk_phase(const Params& p, const bf16_t* __restrict__ SK, int blk0, int nblk, char* smem) {
    const int tid = threadIdx.x, lane = tid & 63, wave = tid >> 6;
    const int r = lane & 31, hh = lane >> 5;
    const bf16_t* QP = (const bf16_t*)(p.ws + OFF_QP);
    int* IDX = (int*)(p.ws + OFF_IDX); float* GATE = (float*)(p.ws + OFF_GATE);
    char* sKey = smem;
    char* sQ = smem + 32768 + wave * 8192;
    for (int item = blk0; item < 1024; item += nblk) {
        const int h = item & 7, tile = (item >> 3) * 4 + wave;
        const size_t tok = (size_t)tile * 32 + r;
        unsigned top[2][16];
#pragma unroll
        for (int ph = 0; ph < 2; ++ph) {
            __syncthreads();
            {
                const bf16_t* ksrc = SK + (size_t)(h * 2 + ph) * 128 * 128;
#pragma unroll
                for (int i = 0; i < 8; ++i) { const int e = tid + 256 * i, row = e >> 4, cc = e & 15; *(uint4*)(sKey + swz_off<128>(row, cc)) = *(const uint4*)(ksrc + row * 128 + cc * 8); }
                const bf16_t* qsrc = QP + (size_t)tile * 32 * 2048 + h * 256 + ph * 128;
#pragma unroll
                for (int i = 0; i < 8; ++i) { const int e = lane + 64 * i, row = e >> 4, cc = e & 15; *(uint4*)(sQ + swz_off<128>(row, cc)) = *(const uint4*)(qsrc + (size_t)row * 2048 + cc * 8); }
            }
            __syncthreads();
            bf16x8 qf[8];
#pragma unroll
            for (int ks = 0; ks < 8; ++ks) qf[ks] = *(const bf16x8*)(sQ + swz_off<128>(r, 2 * ks + hh));
#pragma unroll 1
            for (int rt = 0; rt < 4; ++rt) {
                f32x16 acc;
#pragma unroll
                for (int e = 0; e < 16; ++e) acc[e] = 0.f;
#pragma unroll
                for (int ks = 0; ks < 8; ++ks) {
                    const bf16x8 kf = *(const bf16x8*)(sKey + swz_off<128>(32 * rt + r, 2 * ks + hh));
                    acc = mfma32(kf, qf[ks], acc);
                }
                unsigned kk[16];
#pragma unroll
                for (int e = 0; e < 16; ++e) {
                    const unsigned n = 32 * rt + (e & 3) + 8 * (e >> 2) + 4 * hh;
                    kk[e] = (f2key(acc[e]) & ~127u) | n;
                }
                sort16_desc(kk);
                if (rt == 0) {
#pragma unroll
                    for (int e = 0; e < 16; ++e) top[ph][e] = kk[e];
                } else merge16_desc(top[ph], kk);
            }
            unsigned other[16];
#pragma unroll
            for (int e = 0; e < 16; ++e) other[e] = (unsigned)__shfl_xor((int)top[ph][e], 32);
            merge16_desc(top[ph], other);
        }
        unsigned best[16];
        {
            float s1[16], s2[16];
#pragma unroll
            for (int e = 0; e < 16; ++e) { s1[e] = key2f(top[0][e] & ~127u); s2[e] = key2f(top[1][e] & ~127u); }
            unsigned cand[64];
            unsigned ia[16], ib[16];
#pragma unroll
            for (int e = 0; e < 16; ++e) { ia[e] = (top[0][e] & 127u) << 7; ib[e] = top[1][e] & 127u; }
            int n = 0;
#pragma unroll
            for (int i = 0; i < 16; ++i)
#pragma unroll
                for (int j = 0; j < 16; ++j)
                    if ((i + 1) * (j + 1) <= 16) { cand[n] = (f2key(s1[i] + s2[j]) & ~0x3fffu) | ia[i] | ib[j]; ++n; }
#pragma unroll
            for (int e = 50; e < 64; ++e) cand[e] = 0u;
#pragma unroll
            for (int g = 0; g < 4; ++g) {
                unsigned kk[16];
#pragma unroll
                for (int e = 0; e < 16; ++e) kk[e] = cand[16 * g + e];
                sort16_desc(kk);
                if (g == 0) {
#pragma unroll
                    for (int e = 0; e < 16; ++e) best[e] = kk[e];
                } else merge16_desc(best, kk);
            }
        }
        float sv[16]; int id[16];
#pragma unroll
        for (int e = 0; e < 16; ++e) {
            sv[e] = key2f(best[e] & ~0x3fffu);
            id[e] = (int)(best[e] & 0x3fffu);
        }
        float den = 0.f; const float smax = sv[0];
#pragma unroll
        for (int e = 0; e < 16; ++e) { sv[e] = __expf(sv[e] - smax); den += sv[e]; }
        const float inv = 1.f / den;
        {
            const float* INVT = (const float*)(p.ws + (hh ? OFF_INVU : OFF_INVD));
            float sc[16];
#pragma unroll
            for (int e = 0; e < 16; ++e) sc[e] = INVT[id[e]];
            if (hh == 0) {
                int4* dst = (int4*)(IDX + tok * 128 + h * 16);
                float4* dst2 = (float4*)((float*)(p.ws + OFF_SDN) + tok * 128 + h * 16);
#pragma unroll
                for (int e = 0; e < 4; ++e) { dst[e] = int4{id[4 * e], id[4 * e + 1], id[4 * e + 2], id[4 * e + 3]}; dst2[e] = float4{sc[4 * e], sc[4 * e + 1], sc[4 * e + 2], sc[4 * e + 3]}; }
            } else {
                float4* dst = (float4*)(GATE + tok * 128 + h * 16);
#pragma unroll
                for (int e = 0; e < 4; ++e) dst[e] = float4{sv[4 * e] * inv * sc[4 * e], sv[4 * e + 1] * inv * sc[4 * e + 1], sv[4 * e + 2] * inv * sc[4 * e + 2], sv[4 * e + 3] * inv * sc[4 * e + 3]};
            }
        }
    }
}

typedef float f32x2v __attribute__((ext_vector_type(2)));
#define PEER_QWORD 80000
#define PEER_TPW 8
#define PEER_ITEMS (16384 / (4 * PEER_TPW))
DEVI int queue_pop(const Params& p, int q, char* smem) {
    int* sw = (int*)(smem + PEER_QWORD);
    __syncthreads();
    if (threadIdx.x == 0) *sw = (int)__hip_atomic_fetch_add((unsigned*)(p.ws + OFF_QCNT) + q * 16, 1u, __ATOMIC_RELAXED, __HIP_MEMORY_SCOPE_AGENT);
    __syncthreads();
    return *sw;
}
#define UFMA(ACC, W, X) asm volatile("v_fmac_f32 %0, %1, %2" : "+v"(ACC) : "v"(W), "v"(X))
struct DL { int i0, i1; u32x4 xa, xb; };
struct DG { u32x4 u[8]; };
DEVI void d_load(DL& l, size_t tok, int s, int lane, const int* IDX, const bf16_t* XB) {
    const unsigned o1 = (unsigned)tok * 512u + 4u * (unsigned)lane;
    l.i0 = *(const int*)((const char*)IDX + o1); l.i1 = *(const int*)((const char*)IDX + o1 + 256u);
    const unsigned o2 = (unsigned)tok * 2048u + (unsigned)(256 * s + 32 * (lane & 7));
    l.xa = *(const u32x4*)((const char*)XB + o2); l.xb = *(const u32x4*)((const char*)XB + o2 + 16u);
}
DEVI void d_publish(const DL& l, char* pt, int lane) { *(int*)(pt + 4 * lane) = l.i0; *(int*)(pt + 256 + 4 * lane) = l.i1; }
template <int HLF>
DEVI void d_gather(DG& g, const char* pt, int s, int lane, const char* ED) {
    const int grp = lane >> 3, sub = lane & 7;
#pragma unroll
    for (int i = 0; i < 8; ++i) {
        const unsigned e = *(const unsigned*)(pt + 256 * HLF + 4 * (8 * i + grp));
        g.u[i] = *(const u32x4*)(ED + ((unsigned)s * 16384u + e) * 128u + (unsigned)(16 * sub));
    }
}
template <int HLF>
DEVI void d_dot(const DG& g, const float (&x)[16], char* ex, int lane) {
#pragma unroll
    for (int i = 0; i < 8; ++i) {
        float a = 0.f;
#pragma unroll
        for (int q = 0; q < 4; ++q) {
            const f32x2v lo = __builtin_amdgcn_cvt_pk_f32_fp8((int)g.u[i][q], false), hi = __builtin_amdgcn_cvt_pk_f32_fp8((int)g.u[i][q], true);
            UFMA(a, lo.x, x[4 * q]); UFMA(a, lo.y, x[4 * q + 1]); UFMA(a, hi.x, x[4 * q + 2]); UFMA(a, hi.y, x[4 * q + 3]);
        }
        *(float*)(ex + 256 * (8 * HLF + i) + 4 * lane) = a;
        if (i & 1) __builtin_amdgcn_sched_barrier(0);
    }
}
DEVI void d_finish(char* ex, size_t tok, int s, int lane, float* PART) {
    float r0, r1;
    {
        const float4 a = *(const float4*)(ex + 256 * (lane >> 3) + 32 * (lane & 7)), b = *(const float4*)(ex + 256 * (lane >> 3) + 32 * (lane & 7) + 16);
        r0 = ((a.x + a.y) + (a.z + a.w)) + ((b.x + b.y) + (b.z + b.w));
        const float4 c = *(const float4*)(ex + 256 * (8 + (lane >> 3)) + 32 * (lane & 7)), d = *(const float4*)(ex + 256 * (8 + (lane >> 3)) + 32 * (lane & 7) + 16);
        r1 = ((c.x + c.y) + (c.z + c.w)) + ((d.x + d.y) + (d.z + d.w));
    }
    float* dst = PART + ((size_t)s * 16384 + tok) * 128;
    dst[lane] = r0; dst[64 + lane] = r1;
}
DEVI void peer_down_phase(const Params& p, const float* __restrict__ gain, int qbase, int s0, char* smem) {
    const int tid = threadIdx.x, lane = tid & 63, wave = tid >> 6;
    const char* ED = p.ws + OFF_ED;
    const int* IDX = (const int*)(p.ws + OFF_IDX);
    const bf16_t* XB = (const bf16_t*)(p.ws + OFF_XB);
    float* PART = (float*)(p.ws + OFF_PART);
    (void)gain;
    char* const pt0 = smem + wave * 8192;
    char* const ex = pt0 + 1024;
#pragma unroll 1
    for (int sl = 0; sl < 8; ++sl) {
        const int s = (s0 + sl) & 7;
#pragma unroll 1
        for (;;) {
            const int g = queue_pop(p, qbase + s, smem);
            if (g >= PEER_ITEMS) break;
            const size_t t0 = (size_t)g * (4 * PEER_TPW) + wave * PEER_TPW;
            DL la, lb, lc; DG ga, gb;
            d_load(la, t0, s, lane, IDX, XB); d_load(lb, t0 + 1, s, lane, IDX, XB);
            d_publish(la, pt0, lane); d_publish(lb, pt0 + 512, lane);
            d_gather<0>(ga, pt0, s, lane, ED);
#pragma unroll 1
            for (int j = 0; j < PEER_TPW; ++j) {
                char* const ptj = pt0 + 512 * (j & 1); char* const ptn = pt0 + 512 * ((j + 1) & 1);
                float x[16];
                x[0] = bflo(la.xa[0]); x[1] = bfhi(la.xa[0]); x[2] = bflo(la.xa[1]); x[3] = bfhi(la.xa[1]); x[4] = bflo(la.xa[2]); x[5] = bfhi(la.xa[2]); x[6] = bflo(la.xa[3]); x[7] = bfhi(la.xa[3]);
                x[8] = bflo(la.xb[0]); x[9] = bfhi(la.xb[0]); x[10] = bflo(la.xb[1]); x[11] = bfhi(la.xb[1]); x[12] = bflo(la.xb[2]); x[13] = bfhi(la.xb[2]); x[14] = bflo(la.xb[3]); x[15] = bfhi(la.xb[3]);
                d_gather<1>(gb, ptj, s, lane, ED);
                __builtin_amdgcn_sched_barrier(0);
                d_dot<0>(ga, x, ex, lane);
                __builtin_amdgcn_sched_barrier(0);
                if (j + 2 < PEER_TPW) d_load(lc, t0 + j + 2, s, lane, IDX, XB);
                if (j + 1 < PEER_TPW) d_gather<0>(ga, ptn, s, lane, ED);
                __builtin_amdgcn_sched_barrier(0);
                d_dot<1>(gb, x, ex, lane);
                __builtin_amdgcn_sched_barrier(0);
                d_finish(ex, t0 + j, s, lane, PART);
                __builtin_amdgcn_sched_barrier(0);
                la = lb; lb = lc;
                if (j + 2 < PEER_TPW) d_publish(lb, ptj, lane);
            }
        }
    }
}
DEVI void peer_reduce_phase(const Params& p) {
    const int lane = threadIdx.x & 63, wave = threadIdx.x >> 6;
    const float* PART = (const float*)(p.ws + OFF_PART); const float* GATEU = (const float*)(p.ws + OFF_GATE); const float* SDN = (const float*)(p.ws + OFF_SDN);
    const float* SSQ16 = (const float*)(p.ws + OFF_SSQ16); float* ACTW = (float*)(p.ws + OFF_ACTW);
    for (int it = blockIdx.x; it < 4096; it += gridDim.x) {
        const size_t tok = (size_t)it * 4 + wave;
        float sq = (lane < 16) ? SSQ16[tok * 16 + lane] : 0.f;
        sq += __shfl_xor(sq, 1); sq += __shfl_xor(sq, 2); sq += __shfl_xor(sq, 4); sq += __shfl_xor(sq, 8);
        const float rstd = rsqrtf(__shfl(sq, 0) * (1.f / 1024.f) + 1e-6f);
        float a0 = 0.f, a1 = 0.f;
#pragma unroll
        for (int s = 0; s < 8; ++s) { a0 += PART[((size_t)s * 16384 + tok) * 128 + lane]; a1 += PART[((size_t)s * 16384 + tok) * 128 + 64 + lane]; }
        ACTW[tok * 128 + lane]      = GATEU[tok * 128 + lane]      * gelu_tanh(a0 * rstd * SDN[tok * 128 + lane]);
        ACTW[tok * 128 + 64 + lane] = GATEU[tok * 128 + 64 + lane] * gelu_tanh(a1 * rstd * SDN[tok * 128 + 64 + lane]);
    }
}
struct UL { int i0, i1; float w0, w1; f32x2v x2; };
struct UG { u32x4 u[8]; float w[8]; };
DEVI void u_load(UL& l, size_t tok, int s, int lane, const int* IDX, const float* ACTW, const float* X) {
    const unsigned o1 = (unsigned)tok * 512u + 4u * (unsigned)lane;
    l.i0 = *(const int*)((const char*)IDX + o1); l.i1 = *(const int*)((const char*)IDX + o1 + 256u);
    l.w0 = *(const float*)((const char*)ACTW + o1); l.w1 = *(const float*)((const char*)ACTW + o1 + 256u);
    const unsigned o2 = (unsigned)tok * 4096u + (unsigned)(512 * s + 64 * (lane & 7) + 8 * (lane >> 3));
    { const unsigned xb2 = *(const unsigned*)((const char*)X + (o2 >> 1)); l.x2 = f32x2v{bflo(xb2), bfhi(xb2)}; }
}
DEVI void u_publish(const UL& l, char* pt, int lane) {
    *(uint2*)(pt + 8 * lane) = uint2{(unsigned)l.i0, __float_as_uint(l.w0)};
    *(uint2*)(pt + 512 + 8 * lane) = uint2{(unsigned)l.i1, __float_as_uint(l.w1)};
}
template <int HLF>
DEVI void u_gather(UG& g, const char* pt, int s, int lane, const char* EU) {
    const int grp = lane >> 3, sub = lane & 7;
#pragma unroll
    for (int i = 0; i < 8; ++i) {
        const uint2 ew = *(const uint2*)(pt + 512 * HLF + 8 * (8 * i + grp));
        g.w[i] = __uint_as_float(ew.y);
        const unsigned off = ((unsigned)s * 16384u + ew.x) * 128u + (unsigned)(16 * sub);
        g.u[i] = *(const u32x4*)(EU + off);
    }
}
DEVI void u_fma(const UG& g, float (&acc)[16]) {
#pragma unroll
    for (int i = 0; i < 8; ++i) {
        const float w = g.w[i];
#pragma unroll
        for (int q = 0; q < 4; ++q) {
            const f32x2v lo = __builtin_amdgcn_cvt_pk_f32_fp8((int)g.u[i][q], false), hi = __builtin_amdgcn_cvt_pk_f32_fp8((int)g.u[i][q], true);
            UFMA(acc[4 * q], w, lo.x); UFMA(acc[4 * q + 1], w, lo.y); UFMA(acc[4 * q + 2], w, hi.x); UFMA(acc[4 * q + 3], w, hi.y);
        }
        if (i & 1) __builtin_amdgcn_sched_barrier(0);
    }
}
DEVI void u_finish(float (&acc)[16], const UL& l, char* ex, size_t tok, int s, int lane, float alpha, float* X, bf16_t* XB, float* SSQ8) {
    const int grp = lane >> 3, sub = lane & 7;
#pragma unroll
    for (int pp = 0; pp < 8; ++pp) *(float2*)(ex + 576 * pp + 8 * lane) = float2{acc[2 * pp], acc[2 * pp + 1]};
    float a0 = 0.f, a1 = 0.f;
#pragma unroll
    for (int g2 = 0; g2 < 8; ++g2) { const float2 v = *(const float2*)(ex + 576 * grp + 8 * (8 * g2 + sub)); a0 += v.x; a1 += v.y; }
    const float y0 = l.x2.x + alpha * a0, y1 = l.x2.y + alpha * a1;
    const unsigned col = (unsigned)tok * 1024u + (unsigned)(128 * s + 16 * sub + 2 * grp);
    if (X) *(f32x2v*)((char*)X + 4u * col) = f32x2v{y0, y1};
    const unsigned yb = pack2(y0, y1);
    *(unsigned*)((char*)XB + 2u * col) = yb;
    float sq = bflo(yb) * bflo(yb) + bfhi(yb) * bfhi(yb);
#pragma unroll
    for (int o = 1; o < 64; o <<= 1) sq += __shfl_xor(sq, o);
    if (lane == 0) *(float*)((char*)SSQ8 + ((unsigned)tok * 32u + 4u * (unsigned)s)) = sq;
#pragma unroll
    for (int i = 0; i < 16; ++i) acc[i] = 0.f;
}
DEVI void peer_up_phase(const Params& p, int qbase, int s0, float alpha, float* X, char* smem) {
    const int tid = threadIdx.x, lane = tid & 63, wave = tid >> 6;
    const char* EU = p.ws + OFF_EU;
    const int* IDX = (const int*)(p.ws + OFF_IDX); const float* ACTW = (const float*)(p.ws + OFF_ACTW);
    bf16_t* XB = (bf16_t*)(p.ws + OFF_XB); float* SSQ8 = (float*)(p.ws + OFF_SSQ8);
    char* const pt0 = smem + wave * 8192;
    char* const ex = pt0 + 2048;
#pragma unroll 1
    for (int sl = 0; sl < 8; ++sl) {
        const int s = (s0 + sl) & 7;
#pragma unroll 1
        for (;;) {
            const int g = queue_pop(p, qbase + s, smem);
            if (g >= PEER_ITEMS) break;
            const size_t t0 = (size_t)g * (4 * PEER_TPW) + wave * PEER_TPW;
            UL la, lb, lc; UG ga, gb;
            float acc[16];
#pragma unroll
            for (int i = 0; i < 16; ++i) acc[i] = 0.f;
            u_load(la, t0, s, lane, IDX, ACTW, (const float*)XB); u_load(lb, t0 + 1, s, lane, IDX, ACTW, (const float*)XB);
            u_publish(la, pt0, lane); u_publish(lb, pt0 + 1024, lane);
            u_gather<0>(ga, pt0, s, lane, EU);
#pragma unroll 1
            for (int j = 0; j < PEER_TPW; ++j) {
                char* const ptj = pt0 + 1024 * (j & 1); char* const ptn = pt0 + 1024 * ((j + 1) & 1);
                u_gather<1>(gb, ptj, s, lane, EU);
                __builtin_amdgcn_sched_barrier(0);
                u_fma(ga, acc);
                __builtin_amdgcn_sched_barrier(0);
                if (j + 2 < PEER_TPW) u_load(lc, t0 + j + 2, s, lane, IDX, ACTW, (const float*)XB);
                if (j + 1 < PEER_TPW) u_gather<0>(ga, ptn, s, lane, EU);
                __builtin_amdgcn_sched_barrier(0);
                u_fma(gb, acc);
                __builtin_amdgcn_sched_barrier(0);
                u_finish(acc, la, ex, t0 + j, s, lane, alpha, X, XB, SSQ8);
                __builtin_amdgcn_sched_barrier(0);
                la = lb; lb = lc;
                if (j + 2 < PEER_TPW) u_publish(lb, ptj, lane);
            }
        }
    }
}

DEVI void rope_cs(float pos, int i, float& c, float& s) {
    const float inv = exp2f(-(float)i * (13.287712379549449f / 32.f));
    const float ang = pos * inv;
    const float kf = rintf(ang * 0.15915494309189535f);
    float rr = fmaf(-kf, 6.2831854820251465f, ang);
    rr = fmaf(-kf, -1.7484555e-7f, rr);
    c = __cosf(rr); s = __sinf(rr);
}
#define QSCALE_MLA  (0.07216878364870322f * 1.4426950408889634f)
#define QSCALE_MOBA (0.08838834764831845f * 1.4426950408889634f)

DEVI void moba_prep_item(const Params& p, int item, char* smem) {
    const int tid = threadIdx.x;
    const int h = item & 3, tt = item >> 2;
    const size_t m0 = (size_t)tt * 64;
    const int b = (int)(m0 >> 13), s0 = (int)(m0 & 8191), bh = b * 4 + h;
    const bf16_t* Z1 = (const bf16_t*)(p.ws + OFF_Z1);
    bf16_t* Qd = (bf16_t*)(p.ws + OFF_QD); bf16_t* Kd = (bf16_t*)(p.ws + OFF_KD); bf16_t* VdT = (bf16_t*)(p.ws + OFF_VDT);
    const int row = tid >> 2, j = tid & 3;
    const bf16_t* zr = Z1 + (m0 + row) * 1984;
#pragma unroll
    for (int which = 0; which < 2; ++which) {
        const bf16_t* src = zr + (which ? 960 : 448) + h * 128 + 32 * j;
        const float* gn = (which ? p.l1_mk_norm : p.l1_mq_norm) + 32 * j;
        float v[32]; float ss = 0.f;
#pragma unroll
        for (int i = 0; i < 4; ++i) {
            uint4 u = *(const uint4*)(src + 8 * i);
            v[8 * i] = bflo(u.x); v[8 * i + 1] = bfhi(u.x); v[8 * i + 2] = bflo(u.y); v[8 * i + 3] = bfhi(u.y);
            v[8 * i + 4] = bflo(u.z); v[8 * i + 5] = bfhi(u.z); v[8 * i + 6] = bflo(u.w); v[8 * i + 7] = bfhi(u.w);
        }
#pragma unroll
        for (int i = 0; i < 32; ++i) ss += v[i] * v[i];
        ss += __shfl_xor(ss, 1); ss += __shfl_xor(ss, 2);
        const float sc = rsqrtf(ss * (1.f / 128.f) + 1e-6f) * (which ? 1.f : QSCALE_MOBA);
        bf16_t* dst = (which ? Kd : Qd) + ((size_t)bh * 8192 + s0 + row) * 128 + 32 * j;
#pragma unroll
        for (int i = 0; i < 4; ++i) {
            uint4 o;
            o.x = pack2(v[8 * i] * sc * gn[8 * i], v[8 * i + 1] * sc * gn[8 * i + 1]); o.y = pack2(v[8 * i + 2] * sc * gn[8 * i + 2], v[8 * i + 3] * sc * gn[8 * i + 3]);
            o.z = pack2(v[8 * i + 4] * sc * gn[8 * i + 4], v[8 * i + 5] * sc * gn[8 * i + 5]); o.w = pack2(v[8 * i + 6] * sc * gn[8 * i + 6], v[8 * i + 7] * sc * gn[8 * i + 7]);
            *(uint4*)(dst + 8 * i) = o;
        }
    }
    bf16_t* sT = (bf16_t*)smem;
    {
        const bf16_t* src = zr + 1472 + h * 128 + 32 * j;
#pragma unroll
        for (int i = 0; i < 4; ++i) {
            uint4 u = *(const uint4*)(src + 8 * i);
            const int d0 = 32 * j + 8 * i;
            sT[(d0 + 0) * 66 + row] = (bf16_t)(u.x & 0xffff); sT[(d0 + 1) * 66 + row] = (bf16_t)(u.x >> 16);
            sT[(d0 + 2) * 66 + row] = (bf16_t)(u.y & 0xffff); sT[(d0 + 3) * 66 + row] = (bf16_t)(u.y >> 16);
            sT[(d0 + 4) * 66 + row] = (bf16_t)(u.z & 0xffff); sT[(d0 + 5) * 66 + row] = (bf16_t)(u.z >> 16);
            sT[(d0 + 6) * 66 + row] = (bf16_t)(u.w & 0xffff); sT[(d0 + 7) * 66 + row] = (bf16_t)(u.w >> 16);
        }
    }
    __syncthreads();
    for (int e = tid; e < 128 * 32; e += NTHREADS) {
        const int d = e >> 5, tp = e & 31;
        const unsigned v = (unsigned)sT[d * 66 + 2 * tp] | ((unsigned)sT[d * 66 + 2 * tp + 1] << 16);
        *(unsigned*)(VdT + ((size_t)bh * 128 + d) * 8192 + s0 + (((2 * tp) & ~12) | (((2 * tp) & 4) << 1) | (((2 * tp) & 8) >> 1))) = v;
    }
    __syncthreads();
}

DEVI void moba_kmean_item(const Params& p, int item, char* smem) {
    const int tid = threadIdx.x;
    const int bh = item >> 5, blk = item & 31, b = bh >> 2, h = bh & 3;
    const bf16_t* Z1 = (const bf16_t*)(p.ws + OFF_Z1) + ((size_t)b * 8192 + blk * 256) * 1984 + 960 + h * 128;
    const int cc = tid & 15, rg = tid >> 4;
    float col[8];
#pragma unroll
    for (int i = 0; i < 8; ++i) col[i] = 0.f;
    for (int i = 0; i < 16; ++i) {
        const int row = rg * 16 + i;
        uint4 u = *(const uint4*)(Z1 + (size_t)row * 1984 + cc * 8);
        float v[8] = {bflo(u.x), bfhi(u.x), bflo(u.y), bfhi(u.y), bflo(u.z), bfhi(u.z), bflo(u.w), bfhi(u.w)};
        float ss = 0.f;
#pragma unroll
        for (int e = 0; e < 8; ++e) ss += v[e] * v[e];
        ss += __shfl_xor(ss, 1); ss += __shfl_xor(ss, 2); ss += __shfl_xor(ss, 4); ss += __shfl_xor(ss, 8);
        const float rstd = rsqrtf(ss * (1.f / 128.f) + 1e-6f);
#pragma unroll
        for (int e = 0; e < 8; ++e) col[e] += v[e] * rstd;
    }
    float* sR = (float*)smem;
#pragma unroll
    for (int e = 0; e < 8; ++e) sR[rg * 128 + cc * 8 + e] = col[e];
    __syncthreads();
    if (tid < 128) {
        float s = 0.f;
#pragma unroll
        for (int g = 0; g < 16; ++g) s += sR[g * 128 + tid];
        ((float*)(p.ws + OFF_KMEAN))[((size_t)bh * 32 + blk) * 128 + tid] = s * (1.f / 256.f) * p.l1_mk_norm[tid];
    }
    __syncthreads();
}

DEVI void mla_prep_item(const Params& p, int item, char* smem) {
    const int tid = threadIdx.x;
    const int h = item & 3, tt = item >> 2;
    const size_t m0 = (size_t)tt * 64;
    const int b = (int)(m0 >> 13), s0 = (int)(m0 & 8191), bh = b * 4 + h;
    const bf16_t* Z1 = (const bf16_t*)(p.ws + OFF_Z1);
    const bf16_t* QC = (const bf16_t*)(p.ws + OFF_QC);
    const bf16_t* KV = (const bf16_t*)(p.ws + OFF_KV);
    bf16_t* Q = (bf16_t*)(p.ws + OFF_Q); bf16_t* K = (bf16_t*)(p.ws + OFF_K); bf16_t* VT = (bf16_t*)(p.ws + OFF_VT);
    const int row = tid >> 2, j = tid & 3;
    const size_t m = m0 + row;
    const float pos = (float)p.pos[m];
#pragma unroll
    for (int which = 0; which < 2; ++which) {
        const bf16_t* nsrc = which ? (KV + m * 1024 + h * 256 + 32 * j) : (QC + m * 768 + h * 192 + 32 * j);
        const bf16_t* r1 = which ? (Z1 + m * 1984 + 384 + 8 * j) : (QC + m * 768 + h * 192 + 128 + 8 * j);
        const bf16_t* r2 = r1 + 32;
        const float* gn = which ? p.l1_k_norm : p.l1_q_norm;
        float v[32], a1[8], a2[8]; float ss = 0.f;
#pragma unroll
        for (int i = 0; i < 4; ++i) {
            uint4 u = *(const uint4*)(nsrc + 8 * i);
            v[8 * i] = bflo(u.x); v[8 * i + 1] = bfhi(u.x); v[8 * i + 2] = bflo(u.y); v[8 * i + 3] = bfhi(u.y);
            v[8 * i + 4] = bflo(u.z); v[8 * i + 5] = bfhi(u.z); v[8 * i + 6] = bflo(u.w); v[8 * i + 7] = bfhi(u.w);
        }
        { uint4 u = *(const uint4*)r1; a1[0] = bflo(u.x); a1[1] = bfhi(u.x); a1[2] = bflo(u.y); a1[3] = bfhi(u.y); a1[4] = bflo(u.z); a1[5] = bfhi(u.z); a1[6] = bflo(u.w); a1[7] = bfhi(u.w); }
        { uint4 u = *(const uint4*)r2; a2[0] = bflo(u.x); a2[1] = bfhi(u.x); a2[2] = bflo(u.y); a2[3] = bfhi(u.y); a2[4] = bflo(u.z); a2[5] = bfhi(u.z); a2[6] = bflo(u.w); a2[7] = bfhi(u.w); }
#pragma unroll
        for (int i = 0; i < 32; ++i) ss += v[i] * v[i];
#pragma unroll
        for (int i = 0; i < 8; ++i) ss += a1[i] * a1[i] + a2[i] * a2[i];
        ss += __shfl_xor(ss, 1); ss += __shfl_xor(ss, 2);
        const float rstd = rsqrtf(ss * (1.f / 192.f) + 1e-6f);
        const float sc = which ? 1.f : QSCALE_MLA;
        bf16_t* dst = (which ? K : Q) + ((size_t)bh * 8192 + s0 + row) * 192;
#pragma unroll
        for (int i = 0; i < 4; ++i) {
            const float* g = gn + 32 * j + 8 * i;
            uint4 o;
            o.x = pack2(v[8 * i] * rstd * g[0] * sc, v[8 * i + 1] * rstd * g[1] * sc); o.y = pack2(v[8 * i + 2] * rstd * g[2] * sc, v[8 * i + 3] * rstd * g[3] * sc);
            o.z = pack2(v[8 * i + 4] * rstd * g[4] * sc, v[8 * i + 5] * rstd * g[5] * sc); o.w = pack2(v[8 * i + 6] * rstd * g[6] * sc, v[8 * i + 7] * rstd * g[7] * sc);
            *(uint4*)(dst + 32 * j + 8 * i) = o;
        }
        float o1[8], o2[8];
#pragma unroll
        for (int i = 0; i < 8; ++i) {
            float c, s; rope_cs(pos, 8 * j + i, c, s);
            const float y1 = a1[i] * rstd * gn[128 + 8 * j + i], y2 = a2[i] * rstd * gn[160 + 8 * j + i];
            o1[i] = (y1 * c - y2 * s) * sc; o2[i] = (y2 * c + y1 * s) * sc;
        }
        uint4 w1, w2;
        w1.x = pack2(o1[0], o1[1]); w1.y = pack2(o1[2], o1[3]); w1.z = pack2(o1[4], o1[5]); w1.w = pack2(o1[6], o1[7]);
        w2.x = pack2(o2[0], o2[1]); w2.y = pack2(o2[2], o2[3]); w2.z = pack2(o2[4], o2[5]); w2.w = pack2(o2[6], o2[7]);
        *(uint4*)(dst + 128 + 8 * j) = w1; *(uint4*)(dst + 160 + 8 * j) = w2;
    }
    bf16_t* sT = (bf16_t*)smem;
    {
        const bf16_t* src = KV + m * 1024 + h * 256 + 128 + 32 * j;
#pragma unroll
        for (int i = 0; i < 4; ++i) {
            uint4 u = *(const uint4*)(src + 8 * i);
            const int d0 = 32 * j + 8 * i;
            sT[(d0 + 0) * 66 + row] = (bf16_t)(u.x & 0xffff); sT[(d0 + 1) * 66 + row] = (bf16_t)(u.x >> 16);
            sT[(d0 + 2) * 66 + row] = (bf16_t)(u.y & 0xffff); sT[(d0 + 3) * 66 + row] = (bf16_t)(u.y >> 16);
            sT[(d0 + 4) * 66 + row] = (bf16_t)(u.z & 0xffff); sT[(d0 + 5) * 66 + row] = (bf16_t)(u.z >> 16);
            sT[(d0 + 6) * 66 + row] = (bf16_t)(u.w & 0xffff); sT[(d0 + 7) * 66 + row] = (bf16_t)(u.w >> 16);
        }
    }
    __syncthreads();
    for (int e = tid; e < 128 * 32; e += NTHREADS) {
        const int d = e >> 5, tp = e & 31;
        const unsigned v = (unsigned)sT[d * 66 + 2 * tp] | ((unsigned)sT[d * 66 + 2 * tp + 1] << 16);
        *(unsigned*)(VT + ((size_t)bh * 128 + d) * 8192 + s0 + (((2 * tp) & ~12) | (((2 * tp) & 4) << 1) | (((2 * tp) & 8) >> 1))) = v;
    }
    __syncthreads();
}

template <int DQK, bool MOBA>
DEVI void attn_item(const Params& p, int bh, int qt, char* smem) {
    constexpr int NKS = DQK / 16, KCH = DQK / 8;
    const int tid = threadIdx.x, lane = tid & 63, wave = tid >> 6;
    const int r = lane & 31, hh = lane >> 5;
    char* const ws = opaque_ptr(p.ws);
    const bf16_t* Q  = (const bf16_t*)(ws + (MOBA ? OFF_QD : OFF_Q)) + (size_t)bh * 8192 * DQK;
    const bf16_t* Kg = (const bf16_t*)(ws + (MOBA ? OFF_KD : OFF_K)) + (size_t)bh * 8192 * DQK;
    const bf16_t* Vg = (const bf16_t*)(ws + (MOBA ? OFF_VDT : OFF_VT)) + (size_t)bh * 128 * 8192;
    const int q0 = qt * 128;
    const int qpos = q0 + wave * 32 + r;
    constexpr int KB = 32 * DQK * 2, VB = 8192, STG = KB + VB;
    constexpr int KI = KB / 4096;
    int*  sList = (int*)(smem + 61440);
    unsigned* sSel = (unsigned*)(smem + 62464);
    float* sTop = (float*)(smem + 63232);
    int ntiles;
    unsigned mysel = 0xffffffffu;
    if constexpr (MOBA) {
        const int jblk = q0 >> 8;
        float* sKm = (float*)smem;
        const float* km = (const float*)(ws + OFF_KMEAN) + (size_t)bh * 32 * 128;
        for (int e = tid; e < 1024; e += NTHREADS) ((float4*)sKm)[e] = ((const float4*)km)[e];
        unsigned* sAny = (unsigned*)(smem + 62976);
        if (tid < 32) sAny[tid] = 0u;
        __syncthreads();
        const int qq = tid & 127, par = tid >> 7;
        float ga[16];
#pragma unroll
        for (int i = 0; i < 16; ++i) ga[i] = 0.f;
        const bf16_t* qrow = Q + (size_t)(q0 + qq) * 128;
#pragma unroll 1
        for (int d0 = 0; d0 < 128; d0 += 8) {
            uint4 u = *(const uint4*)(qrow + d0);
            float qv[8] = {bflo(u.x), bfhi(u.x), bflo(u.y), bfhi(u.y), bflo(u.z), bfhi(u.z), bflo(u.w), bfhi(u.w)};
#pragma unroll
            for (int i = 0; i < 16; ++i) {
                const float4 ka = *(const float4*)(sKm + (2 * i + par) * 128 + d0), kb = *(const float4*)(sKm + (2 * i + par) * 128 + d0 + 4);
                ga[i] += qv[0] * ka.x + qv[1] * ka.y + qv[2] * ka.z + qv[3] * ka.w + qv[4] * kb.x + qv[5] * kb.y + qv[6] * kb.z + qv[7] * kb.w;
            }
        }
        float tv[3] = {-3e38f, -3e38f, -3e38f}; int ti[3] = {-1, -1, -1};
#pragma unroll
        for (int i = 0; i < 16; ++i) {
            const int n = 2 * i + par;
            if (n < jblk) {
                const float v = ga[i];
                if (v > tv[0]) { tv[2] = tv[1]; ti[2] = ti[1]; tv[1] = tv[0]; ti[1] = ti[0]; tv[0] = v; ti[0] = n; }
                else if (v > tv[1]) { tv[2] = tv[1]; ti[2] = ti[1]; tv[1] = v; ti[1] = n; }
                else if (v > tv[2]) { tv[2] = v; ti[2] = n; }
            }
        }
#pragma unroll
        for (int i = 0; i < 3; ++i) { sTop[tid * 6 + 2 * i] = tv[i]; sTop[tid * 6 + 2 * i + 1] = __int_as_float(ti[i]); }
        __syncthreads();
        if (par == 0) {
#pragma unroll
            for (int i = 0; i < 3; ++i) {
                const float v = sTop[(tid + 128) * 6 + 2 * i]; const int n = __float_as_int(sTop[(tid + 128) * 6 + 2 * i + 1]);
                if (n >= 0) {
                    if (v > tv[0]) { tv[2] = tv[1]; ti[2] = ti[1]; tv[1] = tv[0]; ti[1] = ti[0]; tv[0] = v; ti[0] = n; }
                    else if (v > tv[1]) { tv[2] = tv[1]; ti[2] = ti[1]; tv[1] = v; ti[1] = n; }
                    else if (v > tv[2]) { tv[2] = v; ti[2] = n; }
                }
            }
            unsigned m = 1u << jblk;
#pragma unroll
            for (int i = 0; i < 3; ++i) if (ti[i] >= 0) { m |= 1u << ti[i]; sAny[ti[i]] = 1u; }
            sSel[qq] = m;
        }
        __syncthreads();
        if (tid == 0) {
            int n = 0;
            for (int blk = 0; blk < jblk; ++blk) if (sAny[blk]) { for (int t = 0; t < 8; ++t) sList[n++] = blk * 8 + t; }
            for (int t = jblk * 8; t < (q0 + 128) / 32; ++t) sList[n++] = t;
            sSel[160] = (unsigned)n;
        }
        __syncthreads();
        ntiles = (int)sSel[160];
        mysel = sSel[wave * 32 + r];
        __syncthreads();
    } else {
        ntiles = 4 * qt + 4;
    }
    bf16x8 qf[NKS];
#pragma unroll
    for (int ks = 0; ks < NKS; ++ks) qf[ks] = *(const bf16x8*)(Q + (size_t)qpos * DQK + ks * 16 + hh * 8);
    f32x16 o[4];
#pragma unroll
    for (int dt = 0; dt < 4; ++dt)
#pragma unroll
        for (int e = 0; e < 16; ++e) o[dt][e] = 0.f;
    float lsum = 0.f;
    int koff[KI], voff[2];
#pragma unroll
    for (int i = 0; i < KI; ++i) {
        const int L = (wave * KI + i) * 64 + lane, row = L / KCH, cp = L % KCH;
        const int f = (DQK == 128) ? (row & 15) : ((row >> 1) & 7);
        koff[i] = row * DQK + (cp ^ f) * 8;
    }
#pragma unroll
    for (int i = 0; i < 2; ++i) {
        const int L = (wave * 2 + i) * 64 + lane, dv = L >> 2, cp = L & 3;
        voff[i] = dv * 8192 + (cp ^ ((dv >> 2) & 3)) * 8;
    }
    const int wv = __builtin_amdgcn_readfirstlane(wave);
#define ATT_ISSUE(LI) { const int u_ = tile_id(LI); char* st_ = smem + ((LI) % 3) * STG; \
        _Pragma("unroll") for (int i = 0; i < KI; ++i) __builtin_amdgcn_global_load_lds((const unsigned*)(Kg + (size_t)u_ * 32 * DQK + koff[i]), (unsigned*)(st_ + (wv * KI + i) * 1024), 16, 0, 0); \
        _Pragma("unroll") for (int i = 0; i < 2; ++i)  __builtin_amdgcn_global_load_lds((const unsigned*)(Vg + (size_t)u_ * 32 + voff[i]),       (unsigned*)(st_ + KB + (wv * 2 + i) * 1024), 16, 0, 0); }
    auto tile_id = [&](int li) -> int { if constexpr (MOBA) return sList[li]; else return li; };
    if (ntiles > 0) ATT_ISSUE(0)
    if (ntiles > 1) ATT_ISSUE(1)
    const int xk = ((DQK == 128) ? (r & 15) : ((r >> 1) & 7)) ^ hh;
    const int xv = (r >> 2) & 3;
#pragma unroll 1
    for (int li = 0; li < ntiles; ++li) {
        if (li + 1 < ntiles) asm volatile("s_waitcnt vmcnt(%0)" :: "n"(KI + 2) : "memory");
        else asm volatile("s_waitcnt vmcnt(0)" ::: "memory");
        G2_RAW_BARRIER();
        if (li + 2 < ntiles) ATT_ISSUE(li + 2)
        const int unit = tile_id(li);
        const int kbase = unit * 32;
        bool allowed = true;
        if constexpr (MOBA) allowed = (mysel >> (unit >> 3)) & 1u;
        const char* sK = smem + (li % 3) * STG;
        const char* sV = sK + KB;
        if (kbase <= q0 + wave * 32 + 31) {
            const char* kbase_l = sK + r * (DQK * 2);
            const char* vbase_l = sV + r * 64;
            f32x16 s;
#pragma unroll
            for (int e = 0; e < 16; ++e) s[e] = 0.f;
#pragma unroll
            for (int ks = 0; ks < NKS; ++ks) {
                const bf16x8 a = *(const bf16x8*)(kbase_l + (((2 * ks) ^ xk) << 4));
                s = mfma32(a, qf[ks], s);
            }
            const bool need_mask = (kbase + 31 > q0 + wave * 32);
            float pr[16];
            if (need_mask) {
                const int kofs = qpos - kbase - 4 * hh;
#pragma unroll
                for (int e = 0; e < 16; ++e) pr[e] = ((e & 3) + 8 * (e >> 2) <= kofs) ? __builtin_amdgcn_exp2f(s[e]) : 0.f;
            } else {
#pragma unroll
                for (int e = 0; e < 16; ++e) pr[e] = __builtin_amdgcn_exp2f(s[e]);
            }
            if constexpr (MOBA) {
                const float am = allowed ? 1.f : 0.f;
#pragma unroll
                for (int e = 0; e < 16; ++e) pr[e] *= am;
            }
            lsum += ((pr[0] + pr[1]) + (pr[2] + pr[3])) + ((pr[4] + pr[5]) + (pr[6] + pr[7])) + ((pr[8] + pr[9]) + (pr[10] + pr[11])) + ((pr[12] + pr[13]) + (pr[14] + pr[15]));
#pragma unroll
            for (int s2 = 0; s2 < 2; ++s2) {
                const u32x4 pbu = {pack2(pr[8 * s2 + 0], pr[8 * s2 + 1]), pack2(pr[8 * s2 + 2], pr[8 * s2 + 3]),
                                   pack2(pr[8 * s2 + 4], pr[8 * s2 + 5]), pack2(pr[8 * s2 + 6], pr[8 * s2 + 7])};
                const bf16x8 pbv = __builtin_bit_cast(bf16x8, pbu);
#pragma unroll
                for (int dt = 0; dt < 4; ++dt) {
                    const char* vb = vbase_l + dt * (32 * 64);
                    const u32x4 vau = *(const u32x4*)(vb + (((2 * s2 + hh) ^ xv) << 4));
                    o[dt] = mfma32(__builtin_bit_cast(bf16x8, vau), pbv, o[dt]);
                }
            }
        }
    }
#undef ATT_ISSUE
    G2_RAW_BARRIER();
    lsum += __shfl_xor(lsum, 32);
    const float inv = 1.f / lsum;
    char* sO = smem + wave * 8704;
#pragma unroll
    for (int dt = 0; dt < 4; ++dt)
#pragma unroll
        for (int e = 0; e < 16; e += 2) {
            const int dv = 32 * dt + (e & 3) + 8 * (e >> 2) + 4 * hh;
            *(unsigned*)(sO + r * 272 + dv * 2) = pack2(o[dt][e] * inv, o[dt][e + 1] * inv);
        }
    __builtin_amdgcn_s_waitcnt(0xc07f);
    __builtin_amdgcn_wave_barrier();
    bf16_t* MIX = (bf16_t*)(ws + OFF_MIX1);
    const int b = bh >> 2, h = bh & 3;
#pragma unroll
    for (int i = 0; i < 8; ++i) {
        const int id = lane + 64 * i, row = id >> 4, cc = id & 15;
        const uint4 v = *(const uint4*)(sO + row * 272 + cc * 16);
        *(uint4*)(MIX + ((size_t)b * 8192 + q0 + wave * 32 + row) * 1024 + (MOBA ? 512 : 0) + h * 128 + cc * 8) = v;
    }
    __syncthreads();
}

DEVI void attn_phase_all(const Params& p, char* smem) {
    const int G = gridDim.x;
#pragma unroll 1
    for (int v = blockIdx.x; v < 512; v += G) attn_item<192, false>(p, v & 7, 63 - (v >> 3), smem);
    __builtin_amdgcn_sched_barrier(0);
#pragma unroll 1
    for (int v = blockIdx.x; v < 512; v += G) attn_item<128, true>(p, v & 7, (v >> 3), smem);
}

#define XB_TMO      128
#define XB_XCNT(j)  (256  + 64 * (j))
#define XB_XSUB(j)  (1280 + 64 * (j))
#define XB_XGEN(j)  (2304 + 64 * (j))
#define XB_TOP      3328
#define XB_TOPGEN   3392
#define XCD_BAR_WORDS 3456
#define XB_SPIN_CAP (1u << 23)
#define LAS __attribute__((address_space(3)))
DEVI unsigned xb_ld(unsigned* p)              { return __hip_atomic_load(p, __ATOMIC_RELAXED, __HIP_MEMORY_SCOPE_AGENT); }
DEVI unsigned xb_add(unsigned* p, unsigned v) { return __hip_atomic_fetch_add(p, v, __ATOMIC_RELAXED, __HIP_MEMORY_SCOPE_AGENT); }
DEVI unsigned xb_xcc_id() { return (unsigned)__builtin_amdgcn_s_getreg((3 << 11) | 20) & 0xFu; }
#define XB_SPIN(cond, bar) do { unsigned _sp = 0; while (cond) { __builtin_amdgcn_s_sleep(1); \
    if ((++_sp & 255u) == 0u) { if (xb_ld(&(bar)[XB_TMO])) break; if (_sp > XB_SPIN_CAP) { atomicAdd(&(bar)[XB_TMO], 1u); break; } } } } while (0)
struct XcdBarrier { unsigned* bar; unsigned x; volatile LAS unsigned* st; };
DEVI XcdBarrier xcd_barrier_post(unsigned* bar, volatile LAS unsigned* st) {
    XcdBarrier b; b.bar = bar; b.x = xb_xcc_id(); b.st = st;
    if (threadIdx.x == 0) st[2] = xb_add(&bar[XB_XCNT(b.x)], 1u);
    return b;
}
DEVI void xcd_barrier_complete(unsigned* bar, unsigned x, unsigned& nloc, unsigned& nx, unsigned& dense) {
    const unsigned G = gridDim.x * gridDim.y * gridDim.z;
    unsigned sum, cnt, mine, sp = 0u;
    for (;;) {
        sum = 0u; cnt = 0u; mine = 0u; dense = 0u;
#pragma unroll
        for (unsigned j = 0; j < 16; ++j) { const unsigned c = xb_ld(&bar[XB_XCNT(j)]); sum += c; cnt += (c > 0u) ? 1u : 0u; mine = (j == x) ? c : mine; dense += (j < x && c > 0u) ? 1u : 0u; }
        if (sum == G) break;
        __builtin_amdgcn_s_sleep(1);
        if ((++sp & 255u) == 0u) { if (xb_ld(&bar[XB_TMO])) break; if (sp > XB_SPIN_CAP) { atomicAdd(&bar[XB_TMO], 1u); break; } }
    }
    nloc = mine > 0u ? mine : 1u; nx = cnt > 0u ? cnt : 1u;
}
DEVI void xcd_barrier(const XcdBarrier& b) {
    asm volatile("s_waitcnt vmcnt(0)" ::: "memory");
    __syncthreads();
    if (threadIdx.x == 0) {
        unsigned* bar = b.bar;
        __builtin_amdgcn_s_waitcnt(0);
        unsigned nloc = b.st[0], nx = b.st[1];
        if (nloc == 0u) { unsigned dense = 0u; xcd_barrier_complete(bar, b.x, nloc, nx, dense); b.st[0] = nloc; b.st[1] = nx; b.st[3] = dense; }
        const unsigned old = xb_add(&bar[XB_XSUB(b.x)], 1u);
        const unsigned gen = old / nloc;
        if (old + 1u == (gen + 1u) * nloc) {
            __builtin_amdgcn_fence(__ATOMIC_RELEASE, "agent");
            asm volatile("s_waitcnt vmcnt(0)" ::: "memory");
            const unsigned og = xb_add(&bar[XB_TOP], 1u);
            const unsigned tg = og / nx;
            if (og + 1u == (tg + 1u) * nx) xb_add(&bar[XB_TOPGEN], 1u);
            else XB_SPIN(xb_ld(&bar[XB_TOPGEN]) == tg, bar);
            __builtin_amdgcn_fence(__ATOMIC_ACQUIRE, "agent");
            xb_add(&bar[XB_XGEN(b.x)], 1u);
            asm volatile("s_waitcnt vmcnt(0)" ::: "memory");
        } else {
            XB_SPIN(xb_ld(&bar[XB_XGEN(b.x)]) == gen, bar);
            __builtin_amdgcn_fence(__ATOMIC_ACQUIRE, "agent");
            asm volatile("s_waitcnt vmcnt(0)" ::: "memory");
        }
    }
    __syncthreads();
}

enum { PH_CONV, PH_INPROJ0, PH_LOCAL, PH_SCAN, PH_HOUT, PH_OUTPROJ0, PH_Q0, PH_TOPK0, PH_PD0, PH_PR0, PH_PU0, PH_INPROJ1, PH_SMALL, PH_MLAPREP, PH_MLA,
       PH_OUTPROJ1, PH_Q1, PH_TOPK1, PH_PD1, PH_PR1, PH_PU1, N_PHASES };
DEVI void run_phase(const Params& p, int ph_in, char* smem, Placement pl) {
    const bool dup = ph_in >= 100; const int ph = dup ? ph_in - 100 : ph_in;
#ifdef ONLY_PHASE
    if (ph != ONLY_PHASE) return;
#endif
    char* ws = p.ws;
    const int bid = blockIdx.x, nb = gridDim.x;
    const int myslice = (pl.nloc > 0) ? (pl.xcc & 7) : (bid & 7);
    switch (ph) {
    case PH_CONV: phase_convert(p, smem); break;
    case PH_INPROJ0: gemm2_phase((const bf16_t*)(ws + OFF_XB), 1024, (const bf16_t*)(ws + OFF_W_IN0T), 128, 12, 1024, (const float*)(ws + OFF_SSQ1), 1,
                        Epi2In0{(bf16_t*)(ws + OFF_Z0), (float*)(ws + OFF_G), (const float*)(ws + OFF_LB), (bf16_t*)(ws + OFF_Z0), 3072, 3072, nullptr, nullptr}, smem, pl); break;
    case PH_LOCAL: for (int it = bid; it < 1024; it += nb) hgrn_local_item(p, it, smem);
            for (int it = nb - 1 - bid; it < 512; it += nb) gmlp_item(p, it, smem);
            break;
    case PH_SCAN: hgrn_scan_phase(p); break;
    case PH_HOUT: for (int it = bid; it < 1024; it += nb) hgrn_out_item(p, it, smem); break;
    case PH_OUTPROJ0: case PH_OUTPROJ1: {
        const bool l1 = (ph == PH_OUTPROJ1);
        gemm2_phase((const bf16_t*)(ws + (l1 ? OFF_MIX1 : OFF_MIX0)), 1024, (const bf16_t*)(ws + (l1 ? OFF_W_OUT1T : OFF_W_OUT0T)), 128, 4, 1024, nullptr, 0,
                    Epi2Resid{(bf16_t*)(ws + OFF_XB), (float*)(ws + OFF_SSQ16), dup ? 0.f : (l1 ? ALPHA_M1 : ALPHA_M0), nullptr, 0, 0, nullptr, nullptr}, smem, pl);
    } break;
    case PH_Q0: case PH_Q1: {
        const bool l1 = (ph == PH_Q1);
        gemm2_phase((const bf16_t*)(ws + OFF_XB), 1024, (const bf16_t*)(ws + (l1 ? OFF_W_Q1T : OFF_W_Q0T)), 128, 8, 1024, (const float*)(ws + OFF_SSQ16), 16,
                    Epi2Bf16{(bf16_t*)(ws + OFF_QP), 2048, 2048, nullptr, nullptr}, smem, pl);
    } break;
    case PH_TOPK0: case PH_TOPK1: peer_topk_phase(p, (const bf16_t*)(ws + (ph == PH_TOPK1 ? OFF_SK1 : OFF_SK0)), bid, nb, smem); break;
    case PH_PD0: case PH_PD1: peer_down_phase(p, (ph == PH_PD1) ? p.l1_norm_ffn : p.l0_norm_ffn, ((ph == PH_PD1) ? 16 : 0) + (dup ? 32 : 0), myslice, smem); break;
    case PH_PR0: case PH_PR1: peer_reduce_phase(p); break;
    case PH_PU0: case PH_PU1: peer_up_phase(p, ((ph == PH_PU1) ? 24 : 8) + (dup ? 32 : 0), myslice, dup ? 0.f : ((ph == PH_PU1) ? ALPHA_P1 : ALPHA_P0), (ph == PH_PU1 && !dup) ? p.out : nullptr, smem); break;
    case PH_INPROJ1: gemm2_phase((const bf16_t*)(ws + OFF_XB), 1024, (const bf16_t*)(ws + OFF_W_IN1T), 128, 8, 1024, (const float*)(ws + OFF_SSQ8), 8, Epi2Bf16{(bf16_t*)(ws + OFF_Z1), 1984, 1984, (float*)(ws + OFF_SSQCQ), (float*)(ws + OFF_SSQCKV)}, smem, pl);
            for (int it = bid; it < 8192; it += nb) conv_experts(p.l1_exp_down, p.l1_exp_up, p.l1_norm_ffn, ws, it);
            break;
    case PH_SMALL: {
        gemm2_phase((const bf16_t*)(ws + OFF_Z1), 1984, (const bf16_t*)(ws + OFF_W_UQT), 128, 3, 256, (const float*)(ws + OFF_SSQCQ), 1, Epi2Bf16{(bf16_t*)(ws + OFF_QC), 768, 768, nullptr, nullptr}, smem, pl);
        gemm2_phase((const bf16_t*)(ws + OFF_Z1) + 256, 1984, (const bf16_t*)(ws + OFF_W_UKVT), 128, 4, 128, (const float*)(ws + OFF_SSQCKV), 1, Epi2Bf16{(bf16_t*)(ws + OFF_KV), 1024, 1024, nullptr, nullptr}, smem, pl);
        for (int it = (bid + nb / 2) % nb; it < 1024 + 256; it += nb) { if (it < 1024) moba_prep_item(p, it, smem); else moba_kmean_item(p, it - 1024, smem); }
    } break;
    case PH_MLAPREP: for (int it = bid; it < 1024; it += nb) mla_prep_item(p, it, smem); break;
    case PH_MLA: attn_phase_all(p, smem); break;
    default: break;
    }
}

extern "C" __global__ void __launch_bounds__(NTHREADS, 2) fwd_kernel(Params p) {
    extern __shared__ __attribute__((aligned(16))) char smem[];
    __shared__ uint4 xb_words;
    XcdBarrier xb; xb.bar = nullptr; xb.x = 0; xb.st = (volatile LAS unsigned*)&xb_words;
    if (p.coop) {
        if (threadIdx.x == 0) xb_words = make_uint4(0u, 0u, 0u, 0u);
        __syncthreads();
        xb = xcd_barrier_post((unsigned*)(p.ws + OFF_BAR), (volatile LAS unsigned*)&xb_words);
    }
    if (p.coop == 2) cg::this_grid().sync();
#define RUN_PH(PH) if (p.ph_lo <= PH && PH < p.ph_hi) { \
        Placement pl_; pl_.xcc = p.coop ? (int)xb.st[3] : 0; pl_.rank = p.coop ? (int)xb.st[2] : 0; pl_.nloc = p.coop ? (int)xb.st[0] : 0; pl_.nx = p.coop ? (int)xb.st[1] : 0; \
        if (PROBE_DUP == PH) { run_phase(p, PH + 100, smem, pl_); if (p.coop) xcd_barrier(xb); } \
        run_phase(p, PH, smem, pl_); if (p.coop && PH + 1 < p.ph_hi) xcd_barrier(xb); }
    RUN_PH(0) RUN_PH(1) RUN_PH(2) RUN_PH(3) RUN_PH(4) RUN_PH(5) RUN_PH(6) RUN_PH(7) RUN_PH(8) RUN_PH(9)
    RUN_PH(10) RUN_PH(11) RUN_PH(12) RUN_PH(13) RUN_PH(14) RUN_PH(15) RUN_PH(16) RUN_PH(17) RUN_PH(18) RUN_PH(19) RUN_PH(20)
}

extern "C" void kernel_launch(void* const* d_in, const int* in_sizes, int n_in, void* d_out, int out_size, void* d_ws, size_t ws_size, hipStream_t stream) {
    static int grid = 0;
    if (grid == 0) {
        if (n_in != 31 || out_size != 16384 * 1024 || ws_size < WS_NEED) { fprintf(stderr, "kernel_launch: unexpected shapes (n_in %d out %d ws %zu need %zu)\n", n_in, out_size, ws_size, (size_t)WS_NEED); grid = -1; return; }
        int dev = 0, cus = 0, per_cu = 0;
        hipGetDevice(&dev);
        hipDeviceGetAttribute(&cus, hipDeviceAttributeMultiprocessorCount, dev);
        if (hipFuncSetAttribute((const void*)fwd_kernel, hipFuncAttributeMaxDynamicSharedMemorySize, LDS_BYTES) != hipSuccess) { fprintf(stderr, "kernel_launch: hipFuncSetAttribute failed\n"); grid = -1; return; }
        if (hipOccupancyMaxActiveBlocksPerMultiprocessor(&per_cu, (const void*)fwd_kernel, NTHREADS, LDS_BYTES) != hipSuccess || per_cu < 1) { fprintf(stderr, "kernel_launch: occupancy query failed (%d)\n", per_cu); per_cu = 1; }
        (void)hipGetLastError();
        if (per_cu > 2) per_cu = 2;
        grid = cus * per_cu;
        fprintf(stderr, "kernel_launch: grid %d (%d CUs x %d)\n", grid, cus, per_cu);
    }
    if (grid < 0) return;
    Params p; memset(&p, 0, sizeof(p));
    const float* const* f = (const float* const*)d_in;
    p.x = f[0]; p.pos = (const int*)d_in[1]; p.lb_logits = f[2];
    p.l0_norm_mix = f[3]; p.l0_w_in = f[4]; p.l0_hgrn_out_norm = f[5]; p.l0_gmlp_v_norm = f[6]; p.l0_gmlp_w_s = f[7]; p.l0_gmlp_b_s = f[8]; p.l0_w_out = f[9];
    p.l0_norm_ffn = f[10]; p.l0_w_query = f[11]; p.l0_sub_keys = f[12]; p.l0_exp_down = f[13]; p.l0_exp_up = f[14];
    p.l1_norm_mix = f[15]; p.l1_w_in = f[16]; p.l1_cq_norm = f[17]; p.l1_ckv_norm = f[18]; p.l1_w_uq = f[19]; p.l1_w_ukv = f[20];
    p.l1_q_norm = f[21]; p.l1_k_norm = f[22]; p.l1_mq_norm = f[23]; p.l1_mk_norm = f[24]; p.l1_w_out = f[25];
    p.l1_norm_ffn = f[26]; p.l1_w_query = f[27]; p.l1_sub_keys = f[28]; p.l1_exp_down = f[29]; p.l1_exp_up = f[30];
    p.out = (float*)d_out; p.ws = (char*)d_ws;
    if (hipMemsetAsync((char*)d_ws + OFF_BAR, 0, 16384 + 4096, stream) != hipSuccess) { fprintf(stderr, "kernel_launch: memset failed\n"); return; }
#if N_LAUNCH_MODE == 1
    p.ph_lo = 0; p.ph_hi = N_PHASES; p.coop = 1;
    void* args[] = {&p};
    hipError_t e = hipLaunchCooperativeKernel((const void*)fwd_kernel, dim3(grid), dim3(NTHREADS), args, LDS_BYTES, stream);
    if (e != hipSuccess) fprintf(stderr, "cooperative launch failed: %s (grid %d)\n", hipGetErrorString(e), grid);
#else
    for (int ph = 0; ph < N_PHASES; ++ph) {
#ifdef ABLATE_M1
        if (ph >= 10 && ph <= 14) continue;
#endif
        p.ph_lo = ph; p.ph_hi = ph + 1; p.coop = 0;
        hipLaunchKernelGGL(fwd_kernel, dim3(grid), dim3(NTHREADS), LDS_BYTES, stream, p);
    }
#endif
}
```

```cpp
#include <hip/hip_runtime.h>
#include <hip/hip_cooperative_groups.h>
#include <stdint.h>
#include <stdio.h>
#include <string.h>
namespace cg = cooperative_groups;

#ifndef ALPHA_P0
#define ALPHA_P0 1.0f
#endif
#ifndef ALPHA_P1
#define ALPHA_P1 1.0f
#endif
#ifndef ALPHA_M0
#define ALPHA_M0 1.0f
#endif
#ifndef ALPHA_M1
#define ALPHA_M1 1.0f
#endif
#ifndef PROBE_DUP
#define PROBE_DUP -1
#endif
#ifndef N_LAUNCH_MODE
#define N_LAUNCH_MODE 1
#endif

typedef unsigned short bf16_t;
using bf16x8 = __attribute__((ext_vector_type(8))) short;
using f32x4  = __attribute__((ext_vector_type(4))) float;
using f32x16 = __attribute__((ext_vector_type(16))) float;
typedef float f32x4v __attribute__((ext_vector_type(4)));
typedef float f32x2_t __attribute__((ext_vector_type(2)));
typedef __bf16 bf16x2_t __attribute__((ext_vector_type(2)));
typedef unsigned u32x4 __attribute__((ext_vector_type(4)));

#define DEVI __device__ __forceinline__
#define NTHREADS 256
#define LDS_BYTES 80896

static constexpr size_t MB = 1024 * 1024;
static constexpr size_t OFF_W_IN0T  = 0;
static constexpr size_t OFF_W_OUT0T = OFF_W_IN0T  + 3072ull * 1024 * 2;
static constexpr size_t OFF_W_Q0T   = OFF_W_OUT0T + 1024ull * 1024 * 2;
static constexpr size_t OFF_SK0     = OFF_W_Q0T   + 2048ull * 1024 * 2;
static constexpr size_t OFF_WS0     = OFF_SK0     + 262144ull * 2;
static constexpr size_t OFF_W_IN1T  = OFF_WS0     + 65536ull * 2;
static constexpr size_t OFF_W_UQT   = OFF_W_IN1T  + 2048ull * 1024 * 2;
static constexpr size_t OFF_W_UKVT  = OFF_W_UQT   + 768ull * 256 * 2;
static constexpr size_t OFF_W_OUT1T = OFF_W_UKVT  + 1024ull * 128 * 2;
static constexpr size_t OFF_W_Q1T   = OFF_W_OUT1T + 1024ull * 1024 * 2;
static constexpr size_t OFF_SK1     = OFF_W_Q1T   + 2048ull * 1024 * 2;
static constexpr size_t OFF_LB      = OFF_SK1     + 262144ull * 2;
static constexpr size_t OFF_INVD    = OFF_LB + 4096;
static constexpr size_t OFF_INVU    = OFF_INVD + 65536;
static constexpr size_t OFF_BAR     = OFF_INVU + 65536;
static constexpr size_t OFF_QCNT    = OFF_BAR + 14336;
static constexpr size_t OFF_ED      = 26 * MB;
static constexpr size_t OFF_EU      = OFF_ED + 32 * MB;
static constexpr size_t OFF_ACT     = OFF_EU + 32 * MB;
static constexpr size_t OFF_Z0   = OFF_ACT;
static constexpr size_t OFF_G    = OFF_Z0  + 16384ull * 3072 * 2;
static constexpr size_t OFF_HST  = OFF_G   + 16384ull * 512 * 4;
static constexpr size_t OFF_DEC  = OFF_HST + 1024ull * 16384 * 4;
static constexpr size_t OFF_MIX0 = OFF_DEC + 1024ull * 128 * 4;
static constexpr size_t OFF_QP   = OFF_ACT;
static constexpr size_t OFF_IDX  = OFF_QP  + 16384ull * 2048 * 2;
static constexpr size_t OFF_GATE = OFF_IDX + 16384ull * 128 * 4;
static constexpr size_t OFF_ACTW = OFF_GATE + 16384ull * 128 * 4;
static constexpr size_t OFF_PART = OFF_QP;
static constexpr size_t OFF_SDN  = OFF_ACTW + 16384ull * 128 * 4;
static constexpr size_t OFF_Z1   = OFF_ACT;
static constexpr size_t OFF_MIX1 = OFF_ACT;
static constexpr size_t OFF_QC   = OFF_Z1  + 16384ull * 1984 * 2;
static constexpr size_t OFF_KV   = OFF_QC  + 16384ull * 768 * 2;
static constexpr size_t OFF_QD   = OFF_KV  + 16384ull * 1024 * 2;
static constexpr size_t OFF_KD   = OFF_QD  + 16384ull * 512 * 2;
static constexpr size_t OFF_VDT  = OFF_KD  + 16384ull * 512 * 2;
static constexpr size_t OFF_Q    = OFF_VDT + 16384ull * 512 * 2;
static constexpr size_t OFF_K    = OFF_Q   + 16384ull * 768 * 2;
static constexpr size_t OFF_VT   = OFF_K   + 16384ull * 768 * 2;
static constexpr size_t OFF_KMEAN= OFF_VT  + 16384ull * 512 * 2;
static constexpr size_t WS_END_L1 = OFF_KMEAN + 8ull * 32 * 128 * 4;
static constexpr size_t WS_END_L0 = OFF_MIX0 + 16384ull * 1024 * 2;
static constexpr size_t WS_END_ACT = (WS_END_L1 > WS_END_L0 ? WS_END_L1 : WS_END_L0);
static constexpr size_t OFF_XB    = (WS_END_ACT + 255) / 256 * 256;
static constexpr size_t OFF_SSQ1  = OFF_XB + 16384ull * 1024 * 2;
static constexpr size_t OFF_SSQ16 = OFF_SSQ1 + 16384ull * 4;
static constexpr size_t OFF_SSQ8  = OFF_SSQ16 + 16384ull * 16 * 4;
static constexpr size_t OFF_XB8   = OFF_ED + 16 * MB;
static constexpr size_t OFF_SSQCQ = OFF_SSQ8 + 16384ull * 8 * 4;
static constexpr size_t OFF_SSQCKV = OFF_SSQCQ + 16384ull * 4;
static constexpr size_t WS_NEED = OFF_SSQCKV + 16384ull * 4;
static_assert(OFF_BAR + 16384 + 4096 <= OFF_ED, "weights overflow");

struct Params {
    const float* x; const int* pos; const float* lb_logits;
    const float *l0_norm_mix, *l0_w_in, *l0_hgrn_out_norm, *l0_gmlp_v_norm, *l0_gmlp_w_s, *l0_gmlp_b_s, *l0_w_out,
                *l0_norm_ffn, *l0_w_query, *l0_sub_keys, *l0_exp_down, *l0_exp_up;
    const float *l1_norm_mix, *l1_w_in, *l1_cq_norm, *l1_ckv_norm, *l1_w_uq, *l1_w_ukv, *l1_q_norm, *l1_k_norm,
                *l1_mq_norm, *l1_mk_norm, *l1_w_out, *l1_norm_ffn, *l1_w_query, *l1_sub_keys, *l1_exp_down, *l1_exp_up;
    float* out;
    char* ws;
    int ph_lo, ph_hi, coop, pad0;
};

DEVI unsigned pack2(float lo, float hi) { f32x2_t v = {lo, hi}; bf16x2_t b = __builtin_convertvector(v, bf16x2_t); return __builtin_bit_cast(unsigned, b); }
DEVI bf16_t f2bf(float f) { return (bf16_t)(pack2(f, 0.f) & 0xffffu); }
DEVI float bf2f(bf16_t h) { return __uint_as_float(((unsigned)h) << 16); }
DEVI float bflo(unsigned u) { return __uint_as_float(u << 16); }
DEVI float bfhi(unsigned u) { return __uint_as_float(u & 0xffff0000u); }
DEVI float sigm(float x) { return 1.f / (1.f + __expf(-x)); }
DEVI float gelu_tanh(float x) {
    float y = 0.7978845608028654f * (x + 0.044715f * x * x * x);
    float e = __expf(2.f * y);
    float t = 1.f - 2.f / (1.f + e);
    return 0.5f * x * (1.f + t);
}
DEVI char* opaque_ptr(char* q) { asm volatile("" : "+s"(q)); return q; }
DEVI f32x4  mfma16(bf16x8 a, bf16x8 b, f32x4 c)  { return __builtin_amdgcn_mfma_f32_16x16x32_bf16(a, b, c, 0, 0, 0); }
DEVI f32x16 mfma32(bf16x8 a, bf16x8 b, f32x16 c) { return __builtin_amdgcn_mfma_f32_32x32x16_bf16(a, b, c, 0, 0, 0); }

template <int KW> DEVI int swz_off(int row, int c) {
    if constexpr (KW == 128) return row * 256 + ((c ^ (row & 15)) << 4);
    else return row * (KW * 2) + ((c ^ ((row >> 1) & 7)) << 4);
}
template <int KW> DEVI int swz_elem(int row, int k) { return swz_off<KW>(row, k >> 3) + ((k & 7) << 1); }

template <int MT, int NT, int KWA, int KWB>
DEVI void mma_nt(f32x4 (&acc)[MT][NT], const char* A, int a_row0, const char* B, int b_row0, int kc0, int nks, int lane) {
    const int r = lane & 15, q = lane >> 4;
#pragma unroll 1
    for (int ks = 0; ks < nks; ++ks) {
        bf16x8 a[MT], b[NT];
#pragma unroll
        for (int i = 0; i < MT; ++i) a[i] = *(const bf16x8*)(A + swz_off<KWA>(a_row0 + 16 * i + r, kc0 + ks * 4 + q));
#pragma unroll
        for (int j = 0; j < NT; ++j) b[j] = *(const bf16x8*)(B + swz_off<KWB>(b_row0 + 16 * j + r, kc0 + ks * 4 + q));
#pragma unroll
        for (int i = 0; i < MT; ++i)
#pragma unroll
            for (int j = 0; j < NT; ++j) acc[i][j] = mfma16(a[i], b[j], acc[i][j]);
    }
}

DEVI void conv_transpose_tile(const float* __restrict__ src, int K, int N, bf16_t* __restrict__ dst, int kt, int nt, char* smem, const float* __restrict__ kgain = nullptr) {
    float* s = (float*)smem;
    const int tid = threadIdx.x;
    for (int e = tid; e < 4096; e += NTHREADS) {
        int kk = e >> 6, nn = e & 63;
        int n = nt * 64 + nn;
        const float gk = kgain ? kgain[kt * 64 + kk] : 1.f;
        s[kk * 65 + nn] = (n < N) ? src[(size_t)(kt * 64 + kk) * N + n] * gk : 0.f;
    }
    __syncthreads();
    for (int e = tid; e < 2048; e += NTHREADS) {
        int nn = e >> 5, kp = e & 31;
        unsigned v = pack2(s[(2 * kp) * 65 + nn], s[(2 * kp + 1) * 65 + nn]);
        *(unsigned*)(dst + (size_t)(nt * 64 + nn) * K + kt * 64 + 2 * kp) = v;
    }
    __syncthreads();
}
DEVI void conv_plain_chunk(const float* __restrict__ src, bf16_t* __restrict__ dst, size_t chunk) {
    const int tid = threadIdx.x;
    size_t base = chunk * 4096 + (size_t)tid * 16;
    const float4* s4 = (const float4*)(src + base);
    float4 a = s4[0], b = s4[1], c = s4[2], d = s4[3];
    uint4 o0, o1;
    o0.x = pack2(a.x, a.y); o0.y = pack2(a.z, a.w); o0.z = pack2(b.x, b.y); o0.w = pack2(b.z, b.w);
    o1.x = pack2(c.x, c.y); o1.y = pack2(c.z, c.w); o1.z = pack2(d.x, d.y); o1.w = pack2(d.z, d.w);
    uint4* d4 = (uint4*)(dst + base);
    d4[0] = o0; d4[1] = o1;
}
DEVI void conv_experts(const float* down, const float* up, const float* __restrict__ dgain, char* ws, int it  ) {
    const int lane = threadIdx.x & 63, wave = threadIdx.x >> 6;
    const bool isup = it >= 4096;
    const int row = (isup ? it - 4096 : it) * 4 + wave;
    const float* src = (isup ? up : down) + (size_t)row * 1024 + 16 * lane;
    float4 a = *(const float4*)src, b = *(const float4*)(src + 4), c = *(const float4*)(src + 8), d = *(const float4*)(src + 12);
    if (!isup) {
        const float4 ga = *(const float4*)(dgain + 16 * lane), gb = *(const float4*)(dgain + 16 * lane + 4), gc = *(const float4*)(dgain + 16 * lane + 8), gd = *(const float4*)(dgain + 16 * lane + 12);
        a.x *= ga.x; a.y *= ga.y; a.z *= ga.z; a.w *= ga.w; b.x *= gb.x; b.y *= gb.y; b.z *= gb.z; b.w *= gb.w;
        c.x *= gc.x; c.y *= gc.y; c.z *= gc.z; c.w *= gc.w; d.x *= gd.x; d.y *= gd.y; d.z *= gd.z; d.w *= gd.w;
    }
    float mx = fmaxf(fmaxf(fmaxf(fabsf(a.x), fabsf(a.y)), fmaxf(fabsf(a.z), fabsf(a.w))), fmaxf(fmaxf(fabsf(b.x), fabsf(b.y)), fmaxf(fabsf(b.z), fabsf(b.w))));
    mx = fmaxf(mx, fmaxf(fmaxf(fmaxf(fabsf(c.x), fabsf(c.y)), fmaxf(fabsf(c.z), fabsf(c.w))), fmaxf(fmaxf(fabsf(d.x), fabsf(d.y)), fmaxf(fabsf(d.z), fabsf(d.w)))));
#pragma unroll
    for (int o = 1; o < 64; o <<= 1) mx = fmaxf(mx, __shfl_xor(mx, o));
    const float sc = (mx > 0.f) ? 416.f / mx : 1.f;
    const float inv = (mx > 0.f) ? mx / 416.f : 1.f;
    int w0 = 0, w1 = 0, w2 = 0, w3 = 0;
    w0 = __builtin_amdgcn_cvt_pk_fp8_f32(a.x * sc, a.y * sc, w0, false); w0 = __builtin_amdgcn_cvt_pk_fp8_f32(a.z * sc, a.w * sc, w0, true);
    w1 = __builtin_amdgcn_cvt_pk_fp8_f32(b.x * sc, b.y * sc, w1, false); w1 = __builtin_amdgcn_cvt_pk_fp8_f32(b.z * sc, b.w * sc, w1, true);
    w2 = __builtin_amdgcn_cvt_pk_fp8_f32(c.x * sc, c.y * sc, w2, false); w2 = __builtin_amdgcn_cvt_pk_fp8_f32(c.z * sc, c.w * sc, w2, true);
    w3 = __builtin_amdgcn_cvt_pk_fp8_f32(d.x * sc, d.y * sc, w3, false); w3 = __builtin_amdgcn_cvt_pk_fp8_f32(d.z * sc, d.w * sc, w3, true);
    *(int4*)(ws + (isup ? OFF_EU : OFF_ED) + ((size_t)(lane >> 3) * 16384 + row) * 128 + 16 * (lane & 7)) = int4{w0, w1, w2, w3};
    if (lane == 0) ((float*)(ws + (isup ? OFF_INVU : OFF_INVD)))[row] = inv;
}

DEVI void phase_convert(const Params& p, char* smem) {
    char* ws = p.ws;
    const int bid = blockIdx.x, nb = gridDim.x;
    for (int t = bid; t < 768; t += nb) conv_transpose_tile(p.l0_w_in,    1024, 3072, (bf16_t*)(ws + OFF_W_IN0T),  t / 48, t % 48, smem, p.l0_norm_mix);
    for (int t = (bid + nb - 256 % nb) % nb; t < 256; t += nb) conv_transpose_tile(p.l0_w_out,   1024, 1024, (bf16_t*)(ws + OFF_W_OUT0T), t / 16, t % 16, smem);
    for (int t = bid; t < 512; t += nb) conv_transpose_tile(p.l0_w_query, 1024, 2048, (bf16_t*)(ws + OFF_W_Q0T),   t / 32, t % 32, smem, p.l0_norm_ffn);
    for (int t = bid; t < 512; t += nb) conv_transpose_tile(p.l1_w_in,    1024, 1984, (bf16_t*)(ws + OFF_W_IN1T),  t / 32, t % 32, smem, p.l1_norm_mix);
    for (int t = bid; t < 48; t += nb)  conv_transpose_tile(p.l1_w_uq,     256,  768, (bf16_t*)(ws + OFF_W_UQT),   t / 12, t % 12, smem, p.l1_cq_norm);
    for (int t = nb - 1 - bid; t < 32; t += nb)  conv_transpose_tile(p.l1_w_ukv,    128, 1024, (bf16_t*)(ws + OFF_W_UKVT),  t / 16, t % 16, smem, p.l1_ckv_norm);
    for (int t = (bid + nb - 256 % nb) % nb; t < 256; t += nb) conv_transpose_tile(p.l1_w_out,   1024, 1024, (bf16_t*)(ws + OFF_W_OUT1T), t / 16, t % 16, smem);
    for (int t = bid; t < 512; t += nb) conv_transpose_tile(p.l1_w_query, 1024, 2048, (bf16_t*)(ws + OFF_W_Q1T),   t / 32, t % 32, smem, p.l1_norm_ffn);
    for (int t = bid - 64; t < 64; t += nb) if (t >= 0) conv_plain_chunk(p.l0_sub_keys, (bf16_t*)(ws + OFF_SK0), t);
    for (int t = bid - 128; t < 64; t += nb) if (t >= 0) conv_plain_chunk(p.l1_sub_keys, (bf16_t*)(ws + OFF_SK1), t);
    for (int chunk = bid - 192; chunk < 16; chunk += nb) if (chunk >= 0) {
        bf16_t* dst = (bf16_t*)(ws + OFF_WS0);
        for (int e = threadIdx.x; e < 4096; e += NTHREADS) {
            int idx = chunk * 4096 + e; int t = (idx >> 7) & 127, sI = idx & 127;
            dst[idx] = f2bf(sI <= t ? p.l0_gmlp_w_s[idx] : 0.f);
        }
    }
    if (bid == nb - 1) {
        float* lb = (float*)(ws + OFF_LB);
        for (int c = threadIdx.x; c < 512; c += NTHREADS) {
            float a0 = p.lb_logits[c], a1 = p.lb_logits[512 + c], a2 = p.lb_logits[1024 + c];
            float m = fmaxf(a0, fmaxf(a1, a2));
            float e0 = __expf(a0 - m), e1 = __expf(a1 - m), e2 = __expf(a2 - m);
            lb[c] = e0 / (e0 + e1 + e2);
        }
    }
    for (int it = bid; it < 8192; it += nb) conv_experts(p.l0_exp_down, p.l0_exp_up, p.l0_norm_ffn, ws, it);
    {
        const int lane = threadIdx.x & 63, wave = threadIdx.x >> 6;
        for (int it = bid; it < 4096; it += nb) {
            const size_t row = (size_t)it * 4 + wave;
            const float* xr = p.x + row * 1024 + 16 * lane;
            const float4 a = *(const float4*)xr, b = *(const float4*)(xr + 4), c = *(const float4*)(xr + 8), d = *(const float4*)(xr + 12);
            float ss = a.x * a.x + a.y * a.y + a.z * a.z + a.w * a.w + b.x * b.x + b.y * b.y + b.z * b.z + b.w * b.w
                     + c.x * c.x + c.y * c.y + c.z * c.z + c.w * c.w + d.x * d.x + d.y * d.y + d.z * d.z + d.w * d.w;
#pragma unroll
            for (int o = 1; o < 64; o <<= 1) ss += __shfl_xor(ss, o);
            uint4 o0, o1;
            o0.x = pack2(a.x, a.y); o0.y = pack2(a.z, a.w); o0.z = pack2(b.x, b.y); o0.w = pack2(b.z, b.w);
            o1.x = pack2(c.x, c.y); o1.y = pack2(c.z, c.w); o1.z = pack2(d.x, d.y); o1.w = pack2(d.z, d.w);
            bf16_t* xb = (bf16_t*)(ws + OFF_XB) + row * 1024 + 16 * lane;
            *(uint4*)xb = o0; *(uint4*)(xb + 8) = o1;
            if (lane == 0) ((float*)(ws + OFF_SSQ1))[row] = ss;
        }
    }
}

template <int AMODE, class Epi>
DEVI void gemm_phase(const void* __restrict__ Aptr, int lda, const float* __restrict__ gain, const bf16_t* __restrict__ Bt,
                           int M, int Npad, int K, Epi epi, char* smem, int blk0, int nblk) {
    const int tid = threadIdx.x, lane = tid & 63, wave = tid >> 6;
    const int wm = wave >> 1, wn = wave & 1;
    const int tn = Npad / 128, tm = M / 128, nkt = K / 64;
    float* sRstd = (float*)(smem + 65536);
    const int crow = tid >> 3, cc = tid & 7;
    for (int tile = blk0; tile < tm * tn; tile += nblk) {
        const int m0 = (tile / tn) * 128, n0 = (tile % tn) * 128;
        f32x4 acc[4][4];
#pragma unroll
        for (int i = 0; i < 4; ++i)
#pragma unroll
            for (int j = 0; j < 4; ++j) acc[i][j] = f32x4{0.f, 0.f, 0.f, 0.f};
        float ss[4] = {0.f, 0.f, 0.f, 0.f};
        f32x4v ra[4][2]; u32x4 rab[4]; u32x4 rb[4]; f32x4v g0, g1;
        auto gload = [&](int kt) {
            const int k0 = kt * 64 + cc * 8;
#pragma unroll
            for (int i = 0; i < 4; ++i) {
                const int row = crow + 32 * i;
                if constexpr (AMODE == 0) {
                    const float* pa = (const float*)Aptr + (size_t)(m0 + row) * lda + k0;
                    ra[i][0] = *(const f32x4v*)pa; ra[i][1] = *(const f32x4v*)(pa + 4);
                } else {
                    const bf16_t* pa = (const bf16_t*)Aptr + (size_t)(m0 + row) * lda + k0;
                    rab[i] = *(const u32x4*)pa;
                }
                rb[i] = *(const u32x4*)(Bt + (size_t)(n0 + row) * K + k0);
            }
            if constexpr (AMODE != 1) { g0 = *(const f32x4v*)(gain + k0); g1 = *(const f32x4v*)(gain + k0 + 4); }
        };
        auto lstore = [&](int buf) {
            char* sA = smem + buf * 32768; char* sB = sA + 16384;
#pragma unroll
            for (int i = 0; i < 4; ++i) {
                const int row = crow + 32 * i;
                u32x4 o;
                if constexpr (AMODE == 0) {
                    f32x4v a = ra[i][0], b = ra[i][1];
                    ss[i] += a.x * a.x + a.y * a.y + a.z * a.z + a.w * a.w + b.x * b.x + b.y * b.y + b.z * b.z + b.w * b.w;
                    o.x = pack2(a.x * g0.x, a.y * g0.y); o.y = pack2(a.z * g0.z, a.w * g0.w);
                    o.z = pack2(b.x * g1.x, b.y * g1.y); o.w = pack2(b.z * g1.z, b.w * g1.w);
                } else if constexpr (AMODE == 2) {
                    u32x4 u = rab[i];
                    float a0 = bflo(u.x), a1 = bfhi(u.x), a2 = bflo(u.y), a3 = bfhi(u.y), a4 = bflo(u.z), a5 = bfhi(u.z), a6 = bflo(u.w), a7 = bfhi(u.w);
                    ss[i] += a0 * a0 + a1 * a1 + a2 * a2 + a3 * a3 + a4 * a4 + a5 * a5 + a6 * a6 + a7 * a7;
                    o.x = pack2(a0 * g0.x, a1 * g0.y); o.y = pack2(a2 * g0.z, a3 * g0.w);
                    o.z = pack2(a4 * g1.x, a5 * g1.y); o.w = pack2(a6 * g1.z, a7 * g1.w);
                } else o = rab[i];
                *(u32x4*)(sA + swz_off<64>(row, cc)) = o;
                *(u32x4*)(sB + swz_off<64>(row, cc)) = rb[i];
            }
        };
        gload(0); lstore(0); __syncthreads();
#pragma unroll 1
        for (int kt = 0; kt < nkt; ++kt) {
            if (kt + 1 < nkt) gload(kt + 1);
            const char* sA = smem + (kt & 1) * 32768; const char* sB = sA + 16384;
            mma_nt<4, 4, 64, 64>(acc, sA, wm * 64, sB, wn * 64, 0, 2, lane);
            if (kt + 1 < nkt) lstore((kt + 1) & 1);
            __syncthreads();
        }
        if constexpr (AMODE != 1) {
#pragma unroll
            for (int i = 0; i < 4; ++i) {
                float s = ss[i];
                s += __shfl_xor(s, 1); s += __shfl_xor(s, 2); s += __shfl_xor(s, 4);
                if (cc == 0) sRstd[crow + 32 * i] = rsqrtf(s / (float)K + 1e-6f);
            }
            __syncthreads();
        }
#pragma unroll
        for (int i = 0; i < 4; ++i)
#pragma unroll
            for (int r = 0; r < 4; ++r) {
                const int rl = wm * 64 + i * 16 + (lane >> 4) * 4 + r;
                const float rs = (AMODE != 1) ? sRstd[rl] : 1.f;
#pragma unroll
                for (int j = 0; j < 4; ++j) epi(m0 + rl, n0 + wn * 64 + j * 16 + (lane & 15), acc[i][j][r] * rs);
                __builtin_amdgcn_sched_barrier(0);
            }
    }
}

struct Placement { int xcc, rank, nloc, nx; };
#define G2_RAW_BARRIER() do { asm volatile("s_waitcnt lgkmcnt(0)" ::: "memory"); __builtin_amdgcn_s_barrier(); } while (0)
template <class Epi>
DEVI void gemm2_phase(const bf16_t* __restrict__ A, int lda, const bf16_t* __restrict__ Bt, int tm, int tn, int K,
                      const float* __restrict__ ssq, int nss, Epi epi, char* smem, Placement pl) {
    const int tid = threadIdx.x, lane = tid & 63;
    const int wave = __builtin_amdgcn_readfirstlane(tid >> 6);
    const int wm = wave >> 1, wn = wave & 1;
    const int nkt = K / 32;
    constexpr int STG = 24576;
    float* sRstd = (float*)(smem + 3 * STG);
    int xcd = blockIdx.x & 7, slot = blockIdx.x >> 3, nslots = gridDim.x >> 3, nxc = 8;
    if (pl.nloc > 0) { xcd = pl.xcc; slot = pl.rank; nslots = pl.nloc; nxc = pl.nx; }
    const int np = (tm + nxc - 1) / nxc;
    const int per_xcd = ((np + 7) >> 3) * tn * 8;
    const int Rl = (lane >> 4) & 3, gl = (((Rl ^ (Rl >> 1)) & 1) << 1) | (Rl >> 1);
    const int Rr = (lane >> 2) & 3, gr = (((Rr ^ (Rr >> 1)) & 1) << 1) | (Rr >> 1);
    const int ld_row = lane >> 2, ld_c = (lane & 3) ^ gl;
    const int rd_off = (lane & 15) * 64 + (((lane >> 4) ^ gr) << 4);
    for (int t = slot; t < per_xcd; t += nslots) {
        const int mi = t & 7, rest = t >> 3, nt_ = rest % tn, mg = rest / tn;
        const int pidx = mg * 8 + mi, panel = xcd + nxc * pidx;
        if (pidx >= np || panel >= tm) continue;
        const int m0 = panel * 128, n0 = nt_ * 256;
        if (ssq) { if (tid < 128) { float sacc = 0.f; for (int i = 0; i < nss; ++i) sacc += ssq[(size_t)(m0 + tid) * nss + i]; sRstd[tid] = rsqrtf(sacc / (float)K + 1e-6f); } }
        else if (tid < 128) sRstd[tid] = 1.f;
        const bf16_t* ga = A  + (size_t)(m0 + 32 * wave + ld_row) * lda + ld_c * 8;
        const bf16_t* gb = Bt + (size_t)(n0 + 64 * wave + ld_row) * K   + ld_c * 8;
        f32x4 acc[4][8];
#pragma unroll
        for (int i = 0; i < 4; ++i)
#pragma unroll
            for (int j = 0; j < 8; ++j) acc[i][j] = f32x4{0.f, 0.f, 0.f, 0.f};
#define G2_ISSUE(KT) { char* st_ = smem + ((KT) % 3) * STG; const int ko_ = (KT) * 32; \
            __builtin_amdgcn_global_load_lds((const unsigned*)(ga + ko_),                    (unsigned*)(st_ + wave * 2048),               16, 0, 0); \
            __builtin_amdgcn_global_load_lds((const unsigned*)(ga + (size_t)16 * lda + ko_), (unsigned*)(st_ + wave * 2048 + 1024),        16, 0, 0); \
            __builtin_amdgcn_global_load_lds((const unsigned*)(gb + ko_),                    (unsigned*)(st_ + 8192 + wave * 4096),        16, 0, 0); \
            __builtin_amdgcn_global_load_lds((const unsigned*)(gb + (size_t)16 * K + ko_),   (unsigned*)(st_ + 8192 + wave * 4096 + 1024), 16, 0, 0); \
            __builtin_amdgcn_global_load_lds((const unsigned*)(gb + (size_t)32 * K + ko_),   (unsigned*)(st_ + 8192 + wave * 4096 + 2048), 16, 0, 0); \
            __builtin_amdgcn_global_load_lds((const unsigned*)(gb + (size_t)48 * K + ko_),   (unsigned*)(st_ + 8192 + wave * 4096 + 3072), 16, 0, 0); }
        G2_ISSUE(0) G2_ISSUE(1)
#pragma unroll 1
        for (int kt = 0; kt < nkt; ++kt) {
            if (kt + 1 < nkt) asm volatile("s_waitcnt vmcnt(6)" ::: "memory");
            else asm volatile("s_waitcnt vmcnt(0)" ::: "memory");
            G2_RAW_BARRIER();
            if (kt + 2 < nkt) G2_ISSUE(kt + 2)
            const char* sA = smem + (kt % 3) * STG + rd_off; const char* sB = sA + 8192;
            bf16x8 a[4], b[8];
#pragma unroll
            for (int i = 0; i < 4; ++i) a[i] = *(const bf16x8*)(sA + (wm * 64 + 16 * i) * 64);
#pragma unroll
            for (int j = 0; j < 8; ++j) b[j] = *(const bf16x8*)(sB + (wn * 128 + 16 * j) * 64);
#pragma unroll
            for (int i = 0; i < 4; ++i)
#pragma unroll
                for (int j = 0; j < 8; ++j) acc[i][j] = mfma16(b[j], a[i], acc[i][j]);
        }
#undef G2_ISSUE
        if (epi.staged(n0)) {
            G2_RAW_BARRIER();
#pragma unroll
            for (int i = 0; i < 4; ++i) {
                const int rl = wm * 64 + i * 16 + (lane & 15);
                const float rs = sRstd[rl];
                char* trow = smem + rl * 528 + (wn * 128 + 4 * (lane >> 4)) * 2;
#pragma unroll
                for (int j = 0; j < 8; ++j) {
                    const int nc = n0 + wn * 128 + 16 * j + 4 * (lane >> 4);
                    *(uint2*)(trow + 32 * j) = uint2{pack2(epi.map(nc, acc[i][j][0] * rs), epi.map(nc + 1, acc[i][j][1] * rs)), pack2(epi.map(nc + 2, acc[i][j][2] * rs), epi.map(nc + 3, acc[i][j][3] * rs))};
                }
            }
            __syncthreads();
            float* const sqp = (n0 == 0) ? epi.SQ0 : ((n0 == 256) ? epi.SQ1 : nullptr);
#pragma unroll 4
            for (int i = 0; i < 16; ++i) {
                const int e = tid + 256 * i, row = e >> 5, cc = e & 31;
                const uint4 v = *(const uint4*)(smem + row * 528 + cc * 16);
                if (n0 + cc * 8 < epi.N) *(uint4*)(epi.D + (size_t)(m0 + row) * epi.ldd + n0 + cc * 8) = v;
                if (sqp) {
                    float q = bflo(v.x) * bflo(v.x) + bfhi(v.x) * bfhi(v.x) + bflo(v.y) * bflo(v.y) + bfhi(v.y) * bfhi(v.y)
                            + bflo(v.z) * bflo(v.z) + bfhi(v.z) * bfhi(v.z) + bflo(v.w) * bflo(v.w) + bfhi(v.w) * bfhi(v.w);
                    if (n0 == 256 && cc >= 16) q = 0.f;
                    q += __shfl_xor(q, 1); q += __shfl_xor(q, 2); q += __shfl_xor(q, 4); q += __shfl_xor(q, 8); q += __shfl_xor(q, 16);
                    if (cc == 0) sqp[m0 + row] = q;
                }
            }
        } else {
#pragma unroll
            for (int i = 0; i < 4; ++i) {
                const int rl = wm * 64 + i * 16 + (lane & 15);
                const float rs = sRstd[rl];
                epi.row(m0 + rl, n0 + wn * 128 + 4 * (lane >> 4), acc[i], rs, lane);
                __builtin_amdgcn_sched_barrier(0);
            }
        }
        __syncthreads();
    }
}

struct Epi2In0 {
    bf16_t* Z0; float* G; const float* lb; bf16_t* D; int ldd; int N; float* SQ0; float* SQ1;
    DEVI bool staged(int n0) const { return (n0 >> 9) != 1; }
    DEVI float map(int n, float v) const { const int blk = n >> 9; return (blk == 0) ? v : ((blk <= 3) ? v * sigm(v) : gelu_tanh(v)); }
    DEVI void row(int m, int n, const f32x4 (&a)[8], float rs, int) const {
#pragma unroll
        for (int j = 0; j < 8; ++j) {
            const int c = n + 16 * j - 512;
            const float4 l4 = *(const float4*)(lb + c);
            float4 o;
            o.x = logf(l4.x + (1.f - l4.x) * sigm(a[j][0] * rs)); o.y = logf(l4.y + (1.f - l4.y) * sigm(a[j][1] * rs));
            o.z = logf(l4.z + (1.f - l4.z) * sigm(a[j][2] * rs)); o.w = logf(l4.w + (1.f - l4.w) * sigm(a[j][3] * rs));
            *(float4*)(G + (size_t)m * 512 + c) = o;
        }
    }
};
struct Epi2Bf16 {
    bf16_t* D; int ldd; int N; float* SQ0; float* SQ1;
    DEVI bool staged(int) const { return true; }
    DEVI float map(int, float v) const { return v; }
    DEVI void row(int, int, const f32x4 (&)[8], float, int) const {}
};
struct Epi2Resid {
    bf16_t* XB; float* SSQ16; float alpha; bf16_t* D; int ldd; int N; float* SQ0; float* SQ1;
    DEVI bool staged(int) const { return false; }
    DEVI float map(int, float v) const { return v; }
    DEVI void row(int m, int n, const f32x4 (&a)[8], float, int lane) const {
        float sq[2] = {0.f, 0.f};
#pragma unroll
        for (int j = 0; j < 8; ++j) {
            bf16_t* px = XB + (size_t)m * 1024 + n + 16 * j;
            const uint2 r = *(const uint2*)px;
            const unsigned w0 = pack2(bflo(r.x) + alpha * a[j][0], bfhi(r.x) + alpha * a[j][1]), w1 = pack2(bflo(r.y) + alpha * a[j][2], bfhi(r.y) + alpha * a[j][3]);
            *(uint2*)px = uint2{w0, w1};
            sq[j >> 2] += bflo(w0) * bflo(w0) + bfhi(w0) * bfhi(w0) + bflo(w1) * bflo(w1) + bfhi(w1) * bfhi(w1);
        }
#pragma unroll
        for (int g = 0; g < 2; ++g) {
            float v = sq[g];
            v += __shfl_xor(v, 16); v += __shfl_xor(v, 32);
            if ((lane >> 4) == 0) SSQ16[(size_t)m * 16 + ((n + 64 * g) >> 6)] = v;
        }
    }
};

struct EpiBf16 { bf16_t* D; int ldd; int N; DEVI void operator()(int m, int n, float v) const { if (n < N) D[(size_t)m * ldd + n] = f2bf(v); } };

DEVI void hgrn_local_item(const Params& p, int item, char* smem) {
    const int tid = threadIdx.x, lane = tid & 63, wave = tid >> 6;
    const int bh = item >> 7, c = item & 127, b = bh >> 2, h = bh & 3;
    const size_t m0 = (size_t)b * 8192 + c * 64;
    const float* G = (const float*)(p.ws + OFF_G) + m0 * 512 + h * 128;
    const bf16_t* Zv = (const bf16_t*)(p.ws + OFF_Z0) + m0 * 3072 + 1024 + h * 128;
    char* sVT = smem; char* sKd = smem + 16384;
    const int k = tid & 127, hf = tid >> 7;
    float bl = 0.f, bmid = 0.f;
#pragma unroll 8
    for (int t = 0; t < 64; ++t) { bl += G[t * 512 + k]; if (t == 31) bmid = bl; }
    float bcur = hf ? bmid : 0.f;
#pragma unroll 1
    for (int ch = 0; ch < 4; ++ch) {
        float kd[8], vv[8];
#pragma unroll
        for (int j = 0; j < 8; ++j) {
            const int t = 32 * hf + 8 * ch + j;
            const float g = G[t * 512 + k];
            bcur += g;
            kd[j] = (1.f - __expf(g)) * __expf(bl - bcur);
            vv[j] = bf2f(Zv[(size_t)t * 3072 + k]);
        }
        uint4 o; o.x = pack2(kd[0], kd[1]); o.y = pack2(kd[2], kd[3]); o.z = pack2(kd[4], kd[5]); o.w = pack2(kd[6], kd[7]);
        *(uint4*)(sKd + swz_off<64>(k, 4 * hf + ch)) = o;
        uint4 w; w.x = pack2(vv[0], vv[1]); w.y = pack2(vv[2], vv[3]); w.z = pack2(vv[4], vv[5]); w.w = pack2(vv[6], vv[7]);
        *(uint4*)(sVT + swz_off<64>(k, 4 * hf + ch)) = w;
    }
    if (hf == 0) ((float*)(p.ws + OFF_DEC))[item * 128 + k] = __expf(bl);
    __syncthreads();
    f32x4 acc[2][8];
#pragma unroll
    for (int i = 0; i < 2; ++i)
#pragma unroll
        for (int j = 0; j < 8; ++j) acc[i][j] = f32x4{0.f, 0.f, 0.f, 0.f};
    mma_nt<2, 8, 64, 64>(acc, sVT, 32 * wave, sKd, 0, 0, 2, lane);
    float* H = (float*)(p.ws + OFF_HST) + (size_t)item * 16384;
#pragma unroll
    for (int i = 0; i < 2; ++i)
#pragma unroll
        for (int j = 0; j < 8; ++j)
#pragma unroll
            for (int r = 0; r < 4; ++r) {
                const int v = 32 * wave + 16 * i + (lane >> 4) * 4 + r, kk = 16 * j + (lane & 15);
                H[v * 128 + kk] = acc[i][j][r];
                if (r == 3) __builtin_amdgcn_sched_barrier(0);
            }
    __syncthreads();
}

DEVI void gmlp_item(const Params& p, int item, char* smem) {
    const int tid = threadIdx.x, lane = tid & 63, wave = tid >> 6;
    const int g = item & 3, chunk = item >> 2;
    const size_t m0 = (size_t)chunk * 128;
    const bf16_t* Z0 = (const bf16_t*)(p.ws + OFF_Z0);
    const bf16_t* Wc = (const bf16_t*)(p.ws + OFF_WS0) + g * 16384;
    char* sW = smem; char* sV = smem + 32768;
#pragma unroll
    for (int i = 0; i < 8; ++i) {
        const int e = tid + 256 * i, row = e >> 4, cc = e & 15;
        *(uint4*)(sW + swz_off<128>(row, cc)) = *(const uint4*)(Wc + row * 128 + cc * 8);
    }
    {
        const int t = tid >> 1, hf = tid & 1;
        const bf16_t* src = Z0 + (m0 + t) * 3072 + 2560 + g * 128 + 64 * hf;
        float vals[64]; float ss = 0.f;
#pragma unroll
        for (int i = 0; i < 8; ++i) {
            uint4 u = *(const uint4*)(src + 8 * i);
            vals[8 * i + 0] = bflo(u.x); vals[8 * i + 1] = bfhi(u.x); vals[8 * i + 2] = bflo(u.y); vals[8 * i + 3] = bfhi(u.y);
            vals[8 * i + 4] = bflo(u.z); vals[8 * i + 5] = bfhi(u.z); vals[8 * i + 6] = bflo(u.w); vals[8 * i + 7] = bfhi(u.w);
        }
#pragma unroll
        for (int i = 0; i < 64; ++i) ss += vals[i] * vals[i];
        ss += __shfl_xor(ss, 1);
        const float rstd = rsqrtf(ss * (1.f / 128.f) + 1e-6f);
        const float* gn = p.l0_gmlp_v_norm + g * 128 + 64 * hf;
#pragma unroll
        for (int i = 0; i < 64; ++i) {
            const int d = 64 * hf + i;
            *(bf16_t*)(sV + swz_elem<128>(d, t)) = f2bf(vals[i] * rstd * gn[i]);
        }
    }
    __syncthreads();
    const int wm = wave >> 1, wn = wave & 1;
    f32x4 acc[4][4];
#pragma unroll
    for (int i = 0; i < 4; ++i)
#pragma unroll
        for (int j = 0; j < 4; ++j) acc[i][j] = f32x4{0.f, 0.f, 0.f, 0.f};
    mma_nt<4, 4, 128, 128>(acc, sW, wm * 64, sV, wn * 64, 0, 4, lane);
    bf16_t* MIX = (bf16_t*)(p.ws + OFF_MIX0);
#pragma unroll
    for (int i = 0; i < 4; ++i)
#pragma unroll
        for (int r = 0; r < 4; ++r) {
            const int t = wm * 64 + i * 16 + (lane >> 4) * 4 + r;
            const float bias = p.l0_gmlp_b_s[g * 128 + t];
#pragma unroll
            for (int j = 0; j < 4; ++j) {
                const int d = wn * 64 + j * 16 + (lane & 15);
                const float u = bf2f(Z0[(m0 + t) * 3072 + 2048 + g * 128 + d]);
                MIX[(m0 + t) * 1024 + 512 + g * 128 + d] = f2bf(u * (acc[i][j][r] + bias));
            }
        }
    __syncthreads();
}

DEVI void hgrn_scan_phase(const Params& p) {
    float* H = (float*)(p.ws + OFF_HST);
    const float* D = (const float*)(p.ws + OFF_DEC);
    for (int e = blockIdx.x * NTHREADS + threadIdx.x; e < 8 * 16384; e += gridDim.x * NTHREADS) {
        const int bh = e >> 14, idx = e & 16383, k = idx & 127;
        float run = 0.f;
        for (int c0 = 0; c0 < 128; c0 += 8) {
            float L[8], d[8];
#pragma unroll
            for (int u = 0; u < 8; ++u) { L[u] = H[((size_t)(bh * 128 + c0 + u)) * 16384 + idx]; d[u] = D[(bh * 128 + c0 + u) * 128 + k]; }
#pragma unroll
            for (int u = 0; u < 8; ++u) { H[((size_t)(bh * 128 + c0 + u)) * 16384 + idx] = run; run = d[u] * run + L[u]; }
        }
    }
}

DEVI void hgrn_out_item(const Params& p, int item, char* smem) {
    const int tid = threadIdx.x, lane = tid & 63, wave = tid >> 6;
    const int bh = item >> 7, c = item & 127, b = bh >> 2, h = bh & 3;
    const size_t m0 = (size_t)b * 8192 + c * 64;
    const float* G = (const float*)(p.ws + OFF_G) + m0 * 512 + h * 128;
    const bf16_t* Z0 = (const bf16_t*)(p.ws + OFF_Z0) + m0 * 3072;
    float* sB  = (float*)smem;
    char*  sHT = smem;
    char*  sQe = smem + 32768;
    char*  sP  = smem + 49152;
    char*  sU  = smem + 57344;
    char*  sQs = sU; char* sKh = sU + 4096; char* sVT = sU;
    float* sRed = (float*)(smem + 77824);
    const int k = tid & 127, hf = tid >> 7;
    if (hf == 0) { float bc = 0.f;
#pragma unroll 8
        for (int t = 0; t < 64; ++t) { bc += G[t * 512 + k]; sB[t * 128 + k] = bc; } }
    __syncthreads();
#pragma unroll 4
    for (int t = 32 * hf; t < 32 * hf + 32; ++t) {
        const float q = bf2f(Z0[(size_t)t * 3072 + h * 128 + k]);
        *(bf16_t*)(sQe + swz_elem<128>(t, k)) = f2bf(q * __expf(sB[t * 128 + k]));
    }
#pragma unroll 1
    for (int i = 0; i < 4; ++i) {
        const float ri = (i == 0) ? 0.f : sB[(16 * i - 1) * 128 + k];
#pragma unroll 4
        for (int tt = 8 * hf; tt < 8 * hf + 8; ++tt) {
            const int t = 16 * i + tt;
            const float q = bf2f(Z0[(size_t)t * 3072 + h * 128 + k]);
            *(bf16_t*)(sQs + swz_elem<128>(tt, k)) = f2bf(q * __expf(sB[t * 128 + k] - ri));
        }
        const int ns = 16 * (i + 1), half = ns >> 1;
#pragma unroll 4
        for (int s = hf * half; s < hf * half + half; ++s) {
            const float bs = sB[s * 128 + k];
            const float gs = bs - (s ? sB[(s - 1) * 128 + k] : 0.f);
            const float kk = 1.f - __expf(gs);
            *(bf16_t*)(sKh + swz_elem<128>(s, k)) = f2bf(kk * __expf(fminf(ri - bs, 80.f)));
        }
        __syncthreads();
        {
            f32x4 acc[1][1]; acc[0][0] = f32x4{0.f, 0.f, 0.f, 0.f};
            if (wave <= i) mma_nt<1, 1, 128, 128>(acc, sQs, 0, sKh, 16 * wave, 0, 4, lane);
#pragma unroll
            for (int r = 0; r < 4; ++r) {
                const int row = (lane >> 4) * 4 + r, col = lane & 15;
                float v = acc[0][0][r];
                if (wave > i || (wave == i && col > row)) v = 0.f;
                *(bf16_t*)(sP + swz_elem<64>(16 * i + row, 16 * wave + col)) = f2bf(v);
            }
        }
        __syncthreads();
    }
    {
        const bf16_t* Zv = Z0 + 1024 + h * 128;
#pragma unroll 1
        for (int ch = 0; ch < 4; ++ch) {
            float vv[8];
#pragma unroll
            for (int j = 0; j < 8; ++j) vv[j] = bf2f(Zv[(size_t)(32 * hf + 8 * ch + j) * 3072 + k]);
            uint4 w; w.x = pack2(vv[0], vv[1]); w.y = pack2(vv[2], vv[3]); w.z = pack2(vv[4], vv[5]); w.w = pack2(vv[6], vv[7]);
            *(uint4*)(sVT + swz_off<64>(k, 4 * hf + ch)) = w;
        }
        const float* H = (const float*)(p.ws + OFF_HST) + (size_t)item * 16384;
#pragma unroll 2
        for (int i = 0; i < 8; ++i) {
            const int e = tid + 256 * i, row = e >> 4, cc = e & 15;
            const float4 a = *(const float4*)(H + row * 128 + cc * 8), bq = *(const float4*)(H + row * 128 + cc * 8 + 4);
            uint4 o; o.x = pack2(a.x, a.y); o.y = pack2(a.z, a.w); o.z = pack2(bq.x, bq.y); o.w = pack2(bq.z, bq.w);
            *(uint4*)(sHT + swz_off<128>(row, cc)) = o;
        }
    }
    __syncthreads();
    f32x4 acc[4][2];
#pragma unroll
    for (int i = 0; i < 4; ++i)
#pragma unroll
        for (int j = 0; j < 2; ++j) acc[i][j] = f32x4{0.f, 0.f, 0.f, 0.f};
    mma_nt<4, 2, 128, 128>(acc, sQe, 0, sHT, 32 * wave, 0, 4, lane);
    mma_nt<4, 2, 64, 64>(acc, sP, 0, sVT, 32 * wave, 0, 2, lane);
#pragma unroll
    for (int i = 0; i < 4; ++i)
#pragma unroll
        for (int r = 0; r < 4; ++r) {
            float s = acc[i][0][r] * acc[i][0][r] + acc[i][1][r] * acc[i][1][r];
            s += __shfl_xor(s, 1); s += __shfl_xor(s, 2); s += __shfl_xor(s, 4); s += __shfl_xor(s, 8);
            if ((lane & 15) == 0) sRed[wave * 64 + i * 16 + (lane >> 4) * 4 + r] = s;
        }
    __syncthreads();
    bf16_t* MIX = (bf16_t*)(p.ws + OFF_MIX0);
#pragma unroll
    for (int i = 0; i < 4; ++i)
#pragma unroll
        for (int r = 0; r < 4; ++r) {
            const int t = i * 16 + (lane >> 4) * 4 + r;
            const float tot = sRed[t] + sRed[64 + t] + sRed[128 + t] + sRed[192 + t];
            const float rstd = rsqrtf(tot * (1.f / 128.f) + 1e-6f);
#pragma unroll
            for (int j = 0; j < 2; ++j) {
                const int v = 32 * wave + 16 * j + (lane & 15);
                const float og = bf2f(Z0[(size_t)t * 3072 + 1536 + h * 128 + v]);
                MIX[(m0 + t) * 1024 + h * 128 + v] = f2bf(acc[i][j][r] * rstd * p.l0_hgrn_out_norm[h * 128 + v] * og);
            }
        }
    __syncthreads();
}

DEVI unsigned f2key(float f) { unsigned u = __float_as_uint(f); return (u & 0x80000000u) ? ~u : (u | 0x80000000u); }
DEVI float key2f(unsigned k) { unsigned u = (k & 0x80000000u) ? (k ^ 0x80000000u) : ~k; return __uint_as_float(u); }
#define CE_DESC(a, b) { unsigned _x = max(a, b), _y = min(a, b); a = _x; b = _y; }
DEVI void sort16_desc(unsigned (&a)[16]) {
#pragma unroll
    for (int k = 2; k <= 16; k <<= 1)
#pragma unroll
        for (int j = k >> 1; j > 0; j >>= 1)
#pragma unroll
            for (int i = 0; i < 16; ++i) {
                const int l = i ^ j;
                if (l > i) {
                    if ((i & k) == 0) { CE_DESC(a[i], a[l]); } else { CE_DESC(a[l], a[i]); }
                }
            }
}
DEVI void merge16_desc(unsigned (&a)[16], const unsigned (&b)[16]) {
#pragma unroll
    for (int i = 0; i < 16; ++i) a[i] = max(a[i], b[15 - i]);
#pragma unroll
    for (int j = 8; j > 0; j >>= 1)
#pragma unroll
        for (int i = 0; i < 16; ++i) { const int l = i ^ j; if (l > i) { CE_DESC(a[i], a[l]); } }
}

DEVI void peer_topk_phase(const Params& p, const bf16_t* __restrict__ SK, int blk0, int nblk, char* smem) {
    const int tid = threadIdx.x, lane = tid & 63, wave = tid >> 6;
    const int r = lane & 31, hh = lane >> 5;
    const bf16_t* QP = (const bf16_t*)(p.ws + OFF_QP);
    int* IDX = (int*)(p.ws + OFF_IDX); float* GATE = (float*)(p.ws + OFF_GATE);
    char* sKey = smem;
    char* sQ = smem + 32768 + wave * 8192;
    for (int item = blk0; item < 1024; item += nblk) {
        const int h = item & 7, tile = (item >> 3) * 4 + wave;
        const size_t tok = (size_t)tile * 32 + r;
        unsigned top[2][16];
#pragma unroll
        for (int ph = 0; ph < 2; ++ph) {
            __syncthreads();
            {
                const bf16_t* ksrc = SK + (size_t)(h * 2 + ph) * 128 * 128;
#pragma unroll
                for (int i = 0; i < 8; ++i) { const int e = tid + 256 * i, row = e >> 4, cc = e & 15; *(uint4*)(sKey + swz_off<128>(row, cc)) = *(const uint4*)(ksrc + row * 128 + cc * 8); }
                const bf16_t* qsrc = QP + (size_t)tile * 32 * 2048 + h * 256 + ph * 128;
#pragma unroll
                for (int i = 0; i < 8; ++i) { const int e = lane + 64 * i, row = e >> 4, cc = e & 15; *(uint4*)(sQ + swz_off<128>(row, cc)) = *(const uint4*)(qsrc + (size_t)row * 2048 + cc * 8); }
            }
            __syncthreads();
            bf16x8 qf[8];
#pragma unroll
            for (int ks = 0; ks < 8; ++ks) qf[ks] = *(const bf16x8*)(sQ + swz_off<128>(r, 2 * ks + hh));
#pragma unroll 1
            for (int rt = 0; rt < 4; ++rt) {
                f32x16 acc;
#pragma unroll
                for (int e = 0; e < 16; ++e) acc[e] = 0.f;
#pragma unroll
                for (int ks = 0; ks < 8; ++ks) {
                    const bf16x8 kf = *(const bf16x8*)(sKey + swz_off<128>(32 * rt + r, 2 * ks + hh));
                    acc = mfma32(kf, qf[ks], acc);
                }
                unsigned kk[16];
#pragma unroll
                for (int e = 0; e < 16; ++e) {
                    const unsigned n = 32 * rt + (e & 3) + 8 * (e >> 2) + 4 * hh;
                    kk[e] = (f2key(acc[e]) & ~127u) | n;
                }
                sort16_desc(kk);
                if (rt == 0) {
#pragma unroll
                    for (int e = 0; e < 16; ++e) top[ph][e] = kk[e];
                } else merge16_desc(top[ph], kk);
            }
            unsigned other[16];
#pragma unroll
            for (int e = 0; e < 16; ++e) other[e] = (unsigned)__shfl_xor((int)top[ph][e], 32);
            merge16_desc(top[ph], other);
        }
        unsigned best[16];
        {
            float s1[16], s2[16];
#pragma unroll
            for (int e = 0; e < 16; ++e) { s1[e] = key2f(top[0][e] & ~127u); s2[e] = key2f(top[1][e] & ~127u); }
            unsigned cand[64];
            unsigned ia[16], ib[16];
#pragma unroll
            for (int e = 0; e < 16; ++e) { ia[e] = (top[0][e] & 127u) << 7; ib[e] = top[1][e] & 127u; }
            int n = 0;
#pragma unroll
            for (int i = 0; i < 16; ++i)
#pragma unroll
                for (int j = 0; j < 16; ++j)
                    if ((i + 1) * (j + 1) <= 16) { cand[n] = (f2key(s1[i] + s2[j]) & ~0x3fffu) | ia[i] | ib[j]; ++n; }
#pragma unroll
            for (int e = 50; e < 64; ++e) cand[e] = 0u;
#pragma unroll
            for (int g = 0; g < 4; ++g) {
                unsigned kk[16];
#pragma unroll
                for (int e = 0; e < 16; ++e) kk[e] = cand[16 * g + e];
                sort16_desc(kk);
                if (g == 0) {
#pragma unroll
                    for (int e = 0; e < 16; ++e) best[e] = kk[e];
                } else merge16_desc(best, kk);
            }
        }
        float sv[16]; int id[16];
#pragma unroll
        for (int e = 0; e < 16; ++e) {
            sv[e] = key2f(best[e] & ~0x3fffu);
            id[e] = (int)(best[e] & 0x3fffu);
        }
        float den = 0.f; const float smax = sv[0];
#pragma unroll
        for (int e = 0; e < 16; ++e) { sv[e] = __expf(sv[e] - smax); den += sv[e]; }
        const float inv = 1.f / den;
        {
            const float* INVT = (const float*)(p.ws + (hh ? OFF_INVU : OFF_INVD));
            float sc[16];
#pragma unroll
            for (int e = 0; e < 16; ++e) sc[e] = INVT[id[e]];
            if (hh == 0) {
                int4* dst = (int4*)(IDX + tok * 128 + h * 16);
                float4* dst2 = (float4*)((float*)(p.ws + OFF_SDN) + tok * 128 + h * 16);
#pragma unroll
                for (int e = 0; e < 4; ++e) { dst[e] = int4{id[4 * e], id[4 * e + 1], id[4 * e + 2], id[4 * e + 3]}; dst2[e] = float4{sc[4 * e], sc[4 * e + 1], sc[4 * e + 2], sc[4 * e + 3]}; }
            } else {
                float4* dst = (float4*)(GATE + tok * 128 + h * 16);
#pragma unroll
                for (int e = 0; e < 4; ++e) dst[e] = float4{sv[4 * e] * inv * sc[4 * e], sv[4 * e + 1] * inv * sc[4 * e + 1], sv[4 * e + 2] * inv * sc[4 * e + 2], sv[4 * e + 3] * inv * sc[4 * e + 3]};
            }
        }
    }
}

typedef float f32x2v __attribute__((ext_vector_type(2)));
#define PEER_QWORD 80000
#define PEER_TPW 8
#define PEER_ITEMS (16384 / (4 * PEER_TPW))
DEVI int queue_pop(const Params& p, int q, char* smem) {
    int* sw = (int*)(smem + PEER_QWORD);
    __syncthreads();
    if (threadIdx.x == 0) *sw = (int)__hip_atomic_fetch_add((unsigned*)(p.ws + OFF_QCNT) + q * 16, 1u, __ATOMIC_RELAXED, __HIP_MEMORY_SCOPE_AGENT);
    __syncthreads();
    return *sw;
}
#define UFMA(ACC, W, X) asm volatile("v_fmac_f32 %0, %1, %2" : "+v"(ACC) : "v"(W), "v"(X))
struct DL { int i0, i1; u32x4 xa, xb; };
struct DG { u32x4 u[8]; };
DEVI void d_load(DL& l, size_t tok, int s, int lane, const int* IDX, const bf16_t* XB) {
    const unsigned o1 = (unsigned)tok * 512u + 4u * (unsigned)lane;
    l.i0 = *(const int*)((const char*)IDX + o1); l.i1 = *(const int*)((const char*)IDX + o1 + 256u);
    const unsigned o2 = (unsigned)tok * 2048u + (unsigned)(256 * s + 32 * (lane & 7));
    l.xa = *(const u32x4*)((const char*)XB + o2); l.xb = *(const u32x4*)((const char*)XB + o2 + 16u);
}
DEVI void d_publish(const DL& l, char* pt, int lane) { *(int*)(pt + 4 * lane) = l.i0; *(int*)(pt + 256 + 4 * lane) = l.i1; }
template <int HLF>
DEVI void d_gather(DG& g, const char* pt, int s, int lane, const char* ED) {
    const int grp = lane >> 3, sub = lane & 7;
#pragma unroll
    for (int i = 0; i < 8; ++i) {
        const unsigned e = *(const unsigned*)(pt + 256 * HLF + 4 * (8 * i + grp));
        g.u[i] = *(const u32x4*)(ED + ((unsigned)s * 16384u + e) * 128u + (unsigned)(16 * sub));
    }
}
template <int HLF>
DEVI void d_dot(const DG& g, const float (&x)[16], char* ex, int lane) {
#pragma unroll
    for (int i = 0; i < 8; ++i) {
        float a = 0.f;
#pragma unroll
        for (int q = 0; q < 4; ++q) {
            const f32x2v lo = __builtin_amdgcn_cvt_pk_f32_fp8((int)g.u[i][q], false), hi = __builtin_amdgcn_cvt_pk_f32_fp8((int)g.u[i][q], true);
            UFMA(a, lo.x, x[4 * q]); UFMA(a, lo.y, x[4 * q + 1]); UFMA(a, hi.x, x[4 * q + 2]); UFMA(a, hi.y, x[4 * q + 3]);
        }
        *(float*)(ex + 256 * (8 * HLF + i) + 4 * lane) = a;
        if (i & 1) __builtin_amdgcn_sched_barrier(0);
    }
}
DEVI void d_finish(char* ex, size_t tok, int s, int lane, float* PART) {
    float r0, r1;
    {
        const float4 a = *(const float4*)(ex + 256 * (lane >> 3) + 32 * (lane & 7)), b = *(const float4*)(ex + 256 * (lane >> 3) + 32 * (lane & 7) + 16);
        r0 = ((a.x + a.y) + (a.z + a.w)) + ((b.x + b.y) + (b.z + b.w));
        const float4 c = *(const float4*)(ex + 256 * (8 + (lane >> 3)) + 32 * (lane & 7)), d = *(const float4*)(ex + 256 * (8 + (lane >> 3)) + 32 * (lane & 7) + 16);
        r1 = ((c.x + c.y) + (c.z + c.w)) + ((d.x + d.y) + (d.z + d.w));
    }
    float* dst = PART + ((size_t)s * 16384 + tok) * 128;
    dst[lane] = r0; dst[64 + lane] = r1;
}
DEVI void peer_down_phase(const Params& p, const float* __restrict__ gain, int qbase, int s0, char* smem) {
    const int tid = threadIdx.x, lane = tid & 63, wave = tid >> 6;
    const char* ED = p.ws + OFF_ED;
    const int* IDX = (const int*)(p.ws + OFF_IDX);
    const bf16_t* XB = (const bf16_t*)(p.ws + OFF_XB);
    float* PART = (float*)(p.ws + OFF_PART);
    (void)gain;
    char* const pt0 = smem + wave * 8192;
    char* const ex = pt0 + 1024;
#pragma unroll 1
    for (int sl = 0; sl < 8; ++sl) {
        const int s = (s0 + sl) & 7;
#pragma unroll 1
        for (;;) {
            const int g = queue_pop(p, qbase + s, smem);
            if (g >= PEER_ITEMS) break;
            const size_t t0 = (size_t)g * (4 * PEER_TPW) + wave * PEER_TPW;
            DL la, lb, lc; DG ga, gb;
            d_load(la, t0, s, lane, IDX, XB); d_load(lb, t0 + 1, s, lane, IDX, XB);
            d_publish(la, pt0, lane); d_publish(lb, pt0 + 512, lane);
            d_gather<0>(ga, pt0, s, lane, ED);
#pragma unroll 1
            for (int j = 0; j < PEER_TPW; ++j) {
                char* const ptj = pt0 + 512 * (j & 1); char* const ptn = pt0 + 512 * ((j + 1) & 1);
                float x[16];
                x[0] = bflo(la.xa[0]); x[1] = bfhi(la.xa[0]); x[2] = bflo(la.xa[1]); x[3] = bfhi(la.xa[1]); x[4] = bflo(la.xa[2]); x[5] = bfhi(la.xa[2]); x[6] = bflo(la.xa[3]); x[7] = bfhi(la.xa[3]);
                x[8] = bflo(la.xb[0]); x[9] = bfhi(la.xb[0]); x[10] = bflo(la.xb[1]); x[11] = bfhi(la.xb[1]); x[12] = bflo(la.xb[2]); x[13] = bfhi(la.xb[2]); x[14] = bflo(la.xb[3]); x[15] = bfhi(la.xb[3]);
                d_gather<1>(gb, ptj, s, lane, ED);
                d_dot<0>(ga, x, ex, lane);
                if (j + 2 < PEER_TPW) d_load(lc, t0 + j + 2, s, lane, IDX, XB);
                if (j + 1 < PEER_TPW) d_gather<0>(ga, ptn, s, lane, ED);
                d_dot<1>(gb, x, ex, lane);
                d_finish(ex, t0 + j, s, lane, PART);
                la = lb; lb = lc;
                if (j + 2 < PEER_TPW) d_publish(lb, ptj, lane);
            }
        }
    }
}
DEVI void peer_reduce_phase(const Params& p) {
    const int lane = threadIdx.x & 63, wave = threadIdx.x >> 6;
    const float* PART = (const float*)(p.ws + OFF_PART); const float* GATEU = (const float*)(p.ws + OFF_GATE); const float* SDN = (const float*)(p.ws + OFF_SDN);
    const float* SSQ16 = (const float*)(p.ws + OFF_SSQ16); float* ACTW = (float*)(p.ws + OFF_ACTW);
    for (int it = blockIdx.x; it < 4096; it += gridDim.x) {
        const size_t tok = (size_t)it * 4 + wave;
        float sq = (lane < 16) ? SSQ16[tok * 16 + lane] : 0.f;
        sq += __shfl_xor(sq, 1); sq += __shfl_xor(sq, 2); sq += __shfl_xor(sq, 4); sq += __shfl_xor(sq, 8);
        const float rstd = rsqrtf(__shfl(sq, 0) * (1.f / 1024.f) + 1e-6f);
        float a0 = 0.f, a1 = 0.f;
#pragma unroll
        for (int s = 0; s < 8; ++s) { a0 += PART[((size_t)s * 16384 + tok) * 128 + lane]; a1 += PART[((size_t)s * 16384 + tok) * 128 + 64 + lane]; }
        ACTW[tok * 128 + lane]      = GATEU[tok * 128 + lane]      * gelu_tanh(a0 * rstd * SDN[tok * 128 + lane]);
        ACTW[tok * 128 + 64 + lane] = GATEU[tok * 128 + 64 + lane] * gelu_tanh(a1 * rstd * SDN[tok * 128 + 64 + lane]);
    }
}
struct UL { int i0, i1; float w0, w1; f32x2v x2; };
struct UG { u32x4 u[8]; float w[8]; };
DEVI void u_load(UL& l, size_t tok, int s, int lane, const int* IDX, const float* ACTW, const float* X) {
    const unsigned o1 = (unsigned)tok * 512u + 4u * (unsigned)lane;
    l.i0 = *(const int*)((const char*)IDX + o1); l.i1 = *(const int*)((const char*)IDX + o1 + 256u);
    l.w0 = *(const float*)((const char*)ACTW + o1); l.w1 = *(const float*)((const char*)ACTW + o1 + 256u);
    const unsigned o2 = (unsigned)tok * 4096u + (unsigned)(512 * s + 64 * (lane & 7) + 8 * (lane >> 3));
    { const unsigned xb2 = *(const unsigned*)((const char*)X + (o2 >> 1)); l.x2 = f32x2v{bflo(xb2), bfhi(xb2)}; }
}
DEVI void u_publish(const UL& l, char* pt, int lane) {
    *(uint2*)(pt + 8 * lane) = uint2{(unsigned)l.i0, __float_as_uint(l.w0)};
    *(uint2*)(pt + 512 + 8 * lane) = uint2{(unsigned)l.i1, __float_as_uint(l.w1)};
}
template <int HLF>
DEVI void u_gather(UG& g, const char* pt, int s, int lane, const char* EU) {
    const int grp = lane >> 3, sub = lane & 7;
#pragma unroll
    for (int i = 0; i < 8; ++i) {
        const uint2 ew = *(const uint2*)(pt + 512 * HLF + 8 * (8 * i + grp));
        g.w[i] = __uint_as_float(ew.y);
        const unsigned off = ((unsigned)s * 16384u + ew.x) * 128u + (unsigned)(16 * sub);
        g.u[i] = *(const u32x4*)(EU + off);
    }
}
DEVI void u_fma(const UG& g, float (&acc)[16]) {
#pragma unroll
    for (int i = 0; i < 8; ++i) {
        const float w = g.w[i];
#pragma unroll
        for (int q = 0; q < 4; ++q) {
            const f32x2v lo = __builtin_amdgcn_cvt_pk_f32_fp8((int)g.u[i][q], false), hi = __builtin_amdgcn_cvt_pk_f32_fp8((int)g.u[i][q], true);
            UFMA(acc[4 * q], w, lo.x); UFMA(acc[4 * q + 1], w, lo.y); UFMA(acc[4 * q + 2], w, hi.x); UFMA(acc[4 * q + 3], w, hi.y);
        }
        if (i & 1) __builtin_amdgcn_sched_barrier(0);
    }
}
DEVI void u_finish(float (&acc)[16], const UL& l, char* ex, size_t tok, int s, int lane, float alpha, float* X, bf16_t* XB, float* SSQ8) {
    const int grp = lane >> 3, sub = lane & 7;
#pragma unroll
    for (int pp = 0; pp < 8; ++pp) *(float2*)(ex + 576 * pp + 8 * lane) = float2{acc[2 * pp], acc[2 * pp + 1]};
    float a0 = 0.f, a1 = 0.f;
#pragma unroll
    for (int g2 = 0; g2 < 8; ++g2) { const float2 v = *(const float2*)(ex + 576 * grp + 8 * (8 * g2 + sub)); a0 += v.x; a1 += v.y; }
    const float y0 = l.x2.x + alpha * a0, y1 = l.x2.y + alpha * a1;
    const unsigned col = (unsigned)tok * 1024u + (unsigned)(128 * s + 16 * sub + 2 * grp);
    if (X) *(f32x2v*)((char*)X + 4u * col) = f32x2v{y0, y1};
    const unsigned yb = pack2(y0, y1);
    *(unsigned*)((char*)XB + 2u * col) = yb;
    float sq = bflo(yb) * bflo(yb) + bfhi(yb) * bfhi(yb);
#pragma unroll
    for (int o = 1; o < 64; o <<= 1) sq += __shfl_xor(sq, o);
    if (lane == 0) *(float*)((char*)SSQ8 + ((unsigned)tok * 32u + 4u * (unsigned)s)) = sq;
#pragma unroll
    for (int i = 0; i < 16; ++i) acc[i] = 0.f;
}
DEVI void peer_up_phase(const Params& p, int qbase, int s0, float alpha, float* X, char* smem) {
    const int tid = threadIdx.x, lane = tid & 63, wave = tid >> 6;
    const char* EU = p.ws + OFF_EU;
    const int* IDX = (const int*)(p.ws + OFF_IDX); const float* ACTW = (const float*)(p.ws + OFF_ACTW);
    bf16_t* XB = (bf16_t*)(p.ws + OFF_XB); float* SSQ8 = (float*)(p.ws + OFF_SSQ8);
    char* const pt0 = smem + wave * 8192;
    char* const ex = pt0 + 2048;
#pragma unroll 1
    for (int sl = 0; sl < 8; ++sl) {
        const int s = (s0 + sl) & 7;
#pragma unroll 1
        for (;;) {
            const int g = queue_pop(p, qbase + s, smem);
            if (g >= PEER_ITEMS) break;
            const size_t t0 = (size_t)g * (4 * PEER_TPW) + wave * PEER_TPW;
            UL la, lb, lc; UG ga, gb;
            float acc[16];
#pragma unroll
            for (int i = 0; i < 16; ++i) acc[i] = 0.f;
            u_load(la, t0, s, lane, IDX, ACTW, (const float*)XB); u_load(lb, t0 + 1, s, lane, IDX, ACTW, (const float*)XB);
            u_publish(la, pt0, lane); u_publish(lb, pt0 + 1024, lane);
            u_gather<0>(ga, pt0, s, lane, EU);
#pragma unroll 1
            for (int j = 0; j < PEER_TPW; ++j) {
                char* const ptj = pt0 + 1024 * (j & 1); char* const ptn = pt0 + 1024 * ((j + 1) & 1);
                u_gather<1>(gb, ptj, s, lane, EU);
                u_fma(ga, acc);
                if (j + 2 < PEER_TPW) u_load(lc, t0 + j + 2, s, lane, IDX, ACTW, (const float*)XB);
                if (j + 1 < PEER_TPW) u_gather<0>(ga, ptn, s, lane, EU);
                u_fma(gb, acc);
                u_finish(acc, la, ex, t0 + j, s, lane, alpha, X, XB, SSQ8);
                la = lb; lb = lc;
                if (j + 2 < PEER_TPW) u_publish(lb, ptj, lane);
            }
        }
    }
}

DEVI void rope_cs(float pos, int i, float& c, float& s) {
    const float inv = exp2f(-(float)i * (13.287712379549449f / 32.f));
    const float ang = pos * inv;
    const float kf = rintf(ang * 0.15915494309189535f);
    float rr = fmaf(-kf, 6.2831854820251465f, ang);
    rr = fmaf(-kf, -1.7484555e-7f, rr);
    c = __cosf(rr); s = __sinf(rr);
}
#define QSCALE_MLA  (0.07216878364870322f * 1.4426950408889634f)
#define QSCALE_MOBA (0.08838834764831845f * 1.4426950408889634f)

DEVI void moba_prep_item(const Params& p, int item, char* smem) {
    const int tid = threadIdx.x;
    const int h = item & 3, tt = item >> 2;
    const size_t m0 = (size_t)tt * 64;
    const int b = (int)(m0 >> 13), s0 = (int)(m0 & 8191), bh = b * 4 + h;
    const bf16_t* Z1 = (const bf16_t*)(p.ws + OFF_Z1);
    bf16_t* Qd = (bf16_t*)(p.ws + OFF_QD); bf16_t* Kd = (bf16_t*)(p.ws + OFF_KD); bf16_t* VdT = (bf16_t*)(p.ws + OFF_VDT);
    const int row = tid >> 2, j = tid & 3;
    const bf16_t* zr = Z1 + (m0 + row) * 1984;
#pragma unroll
    for (int which = 0; which < 2; ++which) {
        const bf16_t* src = zr + (which ? 960 : 448) + h * 128 + 32 * j;
        const float* gn = (which ? p.l1_mk_norm : p.l1_mq_norm) + 32 * j;
        float v[32]; float ss = 0.f;
#pragma unroll
        for (int i = 0; i < 4; ++i) {
            uint4 u = *(const uint4*)(src + 8 * i);
            v[8 * i] = bflo(u.x); v[8 * i + 1] = bfhi(u.x); v[8 * i + 2] = bflo(u.y); v[8 * i + 3] = bfhi(u.y);
            v[8 * i + 4] = bflo(u.z); v[8 * i + 5] = bfhi(u.z); v[8 * i + 6] = bflo(u.w); v[8 * i + 7] = bfhi(u.w);
        }
#pragma unroll
        for (int i = 0; i < 32; ++i) ss += v[i] * v[i];
        ss += __shfl_xor(ss, 1); ss += __shfl_xor(ss, 2);
        const float sc = rsqrtf(ss * (1.f / 128.f) + 1e-6f) * (which ? 1.f : QSCALE_MOBA);
        bf16_t* dst = (which ? Kd : Qd) + ((size_t)bh * 8192 + s0 + row) * 128 + 32 * j;
#pragma unroll
        for (int i = 0; i < 4; ++i) {
            uint4 o;
            o.x = pack2(v[8 * i] * sc * gn[8 * i], v[8 * i + 1] * sc * gn[8 * i + 1]); o.y = pack2(v[8 * i + 2] * sc * gn[8 * i + 2], v[8 * i + 3] * sc * gn[8 * i + 3]);
            o.z = pack2(v[8 * i + 4] * sc * gn[8 * i + 4], v[8 * i + 5] * sc * gn[8 * i + 5]); o.w = pack2(v[8 * i + 6] * sc * gn[8 * i + 6], v[8 * i + 7] * sc * gn[8 * i + 7]);
            *(uint4*)(dst + 8 * i) = o;
        }
    }
    bf16_t* sT = (bf16_t*)smem;
    {
        const bf16_t* src = zr + 1472 + h * 128 + 32 * j;
#pragma unroll
        for (int i = 0; i < 4; ++i) {
            uint4 u = *(const uint4*)(src + 8 * i);
            const int d0 = 32 * j + 8 * i;
            sT[(d0 + 0) * 66 + row] = (bf16_t)(u.x & 0xffff); sT[(d0 + 1) * 66 + row] = (bf16_t)(u.x >> 16);
            sT[(d0 + 2) * 66 + row] = (bf16_t)(u.y & 0xffff); sT[(d0 + 3) * 66 + row] = (bf16_t)(u.y >> 16);
            sT[(d0 + 4) * 66 + row] = (bf16_t)(u.z & 0xffff); sT[(d0 + 5) * 66 + row] = (bf16_t)(u.z >> 16);
            sT[(d0 + 6) * 66 + row] = (bf16_t)(u.w & 0xffff); sT[(d0 + 7) * 66 + row] = (bf16_t)(u.w >> 16);
        }
    }
    __syncthreads();
    for (int e = tid; e < 128 * 32; e += NTHREADS) {
        const int d = e >> 5, tp = e & 31;
        const unsigned v = (unsigned)sT[d * 66 + 2 * tp] | ((unsigned)sT[d * 66 + 2 * tp + 1] << 16);
        *(unsigned*)(VdT + ((size_t)bh * 128 + d) * 8192 + s0 + (((2 * tp) & ~12) | (((2 * tp) & 4) << 1) | (((2 * tp) & 8) >> 1))) = v;
    }
    __syncthreads();
}

DEVI void moba_kmean_item(const Params& p, int item, char* smem) {
    const int tid = threadIdx.x;
    const int bh = item >> 5, blk = item & 31, b = bh >> 2, h = bh & 3;
    const bf16_t* Z1 = (const bf16_t*)(p.ws + OFF_Z1) + ((size_t)b * 8192 + blk * 256) * 1984 + 960 + h * 128;
    const int cc = tid & 15, rg = tid >> 4;
    float col[8];
#pragma unroll
    for (int i = 0; i < 8; ++i) col[i] = 0.f;
    for (int i = 0; i < 16; ++i) {
        const int row = rg * 16 + i;
        uint4 u = *(const uint4*)(Z1 + (size_t)row * 1984 + cc * 8);
        float v[8] = {bflo(u.x), bfhi(u.x), bflo(u.y), bfhi(u.y), bflo(u.z), bfhi(u.z), bflo(u.w), bfhi(u.w)};
        float ss = 0.f;
#pragma unroll
        for (int e = 0; e < 8; ++e) ss += v[e] * v[e];
        ss += __shfl_xor(ss, 1); ss += __shfl_xor(ss, 2); ss += __shfl_xor(ss, 4); ss += __shfl_xor(ss, 8);
        const float rstd = rsqrtf(ss * (1.f / 128.f) + 1e-6f);
#pragma unroll
        for (int e = 0; e < 8; ++e) col[e] += v[e] * rstd;
    }
    float* sR = (float*)smem;
#pragma unroll
    for (int e = 0; e < 8; ++e) sR[rg * 128 + cc * 8 + e] = col[e];
    __syncthreads();
    if (tid < 128) {
        float s = 0.f;
#pragma unroll
        for (int g = 0; g < 16; ++g) s += sR[g * 128 + tid];
        ((float*)(p.ws + OFF_KMEAN))[((size_t)bh * 32 + blk) * 128 + tid] = s * (1.f / 256.f) * p.l1_mk_norm[tid];
    }
    __syncthreads();
}

DEVI void mla_prep_item(const Params& p, int item, char* smem) {
    const int tid = threadIdx.x;
    const int h = item & 3, tt = item >> 2;
    const size_t m0 = (size_t)tt * 64;
    const int b = (int)(m0 >> 13), s0 = (int)(m0 & 8191), bh = b * 4 + h;
    const bf16_t* Z1 = (const bf16_t*)(p.ws + OFF_Z1);
    const bf16_t* QC = (const bf16_t*)(p.ws + OFF_QC);
    const bf16_t* KV = (const bf16_t*)(p.ws + OFF_KV);
    bf16_t* Q = (bf16_t*)(p.ws + OFF_Q); bf16_t* K = (bf16_t*)(p.ws + OFF_K); bf16_t* VT = (bf16_t*)(p.ws + OFF_VT);
    const int row = tid >> 2, j = tid & 3;
    const size_t m = m0 + row;
    const float pos = (float)p.pos[m];
#pragma unroll
    for (int which = 0; which < 2; ++which) {
        const bf16_t* nsrc = which ? (KV + m * 1024 + h * 256 + 32 * j) : (QC + m * 768 + h * 192 + 32 * j);
        const bf16_t* r1 = which ? (Z1 + m * 1984 + 384 + 8 * j) : (QC + m * 768 + h * 192 + 128 + 8 * j);
        const bf16_t* r2 = r1 + 32;
        const float* gn = which ? p.l1_k_norm : p.l1_q_norm;
        float v[32], a1[8], a2[8]; float ss = 0.f;
#pragma unroll
        for (int i = 0; i < 4; ++i) {
            uint4 u = *(const uint4*)(nsrc + 8 * i);
            v[8 * i] = bflo(u.x); v[8 * i + 1] = bfhi(u.x); v[8 * i + 2] = bflo(u.y); v[8 * i + 3] = bfhi(u.y);
            v[8 * i + 4] = bflo(u.z); v[8 * i + 5] = bfhi(u.z); v[8 * i + 6] = bflo(u.w); v[8 * i + 7] = bfhi(u.w);
        }
        { uint4 u = *(const uint4*)r1; a1[0] = bflo(u.x); a1[1] = bfhi(u.x); a1[2] = bflo(u.y); a1[3] = bfhi(u.y); a1[4] = bflo(u.z); a1[5] = bfhi(u.z); a1[6] = bflo(u.w); a1[7] = bfhi(u.w); }
        { uint4 u = *(const uint4*)r2; a2[0] = bflo(u.x); a2[1] = bfhi(u.x); a2[2] = bflo(u.y); a2[3] = bfhi(u.y); a2[4] = bflo(u.z); a2[5] = bfhi(u.z); a2[6] = bflo(u.w); a2[7] = bfhi(u.w); }
#pragma unroll
        for (int i = 0; i < 32; ++i) ss += v[i] * v[i];
#pragma unroll
        for (int i = 0; i < 8; ++i) ss += a1[i] * a1[i] + a2[i] * a2[i];
        ss += __shfl_xor(ss, 1); ss += __shfl_xor(ss, 2);
        const float rstd = rsqrtf(ss * (1.f / 192.f) + 1e-6f);
        const float sc = which ? 1.f : QSCALE_MLA;
        bf16_t* dst = (which ? K : Q) + ((size_t)bh * 8192 + s0 + row) * 192;
#pragma unroll
        for (int i = 0; i < 4; ++i) {
            const float* g = gn + 32 * j + 8 * i;
            uint4 o;
            o.x = pack2(v[8 * i] * rstd * g[0] * sc, v[8 * i + 1] * rstd * g[1] * sc); o.y = pack2(v[8 * i + 2] * rstd * g[2] * sc, v[8 * i + 3] * rstd * g[3] * sc);
            o.z = pack2(v[8 * i + 4] * rstd * g[4] * sc, v[8 * i + 5] * rstd * g[5] * sc); o.w = pack2(v[8 * i + 6] * rstd * g[6] * sc, v[8 * i + 7] * rstd * g[7] * sc);
            *(uint4*)(dst + 32 * j + 8 * i) = o;
        }
        float o1[8], o2[8];
#pragma unroll
        for (int i = 0; i < 8; ++i) {
            float c, s; rope_cs(pos, 8 * j + i, c, s);
            const float y1 = a1[i] * rstd * gn[128 + 8 * j + i], y2 = a2[i] * rstd * gn[160 + 8 * j + i];
            o1[i] = (y1 * c - y2 * s) * sc; o2[i] = (y2 * c + y1 * s) * sc;
        }
        uint4 w1, w2;
        w1.x = pack2(o1[0], o1[1]); w1.y = pack2(o1[2], o1[3]); w1.z = pack2(o1[4], o1[5]); w1.w = pack2(o1[6], o1[7]);
        w2.x = pack2(o2[0], o2[1]); w2.y = pack2(o2[2], o2[3]); w2.z = pack2(o2[4], o2[5]); w2.w = pack2(o2[6], o2[7]);
        *(uint4*)(dst + 128 + 8 * j) = w1; *(uint4*)(dst + 160 + 8 * j) = w2;
    }
    bf16_t* sT = (bf16_t*)smem;
    {
        const bf16_t* src = KV + m * 1024 + h * 256 + 128 + 32 * j;
#pragma unroll
        for (int i = 0; i < 4; ++i) {
            uint4 u = *(const uint4*)(src + 8 * i);
            const int d0 = 32 * j + 8 * i;
            sT[(d0 + 0) * 66 + row] = (bf16_t)(u.x & 0xffff); sT[(d0 + 1) * 66 + row] = (bf16_t)(u.x >> 16);
            sT[(d0 + 2) * 66 + row] = (bf16_t)(u.y & 0xffff); sT[(d0 + 3) * 66 + row] = (bf16_t)(u.y >> 16);
            sT[(d0 + 4) * 66 + row] = (bf16_t)(u.z & 0xffff); sT[(d0 + 5) * 66 + row] = (bf16_t)(u.z >> 16);
            sT[(d0 + 6) * 66 + row] = (bf16_t)(u.w & 0xffff); sT[(d0 + 7) * 66 + row] = (bf16_t)(u.w >> 16);
        }
    }
    __syncthreads();
    for (int e = tid; e < 128 * 32; e += NTHREADS) {
        const int d = e >> 5, tp = e & 31;
        const unsigned v = (unsigned)sT[d * 66 + 2 * tp] | ((unsigned)sT[d * 66 + 2 * tp + 1] << 16);
        *(unsigned*)(VT + ((size_t)bh * 128 + d) * 8192 + s0 + (((2 * tp) & ~12) | (((2 * tp) & 4) << 1) | (((2 * tp) & 8) >> 1))) = v;
    }
    __syncthreads();
}

template <int DQK, bool MOBA>
DEVI void attn_item(const Params& p, int bh, int qt, char* smem) {
    constexpr int NKS = DQK / 16, KCH = DQK / 8;
    const int tid = threadIdx.x, lane = tid & 63, wave = tid >> 6;
    const int r = lane & 31, hh = lane >> 5;
    char* const ws = opaque_ptr(p.ws);
    const bf16_t* Q  = (const bf16_t*)(ws + (MOBA ? OFF_QD : OFF_Q)) + (size_t)bh * 8192 * DQK;
    const bf16_t* Kg = (const bf16_t*)(ws + (MOBA ? OFF_KD : OFF_K)) + (size_t)bh * 8192 * DQK;
    const bf16_t* Vg = (const bf16_t*)(ws + (MOBA ? OFF_VDT : OFF_VT)) + (size_t)bh * 128 * 8192;
    const int q0 = qt * 128;
    const int qpos = q0 + wave * 32 + r;
    constexpr int KB = 32 * DQK * 2, VB = 8192, STG = KB + VB;
    constexpr int KI = KB / 4096;
    int*  sList = (int*)(smem + 61440);
    unsigned* sSel = (unsigned*)(smem + 62464);
    float* sTop = (float*)(smem + 63232);
    int ntiles;
    unsigned mysel = 0xffffffffu;
    if constexpr (MOBA) {
        const int jblk = q0 >> 8;
        float* sKm = (float*)smem;
        const float* km = (const float*)(ws + OFF_KMEAN) + (size_t)bh * 32 * 128;
        for (int e = tid; e < 1024; e += NTHREADS) ((float4*)sKm)[e] = ((const float4*)km)[e];
        unsigned* sAny = (unsigned*)(smem + 62976);
        if (tid < 32) sAny[tid] = 0u;
        __syncthreads();
        const int qq = tid & 127, par = tid >> 7;
        float ga[16];
#pragma unroll
        for (int i = 0; i < 16; ++i) ga[i] = 0.f;
        const bf16_t* qrow = Q + (size_t)(q0 + qq) * 128;
#pragma unroll 1
        for (int d0 = 0; d0 < 128; d0 += 8) {
            uint4 u = *(const uint4*)(qrow + d0);
            float qv[8] = {bflo(u.x), bfhi(u.x), bflo(u.y), bfhi(u.y), bflo(u.z), bfhi(u.z), bflo(u.w), bfhi(u.w)};
#pragma unroll
            for (int i = 0; i < 16; ++i) {
                const float4 ka = *(const float4*)(sKm + (2 * i + par) * 128 + d0), kb = *(const float4*)(sKm + (2 * i + par) * 128 + d0 + 4);
                ga[i] += qv[0] * ka.x + qv[1] * ka.y + qv[2] * ka.z + qv[3] * ka.w + qv[4] * kb.x + qv[5] * kb.y + qv[6] * kb.z + qv[7] * kb.w;
            }
        }
        float tv[3] = {-3e38f, -3e38f, -3e38f}; int ti[3] = {-1, -1, -1};
#pragma unroll
        for (int i = 0; i < 16; ++i) {
            const int n = 2 * i + par;
            if (n < jblk) {
                const float v = ga[i];
                if (v > tv[0]) { tv[2] = tv[1]; ti[2] = ti[1]; tv[1] = tv[0]; ti[1] = ti[0]; tv[0] = v; ti[0] = n; }
                else if (v > tv[1]) { tv[2] = tv[1]; ti[2] = ti[1]; tv[1] = v; ti[1] = n; }
                else if (v > tv[2]) { tv[2] = v; ti[2] = n; }
            }
        }
#pragma unroll
        for (int i = 0; i < 3; ++i) { sTop[tid * 6 + 2 * i] = tv[i]; sTop[tid * 6 + 2 * i + 1] = __int_as_float(ti[i]); }
        __syncthreads();
        if (par == 0) {
#pragma unroll
            for (int i = 0; i < 3; ++i) {
                const float v = sTop[(tid + 128) * 6 + 2 * i]; const int n = __float_as_int(sTop[(tid + 128) * 6 + 2 * i + 1]);
                if (n >= 0) {
                    if (v > tv[0]) { tv[2] = tv[1]; ti[2] = ti[1]; tv[1] = tv[0]; ti[1] = ti[0]; tv[0] = v; ti[0] = n; }
                    else if (v > tv[1]) { tv[2] = tv[1]; ti[2] = ti[1]; tv[1] = v; ti[1] = n; }
                    else if (v > tv[2]) { tv[2] = v; ti[2] = n; }
                }
            }
            unsigned m = 1u << jblk;
#pragma unroll
            for (int i = 0; i < 3; ++i) if (ti[i] >= 0) { m |= 1u << ti[i]; sAny[ti[i]] = 1u; }
            sSel[qq] = m;
        }
        __syncthreads();
        if (tid == 0) {
            int n = 0;
            for (int blk = 0; blk < jblk; ++blk) if (sAny[blk]) { for (int t = 0; t < 8; ++t) sList[n++] = blk * 8 + t; }
            for (int t = jblk * 8; t < (q0 + 128) / 32; ++t) sList[n++] = t;
            sSel[160] = (unsigned)n;
        }
        __syncthreads();
        ntiles = (int)sSel[160];
        mysel = sSel[wave * 32 + r];
        __syncthreads();
    } else {
        ntiles = 4 * qt + 4;
    }
    bf16x8 qf[NKS];
#pragma unroll
    for (int ks = 0; ks < NKS; ++ks) qf[ks] = *(const bf16x8*)(Q + (size_t)qpos * DQK + ks * 16 + hh * 8);
    f32x16 o[4];
#pragma unroll
    for (int dt = 0; dt < 4; ++dt)
#pragma unroll
        for (int e = 0; e < 16; ++e) o[dt][e] = 0.f;
    float lsum = 0.f;
    int koff[KI], voff[2];
#pragma unroll
    for (int i = 0; i < KI; ++i) {
        const int L = (wave * KI + i) * 64 + lane, row = L / KCH, cp = L % KCH;
        const int f = (DQK == 128) ? (row & 15) : ((row >> 1) & 7);
        koff[i] = row * DQK + (cp ^ f) * 8;
    }
#pragma unroll
    for (int i = 0; i < 2; ++i) {
        const int L = (wave * 2 + i) * 64 + lane, dv = L >> 2, cp = L & 3;
        voff[i] = dv * 8192 + (cp ^ ((dv >> 2) & 3)) * 8;
    }
    const int wv = __builtin_amdgcn_readfirstlane(wave);
#define ATT_ISSUE(LI) { const int u_ = tile_id(LI); char* st_ = smem + ((LI) % 3) * STG; \
        _Pragma("unroll") for (int i = 0; i < KI; ++i) __builtin_amdgcn_global_load_lds((const unsigned*)(Kg + (size_t)u_ * 32 * DQK + koff[i]), (unsigned*)(st_ + (wv * KI + i) * 1024), 16, 0, 0); \
        _Pragma("unroll") for (int i = 0; i < 2; ++i)  __builtin_amdgcn_global_load_lds((const unsigned*)(Vg + (size_t)u_ * 32 + voff[i]),       (unsigned*)(st_ + KB + (wv * 2 + i) * 1024), 16, 0, 0); }
    auto tile_id = [&](int li) -> int { if constexpr (MOBA) return sList[li]; else return li; };
    if (ntiles > 0) ATT_ISSUE(0)
    if (ntiles > 1) ATT_ISSUE(1)
    const int xk = ((DQK == 128) ? (r & 15) : ((r >> 1) & 7)) ^ hh;
    const int xv = (r >> 2) & 3;
#pragma unroll 1
    for (int li = 0; li < ntiles; ++li) {
        if (li + 1 < ntiles) asm volatile("s_waitcnt vmcnt(%0)" :: "n"(KI + 2) : "memory");
        else asm volatile("s_waitcnt vmcnt(0)" ::: "memory");
        G2_RAW_BARRIER();
        if (li + 2 < ntiles) ATT_ISSUE(li + 2)
        const int unit = tile_id(li);
        const int kbase = unit * 32;
        bool allowed = true;
        if constexpr (MOBA) allowed = (mysel >> (unit >> 3)) & 1u;
        const char* sK = smem + (li % 3) * STG;
        const char* sV = sK + KB;
        if (kbase <= q0 + wave * 32 + 31) {
            const char* kbase_l = sK + r * (DQK * 2);
            const char* vbase_l = sV + r * 64;
            f32x16 s;
#pragma unroll
            for (int e = 0; e < 16; ++e) s[e] = 0.f;
#pragma unroll
            for (int ks = 0; ks < NKS; ++ks) {
                const bf16x8 a = *(const bf16x8*)(kbase_l + (((2 * ks) ^ xk) << 4));
                s = mfma32(a, qf[ks], s);
            }
            const bool need_mask = (kbase + 31 > q0 + wave * 32);
            float pr[16];
            if (need_mask) {
                const int kofs = qpos - kbase - 4 * hh;
#pragma unroll
                for (int e = 0; e < 16; ++e) pr[e] = ((e & 3) + 8 * (e >> 2) <= kofs) ? __builtin_amdgcn_exp2f(s[e]) : 0.f;
            } else {
#pragma unroll
                for (int e = 0; e < 16; ++e) pr[e] = __builtin_amdgcn_exp2f(s[e]);
            }
            if constexpr (MOBA) {
                const float am = allowed ? 1.f : 0.f;
#pragma unroll
                for (int e = 0; e < 16; ++e) pr[e] *= am;
            }
            lsum += ((pr[0] + pr[1]) + (pr[2] + pr[3])) + ((pr[4] + pr[5]) + (pr[6] + pr[7])) + ((pr[8] + pr[9]) + (pr[10] + pr[11])) + ((pr[12] + pr[13]) + (pr[14] + pr[15]));
#pragma unroll
            for (int s2 = 0; s2 < 2; ++s2) {
                const u32x4 pbu = {pack2(pr[8 * s2 + 0], pr[8 * s2 + 1]), pack2(pr[8 * s2 + 2], pr[8 * s2 + 3]),
                                   pack2(pr[8 * s2 + 4], pr[8 * s2 + 5]), pack2(pr[8 * s2 + 6], pr[8 * s2 + 7])};
                const bf16x8 pbv = __builtin_bit_cast(bf16x8, pbu);
#pragma unroll
                for (int dt = 0; dt < 4; ++dt) {
                    const char* vb = vbase_l + dt * (32 * 64);
                    const u32x4 vau = *(const u32x4*)(vb + (((2 * s2 + hh) ^ xv) << 4));
                    o[dt] = mfma32(__builtin_bit_cast(bf16x8, vau), pbv, o[dt]);
                }
            }
        }
    }
#undef ATT_ISSUE
    G2_RAW_BARRIER();
    lsum += __shfl_xor(lsum, 32);
    const float inv = 1.f / lsum;
    char* sO = smem + wave * 8704;
#pragma unroll
    for (int dt = 0; dt < 4; ++dt)
#pragma unroll
        for (int e = 0; e < 16; e += 2) {
            const int dv = 32 * dt + (e & 3) + 8 * (e >> 2) + 4 * hh;
            *(unsigned*)(sO + r * 272 + dv * 2) = pack2(o[dt][e] * inv, o[dt][e + 1] * inv);
        }
    __builtin_amdgcn_s_waitcnt(0xc07f);
    __builtin_amdgcn_wave_barrier();
    bf16_t* MIX = (bf16_t*)(ws + OFF_MIX1);
    const int b = bh >> 2, h = bh & 3;
#pragma unroll
    for (int i = 0; i < 8; ++i) {
        const int id = lane + 64 * i, row = id >> 4, cc = id & 15;
        const uint4 v = *(const uint4*)(sO + row * 272 + cc * 16);
        *(uint4*)(MIX + ((size_t)b * 8192 + q0 + wave * 32 + row) * 1024 + (MOBA ? 512 : 0) + h * 128 + cc * 8) = v;
    }
    __syncthreads();
}

DEVI void attn_phase_all(const Params& p, char* smem) {
    const int G = gridDim.x;
#pragma unroll 1
    for (int v = blockIdx.x; v < 512; v += G) attn_item<192, false>(p, v & 7, 63 - (v >> 3), smem);
    __builtin_amdgcn_sched_barrier(0);
#pragma unroll 1
    for (int v = blockIdx.x; v < 512; v += G) attn_item<128, true>(p, v & 7, (v >> 3), smem);
}

#define XB_TMO      128
#define XB_XCNT(j)  (256  + 64 * (j))
#define XB_XSUB(j)  (1280 + 64 * (j))
#define XB_XGEN(j)  (2304 + 64 * (j))
#define XB_TOP      3328
#define XB_TOPGEN   3392
#define XCD_BAR_WORDS 3456
#define XB_SPIN_CAP (1u << 23)
#define LAS __attribute__((address_space(3)))
DEVI unsigned xb_ld(unsigned* p)              { return __hip_atomic_load(p, __ATOMIC_RELAXED, __HIP_MEMORY_SCOPE_AGENT); }
DEVI unsigned xb_add(unsigned* p, unsigned v) { return __hip_atomic_fetch_add(p, v, __ATOMIC_RELAXED, __HIP_MEMORY_SCOPE_AGENT); }
DEVI unsigned xb_xcc_id() { return (unsigned)__builtin_amdgcn_s_getreg((3 << 11) | 20) & 0xFu; }
#define XB_SPIN(cond, bar) do { unsigned _sp = 0; while (cond) { __builtin_amdgcn_s_sleep(1); \
    if ((++_sp & 255u) == 0u) { if (xb_ld(&(bar)[XB_TMO])) break; if (_sp > XB_SPIN_CAP) { atomicAdd(&(bar)[XB_TMO], 1u); break; } } } } while (0)
struct XcdBarrier { unsigned* bar; unsigned x; volatile LAS unsigned* st; };
DEVI XcdBarrier xcd_barrier_post(unsigned* bar, volatile LAS unsigned* st) {
    XcdBarrier b; b.bar = bar; b.x = xb_xcc_id(); b.st = st;
    if (threadIdx.x == 0) st[2] = xb_add(&bar[XB_XCNT(b.x)], 1u);
    return b;
}
DEVI void xcd_barrier_complete(unsigned* bar, unsigned x, unsigned& nloc, unsigned& nx, unsigned& dense) {
    const unsigned G = gridDim.x * gridDim.y * gridDim.z;
    unsigned sum, cnt, mine, sp = 0u;
    for (;;) {
        sum = 0u; cnt = 0u; mine = 0u; dense = 0u;
#pragma unroll
        for (unsigned j = 0; j < 16; ++j) { const unsigned c = xb_ld(&bar[XB_XCNT(j)]); sum += c; cnt += (c > 0u) ? 1u : 0u; mine = (j == x) ? c : mine; dense += (j < x && c > 0u) ? 1u : 0u; }
        if (sum == G) break;
        __builtin_amdgcn_s_sleep(1);
        if ((++sp & 255u) == 0u) { if (xb_ld(&bar[XB_TMO])) break; if (sp > XB_SPIN_CAP) { atomicAdd(&bar[XB_TMO], 1u); break; } }
    }
    nloc = mine > 0u ? mine : 1u; nx = cnt > 0u ? cnt : 1u;
}
DEVI void xcd_barrier(const XcdBarrier& b) {
    asm volatile("s_waitcnt vmcnt(0)" ::: "memory");
    __syncthreads();
    if (threadIdx.x == 0) {
        unsigned* bar = b.bar;
        __builtin_amdgcn_s_waitcnt(0);
        unsigned nloc = b.st[0], nx = b.st[1];
        if (nloc == 0u) { unsigned dense = 0u; xcd_barrier_complete(bar, b.x, nloc, nx, dense); b.st[0] = nloc; b.st[1] = nx; b.st[3] = dense; }
        const unsigned old = xb_add(&bar[XB_XSUB(b.x)], 1u);
        const unsigned gen = old / nloc;
        if (old + 1u == (gen + 1u) * nloc) {
            __builtin_amdgcn_fence(__ATOMIC_RELEASE, "agent");
            asm volatile("s_waitcnt vmcnt(0)" ::: "memory");
            const unsigned og = xb_add(&bar[XB_TOP], 1u);
            const unsigned tg = og / nx;
            if (og + 1u == (tg + 1u) * nx) xb_add(&bar[XB_TOPGEN], 1u);
            else XB_SPIN(xb_ld(&bar[XB_TOPGEN]) == tg, bar);
            __builtin_amdgcn_fence(__ATOMIC_ACQUIRE, "agent");
            xb_add(&bar[XB_XGEN(b.x)], 1u);
            asm volatile("s_waitcnt vmcnt(0)" ::: "memory");
        } else {
            XB_SPIN(xb_ld(&bar[XB_XGEN(b.x)]) == gen, bar);
            __builtin_amdgcn_fence(__ATOMIC_ACQUIRE, "agent");
            asm volatile("s_waitcnt vmcnt(0)" ::: "memory");
        }
    }
    __syncthreads();
}

enum { PH_CONV, PH_INPROJ0, PH_LOCAL, PH_SCAN, PH_HOUT, PH_OUTPROJ0, PH_Q0, PH_TOPK0, PH_PD0, PH_PR0, PH_PU0, PH_INPROJ1, PH_SMALL, PH_MLAPREP, PH_MLA,
       PH_OUTPROJ1, PH_Q1, PH_TOPK1, PH_PD1, PH_PR1, PH_PU1, N_PHASES };
DEVI void run_phase(const Params& p, int ph_in, char* smem, Placement pl) {
    const bool dup = ph_in >= 100; const int ph = dup ? ph_in - 100 : ph_in;
#ifdef ONLY_PHASE
    if (ph != ONLY_PHASE) return;
#endif
    char* ws = p.ws;
    const int bid = blockIdx.x, nb = gridDim.x;
    const int myslice = (pl.nloc > 0) ? (pl.xcc & 7) : (bid & 7);
    switch (ph) {
    case PH_CONV: phase_convert(p, smem); break;
    case PH_INPROJ0: gemm2_phase((const bf16_t*)(ws + OFF_XB), 1024, (const bf16_t*)(ws + OFF_W_IN0T), 128, 12, 1024, (const float*)(ws + OFF_SSQ1), 1,
                        Epi2In0{(bf16_t*)(ws + OFF_Z0), (float*)(ws + OFF_G), (const float*)(ws + OFF_LB), (bf16_t*)(ws + OFF_Z0), 3072, 3072, nullptr, nullptr}, smem, pl); break;
    case PH_LOCAL: for (int it = bid; it < 1024; it += nb) hgrn_local_item(p, it, smem);
            for (int it = nb - 1 - bid; it < 512; it += nb) gmlp_item(p, it, smem);
            break;
    case PH_SCAN: hgrn_scan_phase(p); break;
    case PH_HOUT: for (int it = bid; it < 1024; it += nb) hgrn_out_item(p, it, smem); break;
    case PH_OUTPROJ0: case PH_OUTPROJ1: {
        const bool l1 = (ph == PH_OUTPROJ1);
        gemm2_phase((const bf16_t*)(ws + (l1 ? OFF_MIX1 : OFF_MIX0)), 1024, (const bf16_t*)(ws + (l1 ? OFF_W_OUT1T : OFF_W_OUT0T)), 128, 4, 1024, nullptr, 0,
                    Epi2Resid{(bf16_t*)(ws + OFF_XB), (float*)(ws + OFF_SSQ16), dup ? 0.f : (l1 ? ALPHA_M1 : ALPHA_M0), nullptr, 0, 0, nullptr, nullptr}, smem, pl);
    } break;
    case PH_Q0: case PH_Q1: {
        const bool l1 = (ph == PH_Q1);
        gemm2_phase((const bf16_t*)(ws + OFF_XB), 1024, (const bf16_t*)(ws + (l1 ? OFF_W_Q1T : OFF_W_Q0T)), 128, 8, 1024, (const float*)(ws + OFF_SSQ16), 16,
                    Epi2Bf16{(bf16_t*)(ws + OFF_QP), 2048, 2048, nullptr, nullptr}, smem, pl);
    } break;
    case PH_TOPK0: case PH_TOPK1: peer_topk_phase(p, (const bf16_t*)(ws + (ph == PH_TOPK1 ? OFF_SK1 : OFF_SK0)), bid, nb, smem); break;
    case PH_PD0: case PH_PD1: peer_down_phase(p, (ph == PH_PD1) ? p.l1_norm_ffn : p.l0_norm_ffn, ((ph == PH_PD1) ? 16 : 0) + (dup ? 32 : 0), myslice, smem); break;
    case PH_PR0: case PH_PR1: peer_reduce_phase(p); break;
    case PH_PU0: case PH_PU1: peer_up_phase(p, ((ph == PH_PU1) ? 24 : 8) + (dup ? 32 : 0), myslice, dup ? 0.f : ((ph == PH_PU1) ? ALPHA_P1 : ALPHA_P0), (ph == PH_PU1 && !dup) ? p.out : nullptr, smem); break;
    case PH_INPROJ1: gemm2_phase((const bf16_t*)(ws + OFF_XB), 1024, (const bf16_t*)(ws + OFF_W_IN1T), 128, 8, 1024, (const float*)(ws + OFF_SSQ8), 8, Epi2Bf16{(bf16_t*)(ws + OFF_Z1), 1984, 1984, (float*)(ws + OFF_SSQCQ), (float*)(ws + OFF_SSQCKV)}, smem, pl);
            for (int it = bid; it < 8192; it += nb) conv_experts(p.l1_exp_down, p.l1_exp_up, p.l1_norm_ffn, ws, it);
            break;
    case PH_SMALL: {
        gemm2_phase((const bf16_t*)(ws + OFF_Z1), 1984, (const bf16_t*)(ws + OFF_W_UQT), 128, 3, 256, (const float*)(ws + OFF_SSQCQ), 1, Epi2Bf16{(bf16_t*)(ws + OFF_QC), 768, 768, nullptr, nullptr}, smem, pl);
        gemm2_phase((const bf16_t*)(ws + OFF_Z1) + 256, 1984, (const bf16_t*)(ws + OFF_W_UKVT), 128, 4, 128, (const float*)(ws + OFF_SSQCKV), 1, Epi2Bf16{(bf16_t*)(ws + OFF_KV), 1024, 1024, nullptr, nullptr}, smem, pl);
        for (int it = (bid + nb / 2) % nb; it < 1024 + 256; it += nb) { if (it < 1024) moba_prep_item(p, it, smem); else moba_kmean_item(p, it - 1024, smem); }
    } break;
    case PH_MLAPREP: for (int it = bid; it < 1024; it += nb) mla_prep_item(p, it, smem); break;
    case PH_MLA: attn_phase_all(p, smem); break;
    default: break;
    }
}

extern "C" __global__ void __launch_bounds__(NTHREADS, 2) fwd_kernel(Params p) {
    extern __shared__ __attribute__((aligned(16))) char smem[];
    __shared__ uint4 xb_words;
    XcdBarrier xb; xb.bar = nullptr; xb.x = 0; xb.st = (volatile LAS unsigned*)&xb_words;
    if (p.coop) {
        if (threadIdx.x == 0) xb_words = make_uint4(0u, 0u, 0u, 0u);
        __syncthreads();
        xb = xcd_barrier_post((unsigned*)(p.ws + OFF_BAR), (volatile LAS unsigned*)&xb_words);
    }
    if (p.coop == 2) cg::this_grid().sync();
#define RUN_PH(PH) if (p.ph_lo <= PH && PH < p.ph_hi) { \
        Placement pl_; pl_.xcc = p.coop ? (int)xb.st[3] : 0; pl_.rank = p.coop ? (int)xb.st[2] : 0; pl_.nloc = p.coop ? (int)xb.st[0] : 0; pl_.nx = p.coop ? (int)xb.st[1] : 0; \
        if (PROBE_DUP == PH) { run_phase(p, PH + 100, smem, pl_); if (p.coop) xcd_barrier(xb); } \
        run_phase(p, PH, smem, pl_); if (p.coop && PH + 1 < p.ph_hi) xcd_barrier(xb); }
    RUN_PH(0) RUN_PH(1) RUN_PH(2) RUN_PH(3) RUN_PH(4) RUN_PH(5) RUN_PH(6) RUN_PH(7) RUN_PH(8) RUN_PH(9)
    RUN_PH(10) RUN_PH(11) RUN_PH(12) RUN_PH(13) RUN_PH(14) RUN_PH(15) RUN_PH(16) RUN_PH(17) RUN_PH(18) RUN_PH(19) RUN_PH(20)
}

extern "C" void kernel_launch(void* const* d_in, const int* in_sizes, int n_in, void* d_out, int out_size, void* d_ws, size_t ws_size, hipStream_t stream) {
    static int grid = 0;
    if (grid == 0) {
        if (n_in != 31 || out_size != 16384 * 1024 || ws_size < WS_NEED) { fprintf(stderr, "kernel_launch: unexpected shapes (n_in %d out %d ws %zu need %zu)\n", n_in, out_size, ws_size, (size_t)WS_NEED); grid = -1; return; }
        int dev = 0, cus = 0, per_cu = 0;
        hipGetDevice(&dev);
        hipDeviceGetAttribute(&cus, hipDeviceAttributeMultiprocessorCount, dev);
        if (hipFuncSetAttribute((const void*)fwd_kernel, hipFuncAttributeMaxDynamicSharedMemorySize, LDS_BYTES) != hipSuccess) { fprintf(stderr, "kernel_launch: hipFuncSetAttribute failed\n"); grid = -1; return; }
        if (hipOccupancyMaxActiveBlocksPerMultiprocessor(&per_cu, (const void*)fwd_kernel, NTHREADS, LDS_BYTES) != hipSuccess || per_cu < 1) { fprintf(stderr, "kernel_launch: occupancy query failed (%d)\n", per_cu); per_cu = 1; }
        (void)hipGetLastError();
        if (per_cu > 2) per_cu = 2;
        grid = cus * per_cu;
        fprintf(stderr, "kernel_launch: grid %d (%d CUs x %d)\n", grid, cus, per_cu);
    }
    if (grid < 0) return;
    Params p; memset(&p, 0, sizeof(p));
    const float* const* f = (const float* const*)d_in;
    p.x = f[0]; p.pos = (const int*)d_in[1]; p.lb_logits = f[2];
    p.l0_norm_mix = f[3]; p.l0_w_in = f[4]; p.l0_hgrn_out_norm = f[5]; p.l0_gmlp_v_norm = f[6]; p.l0_gmlp_w_s = f[7]; p.l0_gmlp_b_s = f[8]; p.l0_w_out = f[9];
    p.l0_norm_ffn = f[10]; p.l0_w_query = f[11]; p.l0_sub_keys = f[12]; p.l0_exp_down = f[13]; p.l0_exp_up = f[14];
    p.l1_norm_mix = f[15]; p.l1_w_in = f[16]; p.l1_cq_norm = f[17]; p.l1_ckv_norm = f[18]; p.l1_w_uq = f[19]; p.l1_w_ukv = f[20];
    p.l1_q_norm = f[21]; p.l1_k_norm = f[22]; p.l1_mq_norm = f[23]; p.l1_mk_norm = f[24]; p.l1_w_out = f[25];
    p.l1_norm_ffn = f[26]; p.l1_w_query = f[27]; p.l1_sub_keys = f[28]; p.l1_exp_down = f[29]; p.l1_exp_up = f[30];
    p.out = (float*)d_out; p.ws = (char*)d_ws;
    if (hipMemsetAsync((char*)d_ws + OFF_BAR, 0, 16384 + 4096, stream) != hipSuccess) { fprintf(stderr, "kernel_launch: memset failed\n"); return; }
#if N_LAUNCH_MODE == 1
    p.ph_lo = 0; p.ph_hi = N_PHASES; p.coop = 1;
    void* args[] = {&p};
    hipError_t e = hipLaunchCooperativeKernel((const void*)fwd_kernel, dim3(grid), dim3(NTHREADS), args, LDS_BYTES, stream);
    if (e != hipSuccess) fprintf(stderr, "cooperative launch failed: %s (grid %d)\n", hipGetErrorString(e), grid);
#else
    for (int ph = 0; ph < N_PHASES; ++ph) {
#ifdef ABLATE_M1
        if (ph >= 10 && ph <= 14) continue;
#endif
        p.ph_lo = ph; p.ph_hi = ph + 1; p.coop = 0;
        hipLaunchKernelGGL(fwd_kernel, dim3(grid), dim3(NTHREADS), LDS_BYTES, stream, p);
    }
#endif
}
```

```cpp
#include <hip/hip_runtime.h>
#include <hip/hip_cooperative_groups.h>
#include <stdint.h>
#include <stdio.h>
#include <string.h>
namespace cg = cooperative_groups;

#ifndef ALPHA_P0
#define ALPHA_P0 1.0f
#endif
#ifndef ALPHA_P1
#define ALPHA_P1 1.0f
#endif
#ifndef ALPHA_M0
#define ALPHA_M0 1.0f
#endif
#ifndef ALPHA_M1
#define ALPHA_M1 1.0f
#endif
#ifndef PROBE_DUP
#define PROBE_DUP -1
#endif
#ifndef N_LAUNCH_MODE
#define N_LAUNCH_MODE 1
#endif

typedef unsigned short bf16_t;
using bf16x8 = __attribute__((ext_vector_type(8))) short;
using f32x4  = __attribute__((ext_vector_type(4))) float;
using f32x16 = __attribute__((ext_vector_type(16))) float;
typedef float f32x4v __attribute__((ext_vector_type(4)));
typedef float f32x2_t __attribute__((ext_vector_type(2)));
typedef __bf16 bf16x2_t __attribute__((ext_vector_type(2)));
typedef unsigned u32x4 __attribute__((ext_vector_type(4)));

#define DEVI __device__ __forceinline__
#define NTHREADS 256
#define LDS_BYTES 80896

static constexpr size_t MB = 1024 * 1024;
static constexpr size_t OFF_W_IN0T  = 0;
static constexpr size_t OFF_W_OUT0T = OFF_W_IN0T  + 3072ull * 1024 * 2;
static constexpr size_t OFF_W_Q0T   = OFF_W_OUT0T + 1024ull * 1024 * 2;
static constexpr size_t OFF_SK0     = OFF_W_Q0T   + 2048ull * 1024 * 2;
static constexpr size_t OFF_WS0     = OFF_SK0     + 262144ull * 2;
static constexpr size_t OFF_W_IN1T  = OFF_WS0     + 65536ull * 2;
static constexpr size_t OFF_W_UQT   = OFF_W_IN1T  + 2048ull * 1024 * 2;
static constexpr size_t OFF_W_UKVT  = OFF_W_UQT   + 768ull * 256 * 2;
static constexpr size_t OFF_W_OUT1T = OFF_W_UKVT  + 1024ull * 128 * 2;
static constexpr size_t OFF_W_Q1T   = OFF_W_OUT1T + 1024ull * 1024 * 2;
static constexpr size_t OFF_SK1     = OFF_W_Q1T   + 2048ull * 1024 * 2;
static constexpr size_t OFF_LB      = OFF_SK1     + 262144ull * 2;
static constexpr size_t OFF_INVD    = OFF_LB + 4096;
static constexpr size_t OFF_INVU    = OFF_INVD + 65536;
static constexpr size_t OFF_BAR     = OFF_INVU + 65536;
static constexpr size_t OFF_QCNT    = OFF_BAR + 14336;
static constexpr size_t OFF_ED      = 26 * MB;
static constexpr size_t OFF_EU      = OFF_ED + 32 * MB;
static constexpr size_t OFF_ACT     = OFF_EU + 32 * MB;
static constexpr size_t OFF_Z0   = OFF_ACT;
static constexpr size_t OFF_G    = OFF_Z0  + 16384ull * 3072 * 2;
static constexpr size_t OFF_HST  = OFF_G   + 16384ull * 512 * 4;
static constexpr size_t OFF_DEC  = OFF_HST + 1024ull * 16384 * 4;
static constexpr size_t OFF_MIX0 = OFF_DEC + 1024ull * 128 * 4;
static constexpr size_t OFF_QP   = OFF_ACT;
static constexpr size_t OFF_IDX  = OFF_QP  + 16384ull * 2048 * 2;
static constexpr size_t OFF_GATE = OFF_IDX + 16384ull * 128 * 4;
static constexpr size_t OFF_ACTW = OFF_GATE + 16384ull * 128 * 4;
static constexpr size_t OFF_PART = OFF_QP;
static constexpr size_t OFF_SDN  = OFF_ACTW + 16384ull * 128 * 4;
static constexpr size_t OFF_Z1   = OFF_ACT;
static constexpr size_t OFF_MIX1 = OFF_ACT;
static constexpr size_t OFF_QC   = OFF_Z1  + 16384ull * 1984 * 2;
static constexpr size_t OFF_KV   = OFF_QC  + 16384ull * 768 * 2;
static constexpr size_t OFF_QD   = OFF_KV  + 16384ull * 1024 * 2;
static constexpr size_t OFF_KD   = OFF_QD  + 16384ull * 512 * 2;
static constexpr size_t OFF_VDT  = OFF_KD  + 16384ull * 512 * 2;
static constexpr size_t OFF_Q    = OFF_VDT + 16384ull * 512 * 2;
static constexpr size_t OFF_K    = OFF_Q   + 16384ull * 768 * 2;
static constexpr size_t OFF_VT   = OFF_K   + 16384ull * 768 * 2;
static constexpr size_t OFF_KMEAN= OFF_VT  + 16384ull * 512 * 2;
static constexpr size_t WS_END_L1 = OFF_KMEAN + 8ull * 32 * 128 * 4;
static constexpr size_t WS_END_L0 = OFF_MIX0 + 16384ull * 1024 * 2;
static constexpr size_t WS_END_ACT = (WS_END_L1 > WS_END_L0 ? WS_END_L1 : WS_END_L0);
static constexpr size_t OFF_XB    = (WS_END_ACT + 255) / 256 * 256;
static constexpr size_t OFF_SSQ1  = OFF_XB + 16384ull * 1024 * 2;
static constexpr size_t OFF_SSQ16 = OFF_SSQ1 + 16384ull * 4;
static constexpr size_t OFF_SSQ8  = OFF_SSQ16 + 16384ull * 16 * 4;
static constexpr size_t OFF_XB8   = OFF_ED + 16 * MB;
static constexpr size_t OFF_SSQCQ = OFF_SSQ8 + 16384ull * 8 * 4;
static constexpr size_t OFF_SSQCKV = OFF_SSQCQ + 16384ull * 4;
static constexpr size_t WS_NEED = OFF_SSQCKV + 16384ull * 4;
static_assert(OFF_BAR + 16384 + 4096 <= OFF_ED, "weights overflow");

struct Params {
    const float* x; const int* pos; const float* lb_logits;
    const float *l0_norm_mix, *l0_w_in, *l0_hgrn_out_norm, *l0_gmlp_v_norm, *l0_gmlp_w_s, *l0_gmlp_b_s, *l0_w_out,
                *l0_norm_ffn, *l0_w_query, *l0_sub_keys, *l0_exp_down, *l0_exp_up;
    const float *l1_norm_mix, *l1_w_in, *l1_cq_norm, *l1_ckv_norm, *l1_w_uq, *l1_w_ukv, *l1_q_norm, *l1_k_norm,
                *l1_mq_norm, *l1_mk_norm, *l1_w_out, *l1_norm_ffn, *l1_w_query, *l1_sub_keys, *l1_exp_down, *l1_exp_up;
    float* out;
    char* ws;
    int ph_lo, ph_hi, coop, pad0;
};

DEVI unsigned pack2(float lo, float hi) { f32x2_t v = {lo, hi}; bf16x2_t b = __builtin_convertvector(v, bf16x2_t); return __builtin_bit_cast(unsigned, b); }
DEVI bf16_t f2bf(float f) { return (bf16_t)(pack2(f, 0.f) & 0xffffu); }
DEVI float bf2f(bf16_t h) { return __uint_as_float(((unsigned)h) << 16); }
DEVI float bflo(unsigned u) { return __uint_as_float(u << 16); }
DEVI float bfhi(unsigned u) { return __uint_as_float(u & 0xffff0000u); }
DEVI float sigm(float x) { return 1.f / (1.f + __expf(-x)); }
DEVI float gelu_tanh(float x) {
    float y = 0.7978845608028654f * (x + 0.044715f * x * x * x);
    float e = __expf(2.f * y);
    float t = 1.f - 2.f / (1.f + e);
    return 0.5f * x * (1.f + t);
}
DEVI char* opaque_ptr(char* q) { asm volatile("" : "+s"(q)); return q; }
DEVI f32x4  mfma16(bf16x8 a, bf16x8 b, f32x4 c)  { return __builtin_amdgcn_mfma_f32_16x16x32_bf16(a, b, c, 0, 0, 0); }
DEVI f32x16 mfma32(bf16x8 a, bf16x8 b, f32x16 c) { return __builtin_amdgcn_mfma_f32_32x32x16_bf16(a, b, c, 0, 0, 0); }

template <int KW> DEVI int swz_off(int row, int c) {
    if constexpr (KW == 128) return row * 256 + ((c ^ (row & 15)) << 4);
    else return row * (KW * 2) + ((c ^ ((row >> 1) & 7)) << 4);
}
template <int KW> DEVI int swz_elem(int row, int k) { return swz_off<KW>(row, k >> 3) + ((k & 7) << 1); }

template <int MT, int NT, int KWA, int KWB>
DEVI void mma_nt(f32x4 (&acc)[MT][NT], const char* A, int a_row0, const char* B, int b_row0, int kc0, int nks, int lane) {
    const int r = lane & 15, q = lane >> 4;
#pragma unroll 1
    for (int ks = 0; ks < nks; ++ks) {
        bf16x8 a[MT], b[NT];
#pragma unroll
        for (int i = 0; i < MT; ++i) a[i] = *(const bf16x8*)(A + swz_off<KWA>(a_row0 + 16 * i + r, kc0 + ks * 4 + q));
#pragma unroll
        for (int j = 0; j < NT; ++j) b[j] = *(const bf16x8*)(B + swz_off<KWB>(b_row0 + 16 * j + r, kc0 + ks * 4 + q));
#pragma unroll
        for (int i = 0; i < MT; ++i)
#pragma unroll
            for (int j = 0; j < NT; ++j) acc[i][j] = mfma16(a[i], b[j], acc[i][j]);
    }
}

DEVI void conv_transpose_tile(const float* __restrict__ src, int K, int N, bf16_t* __restrict__ dst, int kt, int nt, char* smem, const float* __restrict__ kgain = nullptr) {
    float* s = (float*)smem;
    const int tid = threadIdx.x;
    for (int e = tid; e < 4096; e += NTHREADS) {
        int kk = e >> 6, nn = e & 63;
        int n = nt * 64 + nn;
        const float gk = kgain ? kgain[kt * 64 + kk] : 1.f;
        s[kk * 65 + nn] = (n < N) ? src[(size_t)(kt * 64 + kk) * N + n] * gk : 0.f;
    }
    __syncthreads();
    for (int e = tid; e < 2048; e += NTHREADS) {
        int nn = e >> 5, kp = e & 31;
        unsigned v = pack2(s[(2 * kp) * 65 + nn], s[(2 * kp + 1) * 65 + nn]);
        *(unsigned*)(dst + (size_t)(nt * 64 + nn) * K + kt * 64 + 2 * kp) = v;
    }
    __syncthreads();
}
DEVI void conv_plain_chunk(const float* __restrict__ src, bf16_t* __restrict__ dst, size_t chunk) {
    const int tid = threadIdx.x;
    size_t base = chunk * 4096 + (size_t)tid * 16;
    const float4* s4 = (const float4*)(src + base);
    float4 a = s4[0], b = s4[1], c = s4[2], d = s4[3];
    uint4 o0, o1;
    o0.x = pack2(a.x, a.y); o0.y = pack2(a.z, a.w); o0.z = pack2(b.x, b.y); o0.w = pack2(b.z, b.w);
    o1.x = pack2(c.x, c.y); o1.y = pack2(c.z, c.w); o1.z = pack2(d.x, d.y); o1.w = pack2(d.z, d.w);
    uint4* d4 = (uint4*)(dst + base);
    d4[0] = o0; d4[1] = o1;
}
DEVI void conv_experts(const float* down, const float* up, const float* __restrict__ dgain, char* ws, int it  ) {
    const int lane = threadIdx.x & 63, wave = threadIdx.x >> 6;
    const bool isup = it >= 4096;
    const int row = (isup ? it - 4096 : it) * 4 + wave;
    const float* src = (isup ? up : down) + (size_t)row * 1024 + 16 * lane;
    float4 a = *(const float4*)src, b = *(const float4*)(src + 4), c = *(const float4*)(src + 8), d = *(const float4*)(src + 12);
    if (!isup) {
        const float4 ga = *(const float4*)(dgain + 16 * lane), gb = *(const float4*)(dgain + 16 * lane + 4), gc = *(const float4*)(dgain + 16 * lane + 8), gd = *(const float4*)(dgain + 16 * lane + 12);
        a.x *= ga.x; a.y *= ga.y; a.z *= ga.z; a.w *= ga.w; b.x *= gb.x; b.y *= gb.y; b.z *= gb.z; b.w *= gb.w;
        c.x *= gc.x; c.y *= gc.y; c.z *= gc.z; c.w *= gc.w; d.x *= gd.x; d.y *= gd.y; d.z *= gd.z; d.w *= gd.w;
    }
    float mx = fmaxf(fmaxf(fmaxf(fabsf(a.x), fabsf(a.y)), fmaxf(fabsf(a.z), fabsf(a.w))), fmaxf(fmaxf(fabsf(b.x), fabsf(b.y)), fmaxf(fabsf(b.z), fabsf(b.w))));
    mx = fmaxf(mx, fmaxf(fmaxf(fmaxf(fabsf(c.x), fabsf(c.y)), fmaxf(fabsf(c.z), fabsf(c.w))), fmaxf(fmaxf(fabsf(d.x), fabsf(d.y)), fmaxf(fabsf(d.z), fabsf(d.w)))));
#pragma unroll
    for (int o = 1; o < 64; o <<= 1) mx = fmaxf(mx, __shfl_xor(mx, o));
    const float sc = (mx > 0.f) ? 416.f / mx : 1.f;
    const float inv = (mx > 0.f) ? mx / 416.f : 1.f;
    int w0 = 0, w1 = 0, w2 = 0, w3 = 0;
    w0 = __builtin_amdgcn_cvt_pk_fp8_f32(a.x * sc, a.y * sc, w0, false); w0 = __builtin_amdgcn_cvt_pk_fp8_f32(a.z * sc, a.w * sc, w0, true);
    w1 = __builtin_amdgcn_cvt_pk_fp8_f32(b.x * sc, b.y * sc, w1, false); w1 = __builtin_amdgcn_cvt_pk_fp8_f32(b.z * sc, b.w * sc, w1, true);
    w2 = __builtin_amdgcn_cvt_pk_fp8_f32(c.x * sc, c.y * sc, w2, false); w2 = __builtin_amdgcn_cvt_pk_fp8_f32(c.z * sc, c.w * sc, w2, true);
    w3 = __builtin_amdgcn_cvt_pk_fp8_f32(d.x * sc, d.y * sc, w3, false); w3 = __builtin_amdgcn_cvt_pk_fp8_f32(d.z * sc, d.w * sc, w3, true);
    *(int4*)(ws + (isup ? OFF_EU : OFF_ED) + ((size_t)(lane >> 3) * 16384 + row) * 128 + 16 * (lane & 7)) = int4{w0, w1, w2, w3};
    if (lane == 0) ((float*)(ws + (isup ? OFF_INVU : OFF_INVD)))[row] = inv;
}

DEVI void phase_convert(const Params& p, char* smem) {
    char* ws = p.ws;
    const int bid = blockIdx.x, nb = gridDim.x;
    for (int t = bid; t < 768; t += nb) conv_transpose_tile(p.l0_w_in,    1024, 3072, (bf16_t*)(ws + OFF_W_IN0T),  t / 48, t % 48, smem, p.l0_norm_mix);
    for (int t = (bid + nb - 256 % nb) % nb; t < 256; t += nb) conv_transpose_tile(p.l0_w_out,   1024, 1024, (bf16_t*)(ws + OFF_W_OUT0T), t / 16, t % 16, smem);
    for (int t = bid; t < 512; t += nb) conv_transpose_tile(p.l0_w_query, 1024, 2048, (bf16_t*)(ws + OFF_W_Q0T),   t / 32, t % 32, smem, p.l0_norm_ffn);
    for (int t = bid; t < 512; t += nb) conv_transpose_tile(p.l1_w_in,    1024, 1984, (bf16_t*)(ws + OFF_W_IN1T),  t / 32, t % 32, smem, p.l1_norm_mix);
    for (int t = bid; t < 48; t += nb)  conv_transpose_tile(p.l1_w_uq,     256,  768, (bf16_t*)(ws + OFF_W_UQT),   t / 12, t % 12, smem, p.l1_cq_norm);
    for (int t = nb - 1 - bid; t < 32; t += nb)  conv_transpose_tile(p.l1_w_ukv,    128, 1024, (bf16_t*)(ws + OFF_W_UKVT),  t / 16, t % 16, smem, p.l1_ckv_norm);
    for (int t = (bid + nb - 256 % nb) % nb; t < 256; t += nb) conv_transpose_tile(p.l1_w_out,   1024, 1024, (bf16_t*)(ws + OFF_W_OUT1T), t / 16, t % 16, smem);
    for (int t = bid; t < 512; t += nb) conv_transpose_tile(p.l1_w_query, 1024, 2048, (bf16_t*)(ws + OFF_W_Q1T),   t / 32, t % 32, smem, p.l1_norm_ffn);
    for (int t = bid - 64; t < 64; t += nb) if (t >= 0) conv_plain_chunk(p.l0_sub_keys, (bf16_t*)(ws + OFF_SK0), t);
    for (int t = bid - 128; t < 64; t += nb) if (t >= 0) conv_plain_chunk(p.l1_sub_keys, (bf16_t*)(ws + OFF_SK1), t);
    for (int chunk = bid - 192; chunk < 16; chunk += nb) if (chunk >= 0) {
        bf16_t* dst = (bf16_t*)(ws + OFF_WS0);
        for (int e = threadIdx.x; e < 4096; e += NTHREADS) {
            int idx = chunk * 4096 + e; int t = (idx >> 7) & 127, sI = idx & 127;
            dst[idx] = f2bf(sI <= t ? p.l0_gmlp_w_s[idx] : 0.f);
        }
    }
    if (bid == nb - 1) {
        float* lb = (float*)(ws + OFF_LB);
        for (int c = threadIdx.x; c < 512; c += NTHREADS) {
            float a0 = p.lb_logits[c], a1 = p.lb_logits[512 + c], a2 = p.lb_logits[1024 + c];
            float m = fmaxf(a0, fmaxf(a1, a2));
            float e0 = __expf(a0 - m), e1 = __expf(a1 - m), e2 = __expf(a2 - m);
            lb[c] = e0 / (e0 + e1 + e2);
        }
    }
    for (int it = bid; it < 8192; it += nb) conv_experts(p.l0_exp_down, p.l0_exp_up, p.l0_norm_ffn, ws, it);
    {
        const int lane = threadIdx.x & 63, wave = threadIdx.x >> 6;
        for (int it = bid; it < 4096; it += nb) {
            const size_t row = (size_t)it * 4 + wave;
            const float* xr = p.x + row * 1024 + 16 * lane;
            const float4 a = *(const float4*)xr, b = *(const float4*)(xr + 4), c = *(const float4*)(xr + 8), d = *(const float4*)(xr + 12);
            float ss = a.x * a.x + a.y * a.y + a.z * a.z + a.w * a.w + b.x * b.x + b.y * b.y + b.z * b.z + b.w * b.w
                     + c.x * c.x + c.y * c.y + c.z * c.z + c.w * c.w + d.x * d.x + d.y * d.y + d.z * d.z + d.w * d.w;
#pragma unroll
            for (int o = 1; o < 64; o <<= 1) ss += __shfl_xor(ss, o);
            uint4 o0, o1;
            o0.x = pack2(a.x, a.y); o0.y = pack2(a.z, a.w); o0.z = pack2(b.x, b.y); o0.w = pack2(b.z, b.w);
            o1.x = pack2(c.x, c.y); o1.y = pack2(c.z, c.w); o1.z = pack2(d.x, d.y); o1.w = pack2(d.z, d.w);
            bf16_t* xb = (bf16_t*)(ws + OFF_XB) + row * 1024 + 16 * lane;
            *(uint4*)xb = o0; *(uint4*)(xb + 8) = o1;
            if (lane == 0) ((float*)(ws + OFF_SSQ1))[row] = ss;
        }
    }
}

template <int AMODE, class Epi>
DEVI void gemm_phase(const void* __restrict__ Aptr, int lda, const float* __restrict__ gain, const bf16_t* __restrict__ Bt,
                           int M, int Npad, int K, Epi epi, char* smem, int blk0, int nblk) {
    const int tid = threadIdx.x, lane = tid & 63, wave = tid >> 6;
    const int wm = wave >> 1, wn = wave & 1;
    const int tn = Npad / 128, tm = M / 128, nkt = K / 64;
    float* sRstd = (float*)(smem + 65536);
    const int crow = tid >> 3, cc = tid & 7;
    for (int tile = blk0; tile < tm * tn; tile += nblk) {
        const int m0 = (tile / tn) * 128, n0 = (tile % tn) * 128;
        f32x4 acc[4][4];
#pragma unroll
        for (int i = 0; i < 4; ++i)
#pragma unroll
            for (int j = 0; j < 4; ++j) acc[i][j] = f32x4{0.f, 0.f, 0.f, 0.f};
        float ss[4] = {0.f, 0.f, 0.f, 0.f};
        f32x4v ra[4][2]; u32x4 rab[4]; u32x4 rb[4]; f32x4v g0, g1;
        auto gload = [&](int kt) {
            const int k0 = kt * 64 + cc * 8;
#pragma unroll
            for (int i = 0; i < 4; ++i) {
                const int row = crow + 32 * i;
                if constexpr (AMODE == 0) {
                    const float* pa = (const float*)Aptr + (size_t)(m0 + row) * lda + k0;
                    ra[i][0] = *(const f32x4v*)pa; ra[i][1] = *(const f32x4v*)(pa + 4);
                } else {
                    const bf16_t* pa = (const bf16_t*)Aptr + (size_t)(m0 + row) * lda + k0;
                    rab[i] = *(const u32x4*)pa;
                }
                rb[i] = *(const u32x4*)(Bt + (size_t)(n0 + row) * K + k0);
            }
            if constexpr (AMODE != 1) { g0 = *(const f32x4v*)(gain + k0); g1 = *(const f32x4v*)(gain + k0 + 4); }
        };
        auto lstore = [&](int buf) {
            char* sA = smem + buf * 32768; char* sB = sA + 16384;
#pragma unroll
            for (int i = 0; i < 4; ++i) {
                const int row = crow + 32 * i;
                u32x4 o;
                if constexpr (AMODE == 0) {
                    f32x4v a = ra[i][0], b = ra[i][1];
                    ss[i] += a.x * a.x + a.y * a.y + a.z * a.z + a.w * a.w + b.x * b.x + b.y * b.y + b.z * b.z + b.w * b.w;
                    o.x = pack2(a.x * g0.x, a.y * g0.y); o.y = pack2(a.z * g0.z, a.w * g0.w);
                    o.z = pack2(b.x * g1.x, b.y * g1.y); o.w = pack2(b.z * g1.z, b.w * g1.w);
                } else if constexpr (AMODE == 2) {
                    u32x4 u = rab[i];
                    float a0 = bflo(u.x), a1 = bfhi(u.x), a2 = bflo(u.y), a3 = bfhi(u.y), a4 = bflo(u.z), a5 = bfhi(u.z), a6 = bflo(u.w), a7 = bfhi(u.w);
                    ss[i] += a0 * a0 + a1 * a1 + a2 * a2 + a3 * a3 + a4 * a4 + a5 * a5 + a6 * a6 + a7 * a7;
                    o.x = pack2(a0 * g0.x, a1 * g0.y); o.y = pack2(a2 * g0.z, a3 * g0.w);
                    o.z = pack2(a4 * g1.x, a5 * g1.y); o.w = pack2(a6 * g1.z, a7 * g1.w);
                } else o = rab[i];
                *(u32x4*)(sA + swz_off<64>(row, cc)) = o;
                *(u32x4*)(sB + swz_off<64>(row, cc)) = rb[i];
            }
        };
        gload(0); lstore(0); __syncthreads();
#pragma unroll 1
        for (int kt = 0; kt < nkt; ++kt) {
            if (kt + 1 < nkt) gload(kt + 1);
            const char* sA = smem + (kt & 1) * 32768; const char* sB = sA + 16384;
            mma_nt<4, 4, 64, 64>(acc, sA, wm * 64, sB, wn * 64, 0, 2, lane);
            if (kt + 1 < nkt) lstore((kt + 1) & 1);
            __syncthreads();
        }
        if constexpr (AMODE != 1) {
#pragma unroll
            for (int i = 0; i < 4; ++i) {
                float s = ss[i];
                s += __shfl_xor(s, 1); s += __shfl_xor(s, 2); s += __shfl_xor(s, 4);
                if (cc == 0) sRstd[crow + 32 * i] = rsqrtf(s / (float)K + 1e-6f);
            }
            __syncthreads();
        }
#pragma unroll
        for (int i = 0; i < 4; ++i)
#pragma unroll
            for (int r = 0; r < 4; ++r) {
                const int rl = wm * 64 + i * 16 + (lane >> 4) * 4 + r;
                const float rs = (AMODE != 1) ? sRstd[rl] : 1.f;
#pragma unroll
                for (int j = 0; j < 4; ++j) epi(m0 + rl, n0 + wn * 64 + j * 16 + (lane & 15), acc[i][j][r] * rs);
                __builtin_amdgcn_sched_barrier(0);
            }
    }
}

struct Placement { int xcc, rank, nloc, nx; };
#define G2_RAW_BARRIER() do { asm volatile("s_waitcnt lgkmcnt(0)" ::: "memory"); __builtin_amdgcn_s_barrier(); } while (0)
template <class Epi>
DEVI void gemm2_phase(const bf16_t* __restrict__ A, int lda, const bf16_t* __restrict__ Bt, int tm, int tn, int K,
                      const float* __restrict__ ssq, int nss, Epi epi, char* smem, Placement pl) {
    const int tid = threadIdx.x, lane = tid & 63;
    const int wave = __builtin_amdgcn_readfirstlane(tid >> 6);
    const int wm = wave >> 1, wn = wave & 1;
    const int nkt = K / 32;
    constexpr int STG = 24576;
    float* sRstd = (float*)(smem + 3 * STG);
    int xcd = blockIdx.x & 7, slot = blockIdx.x >> 3, nslots = gridDim.x >> 3, nxc = 8;
    if (pl.nloc > 0) { xcd = pl.xcc; slot = pl.rank; nslots = pl.nloc; nxc = pl.nx; }
    const int np = (tm + nxc - 1) / nxc;
    const int per_xcd = ((np + 7) >> 3) * tn * 8;
    const int Rl = (lane >> 4) & 3, gl = (((Rl ^ (Rl >> 1)) & 1) << 1) | (Rl >> 1);
    const int Rr = (lane >> 2) & 3, gr = (((Rr ^ (Rr >> 1)) & 1) << 1) | (Rr >> 1);
    const int ld_row = lane >> 2, ld_c = (lane & 3) ^ gl;
    const int rd_off = (lane & 15) * 64 + (((lane >> 4) ^ gr) << 4);
    for (int t = slot; t < per_xcd; t += nslots) {
        const int mi = t & 7, rest = t >> 3, nt_ = rest % tn, mg = rest / tn;
        const int pidx = mg * 8 + mi, panel = xcd + nxc * pidx;
        if (pidx >= np || panel >= tm) continue;
        const int m0 = panel * 128, n0 = nt_ * 256;
        if (ssq) { if (tid < 128) { float sacc = 0.f; for (int i = 0; i < nss; ++i) sacc += ssq[(size_t)(m0 + tid) * nss + i]; sRstd[tid] = rsqrtf(sacc / (float)K + 1e-6f); } }
        else if (tid < 128) sRstd[tid] = 1.f;
        const bf16_t* ga = A  + (size_t)(m0 + 32 * wave + ld_row) * lda + ld_c * 8;
        const bf16_t* gb = Bt + (size_t)(n0 + 64 * wave + ld_row) * K   + ld_c * 8;
        f32x4 acc[4][8];
#pragma unroll
        for (int i = 0; i < 4; ++i)
#pragma unroll
            for (int j = 0; j < 8; ++j) acc[i][j] = f32x4{0.f, 0.f, 0.f, 0.f};
#define G2_ISSUE(KT) { char* st_ = smem + ((KT) % 3) * STG; const int ko_ = (KT) * 32; \
            __builtin_amdgcn_global_load_lds((const unsigned*)(ga + ko_),                    (unsigned*)(st_ + wave * 2048),               16, 0, 0); \
            __builtin_amdgcn_global_load_lds((const unsigned*)(ga + (size_t)16 * lda + ko_), (unsigned*)(st_ + wave * 2048 + 1024),        16, 0, 0); \
            __builtin_amdgcn_global_load_lds((const unsigned*)(gb + ko_),                    (unsigned*)(st_ + 8192 + wave * 4096),        16, 0, 0); \
            __builtin_amdgcn_global_load_lds((const unsigned*)(gb + (size_t)16 * K + ko_),   (unsigned*)(st_ + 8192 + wave * 4096 + 1024), 16, 0, 0); \
            __builtin_amdgcn_global_load_lds((const unsigned*)(gb + (size_t)32 * K + ko_),   (unsigned*)(st_ + 8192 + wave * 4096 + 2048), 16, 0, 0); \
            __builtin_amdgcn_global_load_lds((const unsigned*)(gb + (size_t)48 * K + ko_),   (unsigned*)(st_ + 8192 + wave * 4096 + 3072), 16, 0, 0); }
        G2_ISSUE(0) G2_ISSUE(1)
#pragma unroll 1
        for (int kt = 0; kt < nkt; ++kt) {
            if (kt + 1 < nkt) asm volatile("s_waitcnt vmcnt(6)" ::: "memory");
            else asm volatile("s_waitcnt vmcnt(0)" ::: "memory");
            G2_RAW_BARRIER();
            if (kt + 2 < nkt) G2_ISSUE(kt + 2)
            const char* sA = smem + (kt % 3) * STG + rd_off; const char* sB = sA + 8192;
            bf16x8 a[4], b[8];
#pragma unroll
            for (int i = 0; i < 4; ++i) a[i] = *(const bf16x8*)(sA + (wm * 64 + 16 * i) * 64);
#pragma unroll
            for (int j = 0; j < 8; ++j) b[j] = *(const bf16x8*)(sB + (wn * 128 + 16 * j) * 64);
#pragma unroll
            for (int i = 0; i < 4; ++i)
#pragma unroll
                for (int j = 0; j < 8; ++j) acc[i][j] = mfma16(b[j], a[i], acc[i][j]);
        }
#undef G2_ISSUE
        if (epi.staged(n0)) {
            G2_RAW_BARRIER();
#pragma unroll
            for (int i = 0; i < 4; ++i) {
                const int rl = wm * 64 + i * 16 + (lane & 15);
                const float rs = sRstd[rl];
                char* trow = smem + rl * 528 + (wn * 128 + 4 * (lane >> 4)) * 2;
#pragma unroll
                for (int j = 0; j < 8; ++j) {
                    const int nc = n0 + wn * 128 + 16 * j + 4 * (lane >> 4);
                    *(uint2*)(trow + 32 * j) = uint2{pack2(epi.map(nc, acc[i][j][0] * rs), epi.map(nc + 1, acc[i][j][1] * rs)), pack2(epi.map(nc + 2, acc[i][j][2] * rs), epi.map(nc + 3, acc[i][j][3] * rs))};
                }
            }
            __syncthreads();
            float* const sqp = (n0 == 0) ? epi.SQ0 : ((n0 == 256) ? epi.SQ1 : nullptr);
#pragma unroll 4
            for (int i = 0; i < 16; ++i) {
                const int e = tid + 256 * i, row = e >> 5, cc = e & 31;
                const uint4 v = *(const uint4*)(smem + row * 528 + cc * 16);
                if (n0 + cc * 8 < epi.N) *(uint4*)(epi.D + (size_t)(m0 + row) * epi.ldd + n0 + cc * 8) = v;
                if (sqp) {
                    float q = bflo(v.x) * bflo(v.x) + bfhi(v.x) * bfhi(v.x) + bflo(v.y) * bflo(v.y) + bfhi(v.y) * bfhi(v.y)
                            + bflo(v.z) * bflo(v.z) + bfhi(v.z) * bfhi(v.z) + bflo(v.w) * bflo(v.w) + bfhi(v.w) * bfhi(v.w);
                    if (n0 == 256 && cc >= 16) q = 0.f;
                    q += __shfl_xor(q, 1); q += __shfl_xor(q, 2); q += __shfl_xor(q, 4); q += __shfl_xor(q, 8); q += __shfl_xor(q, 16);
                    if (cc == 0) sqp[m0 + row] = q;
                }
            }
        } else {
#pragma unroll
            for (int i = 0; i < 4; ++i) {
                const int rl = wm * 64 + i * 16 + (lane & 15);
                const float rs = sRstd[rl];
                epi.row(m0 + rl, n0 + wn * 128 + 4 * (lane >> 4), acc[i], rs, lane);
                __builtin_amdgcn_sched_barrier(0);
            }
        }
        __syncthreads();
    }
}

struct Epi2In0 {
    bf16_t* Z0; float* G; const float* lb; bf16_t* D; int ldd; int N; float* SQ0; float* SQ1;
    DEVI bool staged(int n0) const { return (n0 >> 9) != 1; }
    DEVI float map(int n, float v) const { const int blk = n >> 9; return (blk == 0) ? v : ((blk <= 3) ? v * sigm(v) : gelu_tanh(v)); }
    DEVI void row(int m, int n, const f32x4 (&a)[8], float rs, int) const {
#pragma unroll
        for (int j = 0; j < 8; ++j) {
            const int c = n + 16 * j - 512;
            const float4 l4 = *(const float4*)(lb + c);
            float4 o;
            o.x = logf(l4.x + (1.f - l4.x) * sigm(a[j][0] * rs)); o.y = logf(l4.y + (1.f - l4.y) * sigm(a[j][1] * rs));
            o.z = logf(l4.z + (1.f - l4.z) * sigm(a[j][2] * rs)); o.w = logf(l4.w + (1.f - l4.w) * sigm(a[j][3] * rs));
            *(float4*)(G + (size_t)m * 512 + c) = o;
        }
    }
};
struct Epi2Bf16 {
    bf16_t* D; int ldd; int N; float* SQ0; float* SQ1;
    DEVI bool staged(int) const { return true; }
    DEVI float map(int, float v) const { return v; }
    DEVI void row(int, int, const f32x4 (&)[8], float, int) const {}
};
struct Epi2Resid {
    bf16_t* XB; float* SSQ16; float alpha; bf16_t* D; int ldd; int N; float* SQ0; float* SQ1;
    DEVI bool staged(int) const { return false; }
    DEVI float map(int, float v) const { return v; }
    DEVI void row(int m, int n, const f32x4 (&a)[8], float, int lane) const {
        float sq[2] = {0.f, 0.f};
#pragma unroll
        for (int j = 0; j < 8; ++j) {
            bf16_t* px = XB + (size_t)m * 1024 + n + 16 * j;
            const uint2 r = *(const uint2*)px;
            const unsigned w0 = pack2(bflo(r.x) + alpha * a[j][0], bfhi(r.x) + alpha * a[j][1]), w1 = pack2(bflo(r.y) + alpha * a[j][2], bfhi(r.y) + alpha * a[j][3]);
            *(uint2*)px = uint2{w0, w1};
            sq[j >> 2] += bflo(w0) * bflo(w0) + bfhi(w0) * bfhi(w0) + bflo(w1) * bflo(w1) + bfhi(w1) * bfhi(w1);
        }
#pragma unroll
        for (int g = 0; g < 2; ++g) {
            float v = sq[g];
            v += __shfl_xor(v, 16); v += __shfl_xor(v, 32);
            if ((lane >> 4) == 0) SSQ16[(size_t)m * 16 + ((n + 64 * g) >> 6)] = v;
        }
    }
};

struct EpiBf16 { bf16_t* D; int ldd; int N; DEVI void operator()(int m, int n, float v) const { if (n < N) D[(size_t)m * ldd + n] = f2bf(v); } };

DEVI void hgrn_local_item(const Params& p, int item, char* smem) {
    const int tid = threadIdx.x, lane = tid & 63, wave = tid >> 6;
    const int bh = item >> 7, c = item & 127, b = bh >> 2, h = bh & 3;
    const size_t m0 = (size_t)b * 8192 + c * 64;
    const float* G = (const float*)(p.ws + OFF_G) + m0 * 512 + h * 128;
    const bf16_t* Zv = (const bf16_t*)(p.ws + OFF_Z0) + m0 * 3072 + 1024 + h * 128;
    char* sVT = smem; char* sKd = smem + 16384;
    const int k = tid & 127, hf = tid >> 7;
    float bl = 0.f, bmid = 0.f;
#pragma unroll 8
    for (int t = 0; t < 64; ++t) { bl += G[t * 512 + k]; if (t == 31) bmid = bl; }
    float bcur = hf ? bmid : 0.f;
#pragma unroll 1
    for (int ch = 0; ch < 4; ++ch) {
        float kd[8], vv[8];
#pragma unroll
        for (int j = 0; j < 8; ++j) {
            const int t = 32 * hf + 8 * ch + j;
            const float g = G[t * 512 + k];
            bcur += g;
            kd[j] = (1.f - __expf(g)) * __expf(bl - bcur);
            vv[j] = bf2f(Zv[(size_t)t * 3072 + k]);
        }
        uint4 o; o.x = pack2(kd[0], kd[1]); o.y = pack2(kd[2], kd[3]); o.z = pack2(kd[4], kd[5]); o.w = pack2(kd[6], kd[7]);
        *(uint4*)(sKd + swz_off<64>(k, 4 * hf + ch)) = o;
        uint4 w; w.x = pack2(vv[0], vv[1]); w.y = pack2(vv[2], vv[3]); w.z = pack2(vv[4], vv[5]); w.w = pack2(vv[6], vv[7]);
        *(uint4*)(sVT + swz_off<64>(k, 4 * hf + ch)) = w;
    }
    if (hf == 0) ((float*)(p.ws + OFF_DEC))[item * 128 + k] = __expf(bl);
    __syncthreads();
    f32x4 acc[2][8];
#pragma unroll
    for (int i = 0; i < 2; ++i)
#pragma unroll
        for (int j = 0; j < 8; ++j) acc[i][j] = f32x4{0.f, 0.f, 0.f, 0.f};
    mma_nt<2, 8, 64, 64>(acc, sVT, 32 * wave, sKd, 0, 0, 2, lane);
    float* H = (float*)(p.ws + OFF_HST) + (size_t)item * 16384;
#pragma unroll
    for (int i = 0; i < 2; ++i)
#pragma unroll
        for (int j = 0; j < 8; ++j)
#pragma unroll
            for (int r = 0; r < 4; ++r) {
                const int v = 32 * wave + 16 * i + (lane >> 4) * 4 + r, kk = 16 * j + (lane & 15);
                H[v * 128 + kk] = acc[i][j][r];
                if (r == 3) __builtin_amdgcn_sched_barrier(0);
            }
    __syncthreads();
}

DEVI void gmlp_item(const Params& p, int item, char* smem) {
    const int tid = threadIdx.x, lane = tid & 63, wave = tid >> 6;
    const int g = item & 3, chunk = item >> 2;
    const size_t m0 = (size_t)chunk * 128;
    const bf16_t* Z0 = (const bf16_t*)(p.ws + OFF_Z0);
    const bf16_t* Wc = (const bf16_t*)(p.ws + OFF_WS0) + g * 16384;
    char* sW = smem; char* sV = smem + 32768;
#pragma unroll
    for (int i = 0; i < 8; ++i) {
        const int e = tid + 256 * i, row = e >> 4, cc = e & 15;
        *(uint4*)(sW + swz_off<128>(row, cc)) = *(const uint4*)(Wc + row * 128 + cc * 8);
    }
    {
        const int t = tid >> 1, hf = tid & 1;
        const bf16_t* src = Z0 + (m0 + t) * 3072 + 2560 + g * 128 + 64 * hf;
        float vals[64]; float ss = 0.f;
#pragma unroll
        for (int i = 0; i < 8; ++i) {
            uint4 u = *(const uint4*)(src + 8 * i);
            vals[8 * i + 0] = bflo(u.x); vals[8 * i + 1] = bfhi(u.x); vals[8 * i + 2] = bflo(u.y); vals[8 * i + 3] = bfhi(u.y);
            vals[8 * i + 4] = bflo(u.z); vals[8 * i + 5] = bfhi(u.z); vals[8 * i + 6] = bflo(u.w); vals[8 * i + 7] = bfhi(u.w);
        }
#pragma unroll
        for (int i = 0; i < 64; ++i) ss += vals[i] * vals[i];
        ss += __shfl_xor(ss, 1);
        const float rstd = rsqrtf(ss * (1.f / 128.f) + 1e-6f);
        const float* gn = p.l0_gmlp_v_norm + g * 128 + 64 * hf;
#pragma unroll
        for (int i = 0; i < 64; ++i) {
            const int d = 64 * hf + i;
            *(bf16_t*)(sV + swz_elem<128>(d, t)) = f2bf(vals[i] * rstd * gn[i]);
        }
    }
    __syncthreads();
    const int wm = wave >> 1, wn = wave & 1;
    f32x4 acc[4][4];
#pragma unroll
    for (int i = 0; i < 4; ++i)
#pragma unroll
        for (int j = 0; j < 4; ++j) acc[i][j] = f32x4{0.f, 0.f, 0.f, 0.f};
    mma_nt<4, 4, 128, 128>(acc, sW, wm * 64, sV, wn * 64, 0, 4, lane);
    bf16_t* MIX = (bf16_t*)(p.ws + OFF_MIX0);
#pragma unroll
    for (int i = 0; i < 4; ++i)
#pragma unroll
        for (int r = 0; r < 4; ++r) {
            const int t = wm * 64 + i * 16 + (lane >> 4) * 4 + r;
            const float bias = p.l0_gmlp_b_s[g * 128 + t];
#pragma unroll
            for (int j = 0; j < 4; ++j) {
                const int d = wn * 64 + j * 16 + (lane & 15);
                const float u = bf2f(Z0[(m0 + t) * 3072 + 2048 + g * 128 + d]);
                MIX[(m0 + t) * 1024 + 512 + g * 128 + d] = f2bf(u * (acc[i][j][r] + bias));
            }
        }
    __syncthreads();
}

DEVI void hgrn_scan_phase(const Params& p) {
    float* H = (float*)(p.ws + OFF_HST);
    const float* D = (const float*)(p.ws + OFF_DEC);
    for (int e = blockIdx.x * NTHREADS + threadIdx.x; e < 8 * 16384; e += gridDim.x * NTHREADS) {
        const int bh = e >> 14, idx = e & 16383, k = idx & 127;
        float run = 0.f;
        for (int c0 = 0; c0 < 128; c0 += 8) {
            float L[8], d[8];
#pragma unroll
            for (int u = 0; u < 8; ++u) { L[u] = H[((size_t)(bh * 128 + c0 + u)) * 16384 + idx]; d[u] = D[(bh * 128 + c0 + u) * 128 + k]; }
#pragma unroll
            for (int u = 0; u < 8; ++u) { H[((size_t)(bh * 128 + c0 + u)) * 16384 + idx] = run; run = d[u] * run + L[u]; }
        }
    }
}

DEVI void hgrn_out_item(const Params& p, int item, char* smem) {
    const int tid = threadIdx.x, lane = tid & 63, wave = tid >> 6;
    const int bh = item >> 7, c = item & 127, b = bh >> 2, h = bh & 3;
    const size_t m0 = (size_t)b * 8192 + c * 64;
    const float* G = (const float*)(p.ws + OFF_G) + m0 * 512 + h * 128;
    const bf16_t* Z0 = (const bf16_t*)(p.ws + OFF_Z0) + m0 * 3072;
    float* sB  = (float*)smem;
    char*  sHT = smem;
    char*  sQe = smem + 32768;
    char*  sP  = smem + 49152;
    char*  sU  = smem + 57344;
    char*  sQs = sU; char* sKh = sU + 4096; char* sVT = sU;
    float* sRed = (float*)(smem + 77824);
    const int k = tid & 127, hf = tid >> 7;
    if (hf == 0) { float bc = 0.f;
#pragma unroll 8
        for (int t = 0; t < 64; ++t) { bc += G[t * 512 + k]; sB[t * 128 + k] = bc; } }
    __syncthreads();
#pragma unroll 4
    for (int t = 32 * hf; t < 32 * hf + 32; ++t) {
        const float q = bf2f(Z0[(size_t)t * 3072 + h * 128 + k]);
        *(bf16_t*)(sQe + swz_elem<128>(t, k)) = f2bf(q * __expf(sB[t * 128 + k]));
    }
#pragma unroll 1
    for (int i = 0; i < 4; ++i) {
        const float ri = (i == 0) ? 0.f : sB[(16 * i - 1) * 128 + k];
#pragma unroll 4
        for (int tt = 8 * hf; tt < 8 * hf + 8; ++tt) {
            const int t = 16 * i + tt;
            const float q = bf2f(Z0[(size_t)t * 3072 + h * 128 + k]);
            *(bf16_t*)(sQs + swz_elem<128>(tt, k)) = f2bf(q * __expf(sB[t * 128 + k] - ri));
        }
        const int ns = 16 * (i + 1), half = ns >> 1;
#pragma unroll 4
        for (int s = hf * half; s < hf * half + half; ++s) {
            const float bs = sB[s * 128 + k];
            const float gs = bs - (s ? sB[(s - 1) * 128 + k] : 0.f);
            const float kk = 1.f - __expf(gs);
            *(bf16_t*)(sKh + swz_elem<128>(s, k)) = f2bf(kk * __expf(fminf(ri - bs, 80.f)));
        }
        __syncthreads();
        {
            f32x4 acc[1][1]; acc[0][0] = f32x4{0.f, 0.f, 0.f, 0.f};
            if (wave <= i) mma_nt<1, 1, 128, 128>(acc, sQs, 0, sKh, 16 * wave, 0, 4, lane);
#pragma unroll
            for (int r = 0; r < 4; ++r) {
                const int row = (lane >> 4) * 4 + r, col = lane & 15;
                float v = acc[0][0][r];
                if (wave > i || (wave == i && col > row)) v = 0.f;
                *(bf16_t*)(sP + swz_elem<64>(16 * i + row, 16 * wave + col)) = f2bf(v);
            }
        }
        __syncthreads();
    }
    {
        const bf16_t* Zv = Z0 + 1024 + h * 128;
#pragma unroll 1
        for (int ch = 0; ch < 4; ++ch) {
            float vv[8];
#pragma unroll
            for (int j = 0; j < 8; ++j) vv[j] = bf2f(Zv[(size_t)(32 * hf + 8 * ch + j) * 3072 + k]);
            uint4 w; w.x = pack2(vv[0], vv[1]); w.y = pack2(vv[2], vv[3]); w.z = pack2(vv[4], vv[5]); w.w = pack2(vv[6], vv[7]);
            *(uint4*)(sVT + swz_off<64>(k, 4 * hf + ch)) = w;
        }
        const float* H = (const float*)(p.ws + OFF_HST) + (size_t)item * 16384;
#pragma unroll 2
        for (int i = 0; i < 8; ++i) {
            const int e = tid + 256 * i, row = e >> 4, cc = e & 15;
            const float4 a = *(const float4*)(H + row * 128 + cc * 8), bq = *(const float4*)(H + row * 128 + cc * 8 + 4);
            uint4 o; o.x = pack2(a.x, a.y); o.y = pack2(a.z, a.w); o.z = pack2(bq.x, bq.y); o.w = pack2(bq.z, bq.w);
            *(uint4*)(sHT + swz_off<128>(row, cc)) = o;
        }
    }
    __syncthreads();
    f32x4 acc[4][2];
#pragma unroll
    for (int i = 0; i < 4; ++i)
#pragma unroll
        for (int j = 0; j < 2; ++j) acc[i][j] = f32x4{0.f, 0.f, 0.f, 0.f};
    mma_nt<4, 2, 128, 128>(acc, sQe, 0, sHT, 32 * wave, 0, 4, lane);
    mma_nt<4, 2, 64, 64>(acc, sP, 0, sVT, 32 * wave, 0, 2, lane);
#pragma unroll
    for (int i = 0; i < 4; ++i)
#pragma unroll
        for (int r = 0; r < 4; ++r) {
            float s = acc[i][0][r] * acc[i][0][r] + acc[i][1][r] * acc[i][1][r];
            s += __shfl_xor(s, 1); s += __shfl_xor(s, 2); s += __shfl_xor(s, 4); s += __shfl_xor(s, 8);
            if ((lane & 15) == 0) sRed[wave * 64 + i * 16 + (lane >> 4) * 4 + r] = s;
        }
    __syncthreads();
    bf16_t* MIX = (bf16_t*)(p.ws + OFF_MIX0);
#pragma unroll
    for (int i = 0; i < 4; ++i)
#pragma unroll
        for (int r = 0; r < 4; ++r) {
            const int t = i * 16 + (lane >> 4) * 4 + r;
            const float tot = sRed[t] + sRed[64 + t] + sRed[128 + t] + sRed[192 + t];
            const float rstd = rsqrtf(tot * (1.f / 128.f) + 1e-6f);
#pragma unroll
            for (int j = 0; j < 2; ++j) {
                const int v = 32 * wave + 16 * j + (lane & 15);
                const float og = bf2f(Z0[(size_t)t * 3072 + 1536 + h * 128 + v]);
                MIX[(m0 + t) * 1024 + h * 128 + v] = f2bf(acc[i][j][r] * rstd * p.l0_hgrn_out_norm[h * 128 + v] * og);
            }
        }
    __syncthreads();
}

DEVI unsigned f2key(float f) { unsigned u = __float_as_uint(f); return (u & 0x80000000u) ? ~u : (u | 0x80000000u); }
DEVI float key2f(unsigned k) { unsigned u = (k & 0x80000000u) ? (k ^ 0x80000000u) : ~k; return __uint_as_float(u); }
#define CE_DESC(a, b) { unsigned _x = max(a, b), _y = min(a, b); a = _x; b = _y; }
DEVI void sort16_desc(unsigned (&a)[16]) {
#pragma unroll
    for (int k = 2; k <= 16; k <<= 1)
#pragma unroll
        for (int j = k >> 1; j > 0; j >>= 1)
#pragma unroll
            for (int i = 0; i < 16; ++i) {
                const int l = i ^ j;
                if (l > i) {
                    if ((i & k) == 0) { CE_DESC(a[i], a[l]); } else { CE_DESC(a[l], a[i]); }
                }
            }
}
DEVI void merge16_desc(unsigned (&a)[16], const unsigned (&b)[16]) {
#pragma unroll
    for (int i = 0; i < 16; ++i) a[i] = max(a[i], b[15 - i]);
#pragma unroll
    for (int j = 8; j > 0; j >>= 1)
#pragma unroll
        for (int i = 0; i < 16; ++i) { const int l = i ^ j; if (l > i) { CE_DESC(a[i], a[l]); } }
}

DEVI void peer_topk_phase(const Params& p, const bf16_t* __restrict__ SK, int blk0, int nblk, char* smem) {
    const int tid = threadIdx.x, lane = tid & 63, wave = tid >> 6;
    const int r = lane & 31, hh = lane >> 5;
    const bf16_t* QP = (const bf16_t*)(p.ws + OFF_QP);
    int* IDX = (int*)(p.ws + OFF_IDX); float* GATE = (float*)(p.ws + OFF_GATE);
    char* sKey = smem;
    char* sQ = smem + 32768 + wave * 8192;
    for (int item = blk0; item < 1024; item += nblk) {
        const int h = item & 7, tile = (item >> 3) * 4 + wave;
        const size_t tok = (size_t)tile * 32 + r;
        unsigned top[2][16];
#pragma unroll
        for (int ph = 0; ph < 2; ++ph) {
            __syncthreads();
            {
                const bf16_t* ksrc = SK + (size_t)(h * 2 + ph) * 128 * 128;
#pragma unroll
                for (int i = 0; i < 8; ++i) { const int e = tid + 256 * i, row = e >> 4, cc = e & 15; *(uint4*)(sKey + swz_off<128>(row, cc)) = *(const uint4*)(ksrc + row * 128 + cc * 8); }
                const bf16_t* qsrc = QP + (size_t)tile * 32 * 2048 + h * 256 + ph * 128;
#pragma unroll
                for (int i = 0; i < 8; ++i) { const int e = lane + 64 * i, row = e >> 4, cc = e & 15; *(uint4*)(sQ + swz_off<128>(row, cc)) = *(const uint4*)(qsrc + (size_t)row * 2048 + cc * 8); }
            }
            __syncthreads();
            bf16x8 qf[8];
#pragma unroll
            for (int ks = 0; ks < 8; ++ks) qf[ks] = *(const bf16x8*)(sQ + swz_off<128>(r, 2 * ks + hh));
#pragma unroll 1
            for (int rt = 0; rt < 4; ++rt) {
                f32x16 acc;
#pragma unroll
                for (int e = 0; e < 16; ++e) acc[e] = 0.f;
#pragma unroll
                for (int ks = 0; ks < 8; ++ks) {
                    const bf16x8 kf = *(const bf16x8*)(sKey + swz_off<128>(32 * rt + r, 2 * ks + hh));
                    acc = mfma32(kf, qf[ks], acc);
                }
                unsigned kk[16];
#pragma unroll
                for (int e = 0; e < 16; ++e) {
                    const unsigned n = 32 * rt + (e & 3) + 8 * (e >> 2) + 4 * hh;
                    kk[e] = (f2key(acc[e]) & ~127u) | n;
                }
                sort16_desc(kk);
                if (rt == 0) {
#pragma unroll
                    for (int e = 0; e < 16; ++e) top[ph][e] = kk[e];
                } else merge16_desc(top[ph], kk);
            }
            unsigned other[16];
#pragma unroll
            for (int e = 0; e < 16; ++e) other[e] = (unsigned)__shfl_xor((int)top[ph][e], 32);
            merge16_desc(top[ph], other);
        }
        unsigned best[16];
        {
            float s1[16], s2[16];
#pragma unroll
            for (int e = 0; e < 16; ++e) { s1[e] = key2f(top[0][e] & ~127u); s2[e] = key2f(top[1][e] & ~127u); }
            unsigned cand[64];
            unsigned ia[16], ib[16];
#pragma unroll
            for (int e = 0; e < 16; ++e) { ia[e] = (top[0][e] & 127u) << 7; ib[e] = top[1][e] & 127u; }
            int n = 0;
#pragma unroll
            for (int i = 0; i < 16; ++i)
#pragma unroll
                for (int j = 0; j < 16; ++j)
                    if ((i + 1) * (j + 1) <= 16) { cand[n] = (f2key(s1[i] + s2[j]) & ~0x3fffu) | ia[i] | ib[j]; ++n; }
#pragma unroll
            for (int e = 50; e < 64; ++e) cand[e] = 0u;
#pragma unroll
            for (int g = 0; g < 4; ++g) {
                unsigned kk[16];
#pragma unroll
                for (int e = 0; e < 16; ++e) kk[e] = cand[16 * g + e];
                sort16_desc(kk);
                if (g == 0) {
#pragma unroll
                    for (int e = 0; e < 16; ++e) best[e] = kk[e];
                } else merge16_desc(best, kk);
            }
        }
        float sv[16]; int id[16];
#pragma unroll
        for (int e = 0; e < 16; ++e) {
            sv[e] = key2f(best[e] & ~0x3fffu);
            id[e] = (int)(best[e] & 0x3fffu);
        }
        float den = 0.f; const float smax = sv[0];
#pragma unroll
        for (int e = 0; e < 16; ++e) { sv[e] = __expf(sv[e] - smax); den += sv[e]; }
        const float inv = 1.f / den;
        {
            const float* INVT = (const float*)(p.ws + (hh ? OFF_INVU : OFF_INVD));
            float sc[16];
#pragma unroll
            for (int e = 0; e < 16; ++e) sc[e] = INVT[id[e]];
            if (hh == 0) {
                int4* dst = (int4*)(IDX + tok * 128 + h * 16);
                float4* dst2 = (float4*)((float*)(p.ws + OFF_SDN) + tok * 128 + h * 16);
#pragma unroll
                for (int e = 0; e < 4; ++e) { dst[e] = int4{id[4 * e], id[4 * e + 1], id[4 * e + 2], id[4 * e + 3]}; dst2[e] = float4{sc[4 * e], sc[4 * e + 1], sc[4 * e + 2], sc[4 * e + 3]}; }
            } else {
                float4* dst = (float4*)(GATE + tok * 128 + h * 16);
#pragma unroll
                for (int e = 0; e < 4; ++e) dst[e] = float4{sv[4 * e] * inv * sc[4 * e], sv[4 * e + 1] * inv * sc[4 * e + 1], sv[4 * e + 2] * inv * sc[4 * e + 2], sv[4 * e + 3] * inv * sc[4 * e + 3]};
            }
        }
    }
    for (int it = blk0; it < 4096; it += nblk) {
        const size_t row = (size_t)it * 4 + wave;
        const bf16_t* xb = (const bf16_t*)(p.ws + OFF_XB) + row * 1024 + 16 * lane;
        const uint4 a = *(const uint4*)xb, b = *(const uint4*)(xb + 8);
        float v[16] = {bflo(a.x), bfhi(a.x), bflo(a.y), bfhi(a.y), bflo(a.z), bfhi(a.z), bflo(a.w), bfhi(a.w),
                       bflo(b.x), bfhi(b.x), bflo(b.y), bfhi(b.y), bflo(b.z), bfhi(b.z), bflo(b.w), bfhi(b.w)};
#pragma unroll
        for (int i = 0; i < 16; ++i) v[i] = fminf(fmaxf(v[i] * 32.f, -400.f), 400.f);
        int w0 = 0, w1 = 0, w2 = 0, w3 = 0;
        w0 = __builtin_amdgcn_cvt_pk_fp8_f32(v[0], v[1], w0, false);   w0 = __builtin_amdgcn_cvt_pk_fp8_f32(v[2], v[3], w0, true);
        w1 = __builtin_amdgcn_cvt_pk_fp8_f32(v[4], v[5], w1, false);   w1 = __builtin_amdgcn_cvt_pk_fp8_f32(v[6], v[7], w1, true);
        w2 = __builtin_amdgcn_cvt_pk_fp8_f32(v[8], v[9], w2, false);   w2 = __builtin_amdgcn_cvt_pk_fp8_f32(v[10], v[11], w2, true);
        w3 = __builtin_amdgcn_cvt_pk_fp8_f32(v[12], v[13], w3, false); w3 = __builtin_amdgcn_cvt_pk_fp8_f32(v[14], v[15], w3, true);
        *(int4*)(p.ws + OFF_XB8 + row * 1024 + 16 * lane) = int4{w0, w1, w2, w3};
    }
}

typedef float f32x2v __attribute__((ext_vector_type(2)));
#define PEER_QWORD 80000
#define PEER_TPW 8
#define PEER_ITEMS (16384 / (4 * PEER_TPW))
DEVI int queue_pop(const Params& p, int q, char* smem) {
    int* sw = (int*)(smem + PEER_QWORD);
    __syncthreads();
    if (threadIdx.x == 0) *sw = (int)__hip_atomic_fetch_add((unsigned*)(p.ws + OFF_QCNT) + q * 16, 1u, __ATOMIC_RELAXED, __HIP_MEMORY_SCOPE_AGENT);
    __syncthreads();
    return *sw;
}
#define UFMA(ACC, W, X) asm volatile("v_fmac_f32 %0, %1, %2" : "+v"(ACC) : "v"(W), "v"(X))
DEVI void d_stream(size_t tok, int s, int lane, char* slot, const int* IDX, const char* XB8) {
    const unsigned o1 = (unsigned)tok * 512u + 4u * (unsigned)lane;
    __builtin_amdgcn_global_load_lds((const unsigned*)((const char*)IDX + o1),        (unsigned*)(slot),       4, 0, 0);
    __builtin_amdgcn_global_load_lds((const unsigned*)((const char*)IDX + o1 + 256u), (unsigned*)(slot + 256), 4, 0, 0);
    __builtin_amdgcn_global_load_lds((const unsigned*)(XB8 + (unsigned)tok * 1024u + (unsigned)(128 * s + 4 * (lane & 31))), (unsigned*)(slot + 512), 4, 0, 0);
}
template <int HLF>
DEVI void d_dma(const char* slot, char* buf, int s, int lane, const char* ED) {
    const int grp = lane >> 3, sub = lane & 7;
    unsigned e[8];
#pragma unroll
    for (int i = 0; i < 8; ++i) e[i] = *(const unsigned*)(slot + 256 * HLF + 4 * (8 * i + grp));
#pragma unroll
    for (int i = 0; i < 8; ++i) {
        const int pl_ = 8 * i + grp;
        const unsigned src = ((unsigned)s * 16384u + e[i]) * 128u + (unsigned)(16 * (sub ^ ((pl_ >> 1) & 7)));
        __builtin_amdgcn_global_load_lds((const unsigned*)(ED + src), (unsigned*)(buf + i * 1024), 16, 0, 0);
    }
}
template <int HLF>
DEVI void d_mma(const char* buf, const char* slot, size_t tok, int s, int lane, float* PART) {
    const int r = lane & 15, q = lane >> 4;
    const long b0 = *(const long*)(slot + 512 + 32 * q), b1 = *(const long*)(slot + 512 + 32 * q + 8), b2 = *(const long*)(slot + 512 + 32 * q + 16), b3 = *(const long*)(slot + 512 + 32 * q + 24);
    float* dst = PART + ((size_t)s * 16384 + tok) * 128 + 64 * HLF;
#pragma unroll
    for (int t = 0; t < 4; ++t) {
        const int row = 16 * t + r, key = (row >> 1) & 7;
        const char* rp = buf + row * 128;
        const long a0 = *(const long*)(rp + ((((4 * q + 0) >> 1) ^ key) << 4) + 8 * ((4 * q + 0) & 1));
        const long a1 = *(const long*)(rp + ((((4 * q + 1) >> 1) ^ key) << 4) + 8 * ((4 * q + 1) & 1));
        const long a2 = *(const long*)(rp + ((((4 * q + 2) >> 1) ^ key) << 4) + 8 * ((4 * q + 2) & 1));
        const long a3 = *(const long*)(rp + ((((4 * q + 3) >> 1) ^ key) << 4) + 8 * ((4 * q + 3) & 1));
        f32x4 acc = {0.f, 0.f, 0.f, 0.f};
        acc = __builtin_amdgcn_mfma_f32_16x16x32_fp8_fp8(a0, b0, acc, 0, 0, 0);
        acc = __builtin_amdgcn_mfma_f32_16x16x32_fp8_fp8(a1, b1, acc, 0, 0, 0);
        acc = __builtin_amdgcn_mfma_f32_16x16x32_fp8_fp8(a2, b2, acc, 0, 0, 0);
        acc = __builtin_amdgcn_mfma_f32_16x16x32_fp8_fp8(a3, b3, acc, 0, 0, 0);
        if (r == 0) *(float4*)(dst + 16 * t + 4 * q) = float4{acc[0] * (1.f / 32.f), acc[1] * (1.f / 32.f), acc[2] * (1.f / 32.f), acc[3] * (1.f / 32.f)};
    }
}
DEVI void peer_down_phase(const Params& p, const float* __restrict__ gain, int qbase, int s0, char* smem) {
    const int tid = threadIdx.x, lane = tid & 63;
    const int wave = __builtin_amdgcn_readfirstlane(tid >> 6);
    const char* ED = p.ws + OFF_ED; const char* XB8 = p.ws + OFF_XB8;
    const int* IDX = (const int*)(p.ws + OFF_IDX);
    float* PART = (float*)(p.ws + OFF_PART);
    (void)gain;
    char* const img = smem + wave * 16384;
    char* const tb0 = smem + 65536 + wave * 3072;
#pragma unroll 1
    for (int sl = 0; sl < 8; ++sl) {
        const int s = (s0 + sl) & 7;
#pragma unroll 1
        for (;;) {
            const int g = queue_pop(p, qbase + s, smem);
            if (g >= PEER_ITEMS) break;
            const size_t t0 = (size_t)g * (4 * PEER_TPW) + wave * PEER_TPW;
            d_stream(t0, s, lane, tb0, IDX, XB8); d_stream(t0 + 1, s, lane, tb0 + 768, IDX, XB8);
            asm volatile("s_waitcnt vmcnt(0)" ::: "memory");
            d_dma<0>(tb0, img, s, lane, ED);
#pragma unroll 1
            for (int j = 0; j < PEER_TPW; ++j) {
                char* const slj = tb0 + 768 * (j & 3); char* const sln = tb0 + 768 * ((j + 1) & 3);
                if (j + 2 < PEER_TPW) d_stream(t0 + j + 2, s, lane, tb0 + 768 * ((j + 2) & 3), IDX, XB8);
                d_dma<1>(slj, img + 8192, s, lane, ED);
                if (j + 2 < PEER_TPW) asm volatile("s_waitcnt vmcnt(11)" ::: "memory"); else asm volatile("s_waitcnt vmcnt(8)" ::: "memory");
                d_mma<0>(img, slj, t0 + j, s, lane, PART);
                asm volatile("s_waitcnt lgkmcnt(0)" ::: "memory");
                if (j + 1 < PEER_TPW) { d_dma<0>(sln, img, s, lane, ED); asm volatile("s_waitcnt vmcnt(8)" ::: "memory"); }
                else asm volatile("s_waitcnt vmcnt(0)" ::: "memory");
                d_mma<1>(img + 8192, slj, t0 + j, s, lane, PART);
                asm volatile("s_waitcnt lgkmcnt(0)" ::: "memory");
            }
        }
    }
}
DEVI void peer_reduce_phase(const Params& p) {
    const int lane = threadIdx.x & 63, wave = threadIdx.x >> 6;
    const float* PART = (const float*)(p.ws + OFF_PART); const float* GATEU = (const float*)(p.ws + OFF_GATE); const float* SDN = (const float*)(p.ws + OFF_SDN);
    const float* SSQ16 = (const float*)(p.ws + OFF_SSQ16); float* ACTW = (float*)(p.ws + OFF_ACTW);
    for (int it = blockIdx.x; it < 4096; it += gridDim.x) {
        const size_t tok = (size_t)it * 4 + wave;
        float sq = (lane < 16) ? SSQ16[tok * 16 + lane] : 0.f;
        sq += __shfl_xor(sq, 1); sq += __shfl_xor(sq, 2); sq += __shfl_xor(sq, 4); sq += __shfl_xor(sq, 8);
        const float rstd = rsqrtf(__shfl(sq, 0) * (1.f / 1024.f) + 1e-6f);
        float a0 = 0.f, a1 = 0.f;
#pragma unroll
        for (int s = 0; s < 8; ++s) { a0 += PART[((size_t)s * 16384 + tok) * 128 + lane]; a1 += PART[((size_t)s * 16384 + tok) * 128 + 64 + lane]; }
        ACTW[tok * 128 + lane]      = GATEU[tok * 128 + lane]      * gelu_tanh(a0 * rstd * SDN[tok * 128 + lane]);
        ACTW[tok * 128 + 64 + lane] = GATEU[tok * 128 + 64 + lane] * gelu_tanh(a1 * rstd * SDN[tok * 128 + 64 + lane]);
    }
}
struct UL { int i0, i1; float w0, w1; f32x2v x2; };
struct UG { u32x4 u[8]; float w[8]; };
DEVI void u_load(UL& l, size_t tok, int s, int lane, const int* IDX, const float* ACTW, const float* X) {
    const unsigned o1 = (unsigned)tok * 512u + 4u * (unsigned)lane;
    l.i0 = *(const int*)((const char*)IDX + o1); l.i1 = *(const int*)((const char*)IDX + o1 + 256u);
    l.w0 = *(const float*)((const char*)ACTW + o1); l.w1 = *(const float*)((const char*)ACTW + o1 + 256u);
    const unsigned o2 = (unsigned)tok * 4096u + (unsigned)(512 * s + 64 * (lane & 7) + 8 * (lane >> 3));
    { const unsigned xb2 = *(const unsigned*)((const char*)X + (o2 >> 1)); l.x2 = f32x2v{bflo(xb2), bfhi(xb2)}; }
}
DEVI void u_publish(const UL& l, char* pt, int lane) {
    *(uint2*)(pt + 8 * lane) = uint2{(unsigned)l.i0, __float_as_uint(l.w0)};
    *(uint2*)(pt + 512 + 8 * lane) = uint2{(unsigned)l.i1, __float_as_uint(l.w1)};
}
template <int HLF>
DEVI void u_gather(UG& g, const char* pt, int s, int lane, const char* EU) {
    const int grp = lane >> 3, sub = lane & 7;
#pragma unroll
    for (int i = 0; i < 8; ++i) {
        const uint2 ew = *(const uint2*)(pt + 512 * HLF + 8 * (8 * i + grp));
        g.w[i] = __uint_as_float(ew.y);
        const unsigned off = ((unsigned)s * 16384u + ew.x) * 128u + (unsigned)(16 * sub);
        g.u[i] = *(const u32x4*)(EU + off);
    }
}
DEVI void u_fma(const UG& g, float (&acc)[16]) {
#pragma unroll
    for (int i = 0; i < 8; ++i) {
        const float w = g.w[i];
#pragma unroll
        for (int q = 0; q < 4; ++q) {
            const f32x2v lo = __builtin_amdgcn_cvt_pk_f32_fp8((int)g.u[i][q], false), hi = __builtin_amdgcn_cvt_pk_f32_fp8((int)g.u[i][q], true);
            UFMA(acc[4 * q], w, lo.x); UFMA(acc[4 * q + 1], w, lo.y); UFMA(acc[4 * q + 2], w, hi.x); UFMA(acc[4 * q + 3], w, hi.y);
        }
        if (i & 1) __builtin_amdgcn_sched_barrier(0);
    }
}
DEVI void u_finish(float (&acc)[16], const UL& l, char* ex, size_t tok, int s, int lane, float alpha, float* X, bf16_t* XB, float* SSQ8) {
    const int grp = lane >> 3, sub = lane & 7;
#pragma unroll
    for (int pp = 0; pp < 8; ++pp) *(float2*)(ex + 576 * pp + 8 * lane) = float2{acc[2 * pp], acc[2 * pp + 1]};
    float a0 = 0.f, a1 = 0.f;
#pragma unroll
    for (int g2 = 0; g2 < 8; ++g2) { const float2 v = *(const float2*)(ex + 576 * grp + 8 * (8 * g2 + sub)); a0 += v.x; a1 += v.y; }
    const float y0 = l.x2.x + alpha * a0, y1 = l.x2.y + alpha * a1;
    const unsigned col = (unsigned)tok * 1024u + (unsigned)(128 * s + 16 * sub + 2 * grp);
    if (X) *(f32x2v*)((char*)X + 4u * col) = f32x2v{y0, y1};
    const unsigned yb = pack2(y0, y1);
    *(unsigned*)((char*)XB + 2u * col) = yb;
    float sq = bflo(yb) * bflo(yb) + bfhi(yb) * bfhi(yb);
#pragma unroll
    for (int o = 1; o < 64; o <<= 1) sq += __shfl_xor(sq, o);
    if (lane == 0) *(float*)((char*)SSQ8 + ((unsigned)tok * 32u + 4u * (unsigned)s)) = sq;
#pragma unroll
    for (int i = 0; i < 16; ++i) acc[i] = 0.f;
}
DEVI void peer_up_phase(const Params& p, int qbase, int s0, float alpha, float* X, char* smem) {
    const int tid = threadIdx.x, lane = tid & 63, wave = tid >> 6;
    const char* EU = p.ws + OFF_EU;
    const int* IDX = (const int*)(p.ws + OFF_IDX); const float* ACTW = (const float*)(p.ws + OFF_ACTW);
    bf16_t* XB = (bf16_t*)(p.ws + OFF_XB); float* SSQ8 = (float*)(p.ws + OFF_SSQ8);
    char* const pt0 = smem + wave * 8192;
    char* const ex = pt0 + 2048;
#pragma unroll 1
    for (int sl = 0; sl < 8; ++sl) {
        const int s = (s0 + sl) & 7;
#pragma unroll 1
        for (;;) {
            const int g = queue_pop(p, qbase + s, smem);
            if (g >= PEER_ITEMS) break;
            const size_t t0 = (size_t)g * (4 * PEER_TPW) + wave * PEER_TPW;
            UL la, lb, lc; UG ga, gb;
            float acc[16];
#pragma unroll
            for (int i = 0; i < 16; ++i) acc[i] = 0.f;
            u_load(la, t0, s, lane, IDX, ACTW, (const float*)XB); u_load(lb, t0 + 1, s, lane, IDX, ACTW, (const float*)XB);
            u_publish(la, pt0, lane); u_publish(lb, pt0 + 1024, lane);
            u_gather<0>(ga, pt0, s, lane, EU);
#pragma unroll 1
            for (int j = 0; j < PEER_TPW; ++j) {
                char* const ptj = pt0 + 1024 * (j & 1); char* const ptn = pt0 + 1024 * ((j + 1) & 1);
                u_gather<1>(gb, ptj, s, lane, EU);
                u_fma(ga, acc);
                if (j + 2 < PEER_TPW) u_load(lc, t0 + j + 2, s, lane, IDX, ACTW, (const float*)XB);
                if (j + 1 < PEER_TPW) u_gather<0>(ga, ptn, s, lane, EU);
                u_fma(gb, acc);
                u_finish(acc, la, ex, t0 + j, s, lane, alpha, X, XB, SSQ8);
                la = lb; lb = lc;
                if (j + 2 < PEER_TPW) u_publish(lb, ptj, lane);
            }
        }
    }
}

DEVI void rope_cs(float pos, int i, float& c, float& s) {
    const float inv = exp2f(-(float)i * (13.287712379549449f / 32.f));
    const float ang = pos * inv;
    const float kf = rintf(ang * 0.15915494309189535f);
    float rr = fmaf(-kf, 6.2831854820251465f, ang);
    rr = fmaf(-kf, -1.7484555e-7f, rr);
    c = __cosf(rr); s = __sinf(rr);
}
#define QSCALE_MLA  (0.07216878364870322f * 1.4426950408889634f)
#define QSCALE_MOBA (0.08838834764831845f * 1.4426950408889634f)

DEVI void moba_prep_item(const Params& p, int item, char* smem) {
    const int tid = threadIdx.x;
    const int h = item & 3, tt = item >> 2;
    const size_t m0 = (size_t)tt * 64;
    const int b = (int)(m0 >> 13), s0 = (int)(m0 & 8191), bh = b * 4 + h;
    const bf16_t* Z1 = (const bf16_t*)(p.ws + OFF_Z1);
    bf16_t* Qd = (bf16_t*)(p.ws + OFF_QD); bf16_t* Kd = (bf16_t*)(p.ws + OFF_KD); bf16_t* VdT = (bf16_t*)(p.ws + OFF_VDT);
    const int row = tid >> 2, j = tid & 3;
    const bf16_t* zr = Z1 + (m0 + row) * 1984;
#pragma unroll
    for (int which = 0; which < 2; ++which) {
        const bf16_t* src = zr + (which ? 960 : 448) + h * 128 + 32 * j;
        const float* gn = (which ? p.l1_mk_norm : p.l1_mq_norm) + 32 * j;
        float v[32]; float ss = 0.f;
#pragma unroll
        for (int i = 0; i < 4; ++i) {
            uint4 u = *(const uint4*)(src + 8 * i);
            v[8 * i] = bflo(u.x); v[8 * i + 1] = bfhi(u.x); v[8 * i + 2] = bflo(u.y); v[8 * i + 3] = bfhi(u.y);
            v[8 * i + 4] = bflo(u.z); v[8 * i + 5] = bfhi(u.z); v[8 * i + 6] = bflo(u.w); v[8 * i + 7] = bfhi(u.w);
        }
#pragma unroll
        for (int i = 0; i < 32; ++i) ss += v[i] * v[i];
        ss += __shfl_xor(ss, 1); ss += __shfl_xor(ss, 2);
        const float sc = rsqrtf(ss * (1.f / 128.f) + 1e-6f) * (which ? 1.f : QSCALE_MOBA);
        bf16_t* dst = (which ? Kd : Qd) + ((size_t)bh * 8192 + s0 + row) * 128 + 32 * j;
#pragma unroll
        for (int i = 0; i < 4; ++i) {
            uint4 o;
            o.x = pack2(v[8 * i] * sc * gn[8 * i], v[8 * i + 1] * sc * gn[8 * i + 1]); o.y = pack2(v[8 * i + 2] * sc * gn[8 * i + 2], v[8 * i + 3] * sc * gn[8 * i + 3]);
            o.z = pack2(v[8 * i + 4] * sc * gn[8 * i + 4], v[8 * i + 5] * sc * gn[8 * i + 5]); o.w = pack2(v[8 * i + 6] * sc * gn[8 * i + 6], v[8 * i + 7] * sc * gn[8 * i + 7]);
            *(uint4*)(dst + 8 * i) = o;
        }
    }
    bf16_t* sT = (bf16_t*)smem;
    {
        const bf16_t* src = zr + 1472 + h * 128 + 32 * j;
#pragma unroll
        for (int i = 0; i < 4; ++i) {
            uint4 u = *(const uint4*)(src + 8 * i);
            const int d0 = 32 * j + 8 * i;
            sT[(d0 + 0) * 66 + row] = (bf16_t)(u.x & 0xffff); sT[(d0 + 1) * 66 + row] = (bf16_t)(u.x >> 16);
            sT[(d0 + 2) * 66 + row] = (bf16_t)(u.y & 0xffff); sT[(d0 + 3) * 66 + row] = (bf16_t)(u.y >> 16);
            sT[(d0 + 4) * 66 + row] = (bf16_t)(u.z & 0xffff); sT[(d0 + 5) * 66 + row] = (bf16_t)(u.z >> 16);
            sT[(d0 + 6) * 66 + row] = (bf16_t)(u.w & 0xffff); sT[(d0 + 7) * 66 + row] = (bf16_t)(u.w >> 16);
        }
    }
    __syncthreads();
    for (int e = tid; e < 128 * 32; e += NTHREADS) {
        const int d = e >> 5, tp = e & 31;
        const unsigned v = (unsigned)sT[d * 66 + 2 * tp] | ((unsigned)sT[d * 66 + 2 * tp + 1] << 16);
        *(unsigned*)(VdT + ((size_t)bh * 128 + d) * 8192 + s0 + (((2 * tp) & ~12) | (((2 * tp) & 4) << 1) | (((2 * tp) & 8) >> 1))) = v;
    }
    __syncthreads();
}

DEVI void moba_kmean_item(const Params& p, int item, char* smem) {
    const int tid = threadIdx.x;
    const int bh = item >> 5, blk = item & 31, b = bh >> 2, h = bh & 3;
    const bf16_t* Z1 = (const bf16_t*)(p.ws + OFF_Z1) + ((size_t)b * 8192 + blk * 256) * 1984 + 960 + h * 128;
    const int cc = tid & 15, rg = tid >> 4;
    float col[8];
#pragma unroll
    for (int i = 0; i < 8; ++i) col[i] = 0.f;
    for (int i = 0; i < 16; ++i) {
        const int row = rg * 16 + i;
        uint4 u = *(const uint4*)(Z1 + (size_t)row * 1984 + cc * 8);
        float v[8] = {bflo(u.x), bfhi(u.x), bflo(u.y), bfhi(u.y), bflo(u.z), bfhi(u.z), bflo(u.w), bfhi(u.w)};
        float ss = 0.f;
#pragma unroll
        for (int e = 0; e < 8; ++e) ss += v[e] * v[e];
        ss += __shfl_xor(ss, 1); ss += __shfl_xor(ss, 2); ss += __shfl_xor(ss, 4); ss += __shfl_xor(ss, 8);
        const float rstd = rsqrtf(ss * (1.f / 128.f) + 1e-6f);
#pragma unroll
        for (int e = 0; e < 8; ++e) col[e] += v[e] * rstd;
    }
    float* sR = (float*)smem;
#pragma unroll
    for (int e = 0; e < 8; ++e) sR[rg * 128 + cc * 8 + e] = col[e];
    __syncthreads();
    if (tid < 128) {
        float s = 0.f;
#pragma unroll
        for (int g = 0; g < 16; ++g) s += sR[g * 128 + tid];
        ((float*)(p.ws + OFF_KMEAN))[((size_t)bh * 32 + blk) * 128 + tid] = s * (1.f / 256.f) * p.l1_mk_norm[tid];
    }
    __syncthreads();
}

DEVI void mla_prep_item(const Params& p, int item, char* smem) {
    const int tid = threadIdx.x;
    const int h = item & 3, tt = item >> 2;
    const size_t m0 = (size_t)tt * 64;
    const int b = (int)(m0 >> 13), s0 = (int)(m0 & 8191), bh = b * 4 + h;
    const bf16_t* Z1 = (const bf16_t*)(p.ws + OFF_Z1);
    const bf16_t* QC = (const bf16_t*)(p.ws + OFF_QC);
    const bf16_t* KV = (const bf16_t*)(p.ws + OFF_KV);
    bf16_t* Q = (bf16_t*)(p.ws + OFF_Q); bf16_t* K = (bf16_t*)(p.ws + OFF_K); bf16_t* VT = (bf16_t*)(p.ws + OFF_VT);
    const int row = tid >> 2, j = tid & 3;
    const size_t m = m0 + row;
    const float pos = (float)p.pos[m];
#pragma unroll
    for (int which = 0; which < 2; ++which) {
        const bf16_t* nsrc = which ? (KV + m * 1024 + h * 256 + 32 * j) : (QC + m * 768 + h * 192 + 32 * j);
        const bf16_t* r1 = which ? (Z1 + m * 1984 + 384 + 8 * j) : (QC + m * 768 + h * 192 + 128 + 8 * j);
        const bf16_t* r2 = r1 + 32;
        const float* gn = which ? p.l1_k_norm : p.l1_q_norm;
        float v[32], a1[8], a2[8]; float ss = 0.f;
#pragma unroll
        for (int i = 0; i < 4; ++i) {
            uint4 u = *(const uint4*)(nsrc + 8 * i);
            v[8 * i] = bflo(u.x); v[8 * i + 1] = bfhi(u.x); v[8 * i + 2] = bflo(u.y); v[8 * i + 3] = bfhi(u.y);
            v[8 * i + 4] = bflo(u.z); v[8 * i + 5] = bfhi(u.z); v[8 * i + 6] = bflo(u.w); v[8 * i + 7] = bfhi(u.w);
        }
        { uint4 u = *(const uint4*)r1; a1[0] = bflo(u.x); a1[1] = bfhi(u.x); a1[2] = bflo(u.y); a1[3] = bfhi(u.y); a1[4] = bflo(u.z); a1[5] = bfhi(u.z); a1[6] = bflo(u.w); a1[7] = bfhi(u.w); }
        { uint4 u = *(const uint4*)r2; a2[0] = bflo(u.x); a2[1] = bfhi(u.x); a2[2] = bflo(u.y); a2[3] = bfhi(u.y); a2[4] = bflo(u.z); a2[5] = bfhi(u.z); a2[6] = bflo(u.w); a2[7] = bfhi(u.w); }
#pragma unroll
        for (int i = 0; i < 32; ++i) ss += v[i] * v[i];
#pragma unroll
        for (int i = 0; i < 8; ++i) ss += a1[i] * a1[i] + a2[i] * a2[i];
        ss += __shfl_xor(ss, 1); ss += __shfl_xor(ss, 2);
        const float rstd = rsqrtf(ss * (1.f / 192.f) + 1e-6f);
        const float sc = which ? 1.f : QSCALE_MLA;
        bf16_t* dst = (which ? K : Q) + ((size_t)bh * 8192 + s0 + row) * 192;
#pragma unroll
        for (int i = 0; i < 4; ++i) {
            const float* g = gn + 32 * j + 8 * i;
            uint4 o;
            o.x = pack2(v[8 * i] * rstd * g[0] * sc, v[8 * i + 1] * rstd * g[1] * sc); o.y = pack2(v[8 * i + 2] * rstd * g[2] * sc, v[8 * i + 3] * rstd * g[3] * sc);
            o.z = pack2(v[8 * i + 4] * rstd * g[4] * sc, v[8 * i + 5] * rstd * g[5] * sc); o.w = pack2(v[8 * i + 6] * rstd * g[6] * sc, v[8 * i + 7] * rstd * g[7] * sc);
            *(uint4*)(dst + 32 * j + 8 * i) = o;
        }
        float o1[8], o2[8];
#pragma unroll
        for (int i = 0; i < 8; ++i) {
            float c, s; rope_cs(pos, 8 * j + i, c, s);
            const float y1 = a1[i] * rstd * gn[128 + 8 * j + i], y2 = a2[i] * rstd * gn[160 + 8 * j + i];
            o1[i] = (y1 * c - y2 * s) * sc; o2[i] = (y2 * c + y1 * s) * sc;
        }
        uint4 w1, w2;
        w1.x = pack2(o1[0], o1[1]); w1.y = pack2(o1[2], o1[3]); w1.z = pack2(o1[4], o1[5]); w1.w = pack2(o1[6], o1[7]);
        w2.x = pack2(o2[0], o2[1]); w2.y = pack2(o2[2], o2[3]); w2.z = pack2(o2[4], o2[5]); w2.w = pack2(o2[6], o2[7]);
        *(uint4*)(dst + 128 + 8 * j) = w1; *(uint4*)(dst + 160 + 8 * j) = w2;
    }
    bf16_t* sT = (bf16_t*)smem;
    {
        const bf16_t* src = KV + m * 1024 + h * 256 + 128 + 32 * j;
#pragma unroll
        for (int i = 0; i < 4; ++i) {
            uint4 u = *(const uint4*)(src + 8 * i);
            const int d0 = 32 * j + 8 * i;
            sT[(d0 + 0) * 66 + row] = (bf16_t)(u.x & 0xffff); sT[(d0 + 1) * 66 + row] = (bf16_t)(u.x >> 16);
            sT[(d0 + 2) * 66 + row] = (bf16_t)(u.y & 0xffff); sT[(d0 + 3) * 66 + row] = (bf16_t)(u.y >> 16);
            sT[(d0 + 4) * 66 + row] = (bf16_t)(u.z & 0xffff); sT[(d0 + 5) * 66 + row] = (bf16_t)(u.z >> 16);
            sT[(d0 + 6) * 66 + row] = (bf16_t)(u.w & 0xffff); sT[(d0 + 7) * 66 + row] = (bf16_t)(u.w >> 16);
        }
    }
    __syncthreads();
    for (int e = tid; e < 128 * 32; e += NTHREADS) {
        const int d = e >> 5, tp = e & 31;
        const unsigned v = (unsigned)sT[d * 66 + 2 * tp] | ((unsigned)sT[d * 66 + 2 * tp + 1] << 16);
        *(unsigned*)(VT + ((size_t)bh * 128 + d) * 8192 + s0 + (((2 * tp) & ~12) | (((2 * tp) & 4) << 1) | (((2 * tp) & 8) >> 1))) = v;
    }
    __syncthreads();
}

template <int DQK, bool MOBA>
DEVI void attn_item(const Params& p, int bh, int qt, char* smem) {
    constexpr int NKS = DQK / 16, KCH = DQK / 8;
    const int tid = threadIdx.x, lane = tid & 63, wave = tid >> 6;
    const int r = lane & 31, hh = lane >> 5;
    char* const ws = opaque_ptr(p.ws);
    const bf16_t* Q  = (const bf16_t*)(ws + (MOBA ? OFF_QD : OFF_Q)) + (size_t)bh * 8192 * DQK;
    const bf16_t* Kg = (const bf16_t*)(ws + (MOBA ? OFF_KD : OFF_K)) + (size_t)bh * 8192 * DQK;
    const bf16_t* Vg = (const bf16_t*)(ws + (MOBA ? OFF_VDT : OFF_VT)) + (size_t)bh * 128 * 8192;
    const int q0 = qt * 128;
    const int qpos = q0 + wave * 32 + r;
    constexpr int KB = 32 * DQK * 2, VB = 8192, STG = KB + VB;
    constexpr int KI = KB / 4096;
    int*  sList = (int*)(smem + 61440);
    unsigned* sSel = (unsigned*)(smem + 62464);
    float* sTop = (float*)(smem + 63232);
    int ntiles;
    unsigned mysel = 0xffffffffu;
    if constexpr (MOBA) {
        const int jblk = q0 >> 8;
        float* sKm = (float*)smem;
        const float* km = (const float*)(ws + OFF_KMEAN) + (size_t)bh * 32 * 128;
        for (int e = tid; e < 1024; e += NTHREADS) ((float4*)sKm)[e] = ((const float4*)km)[e];
        unsigned* sAny = (unsigned*)(smem + 62976);
        if (tid < 32) sAny[tid] = 0u;
        __syncthreads();
        const int qq = tid & 127, par = tid >> 7;
        float ga[16];
#pragma unroll
        for (int i = 0; i < 16; ++i) ga[i] = 0.f;
        const bf16_t* qrow = Q + (size_t)(q0 + qq) * 128;
#pragma unroll 1
        for (int d0 = 0; d0 < 128; d0 += 8) {
            uint4 u = *(const uint4*)(qrow + d0);
            float qv[8] = {bflo(u.x), bfhi(u.x), bflo(u.y), bfhi(u.y), bflo(u.z), bfhi(u.z), bflo(u.w), bfhi(u.w)};
#pragma unroll
            for (int i = 0; i < 16; ++i) {
                const float4 ka = *(const float4*)(sKm + (2 * i + par) * 128 + d0), kb = *(const float4*)(sKm + (2 * i + par) * 128 + d0 + 4);
                ga[i] += qv[0] * ka.x + qv[1] * ka.y + qv[2] * ka.z + qv[3] * ka.w + qv[4] * kb.x + qv[5] * kb.y + qv[6] * kb.z + qv[7] * kb.w;
            }
        }
        float tv[3] = {-3e38f, -3e38f, -3e38f}; int ti[3] = {-1, -1, -1};
#pragma unroll
        for (int i = 0; i < 16; ++i) {
            const int n = 2 * i + par;
            if (n < jblk) {
                const float v = ga[i];
                if (v > tv[0]) { tv[2] = tv[1]; ti[2] = ti[1]; tv[1] = tv[0]; ti[1] = ti[0]; tv[0] = v; ti[0] = n; }
                else if (v > tv[1]) { tv[2] = tv[1]; ti[2] = ti[1]; tv[1] = v; ti[1] = n; }
                else if (v > tv[2]) { tv[2] = v; ti[2] = n; }
            }
        }
#pragma unroll
        for (int i = 0; i < 3; ++i) { sTop[tid * 6 + 2 * i] = tv[i]; sTop[tid * 6 + 2 * i + 1] = __int_as_float(ti[i]); }
        __syncthreads();
        if (par == 0) {
#pragma unroll
            for (int i = 0; i < 3; ++i) {
                const float v = sTop[(tid + 128) * 6 + 2 * i]; const int n = __float_as_int(sTop[(tid + 128) * 6 + 2 * i + 1]);
                if (n >= 0) {
                    if (v > tv[0]) { tv[2] = tv[1]; ti[2] = ti[1]; tv[1] = tv[0]; ti[1] = ti[0]; tv[0] = v; ti[0] = n; }
                    else if (v > tv[1]) { tv[2] = tv[1]; ti[2] = ti[1]; tv[1] = v; ti[1] = n; }
                    else if (v > tv[2]) { tv[2] = v; ti[2] = n; }
                }
            }
            unsigned m = 1u << jblk;
#pragma unroll
            for (int i = 0; i < 3; ++i) if (ti[i] >= 0) { m |= 1u << ti[i]; sAny[ti[i]] = 1u; }
            sSel[qq] = m;
        }
        __syncthreads();
        if (tid == 0) {
            int n = 0;
            for (int blk = 0; blk < jblk; ++blk) if (sAny[blk]) { for (int t = 0; t < 8; ++t) sList[n++] = blk * 8 + t; }
            for (int t = jblk * 8; t < (q0 + 128) / 32; ++t) sList[n++] = t;
            sSel[160] = (unsigned)n;
        }
        __syncthreads();
        ntiles = (int)sSel[160];
        mysel = sSel[wave * 32 + r];
        __syncthreads();
    } else {
        ntiles = 4 * qt + 4;
    }
    bf16x8 qf[NKS];
#pragma unroll
    for (int ks = 0; ks < NKS; ++ks) qf[ks] = *(const bf16x8*)(Q + (size_t)qpos * DQK + ks * 16 + hh * 8);
    f32x16 o[4];
#pragma unroll
    for (int dt = 0; dt < 4; ++dt)
#pragma unroll
        for (int e = 0; e < 16; ++e) o[dt][e] = 0.f;
    float lsum = 0.f;
    int koff[KI], voff[2];
#pragma unroll
    for (int i = 0; i < KI; ++i) {
        const int L = (wave * KI + i) * 64 + lane, row = L / KCH, cp = L % KCH;
        const int f = (DQK == 128) ? (row & 15) : ((row >> 1) & 7);
        koff[i] = row * DQK + (cp ^ f) * 8;
    }
#pragma unroll
    for (int i = 0; i < 2; ++i) {
        const int L = (wave * 2 + i) * 64 + lane, dv = L >> 2, cp = L & 3;
        voff[i] = dv * 8192 + (cp ^ ((dv >> 2) & 3)) * 8;
    }
    const int wv = __builtin_amdgcn_readfirstlane(wave);
#define ATT_ISSUE(LI) { const int u_ = tile_id(LI); char* st_ = smem + ((LI) % 3) * STG; \
        _Pragma("unroll") for (int i = 0; i < KI; ++i) __builtin_amdgcn_global_load_lds((const unsigned*)(Kg + (size_t)u_ * 32 * DQK + koff[i]), (unsigned*)(st_ + (wv * KI + i) * 1024), 16, 0, 0); \
        _Pragma("unroll") for (int i = 0; i < 2; ++i)  __builtin_amdgcn_global_load_lds((const unsigned*)(Vg + (size_t)u_ * 32 + voff[i]),       (unsigned*)(st_ + KB + (wv * 2 + i) * 1024), 16, 0, 0); }
    auto tile_id = [&](int li) -> int { if constexpr (MOBA) return sList[li]; else return li; };
    if (ntiles > 0) ATT_ISSUE(0)
    if (ntiles > 1) ATT_ISSUE(1)
    const int xk = ((DQK == 128) ? (r & 15) : ((r >> 1) & 7)) ^ hh;
    const int xv = (r >> 2) & 3;
#pragma unroll 1
    for (int li = 0; li < ntiles; ++li) {
        if (li + 1 < ntiles) asm volatile("s_waitcnt vmcnt(%0)" :: "n"(KI + 2) : "memory");
        else asm volatile("s_waitcnt vmcnt(0)" ::: "memory");
        G2_RAW_BARRIER();
        if (li + 2 < ntiles) ATT_ISSUE(li + 2)
        const int unit = tile_id(li);
        const int kbase = unit * 32;
        bool allowed = true;
        if constexpr (MOBA) allowed = (mysel >> (unit >> 3)) & 1u;
        const char* sK = smem + (li % 3) * STG;
        const char* sV = sK + KB;
        if (kbase <= q0 + wave * 32 + 31) {
            const char* kbase_l = sK + r * (DQK * 2);
            const char* vbase_l = sV + r * 64;
            f32x16 s;
#pragma unroll
            for (int e = 0; e < 16; ++e) s[e] = 0.f;
#pragma unroll
            for (int ks = 0; ks < NKS; ++ks) {
                const bf16x8 a = *(const bf16x8*)(kbase_l + (((2 * ks) ^ xk) << 4));
                s = mfma32(a, qf[ks], s);
            }
            const bool need_mask = (kbase + 31 > q0 + wave * 32);
            float pr[16];
            if (need_mask) {
                const int kofs = qpos - kbase - 4 * hh;
#pragma unroll
                for (int e = 0; e < 16; ++e) pr[e] = ((e & 3) + 8 * (e >> 2) <= kofs) ? __builtin_amdgcn_exp2f(s[e]) : 0.f;
            } else {
#pragma unroll
                for (int e = 0; e < 16; ++e) pr[e] = __builtin_amdgcn_exp2f(s[e]);
            }
            if constexpr (MOBA) {
                const float am = allowed ? 1.f : 0.f;
#pragma unroll
                for (int e = 0; e < 16; ++e) pr[e] *= am;
            }
            lsum += ((pr[0] + pr[1]) + (pr[2] + pr[3])) + ((pr[4] + pr[5]) + (pr[6] + pr[7])) + ((pr[8] + pr[9]) + (pr[10] + pr[11])) + ((pr[12] + pr[13]) + (pr[14] + pr[15]));
#pragma unroll
            for (int s2 = 0; s2 < 2; ++s2) {
                const u32x4 pbu = {pack2(pr[8 * s2 + 0], pr[8 * s2 + 1]), pack2(pr[8 * s2 + 2], pr[8 * s2 + 3]),
                                   pack2(pr[8 * s2 + 4], pr[8 * s2 + 5]), pack2(pr[8 * s2 + 6], pr[8 * s2 + 7])};
                const bf16x8 pbv = __builtin_bit_cast(bf16x8, pbu);
#pragma unroll
                for (int dt = 0; dt < 4; ++dt) {
                    const char* vb = vbase_l + dt * (32 * 64);
                    const u32x4 vau = *(const u32x4*)(vb + (((2 * s2 + hh) ^ xv) << 4));
                    o[dt] = mfma32(__builtin_bit_cast(bf16x8, vau), pbv, o[dt]);
                }
            }
        }
    }
#undef ATT_ISSUE
    G2_RAW_BARRIER();
    lsum += __shfl_xor(lsum, 32);
    const float inv = 1.f / lsum;
    char* sO = smem + wave * 8704;
#pragma unroll
    for (int dt = 0; dt < 4; ++dt)
#pragma unroll
        for (int e = 0; e < 16; e += 2) {
            const int dv = 32 * dt + (e & 3) + 8 * (e >> 2) + 4 * hh;
            *(unsigned*)(sO + r * 272 + dv * 2) = pack2(o[dt][e] * inv, o[dt][e + 1] * inv);
        }
    __builtin_amdgcn_s_waitcnt(0xc07f);
    __builtin_amdgcn_wave_barrier();
    bf16_t* MIX = (bf16_t*)(ws + OFF_MIX1);
    const int b = bh >> 2, h = bh & 3;
#pragma unroll
    for (int i = 0; i < 8; ++i) {
        const int id = lane + 64 * i, row = id >> 4, cc = id & 15;
        const uint4 v = *(const uint4*)(sO + row * 272 + cc * 16);
        *(uint4*)(MIX + ((size_t)b * 8192 + q0 + wave * 32 + row) * 1024 + (MOBA ? 512 : 0) + h * 128 + cc * 8) = v;
    }
    __syncthreads();
}

DEVI void attn_phase_all(const Params& p, char* smem) {
    const int G = gridDim.x;
#pragma unroll 1
    for (int v = blockIdx.x; v < 512; v += G) attn_item<192, false>(p, v & 7, 63 - (v >> 3), smem);
    __builtin_amdgcn_sched_barrier(0);
#pragma unroll 1
    for (int v = blockIdx.x; v < 512; v += G) attn_item<128, true>(p, v & 7, (v >> 3), smem);
}

#define XB_TMO      128
#define XB_XCNT(j)  (256  + 64 * (j))
#define XB_XSUB(j)  (1280 + 64 * (j))
#define XB_XGEN(j)  (2304 + 64 * (j))
#define XB_TOP      3328
#define XB_TOPGEN   3392
#define XCD_BAR_WORDS 3456
#define XB_SPIN_CAP (1u << 23)
#define LAS __attribute__((address_space(3)))
DEVI unsigned xb_ld(unsigned* p)              { return __hip_atomic_load(p, __ATOMIC_RELAXED, __HIP_MEMORY_SCOPE_AGENT); }
DEVI unsigned xb_add(unsigned* p, unsigned v) { return __hip_atomic_fetch_add(p, v, __ATOMIC_RELAXED, __HIP_MEMORY_SCOPE_AGENT); }
DEVI unsigned xb_xcc_id() { return (unsigned)__builtin_amdgcn_s_getreg((3 << 11) | 20) & 0xFu; }
#define XB_SPIN(cond, bar) do { unsigned _sp = 0; while (cond) { __builtin_amdgcn_s_sleep(1); \
    if ((++_sp & 255u) == 0u) { if (xb_ld(&(bar)[XB_TMO])) break; if (_sp > XB_SPIN_CAP) { atomicAdd(&(bar)[XB_TMO], 1u); break; } } } } while (0)
struct XcdBarrier { unsigned* bar; unsigned x; volatile LAS unsigned* st; };
DEVI XcdBarrier xcd_barrier_post(unsigned* bar, volatile LAS unsigned* st) {
    XcdBarrier b; b.bar = bar; b.x = xb_xcc_id(); b.st = st;
    if (threadIdx.x == 0) st[2] = xb_add(&bar[XB_XCNT(b.x)], 1u);
    return b;
}
DEVI void xcd_barrier_complete(unsigned* bar, unsigned x, unsigned& nloc, unsigned& nx, unsigned& dense) {
    const unsigned G = gridDim.x * gridDim.y * gridDim.z;
    unsigned sum, cnt, mine, sp = 0u;
    for (;;) {
        sum = 0u; cnt = 0u; mine = 0u; dense = 0u;
#pragma unroll
        for (unsigned j = 0; j < 16; ++j) { const unsigned c = xb_ld(&bar[XB_XCNT(j)]); sum += c; cnt += (c > 0u) ? 1u : 0u; mine = (j == x) ? c : mine; dense += (j < x && c > 0u) ? 1u : 0u; }
        if (sum == G) break;
        __builtin_amdgcn_s_sleep(1);
        if ((++sp & 255u) == 0u) { if (xb_ld(&bar[XB_TMO])) break; if (sp > XB_SPIN_CAP) { atomicAdd(&bar[XB_TMO], 1u); break; } }
    }
    nloc = mine > 0u ? mine : 1u; nx = cnt > 0u ? cnt : 1u;
}
DEVI void xcd_barrier(const XcdBarrier& b) {
    asm volatile("s_waitcnt vmcnt(0)" ::: "memory");
    __syncthreads();
    if (threadIdx.x == 0) {
        unsigned* bar = b.bar;
        __builtin_amdgcn_s_waitcnt(0);
        unsigned nloc = b.st[0], nx = b.st[1];
        if (nloc == 0u) { unsigned dense = 0u; xcd_barrier_complete(bar, b.x, nloc, nx, dense); b.st[0] = nloc; b.st[1] = nx; b.st[3] = dense; }
        const unsigned old = xb_add(&bar[XB_XSUB(b.x)], 1u);
        const unsigned gen = old / nloc;
        if (old + 1u == (gen + 1u) * nloc) {
            __builtin_amdgcn_fence(__ATOMIC_RELEASE, "agent");
            asm volatile("s_waitcnt vmcnt(0)" ::: "memory");
            const unsigned og = xb_add(&bar[XB_TOP], 1u);
            const unsigned tg = og / nx;
            if (og + 1u == (tg + 1u) * nx) xb_add(&bar[XB_TOPGEN], 1u);
            else XB_SPIN(xb_ld(&bar[XB_TOPGEN]) == tg, bar);
            __builtin_amdgcn_fence(__ATOMIC_ACQUIRE, "agent");
            xb_add(&bar[XB_XGEN(b.x)], 1u);
            asm volatile("s_waitcnt vmcnt(0)" ::: "memory");
        } else {
            XB_SPIN(xb_ld(&bar[XB_XGEN(b.x)]) == gen, bar);
            __builtin_amdgcn_fence(__ATOMIC_ACQUIRE, "agent");
            asm volatile("s_waitcnt vmcnt(0)" ::: "memory");
        }
    }
    __syncthreads();
}

enum { PH_CONV, PH_INPROJ0, PH_LOCAL, PH_SCAN, PH_HOUT, PH_OUTPROJ0, PH_Q0, PH_TOPK0, PH_PD0, PH_PR0, PH_PU0, PH_INPROJ1, PH_SMALL, PH_MLAPREP, PH_MLA,
       PH_OUTPROJ1, PH_Q1, PH_TOPK1, PH_PD1, PH_PR1, PH_PU1, N_PHASES };
DEVI void run_phase(const Params& p, int ph_in, char* smem, Placement pl) {
    const bool dup = ph_in >= 100; const int ph = dup ? ph_in - 100 : ph_in;
#ifdef ONLY_PHASE
    if (ph != ONLY_PHASE) return;
#endif
    char* ws = p.ws;
    const int bid = blockIdx.x, nb = gridDim.x;
    const int myslice = (pl.nloc > 0) ? (pl.xcc & 7) : (bid & 7);
    switch (ph) {
    case PH_CONV: phase_convert(p, smem); break;
    case PH_INPROJ0: gemm2_phase((const bf16_t*)(ws + OFF_XB), 1024, (const bf16_t*)(ws + OFF_W_IN0T), 128, 12, 1024, (const float*)(ws + OFF_SSQ1), 1,
                        Epi2In0{(bf16_t*)(ws + OFF_Z0), (float*)(ws + OFF_G), (const float*)(ws + OFF_LB), (bf16_t*)(ws + OFF_Z0), 3072, 3072, nullptr, nullptr}, smem, pl); break;
    case PH_LOCAL: for (int it = bid; it < 1024; it += nb) hgrn_local_item(p, it, smem);
            for (int it = nb - 1 - bid; it < 512; it += nb) gmlp_item(p, it, smem);
            break;
    case PH_SCAN: hgrn_scan_phase(p); break;
    case PH_HOUT: for (int it = bid; it < 1024; it += nb) hgrn_out_item(p, it, smem); break;
    case PH_OUTPROJ0: case PH_OUTPROJ1: {
        const bool l1 = (ph == PH_OUTPROJ1);
        gemm2_phase((const bf16_t*)(ws + (l1 ? OFF_MIX1 : OFF_MIX0)), 1024, (const bf16_t*)(ws + (l1 ? OFF_W_OUT1T : OFF_W_OUT0T)), 128, 4, 1024, nullptr, 0,
                    Epi2Resid{(bf16_t*)(ws + OFF_XB), (float*)(ws + OFF_SSQ16), dup ? 0.f : (l1 ? ALPHA_M1 : ALPHA_M0), nullptr, 0, 0, nullptr, nullptr}, smem, pl);
    } break;
    case PH_Q0: case PH_Q1: {
        const bool l1 = (ph == PH_Q1);
        gemm2_phase((const bf16_t*)(ws + OFF_XB), 1024, (const bf16_t*)(ws + (l1 ? OFF_W_Q1T : OFF_W_Q0T)), 128, 8, 1024, (const float*)(ws + OFF_SSQ16), 16,
                    Epi2Bf16{(bf16_t*)(ws + OFF_QP), 2048, 2048, nullptr, nullptr}, smem, pl);
    } break;
    case PH_TOPK0: case PH_TOPK1: peer_topk_phase(p, (const bf16_t*)(ws + (ph == PH_TOPK1 ? OFF_SK1 : OFF_SK0)), bid, nb, smem); break;
    case PH_PD0: case PH_PD1: peer_down_phase(p, (ph == PH_PD1) ? p.l1_norm_ffn : p.l0_norm_ffn, ((ph == PH_PD1) ? 16 : 0) + (dup ? 32 : 0), myslice, smem); break;
    case PH_PR0: case PH_PR1: peer_reduce_phase(p); break;
    case PH_PU0: case PH_PU1: peer_up_phase(p, ((ph == PH_PU1) ? 24 : 8) + (dup ? 32 : 0), myslice, dup ? 0.f : ((ph == PH_PU1) ? ALPHA_P1 : ALPHA_P0), (ph == PH_PU1 && !dup) ? p.out : nullptr, smem); break;
    case PH_INPROJ1: gemm2_phase((const bf16_t*)(ws + OFF_XB), 1024, (const bf16_t*)(ws + OFF_W_IN1T), 128, 8, 1024, (const float*)(ws + OFF_SSQ8), 8, Epi2Bf16{(bf16_t*)(ws + OFF_Z1), 1984, 1984, (float*)(ws + OFF_SSQCQ), (float*)(ws + OFF_SSQCKV)}, smem, pl);
            for (int it = bid; it < 8192; it += nb) conv_experts(p.l1_exp_down, p.l1_exp_up, p.l1_norm_ffn, ws, it);
            break;
    case PH_SMALL: {
        gemm2_phase((const bf16_t*)(ws + OFF_Z1), 1984, (const bf16_t*)(ws + OFF_W_UQT), 128, 3, 256, (const float*)(ws + OFF_SSQCQ), 1, Epi2Bf16{(bf16_t*)(ws + OFF_QC), 768, 768, nullptr, nullptr}, smem, pl);
        gemm2_phase((const bf16_t*)(ws + OFF_Z1) + 256, 1984, (const bf16_t*)(ws + OFF_W_UKVT), 128, 4, 128, (const float*)(ws + OFF_SSQCKV), 1, Epi2Bf16{(bf16_t*)(ws + OFF_KV), 1024, 1024, nullptr, nullptr}, smem, pl);
        for (int it = (bid + nb / 2) % nb; it < 1024 + 256; it += nb) { if (it < 1024) moba_prep_item(p, it, smem); else moba_kmean_item(p, it - 1024, smem); }
    } break;
    case PH_MLAPREP: for (int it = bid; it < 1024; it += nb) mla_prep_item(p, it, smem); break;
    case PH_MLA: attn_phase_all(p, smem); break;
    default: break;
    }
}

extern "C" __global__ void __launch_bounds__(NTHREADS, 2) fwd_kernel(Params p) {
    extern __shared__ __attribute__((aligned(16))) char smem[];
    __shared__ uint4 xb_words;
    XcdBarrier xb; xb.bar = nullptr; xb.x = 0; xb.st = (volatile LAS unsigned*)&xb_words;
    if (p.coop) {
        if (threadIdx.x == 0) xb_words = make_uint4(0u, 0u, 0u, 0u);
        __syncthreads();
        xb = xcd_barrier_post((unsigned*)(p.ws + OFF_BAR), (volatile LAS unsigned*)&xb_words);
    }
    if (p.coop == 2) cg::this_grid().sync();
#define RUN_PH(PH) if (p.ph_lo <= PH && PH < p.ph_hi) { \
        Placement pl_; pl_.xcc = p.coop ? (int)xb.st[3] : 0; pl_.rank = p.coop ? (int)xb.st[2] : 0; pl_.nloc = p.coop ? (int)xb.st[0] : 0; pl_.nx = p.coop ? (int)xb.st[1] : 0; \
        if (PROBE_DUP == PH) { run_phase(p, PH + 100, smem, pl_); if (p.coop) xcd_barrier(xb); } \
        run_phase(p, PH, smem, pl_); if (p.coop && PH + 1 < p.ph_hi) xcd_barrier(xb); }
    RUN_PH(0) RUN_PH(1) RUN_PH(2) RUN_PH(3) RUN_PH(4) RUN_PH(5) RUN_PH(6) RUN_PH(7) RUN_PH(8) RUN_PH(9)
    RUN_PH(10) RUN_PH(11) RUN_PH(12) RUN_PH(13) RUN_PH(14) RUN_PH(15) RUN_PH(16) RUN_PH(17) RUN_PH(18) RUN_PH(19) RUN_PH(20)
}

extern "C" void kernel_launch(void* const* d_in, const int* in_sizes, int n_in, void* d_out, int out_size, void* d_ws, size_t ws_size, hipStream_t stream) {
    static int grid = 0;
    if (grid == 0) {
        if (n_in != 31 || out_size != 16384 * 1024 || ws_size < WS_NEED) { fprintf(stderr, "kernel_launch: unexpected shapes (n_in %d out %d ws %zu need %zu)\n", n_in, out_size, ws_size, (size_t)WS_NEED); grid = -1; return; }
        int dev = 0, cus = 0, per_cu = 0;
        hipGetDevice(&dev);
        hipDeviceGetAttribute(&cus, hipDeviceAttributeMultiprocessorCount, dev);
        if (hipFuncSetAttribute((const void*)fwd_kernel, hipFuncAttributeMaxDynamicSharedMemorySize, LDS_BYTES) != hipSuccess) { fprintf(stderr, "kernel_launch: hipFuncSetAttribute failed\n"); grid = -1; return; }
        if (hipOccupancyMaxActiveBlocksPerMultiprocessor(&per_cu, (const void*)fwd_kernel, NTHREADS, LDS_BYTES) != hipSuccess || per_cu < 1) { fprintf(stderr, "kernel_launch: occupancy query failed (%d)\n", per_cu); per_cu = 1; }
        (void)hipGetLastError();
        if (per_cu > 2) per_cu = 2;
        grid = cus * per_cu;
        fprintf(stderr, "kernel_launch: grid %d (%d CUs x %d)\n", grid, cus, per_cu);
    }
    if (grid < 0) return;
    Params p; memset(&p, 0, sizeof(p));
    const float* const* f = (const float* const*)d_in;
    p.x = f[0]; p.pos = (const int*)d_in[1]; p.lb_logits = f[2];
    p.l0_norm_mix = f[3]; p.l0_w_in = f[4]; p.l0_hgrn_out_norm = f[5]; p.l0_gmlp_v_norm = f[6]; p.l0_gmlp_w_s = f[7]; p.l0_gmlp_b_s = f[8]; p.l0_w_out = f[9];
    p.l0_norm_ffn = f[10]; p.l0_w_query = f[11]; p.l0_sub_keys = f[12]; p.l0_exp_down = f[13]; p.l0_exp_up = f[14];
    p.l1_norm_mix = f[15]; p.l1_w_in = f[16]; p.l1_cq_norm = f[17]; p.l1_ckv_norm = f[18]; p.l1_w_uq = f[19]; p.l1_w_ukv = f[20];
    p.l1_q_norm = f[21]; p.l1_k_norm = f[22]; p.l1_mq_norm = f[23]; p.l1_mk_norm = f[24]; p.l1_w_out = f[25];
    p.l1_norm_ffn = f[26]; p.l1_w_query = f[27]; p.l1_sub_keys = f[28]; p.l1_exp_down = f[29]; p.l1_exp_up = f[30];
    p.out = (float*)d_out; p.ws = (char*)d_ws;
    if (hipMemsetAsync((char*)d_ws + OFF_BAR, 0, 16384 + 4096, stream) != hipSuccess) { fprintf(stderr, "kernel_launch: memset failed\n"); return; }
#if N_LAUNCH_MODE == 1
    p.ph_lo = 0; p.ph_hi = N_PHASES; p.coop = 1;
    void* args[] = {&p};
    hipError_t e = hipLaunchCooperativeKernel((const void*)fwd_kernel, dim3(grid), dim3(NTHREADS), args, LDS_BYTES, stream);
    if (e != hipSuccess) fprintf(stderr, "cooperative launch failed: %s (grid %d)\n", hipGetErrorString(e), grid);
#else
    for (int ph = 0; ph < N_PHASES; ++ph) {
#ifdef ABLATE_M1
        if (ph >= 10 && ph <= 14) continue;
#endif
        p.ph_lo = ph; p.ph_hi = ph + 1; p.coop = 0;
        hipLaunchKernelGGL(fwd_kernel, dim3(grid), dim3(NTHREADS), LDS_BYTES, stream, p);
    }
#endif
}
```

```cpp
#include <hip/hip_runtime.h>
#include <hip/hip_cooperative_groups.h>
#include <stdint.h>
#include <stdio.h>
#include <string.h>
namespace cg = cooperative_groups;

#ifndef ALPHA_P0
#define ALPHA_P0 1.0f
#endif
#ifndef ALPHA_P1
#define ALPHA_P1 1.0f
#endif
#ifndef ALPHA_M0
#define ALPHA_M0 1.0f
#endif
#ifndef ALPHA_M1
#define ALPHA_M1 1.0f
#endif
#ifndef PROBE_NOMMA
#define PROBE_NOMMA 0
#endif
#ifndef PROBE_DUP
#define PROBE_DUP -1
#endif
#ifndef N_LAUNCH_MODE
#define N_LAUNCH_MODE 1
#endif

typedef unsigned short bf16_t;
using bf16x8 = __attribute__((ext_vector_type(8))) short;
using f32x4  = __attribute__((ext_vector_type(4))) float;
using f32x16 = __attribute__((ext_vector_type(16))) float;
typedef float f32x4v __attribute__((ext_vector_type(4)));
typedef float f32x2_t __attribute__((ext_vector_type(2)));
typedef __bf16 bf16x2_t __attribute__((ext_vector_type(2)));
typedef unsigned u32x4 __attribute__((ext_vector_type(4)));

#define DEVI __device__ __forceinline__
#define NTHREADS 256
#define LDS_BYTES 80896

static constexpr size_t MB = 1024 * 1024;
static constexpr size_t OFF_W_IN0T  = 0;
static constexpr size_t OFF_W_OUT0T = OFF_W_IN0T  + 3072ull * 1024 * 2;
static constexpr size_t OFF_W_Q0T   = OFF_W_OUT0T + 1024ull * 1024 * 2;
static constexpr size_t OFF_SK0     = OFF_W_Q0T   + 2048ull * 1024 * 2;
static constexpr size_t OFF_WS0     = OFF_SK0     + 262144ull * 2;
static constexpr size_t OFF_W_IN1T  = OFF_WS0     + 65536ull * 2;
static constexpr size_t OFF_W_UQT   = OFF_W_IN1T  + 2048ull * 1024 * 2;
static constexpr size_t OFF_W_UKVT  = OFF_W_UQT   + 768ull * 256 * 2;
static constexpr size_t OFF_W_OUT1T = OFF_W_UKVT  + 1024ull * 128 * 2;
static constexpr size_t OFF_W_Q1T   = OFF_W_OUT1T + 1024ull * 1024 * 2;
static constexpr size_t OFF_SK1     = OFF_W_Q1T   + 2048ull * 1024 * 2;
static constexpr size_t OFF_LB      = OFF_SK1     + 262144ull * 2;
static constexpr size_t OFF_INVD    = OFF_LB + 4096;
static constexpr size_t OFF_INVU    = OFF_INVD + 65536;
static constexpr size_t OFF_BAR     = OFF_INVU + 65536;
static constexpr size_t OFF_QCNT    = OFF_BAR + 14336;
static constexpr size_t OFF_ED      = 26 * MB;
static constexpr size_t OFF_EU      = OFF_ED + 32 * MB;
static constexpr size_t OFF_ACT     = OFF_EU + 32 * MB;
static constexpr size_t OFF_Z0   = OFF_ACT;
static constexpr size_t OFF_G    = OFF_Z0  + 16384ull * 3072 * 2;
static constexpr size_t OFF_HST  = OFF_G   + 16384ull * 512 * 4;
static constexpr size_t OFF_DEC  = OFF_HST + 1024ull * 16384 * 4;
static constexpr size_t OFF_MIX0 = OFF_DEC + 1024ull * 128 * 4;
static constexpr size_t OFF_QP   = OFF_ACT;
static constexpr size_t OFF_IDX  = OFF_QP  + 16384ull * 2048 * 2;
static constexpr size_t OFF_GATE = OFF_IDX + 16384ull * 128 * 4;
static constexpr size_t OFF_ACTW = OFF_GATE + 16384ull * 128 * 4;
static constexpr size_t OFF_PART = OFF_QP;
static constexpr size_t OFF_SDN  = OFF_ACTW + 16384ull * 128 * 4;
static constexpr size_t OFF_Z1   = OFF_ACT;
static constexpr size_t OFF_MIX1 = OFF_ACT;
static constexpr size_t OFF_QC   = OFF_Z1  + 16384ull * 1984 * 2;
static constexpr size_t OFF_KV   = OFF_QC  + 16384ull * 768 * 2;
static constexpr size_t OFF_QD   = OFF_KV  + 16384ull * 1024 * 2;
static constexpr size_t OFF_KD   = OFF_QD  + 16384ull * 512 * 2;
static constexpr size_t OFF_VDT  = OFF_KD  + 16384ull * 512 * 2;
static constexpr size_t OFF_Q    = OFF_VDT + 16384ull * 512 * 2;
static constexpr size_t OFF_K    = OFF_Q   + 16384ull * 768 * 2;
static constexpr size_t OFF_VT   = OFF_K   + 16384ull * 768 * 2;
static constexpr size_t OFF_KMEAN= OFF_VT  + 16384ull * 512 * 2;
static constexpr size_t WS_END_L1 = OFF_KMEAN + 8ull * 32 * 128 * 4;
static constexpr size_t WS_END_L0 = OFF_MIX0 + 16384ull * 1024 * 2;
static constexpr size_t WS_END_ACT = (WS_END_L1 > WS_END_L0 ? WS_END_L1 : WS_END_L0);
static constexpr size_t OFF_XB    = (WS_END_ACT + 255) / 256 * 256;
static constexpr size_t OFF_SSQ1  = OFF_XB + 16384ull * 1024 * 2;
static constexpr size_t OFF_SSQ16 = OFF_SSQ1 + 16384ull * 4;
static constexpr size_t OFF_SSQ8  = OFF_SSQ16 + 16384ull * 16 * 4;
static constexpr size_t OFF_XB8   = OFF_ED + 16 * MB;
static constexpr size_t OFF_SSQCQ = OFF_SSQ8 + 16384ull * 8 * 4;
static constexpr size_t OFF_SSQCKV = OFF_SSQCQ + 16384ull * 4;
static constexpr size_t WS_NEED = OFF_SSQCKV + 16384ull * 4;
static_assert(OFF_BAR + 16384 + 4096 <= OFF_ED, "weights overflow");

struct Params {
    const float* x; const int* pos; const float* lb_logits;
    const float *l0_norm_mix, *l0_w_in, *l0_hgrn_out_norm, *l0_gmlp_v_norm, *l0_gmlp_w_s, *l0_gmlp_b_s, *l0_w_out,
                *l0_norm_ffn, *l0_w_query, *l0_sub_keys, *l0_exp_down, *l0_exp_up;
    const float *l1_norm_mix, *l1_w_in, *l1_cq_norm, *l1_ckv_norm, *l1_w_uq, *l1_w_ukv, *l1_q_norm, *l1_k_norm,
                *l1_mq_norm, *l1_mk_norm, *l1_w_out, *l1_norm_ffn, *l1_w_query, *l1_sub_keys, *l1_exp_down, *l1_exp_up;
    float* out;
    char* ws;
    int ph_lo, ph_hi, coop, pad0;
};

DEVI unsigned pack2(float lo, float hi) { f32x2_t v = {lo, hi}; bf16x2_t b = __builtin_convertvector(v, bf16x2_t); return __builtin_bit_cast(unsigned, b); }
DEVI bf16_t f2bf(float f) { return (bf16_t)(pack2(f, 0.f) & 0xffffu); }
DEVI float bf2f(bf16_t h) { return __uint_as_float(((unsigned)h) << 16); }
DEVI float bflo(unsigned u) { return __uint_as_float(u << 16); }
DEVI float bfhi(unsigned u) { return __uint_as_float(u & 0xffff0000u); }
DEVI float sigm(float x) { return 1.f / (1.f + __expf(-x)); }
DEVI float gelu_tanh(float x) {
    float y = 0.7978845608028654f * (x + 0.044715f * x * x * x);
    float e = __expf(2.f * y);
    float t = 1.f - 2.f / (1.f + e);
    return 0.5f * x * (1.f + t);
}
DEVI char* opaque_ptr(char* q) { asm volatile("" : "+s"(q)); return q; }
DEVI f32x4  mfma16(bf16x8 a, bf16x8 b, f32x4 c)  { return __builtin_amdgcn_mfma_f32_16x16x32_bf16(a, b, c, 0, 0, 0); }
DEVI f32x16 mfma32(bf16x8 a, bf16x8 b, f32x16 c) { return __builtin_amdgcn_mfma_f32_32x32x16_bf16(a, b, c, 0, 0, 0); }

template <int KW> DEVI int swz_off(int row, int c) {
    if constexpr (KW == 128) return row * 256 + ((c ^ (row & 15)) << 4);
    else return row * (KW * 2) + ((c ^ ((row >> 1) & 7)) << 4);
}
template <int KW> DEVI int swz_elem(int row, int k) { return swz_off<KW>(row, k >> 3) + ((k & 7) << 1); }

template <int MT, int NT, int KWA, int KWB>
DEVI void mma_nt(f32x4 (&acc)[MT][NT], const char* A, int a_row0, const char* B, int b_row0, int kc0, int nks, int lane) {
    const int r = lane & 15, q = lane >> 4;
#pragma unroll 1
    for (int ks = 0; ks < nks; ++ks) {
        bf16x8 a[MT], b[NT];
#pragma unroll
        for (int i = 0; i < MT; ++i) a[i] = *(const bf16x8*)(A + swz_off<KWA>(a_row0 + 16 * i + r, kc0 + ks * 4 + q));
#pragma unroll
        for (int j = 0; j < NT; ++j) b[j] = *(const bf16x8*)(B + swz_off<KWB>(b_row0 + 16 * j + r, kc0 + ks * 4 + q));
#pragma unroll
        for (int i = 0; i < MT; ++i)
#pragma unroll
            for (int j = 0; j < NT; ++j) acc[i][j] = mfma16(a[i], b[j], acc[i][j]);
    }
}

DEVI void conv_transpose_tile(const float* __restrict__ src, int K, int N, bf16_t* __restrict__ dst, int kt, int nt, char* smem, const float* __restrict__ kgain = nullptr) {
    float* s = (float*)smem;
    const int tid = threadIdx.x;
    for (int e = tid; e < 4096; e += NTHREADS) {
        int kk = e >> 6, nn = e & 63;
        int n = nt * 64 + nn;
        const float gk = kgain ? kgain[kt * 64 + kk] : 1.f;
        s[kk * 65 + nn] = (n < N) ? src[(size_t)(kt * 64 + kk) * N + n] * gk : 0.f;
    }
    __syncthreads();
    for (int e = tid; e < 2048; e += NTHREADS) {
        int nn = e >> 5, kp = e & 31;
        unsigned v = pack2(s[(2 * kp) * 65 + nn], s[(2 * kp + 1) * 65 + nn]);
        *(unsigned*)(dst + (size_t)(nt * 64 + nn) * K + kt * 64 + 2 * kp) = v;
    }
    __syncthreads();
}
DEVI void conv_plain_chunk(const float* __restrict__ src, bf16_t* __restrict__ dst, size_t chunk) {
    const int tid = threadIdx.x;
    size_t base = chunk * 4096 + (size_t)tid * 16;
    const float4* s4 = (const float4*)(src + base);
    float4 a = s4[0], b = s4[1], c = s4[2], d = s4[3];
    uint4 o0, o1;
    o0.x = pack2(a.x, a.y); o0.y = pack2(a.z, a.w); o0.z = pack2(b.x, b.y); o0.w = pack2(b.z, b.w);
    o1.x = pack2(c.x, c.y); o1.y = pack2(c.z, c.w); o1.z = pack2(d.x, d.y); o1.w = pack2(d.z, d.w);
    uint4* d4 = (uint4*)(dst + base);
    d4[0] = o0; d4[1] = o1;
}
DEVI void conv_experts(const float* down, const float* up, const float* __restrict__ dgain, char* ws, int it  ) {
    const int lane = threadIdx.x & 63, wave = threadIdx.x >> 6;
    const bool isup = it >= 4096;
    const int row = (isup ? it - 4096 : it) * 4 + wave;
    const float* src = (isup ? up : down) + (size_t)row * 1024 + 16 * lane;
    float4 a = *(const float4*)src, b = *(const float4*)(src + 4), c = *(const float4*)(src + 8), d = *(const float4*)(src + 12);
    if (!isup) {
        const float4 ga = *(const float4*)(dgain + 16 * lane), gb = *(const float4*)(dgain + 16 * lane + 4), gc = *(const float4*)(dgain + 16 * lane + 8), gd = *(const float4*)(dgain + 16 * lane + 12);
        a.x *= ga.x; a.y *= ga.y; a.z *= ga.z; a.w *= ga.w; b.x *= gb.x; b.y *= gb.y; b.z *= gb.z; b.w *= gb.w;
        c.x *= gc.x; c.y *= gc.y; c.z *= gc.z; c.w *= gc.w; d.x *= gd.x; d.y *= gd.y; d.z *= gd.z; d.w *= gd.w;
    }
    float mx = fmaxf(fmaxf(fmaxf(fabsf(a.x), fabsf(a.y)), fmaxf(fabsf(a.z), fabsf(a.w))), fmaxf(fmaxf(fabsf(b.x), fabsf(b.y)), fmaxf(fabsf(b.z), fabsf(b.w))));
    mx = fmaxf(mx, fmaxf(fmaxf(fmaxf(fabsf(c.x), fabsf(c.y)), fmaxf(fabsf(c.z), fabsf(c.w))), fmaxf(fmaxf(fabsf(d.x), fabsf(d.y)), fmaxf(fabsf(d.z), fabsf(d.w)))));
#pragma unroll
    for (int o = 1; o < 64; o <<= 1) mx = fmaxf(mx, __shfl_xor(mx, o));
    const float sc = (mx > 0.f) ? 416.f / mx : 1.f;
    const float inv = (mx > 0.f) ? mx / 416.f : 1.f;
    int w0 = 0, w1 = 0, w2 = 0, w3 = 0;
    w0 = __builtin_amdgcn_cvt_pk_fp8_f32(a.x * sc, a.y * sc, w0, false); w0 = __builtin_amdgcn_cvt_pk_fp8_f32(a.z * sc, a.w * sc, w0, true);
    w1 = __builtin_amdgcn_cvt_pk_fp8_f32(b.x * sc, b.y * sc, w1, false); w1 = __builtin_amdgcn_cvt_pk_fp8_f32(b.z * sc, b.w * sc, w1, true);
    w2 = __builtin_amdgcn_cvt_pk_fp8_f32(c.x * sc, c.y * sc, w2, false); w2 = __builtin_amdgcn_cvt_pk_fp8_f32(c.z * sc, c.w * sc, w2, true);
    w3 = __builtin_amdgcn_cvt_pk_fp8_f32(d.x * sc, d.y * sc, w3, false); w3 = __builtin_amdgcn_cvt_pk_fp8_f32(d.z * sc, d.w * sc, w3, true);
    *(int4*)(ws + (isup ? OFF_EU : OFF_ED) + ((size_t)(lane >> 3) * 16384 + row) * 128 + 16 * (lane & 7)) = int4{w0, w1, w2, w3};
    if (lane == 0) ((float*)(ws + (isup ? OFF_INVU : OFF_INVD)))[row] = inv;
}

DEVI void phase_convert(const Params& p, char* smem) {
    char* ws = p.ws;
    const int bid = blockIdx.x, nb = gridDim.x;
    for (int t = bid; t < 768; t += nb) conv_transpose_tile(p.l0_w_in,    1024, 3072, (bf16_t*)(ws + OFF_W_IN0T),  t / 48, t % 48, smem, p.l0_norm_mix);
    for (int t = (bid + nb - 256 % nb) % nb; t < 256; t += nb) conv_transpose_tile(p.l0_w_out,   1024, 1024, (bf16_t*)(ws + OFF_W_OUT0T), t / 16, t % 16, smem);
    for (int t = bid; t < 512; t += nb) conv_transpose_tile(p.l0_w_query, 1024, 2048, (bf16_t*)(ws + OFF_W_Q0T),   t / 32, t % 32, smem, p.l0_norm_ffn);
    for (int t = bid; t < 512; t += nb) conv_transpose_tile(p.l1_w_in,    1024, 1984, (bf16_t*)(ws + OFF_W_IN1T),  t / 32, t % 32, smem, p.l1_norm_mix);
    for (int t = bid; t < 48; t += nb)  conv_transpose_tile(p.l1_w_uq,     256,  768, (bf16_t*)(ws + OFF_W_UQT),   t / 12, t % 12, smem, p.l1_cq_norm);
    for (int t = nb - 1 - bid; t < 32; t += nb)  conv_transpose_tile(p.l1_w_ukv,    128, 1024, (bf16_t*)(ws + OFF_W_UKVT),  t / 16, t % 16, smem, p.l1_ckv_norm);
    for (int t = (bid + nb - 256 % nb) % nb; t < 256; t += nb) conv_transpose_tile(p.l1_w_out,   1024, 1024, (bf16_t*)(ws + OFF_W_OUT1T), t / 16, t % 16, smem);
    for (int t = bid; t < 512; t += nb) conv_transpose_tile(p.l1_w_query, 1024, 2048, (bf16_t*)(ws + OFF_W_Q1T),   t / 32, t % 32, smem, p.l1_norm_ffn);
    for (int t = bid - 64; t < 64; t += nb) if (t >= 0) conv_plain_chunk(p.l0_sub_keys, (bf16_t*)(ws + OFF_SK0), t);
    for (int t = bid - 128; t < 64; t += nb) if (t >= 0) conv_plain_chunk(p.l1_sub_keys, (bf16_t*)(ws + OFF_SK1), t);
    for (int chunk = bid - 192; chunk < 16; chunk += nb) if (chunk >= 0) {
        bf16_t* dst = (bf16_t*)(ws + OFF_WS0);
        for (int e = threadIdx.x; e < 4096; e += NTHREADS) {
            int idx = chunk * 4096 + e; int t = (idx >> 7) & 127, sI = idx & 127;
            dst[idx] = f2bf(sI <= t ? p.l0_gmlp_w_s[idx] : 0.f);
        }
    }
    if (bid == nb - 1) {
        float* lb = (float*)(ws + OFF_LB);
        for (int c = threadIdx.x; c < 512; c += NTHREADS) {
            float a0 = p.lb_logits[c], a1 = p.lb_logits[512 + c], a2 = p.lb_logits[1024 + c];
            float m = fmaxf(a0, fmaxf(a1, a2));
            float e0 = __expf(a0 - m), e1 = __expf(a1 - m), e2 = __expf(a2 - m);
            lb[c] = e0 / (e0 + e1 + e2);
        }
    }
    for (int it = bid; it < 8192; it += nb) conv_experts(p.l0_exp_down, p.l0_exp_up, p.l0_norm_ffn, ws, it);
    {
        const int lane = threadIdx.x & 63, wave = threadIdx.x >> 6;
        for (int it = bid; it < 4096; it += nb) {
            const size_t row = (size_t)it * 4 + wave;
            const float* xr = p.x + row * 1024 + 16 * lane;
            const float4 a = *(const float4*)xr, b = *(const float4*)(xr + 4), c = *(const float4*)(xr + 8), d = *(const float4*)(xr + 12);
            float ss = a.x * a.x + a.y * a.y + a.z * a.z + a.w * a.w + b.x * b.x + b.y * b.y + b.z * b.z + b.w * b.w
                     + c.x * c.x + c.y * c.y + c.z * c.z + c.w * c.w + d.x * d.x + d.y * d.y + d.z * d.z + d.w * d.w;
#pragma unroll
            for (int o = 1; o < 64; o <<= 1) ss += __shfl_xor(ss, o);
            uint4 o0, o1;
            o0.x = pack2(a.x, a.y); o0.y = pack2(a.z, a.w); o0.z = pack2(b.x, b.y); o0.w = pack2(b.z, b.w);
            o1.x = pack2(c.x, c.y); o1.y = pack2(c.z, c.w); o1.z = pack2(d.x, d.y); o1.w = pack2(d.z, d.w);
            bf16_t* xb = (bf16_t*)(ws + OFF_XB) + row * 1024 + 16 * lane;
            *(uint4*)xb = o0; *(uint4*)(xb + 8) = o1;
            if (lane == 0) ((float*)(ws + OFF_SSQ1))[row] = ss;
        }
    }
}

template <int AMODE, class Epi>
DEVI void gemm_phase(const void* __restrict__ Aptr, int lda, const float* __restrict__ gain, const bf16_t* __restrict__ Bt,
                           int M, int Npad, int K, Epi epi, char* smem, int blk0, int nblk) {
    const int tid = threadIdx.x, lane = tid & 63, wave = tid >> 6;
    const int wm = wave >> 1, wn = wave & 1;
    const int tn = Npad / 128, tm = M / 128, nkt = K / 64;
    float* sRstd = (float*)(smem + 65536);
    const int crow = tid >> 3, cc = tid & 7;
    for (int tile = blk0; tile < tm * tn; tile += nblk) {
        const int m0 = (tile / tn) * 128, n0 = (tile % tn) * 128;
        f32x4 acc[4][4];
#pragma unroll
        for (int i = 0; i < 4; ++i)
#pragma unroll
            for (int j = 0; j < 4; ++j) acc[i][j] = f32x4{0.f, 0.f, 0.f, 0.f};
        float ss[4] = {0.f, 0.f, 0.f, 0.f};
        f32x4v ra[4][2]; u32x4 rab[4]; u32x4 rb[4]; f32x4v g0, g1;
        auto gload = [&](int kt) {
            const int k0 = kt * 64 + cc * 8;
#pragma unroll
            for (int i = 0; i < 4; ++i) {
                const int row = crow + 32 * i;
                if constexpr (AMODE == 0) {
                    const float* pa = (const float*)Aptr + (size_t)(m0 + row) * lda + k0;
                    ra[i][0] = *(const f32x4v*)pa; ra[i][1] = *(const f32x4v*)(pa + 4);
                } else {
                    const bf16_t* pa = (const bf16_t*)Aptr + (size_t)(m0 + row) * lda + k0;
                    rab[i] = *(const u32x4*)pa;
                }
                rb[i] = *(const u32x4*)(Bt + (size_t)(n0 + row) * K + k0);
            }
            if constexpr (AMODE != 1) { g0 = *(const f32x4v*)(gain + k0); g1 = *(const f32x4v*)(gain + k0 + 4); }
        };
        auto lstore = [&](int buf) {
            char* sA = smem + buf * 32768; char* sB = sA + 16384;
#pragma unroll
            for (int i = 0; i < 4; ++i) {
                const int row = crow + 32 * i;
                u32x4 o;
                if constexpr (AMODE == 0) {
                    f32x4v a = ra[i][0], b = ra[i][1];
                    ss[i] += a.x * a.x + a.y * a.y + a.z * a.z + a.w * a.w + b.x * b.x + b.y * b.y + b.z * b.z + b.w * b.w;
                    o.x = pack2(a.x * g0.x, a.y * g0.y); o.y = pack2(a.z * g0.z, a.w * g0.w);
                    o.z = pack2(b.x * g1.x, b.y * g1.y); o.w = pack2(b.z * g1.z, b.w * g1.w);
                } else if constexpr (AMODE == 2) {
                    u32x4 u = rab[i];
                    float a0 = bflo(u.x), a1 = bfhi(u.x), a2 = bflo(u.y), a3 = bfhi(u.y), a4 = bflo(u.z), a5 = bfhi(u.z), a6 = bflo(u.w), a7 = bfhi(u.w);
                    ss[i] += a0 * a0 + a1 * a1 + a2 * a2 + a3 * a3 + a4 * a4 + a5 * a5 + a6 * a6 + a7 * a7;
                    o.x = pack2(a0 * g0.x, a1 * g0.y); o.y = pack2(a2 * g0.z, a3 * g0.w);
                    o.z = pack2(a4 * g1.x, a5 * g1.y); o.w = pack2(a6 * g1.z, a7 * g1.w);
                } else o = rab[i];
                *(u32x4*)(sA + swz_off<64>(row, cc)) = o;
                *(u32x4*)(sB + swz_off<64>(row, cc)) = rb[i];
            }
        };
        gload(0); lstore(0); __syncthreads();
#pragma unroll 1
        for (int kt = 0; kt < nkt; ++kt) {
            if (kt + 1 < nkt) gload(kt + 1);
            const char* sA = smem + (kt & 1) * 32768; const char* sB = sA + 16384;
            mma_nt<4, 4, 64, 64>(acc, sA, wm * 64, sB, wn * 64, 0, 2, lane);
            if (kt + 1 < nkt) lstore((kt + 1) & 1);
            __syncthreads();
        }
        if constexpr (AMODE != 1) {
#pragma unroll
            for (int i = 0; i < 4; ++i) {
                float s = ss[i];
                s += __shfl_xor(s, 1); s += __shfl_xor(s, 2); s += __shfl_xor(s, 4);
                if (cc == 0) sRstd[crow + 32 * i] = rsqrtf(s / (float)K + 1e-6f);
            }
            __syncthreads();
        }
#pragma unroll
        for (int i = 0; i < 4; ++i)
#pragma unroll
            for (int r = 0; r < 4; ++r) {
                const int rl = wm * 64 + i * 16 + (lane >> 4) * 4 + r;
                const float rs = (AMODE != 1) ? sRstd[rl] : 1.f;
#pragma unroll
                for (int j = 0; j < 4; ++j) epi(m0 + rl, n0 + wn * 64 + j * 16 + (lane & 15), acc[i][j][r] * rs);
                __builtin_amdgcn_sched_barrier(0);
            }
    }
}

struct Placement { int xcc, rank, nloc, nx; };
#define G2_RAW_BARRIER() do { asm volatile("s_waitcnt lgkmcnt(0)" ::: "memory"); __builtin_amdgcn_s_barrier(); } while (0)
template <class Epi>
DEVI void gemm2_phase(const bf16_t* __restrict__ A, int lda, const bf16_t* __restrict__ Bt, int tm, int tn, int K,
                      const float* __restrict__ ssq, int nss, Epi epi, char* smem, Placement pl) {
    const int tid = threadIdx.x, lane = tid & 63;
    const int wave = __builtin_amdgcn_readfirstlane(tid >> 6);
    const int wm = wave >> 1, wn = wave & 1;
    const int nkt = K / 32;
    constexpr int STG = 24576;
    float* sRstd = (float*)(smem + 3 * STG);
    int xcd = blockIdx.x & 7, slot = blockIdx.x >> 3, nslots = gridDim.x >> 3, nxc = 8;
    if (pl.nloc > 0) { xcd = pl.xcc; slot = pl.rank; nslots = pl.nloc; nxc = pl.nx; }
    const int np = (tm + nxc - 1) / nxc;
    const int per_xcd = ((np + 7) >> 3) * tn * 8;
    const int Rl = (lane >> 4) & 3, gl = (((Rl ^ (Rl >> 1)) & 1) << 1) | (Rl >> 1);
    const int Rr = (lane >> 2) & 3, gr = (((Rr ^ (Rr >> 1)) & 1) << 1) | (Rr >> 1);
    const int ld_row = lane >> 2, ld_c = (lane & 3) ^ gl;
    const int rd_off = (lane & 15) * 64 + (((lane >> 4) ^ gr) << 4);
    for (int t = slot; t < per_xcd; t += nslots) {
        const int mi = t & 7, rest = t >> 3, nt_ = rest % tn, mg = rest / tn;
        const int pidx = mg * 8 + mi, panel = xcd + nxc * pidx;
        if (pidx >= np || panel >= tm) continue;
        const int m0 = panel * 128, n0 = nt_ * 256;
        if (ssq) { if (tid < 128) { float sacc = 0.f; for (int i = 0; i < nss; ++i) sacc += ssq[(size_t)(m0 + tid) * nss + i]; sRstd[tid] = rsqrtf(sacc / (float)K + 1e-6f); } }
        else if (tid < 128) sRstd[tid] = 1.f;
        const bf16_t* ga = A  + (size_t)(m0 + 32 * wave + ld_row) * lda + ld_c * 8;
        const bf16_t* gb = Bt + (size_t)(n0 + 64 * wave + ld_row) * K   + ld_c * 8;
        f32x4 acc[4][8];
#pragma unroll
        for (int i = 0; i < 4; ++i)
#pragma unroll
            for (int j = 0; j < 8; ++j) acc[i][j] = f32x4{0.f, 0.f, 0.f, 0.f};
#define G2_ISSUE(KT) { char* st_ = smem + ((KT) % 3) * STG; const int ko_ = (KT) * 32; \
            __builtin_amdgcn_global_load_lds((const unsigned*)(ga + ko_),                    (unsigned*)(st_ + wave * 2048),               16, 0, 0); \
            __builtin_amdgcn_global_load_lds((const unsigned*)(ga + (size_t)16 * lda + ko_), (unsigned*)(st_ + wave * 2048 + 1024),        16, 0, 0); \
            __builtin_amdgcn_global_load_lds((const unsigned*)(gb + ko_),                    (unsigned*)(st_ + 8192 + wave * 4096),        16, 0, 0); \
            __builtin_amdgcn_global_load_lds((const unsigned*)(gb + (size_t)16 * K + ko_),   (unsigned*)(st_ + 8192 + wave * 4096 + 1024), 16, 0, 0); \
            __builtin_amdgcn_global_load_lds((const unsigned*)(gb + (size_t)32 * K + ko_),   (unsigned*)(st_ + 8192 + wave * 4096 + 2048), 16, 0, 0); \
            __builtin_amdgcn_global_load_lds((const unsigned*)(gb + (size_t)48 * K + ko_),   (unsigned*)(st_ + 8192 + wave * 4096 + 3072), 16, 0, 0); }
        G2_ISSUE(0) G2_ISSUE(1)
#pragma unroll 1
        for (int kt = 0; kt < nkt; ++kt) {
            if (kt + 1 < nkt) asm volatile("s_waitcnt vmcnt(6)" ::: "memory");
            else asm volatile("s_waitcnt vmcnt(0)" ::: "memory");
            G2_RAW_BARRIER();
            if (kt + 2 < nkt) G2_ISSUE(kt + 2)
            const char* sA = smem + (kt % 3) * STG + rd_off; const char* sB = sA + 8192;
            bf16x8 a[4], b[8];
#pragma unroll
            for (int i = 0; i < 4; ++i) a[i] = *(const bf16x8*)(sA + (wm * 64 + 16 * i) * 64);
#pragma unroll
            for (int j = 0; j < 8; ++j) b[j] = *(const bf16x8*)(sB + (wn * 128 + 16 * j) * 64);
#pragma unroll
            for (int i = 0; i < 4; ++i)
#pragma unroll
                for (int j = 0; j < 8; ++j) acc[i][j] = mfma16(b[j], a[i], acc[i][j]);
        }
#undef G2_ISSUE
        if (epi.staged(n0)) {
            G2_RAW_BARRIER();
#pragma unroll
            for (int i = 0; i < 4; ++i) {
                const int rl = wm * 64 + i * 16 + (lane & 15);
                const float rs = sRstd[rl];
                char* trow = smem + rl * 528 + (wn * 128 + 4 * (lane >> 4)) * 2;
#pragma unroll
                for (int j = 0; j < 8; ++j) {
                    const int nc = n0 + wn * 128 + 16 * j + 4 * (lane >> 4);
                    *(uint2*)(trow + 32 * j) = uint2{pack2(epi.map(nc, acc[i][j][0] * rs), epi.map(nc + 1, acc[i][j][1] * rs)), pack2(epi.map(nc + 2, acc[i][j][2] * rs), epi.map(nc + 3, acc[i][j][3] * rs))};
                }
            }
            __syncthreads();
            float* const sqp = (n0 == 0) ? epi.SQ0 : ((n0 == 256) ? epi.SQ1 : nullptr);
#pragma unroll 4
            for (int i = 0; i < 16; ++i) {
                const int e = tid + 256 * i, row = e >> 5, cc = e & 31;
                const uint4 v = *(const uint4*)(smem + row * 528 + cc * 16);
                if (n0 + cc * 8 < epi.N) *(uint4*)(epi.D + (size_t)(m0 + row) * epi.ldd + n0 + cc * 8) = v;
                if (sqp) {
                    float q = bflo(v.x) * bflo(v.x) + bfhi(v.x) * bfhi(v.x) + bflo(v.y) * bflo(v.y) + bfhi(v.y) * bfhi(v.y)
                            + bflo(v.z) * bflo(v.z) + bfhi(v.z) * bfhi(v.z) + bflo(v.w) * bflo(v.w) + bfhi(v.w) * bfhi(v.w);
                    if (n0 == 256 && cc >= 16) q = 0.f;
                    q += __shfl_xor(q, 1); q += __shfl_xor(q, 2); q += __shfl_xor(q, 4); q += __shfl_xor(q, 8); q += __shfl_xor(q, 16);
                    if (cc == 0) sqp[m0 + row] = q;
                }
            }
        } else {
#pragma unroll
            for (int i = 0; i < 4; ++i) {
                const int rl = wm * 64 + i * 16 + (lane & 15);
                const float rs = sRstd[rl];
                epi.row(m0 + rl, n0 + wn * 128 + 4 * (lane >> 4), acc[i], rs, lane);
                __builtin_amdgcn_sched_barrier(0);
            }
        }
        __syncthreads();
    }
}

struct Epi2In0 {
    bf16_t* Z0; float* G; const float* lb; bf16_t* D; int ldd; int N; float* SQ0; float* SQ1;
    DEVI bool staged(int n0) const { return (n0 >> 9) != 1; }
    DEVI float map(int n, float v) const { const int blk = n >> 9; return (blk == 0) ? v : ((blk <= 3) ? v * sigm(v) : gelu_tanh(v)); }
    DEVI void row(int m, int n, const f32x4 (&a)[8], float rs, int) const {
#pragma unroll
        for (int j = 0; j < 8; ++j) {
            const int c = n + 16 * j - 512;
            const float4 l4 = *(const float4*)(lb + c);
            float4 o;
            o.x = logf(l4.x + (1.f - l4.x) * sigm(a[j][0] * rs)); o.y = logf(l4.y + (1.f - l4.y) * sigm(a[j][1] * rs));
            o.z = logf(l4.z + (1.f - l4.z) * sigm(a[j][2] * rs)); o.w = logf(l4.w + (1.f - l4.w) * sigm(a[j][3] * rs));
            *(float4*)(G + (size_t)m * 512 + c) = o;
        }
    }
};
struct Epi2Bf16 {
    bf16_t* D; int ldd; int N; float* SQ0; float* SQ1;
    DEVI bool staged(int) const { return true; }
    DEVI float map(int, float v) const { return v; }
    DEVI void row(int, int, const f32x4 (&)[8], float, int) const {}
};
struct Epi2Resid {
    bf16_t* XB; float* SSQ16; float alpha; bf16_t* D; int ldd; int N; float* SQ0; float* SQ1;
    DEVI bool staged(int) const { return false; }
    DEVI float map(int, float v) const { return v; }
    DEVI void row(int m, int n, const f32x4 (&a)[8], float, int lane) const {
        float sq[2] = {0.f, 0.f};
#pragma unroll
        for (int j = 0; j < 8; ++j) {
            bf16_t* px = XB + (size_t)m * 1024 + n + 16 * j;
            const uint2 r = *(const uint2*)px;
            const unsigned w0 = pack2(bflo(r.x) + alpha * a[j][0], bfhi(r.x) + alpha * a[j][1]), w1 = pack2(bflo(r.y) + alpha * a[j][2], bfhi(r.y) + alpha * a[j][3]);
            *(uint2*)px = uint2{w0, w1};
            sq[j >> 2] += bflo(w0) * bflo(w0) + bfhi(w0) * bfhi(w0) + bflo(w1) * bflo(w1) + bfhi(w1) * bfhi(w1);
        }
#pragma unroll
        for (int g = 0; g < 2; ++g) {
            float v = sq[g];
            v += __shfl_xor(v, 16); v += __shfl_xor(v, 32);
            if ((lane >> 4) == 0) SSQ16[(size_t)m * 16 + ((n + 64 * g) >> 6)] = v;
        }
    }
};

struct EpiBf16 { bf16_t* D; int ldd; int N; DEVI void operator()(int m, int n, float v) const { if (n < N) D[(size_t)m * ldd + n] = f2bf(v); } };

DEVI void hgrn_local_item(const Params& p, int item, char* smem) {
    const int tid = threadIdx.x, lane = tid & 63, wave = tid >> 6;
    const int bh = item >> 7, c = item & 127, b = bh >> 2, h = bh & 3;
    const size_t m0 = (size_t)b * 8192 + c * 64;
    const float* G = (const float*)(p.ws + OFF_G) + m0 * 512 + h * 128;
    const bf16_t* Zv = (const bf16_t*)(p.ws + OFF_Z0) + m0 * 3072 + 1024 + h * 128;
    char* sVT = smem; char* sKd = smem + 16384;
    const int k = tid & 127, hf = tid >> 7;
    float bl = 0.f, bmid = 0.f;
#pragma unroll 8
    for (int t = 0; t < 64; ++t) { bl += G[t * 512 + k]; if (t == 31) bmid = bl; }
    float bcur = hf ? bmid : 0.f;
#pragma unroll 1
    for (int ch = 0; ch < 4; ++ch) {
        float kd[8], vv[8];
#pragma unroll
        for (int j = 0; j < 8; ++j) {
            const int t = 32 * hf + 8 * ch + j;
            const float g = G[t * 512 + k];
            bcur += g;
            kd[j] = (1.f - __expf(g)) * __expf(bl - bcur);
            vv[j] = bf2f(Zv[(size_t)t * 3072 + k]);
        }
        uint4 o; o.x = pack2(kd[0], kd[1]); o.y = pack2(kd[2], kd[3]); o.z = pack2(kd[4], kd[5]); o.w = pack2(kd[6], kd[7]);
        *(uint4*)(sKd + swz_off<64>(k, 4 * hf + ch)) = o;
        uint4 w; w.x = pack2(vv[0], vv[1]); w.y = pack2(vv[2], vv[3]); w.z = pack2(vv[4], vv[5]); w.w = pack2(vv[6], vv[7]);
        *(uint4*)(sVT + swz_off<64>(k, 4 * hf + ch)) = w;
    }
    if (hf == 0) ((float*)(p.ws + OFF_DEC))[item * 128 + k] = __expf(bl);
    __syncthreads();
    f32x4 acc[2][8];
#pragma unroll
    for (int i = 0; i < 2; ++i)
#pragma unroll
        for (int j = 0; j < 8; ++j) acc[i][j] = f32x4{0.f, 0.f, 0.f, 0.f};
    mma_nt<2, 8, 64, 64>(acc, sVT, 32 * wave, sKd, 0, 0, 2, lane);
    float* H = (float*)(p.ws + OFF_HST) + (size_t)item * 16384;
#pragma unroll
    for (int i = 0; i < 2; ++i)
#pragma unroll
        for (int j = 0; j < 8; ++j)
#pragma unroll
            for (int r = 0; r < 4; ++r) {
                const int v = 32 * wave + 16 * i + (lane >> 4) * 4 + r, kk = 16 * j + (lane & 15);
                H[v * 128 + kk] = acc[i][j][r];
                if (r == 3) __builtin_amdgcn_sched_barrier(0);
            }
    __syncthreads();
}

DEVI void gmlp_item(const Params& p, int item, char* smem) {
    const int tid = threadIdx.x, lane = tid & 63, wave = tid >> 6;
    const int g = item & 3, chunk = item >> 2;
    const size_t m0 = (size_t)chunk * 128;
    const bf16_t* Z0 = (const bf16_t*)(p.ws + OFF_Z0);
    const bf16_t* Wc = (const bf16_t*)(p.ws + OFF_WS0) + g * 16384;
    char* sW = smem; char* sV = smem + 32768;
#pragma unroll
    for (int i = 0; i < 8; ++i) {
        const int e = tid + 256 * i, row = e >> 4, cc = e & 15;
        *(uint4*)(sW + swz_off<128>(row, cc)) = *(const uint4*)(Wc + row * 128 + cc * 8);
    }
    {
        const int t = tid >> 1, hf = tid & 1;
        const bf16_t* src = Z0 + (m0 + t) * 3072 + 2560 + g * 128 + 64 * hf;
        float vals[64]; float ss = 0.f;
#pragma unroll
        for (int i = 0; i < 8; ++i) {
            uint4 u = *(const uint4*)(src + 8 * i);
            vals[8 * i + 0] = bflo(u.x); vals[8 * i + 1] = bfhi(u.x); vals[8 * i + 2] = bflo(u.y); vals[8 * i + 3] = bfhi(u.y);
            vals[8 * i + 4] = bflo(u.z); vals[8 * i + 5] = bfhi(u.z); vals[8 * i + 6] = bflo(u.w); vals[8 * i + 7] = bfhi(u.w);
        }
#pragma unroll
        for (int i = 0; i < 64; ++i) ss += vals[i] * vals[i];
        ss += __shfl_xor(ss, 1);
        const float rstd = rsqrtf(ss * (1.f / 128.f) + 1e-6f);
        const float* gn = p.l0_gmlp_v_norm + g * 128 + 64 * hf;
#pragma unroll
        for (int i = 0; i < 64; ++i) {
            const int d = 64 * hf + i;
            *(bf16_t*)(sV + swz_elem<128>(d, t)) = f2bf(vals[i] * rstd * gn[i]);
        }
    }
    __syncthreads();
    const int wm = wave >> 1, wn = wave & 1;
    f32x4 acc[4][4];
#pragma unroll
    for (int i = 0; i < 4; ++i)
#pragma unroll
        for (int j = 0; j < 4; ++j) acc[i][j] = f32x4{0.f, 0.f, 0.f, 0.f};
    mma_nt<4, 4, 128, 128>(acc, sW, wm * 64, sV, wn * 64, 0, 4, lane);
    bf16_t* MIX = (bf16_t*)(p.ws + OFF_MIX0);
#pragma unroll
    for (int i = 0; i < 4; ++i)
#pragma unroll
        for (int r = 0; r < 4; ++r) {
            const int t = wm * 64 + i * 16 + (lane >> 4) * 4 + r;
            const float bias = p.l0_gmlp_b_s[g * 128 + t];
#pragma unroll
            for (int j = 0; j < 4; ++j) {
                const int d = wn * 64 + j * 16 + (lane & 15);
                const float u = bf2f(Z0[(m0 + t) * 3072 + 2048 + g * 128 + d]);
                MIX[(m0 + t) * 1024 + 512 + g * 128 + d] = f2bf(u * (acc[i][j][r] + bias));
            }
        }
    __syncthreads();
}

DEVI void hgrn_scan_phase(const Params& p) {
    float* H = (float*)(p.ws + OFF_HST);
    const float* D = (const float*)(p.ws + OFF_DEC);
    for (int e = blockIdx.x * NTHREADS + threadIdx.x; e < 8 * 16384; e += gridDim.x * NTHREADS) {
        const int bh = e >> 14, idx = e & 16383, k = idx & 127;
        float run = 0.f;
        for (int c0 = 0; c0 < 128; c0 += 8) {
            float L[8], d[8];
#pragma unroll
            for (int u = 0; u < 8; ++u) { L[u] = H[((size_t)(bh * 128 + c0 + u)) * 16384 + idx]; d[u] = D[(bh * 128 + c0 + u) * 128 + k]; }
#pragma unroll
            for (int u = 0; u < 8; ++u) { H[((size_t)(bh * 128 + c0 + u)) * 16384 + idx] = run; run = d[u] * run + L[u]; }
        }
    }
}

DEVI void hgrn_out_item(const Params& p, int item, char* smem) {
    const int tid = threadIdx.x, lane = tid & 63, wave = tid >> 6;
    const int bh = item >> 7, c = item & 127, b = bh >> 2, h = bh & 3;
    const size_t m0 = (size_t)b * 8192 + c * 64;
    const float* G = (const float*)(p.ws + OFF_G) + m0 * 512 + h * 128;
    const bf16_t* Z0 = (const bf16_t*)(p.ws + OFF_Z0) + m0 * 3072;
    float* sB  = (float*)smem;
    char*  sHT = smem;
    char*  sQe = smem + 32768;
    char*  sP  = smem + 49152;
    char*  sU  = smem + 57344;
    char*  sQs = sU; char* sKh = sU + 4096; char* sVT = sU;
    float* sRed = (float*)(smem + 77824);
    const int k = tid & 127, hf = tid >> 7;
    if (hf == 0) { float bc = 0.f;
#pragma unroll 8
        for (int t = 0; t < 64; ++t) { bc += G[t * 512 + k]; sB[t * 128 + k] = bc; } }
    __syncthreads();
#pragma unroll 4
    for (int t = 32 * hf; t < 32 * hf + 32; ++t) {
        const float q = bf2f(Z0[(size_t)t * 3072 + h * 128 + k]);
        *(bf16_t*)(sQe + swz_elem<128>(t, k)) = f2bf(q * __expf(sB[t * 128 + k]));
    }
#pragma unroll 1
    for (int i = 0; i < 4; ++i) {
        const float ri = (i == 0) ? 0.f : sB[(16 * i - 1) * 128 + k];
#pragma unroll 4
        for (int tt = 8 * hf; tt < 8 * hf + 8; ++tt) {
            const int t = 16 * i + tt;
            const float q = bf2f(Z0[(size_t)t * 3072 + h * 128 + k]);
            *(bf16_t*)(sQs + swz_elem<128>(tt, k)) = f2bf(q * __expf(sB[t * 128 + k] - ri));
        }
        const int ns = 16 * (i + 1), half = ns >> 1;
#pragma unroll 4
        for (int s = hf * half; s < hf * half + half; ++s) {
            const float bs = sB[s * 128 + k];
            const float gs = bs - (s ? sB[(s - 1) * 128 + k] : 0.f);
            const float kk = 1.f - __expf(gs);
            *(bf16_t*)(sKh + swz_elem<128>(s, k)) = f2bf(kk * __expf(fminf(ri - bs, 80.f)));
        }
        __syncthreads();
        {
            f32x4 acc[1][1]; acc[0][0] = f32x4{0.f, 0.f, 0.f, 0.f};
            if (wave <= i) mma_nt<1, 1, 128, 128>(acc, sQs, 0, sKh, 16 * wave, 0, 4, lane);
#pragma unroll
            for (int r = 0; r < 4; ++r) {
                const int row = (lane >> 4) * 4 + r, col = lane & 15;
                float v = acc[0][0][r];
                if (wave > i || (wave == i && col > row)) v = 0.f;
                *(bf16_t*)(sP + swz_elem<64>(16 * i + row, 16 * wave + col)) = f2bf(v);
            }
        }
        __syncthreads();
    }
    {
        const bf16_t* Zv = Z0 + 1024 + h * 128;
#pragma unroll 1
        for (int ch = 0; ch < 4; ++ch) {
            float vv[8];
#pragma unroll
            for (int j = 0; j < 8; ++j) vv[j] = bf2f(Zv[(size_t)(32 * hf + 8 * ch + j) * 3072 + k]);
            uint4 w; w.x = pack2(vv[0], vv[1]); w.y = pack2(vv[2], vv[3]); w.z = pack2(vv[4], vv[5]); w.w = pack2(vv[6], vv[7]);
            *(uint4*)(sVT + swz_off<64>(k, 4 * hf + ch)) = w;
        }
        const float* H = (const float*)(p.ws + OFF_HST) + (size_t)item * 16384;
#pragma unroll 2
        for (int i = 0; i < 8; ++i) {
            const int e = tid + 256 * i, row = e >> 4, cc = e & 15;
            const float4 a = *(const float4*)(H + row * 128 + cc * 8), bq = *(const float4*)(H + row * 128 + cc * 8 + 4);
            uint4 o; o.x = pack2(a.x, a.y); o.y = pack2(a.z, a.w); o.z = pack2(bq.x, bq.y); o.w = pack2(bq.z, bq.w);
            *(uint4*)(sHT + swz_off<128>(row, cc)) = o;
        }
    }
    __syncthreads();
    f32x4 acc[4][2];
#pragma unroll
    for (int i = 0; i < 4; ++i)
#pragma unroll
        for (int j = 0; j < 2; ++j) acc[i][j] = f32x4{0.f, 0.f, 0.f, 0.f};
    mma_nt<4, 2, 128, 128>(acc, sQe, 0, sHT, 32 * wave, 0, 4, lane);
    mma_nt<4, 2, 64, 64>(acc, sP, 0, sVT, 32 * wave, 0, 2, lane);
#pragma unroll
    for (int i = 0; i < 4; ++i)
#pragma unroll
        for (int r = 0; r < 4; ++r) {
            float s = acc[i][0][r] * acc[i][0][r] + acc[i][1][r] * acc[i][1][r];
            s += __shfl_xor(s, 1); s += __shfl_xor(s, 2); s += __shfl_xor(s, 4); s += __shfl_xor(s, 8);
            if ((lane & 15) == 0) sRed[wave * 64 + i * 16 + (lane >> 4) * 4 + r] = s;
        }
    __syncthreads();
    bf16_t* MIX = (bf16_t*)(p.ws + OFF_MIX0);
#pragma unroll
    for (int i = 0; i < 4; ++i)
#pragma unroll
        for (int r = 0; r < 4; ++r) {
            const int t = i * 16 + (lane >> 4) * 4 + r;
            const float tot = sRed[t] + sRed[64 + t] + sRed[128 + t] + sRed[192 + t];
            const float rstd = rsqrtf(tot * (1.f / 128.f) + 1e-6f);
#pragma unroll
            for (int j = 0; j < 2; ++j) {
                const int v = 32 * wave + 16 * j + (lane & 15);
                const float og = bf2f(Z0[(size_t)t * 3072 + 1536 + h * 128 + v]);
                MIX[(m0 + t) * 1024 + h * 128 + v] = f2bf(acc[i][j][r] * rstd * p.l0_hgrn_out_norm[h * 128 + v] * og);
            }
        }
    __syncthreads();
}

DEVI unsigned f2key(float f) { unsigned u = __float_as_uint(f); return (u & 0x80000000u) ? ~u : (u | 0x80000000u); }
DEVI float key2f(unsigned k) { unsigned u = (k & 0x80000000u) ? (k ^ 0x80000000u) : ~k; return __uint_as_float(u); }
#define CE_DESC(a, b) { unsigned _x = max(a, b), _y = min(a, b); a = _x; b = _y; }
DEVI void sort16_desc(unsigned (&a)[16]) {
#pragma unroll
    for (int k = 2; k <= 16; k <<= 1)
#pragma unroll
        for (int j = k >> 1; j > 0; j >>= 1)
#pragma unroll
            for (int i = 0; i < 16; ++i) {
                const int l = i ^ j;
                if (l > i) {
                    if ((i & k) == 0) { CE_DESC(a[i], a[l]); } else { CE_DESC(a[l], a[i]); }
                }
            }
}
DEVI void merge16_desc(unsigned (&a)[16], const unsigned (&b)[16]) {
#pragma unroll
    for (int i = 0; i < 16; ++i) a[i] = max(a[i], b[15 - i]);
#pragma unroll
    for (int j = 8; j > 0; j >>= 1)
#pragma unroll
        for (int i = 0; i < 16; ++i) { const int l = i ^ j; if (l > i) { CE_DESC(a[i], a[l]); } }
}

DEVI void peer_topk_phase(const Params& p, const bf16_t* __restrict__ SK, int blk0, int nblk, char* smem) {
    const int tid = threadIdx.x, lane = tid & 63, wave = tid >> 6;
    const int r = lane & 31, hh = lane >> 5;
    const bf16_t* QP = (const bf16_t*)(p.ws + OFF_QP);
    int* IDX = (int*)(p.ws + OFF_IDX); float* GATE = (float*)(p.ws + OFF_GATE);
    char* sKey = smem;
    char* sQ = smem + 32768 + wave * 8192;
    for (int item = blk0; item < 1024; item += nblk) {
        const int h = item & 7, tile = (item >> 3) * 4 + wave;
        const size_t tok = (size_t)tile * 32 + r;
        unsigned top[2][16];
#pragma unroll
        for (int ph = 0; ph < 2; ++ph) {
            __syncthreads();
            {
                const bf16_t* ksrc = SK + (size_t)(h * 2 + ph) * 128 * 128;
#pragma unroll
                for (int i = 0; i < 8; ++i) { const int e = tid + 256 * i, row = e >> 4, cc = e & 15; *(uint4*)(sKey + swz_off<128>(row, cc)) = *(const uint4*)(ksrc + row * 128 + cc * 8); }
                const bf16_t* qsrc = QP + (size_t)tile * 32 * 2048 + h * 256 + ph * 128;
#pragma unroll
                for (int i = 0; i < 8; ++i) { const int e = lane + 64 * i, row = e >> 4, cc = e & 15; *(uint4*)(sQ + swz_off<128>(row, cc)) = *(const uint4*)(qsrc + (size_t)row * 2048 + cc * 8); }
            }
            __syncthreads();
            bf16x8 qf[8];
#pragma unroll
            for (int ks = 0; ks < 8; ++ks) qf[ks] = *(const bf16x8*)(sQ + swz_off<128>(r, 2 * ks + hh));
#pragma unroll 1
            for (int rt = 0; rt < 4; ++rt) {
                f32x16 acc;
#pragma unroll
                for (int e = 0; e < 16; ++e) acc[e] = 0.f;
#pragma unroll
                for (int ks = 0; ks < 8; ++ks) {
                    const bf16x8 kf = *(const bf16x8*)(sKey + swz_off<128>(32 * rt + r, 2 * ks + hh));
                    acc = mfma32(kf, qf[ks], acc);
                }
                unsigned kk[16];
#pragma unroll
                for (int e = 0; e < 16; ++e) {
                    const unsigned n = 32 * rt + (e & 3) + 8 * (e >> 2) + 4 * hh;
                    kk[e] = (f2key(acc[e]) & ~127u) | n;
                }
                sort16_desc(kk);
                if (rt == 0) {
#pragma unroll
                    for (int e = 0; e < 16; ++e) top[ph][e] = kk[e];
                } else merge16_desc(top[ph], kk);
            }
            unsigned other[16];
#pragma unroll
            for (int e = 0; e < 16; ++e) other[e] = (unsigned)__shfl_xor((int)top[ph][e], 32);
            merge16_desc(top[ph], other);
        }
        unsigned best[16];
        {
            float s1[16], s2[16];
#pragma unroll
            for (int e = 0; e < 16; ++e) { s1[e] = key2f(top[0][e] & ~127u); s2[e] = key2f(top[1][e] & ~127u); }
            unsigned cand[64];
            unsigned ia[16], ib[16];
#pragma unroll
            for (int e = 0; e < 16; ++e) { ia[e] = (top[0][e] & 127u) << 7; ib[e] = top[1][e] & 127u; }
            int n = 0;
#pragma unroll
            for (int i = 0; i < 16; ++i)
#pragma unroll
                for (int j = 0; j < 16; ++j)
                    if ((i + 1) * (j + 1) <= 16) { cand[n] = (f2key(s1[i] + s2[j]) & ~0x3fffu) | ia[i] | ib[j]; ++n; }
#pragma unroll
            for (int e = 50; e < 64; ++e) cand[e] = 0u;
#pragma unroll
            for (int g = 0; g < 4; ++g) {
                unsigned kk[16];
#pragma unroll
                for (int e = 0; e < 16; ++e) kk[e] = cand[16 * g + e];
                sort16_desc(kk);
                if (g == 0) {
#pragma unroll
                    for (int e = 0; e < 16; ++e) best[e] = kk[e];
                } else merge16_desc(best, kk);
            }
        }
        float sv[16]; int id[16];
#pragma unroll
        for (int e = 0; e < 16; ++e) {
            sv[e] = key2f(best[e] & ~0x3fffu);
            id[e] = (int)(best[e] & 0x3fffu);
        }
        float den = 0.f; const float smax = sv[0];
#pragma unroll
        for (int e = 0; e < 16; ++e) { sv[e] = __expf(sv[e] - smax); den += sv[e]; }
        const float inv = 1.f / den;
        {
            const float* INVT = (const float*)(p.ws + (hh ? OFF_INVU : OFF_INVD));
            float sc[16];
#pragma unroll
            for (int e = 0; e < 16; ++e) sc[e] = INVT[id[e]];
            if (hh == 0) {
                int4* dst = (int4*)(IDX + tok * 128 + h * 16);
                float4* dst2 = (float4*)((float*)(p.ws + OFF_SDN) + tok * 128 + h * 16);
#pragma unroll
                for (int e = 0; e < 4; ++e) { dst[e] = int4{id[4 * e], id[4 * e + 1], id[4 * e + 2], id[4 * e + 3]}; dst2[e] = float4{sc[4 * e], sc[4 * e + 1], sc[4 * e + 2], sc[4 * e + 3]}; }
            } else {
                float4* dst = (float4*)(GATE + tok * 128 + h * 16);
#pragma unroll
                for (int e = 0; e < 4; ++e) dst[e] = float4{sv[4 * e] * inv * sc[4 * e], sv[4 * e + 1] * inv * sc[4 * e + 1], sv[4 * e + 2] * inv * sc[4 * e + 2], sv[4 * e + 3] * inv * sc[4 * e + 3]};
            }
        }
    }
    for (int it = blk0; it < 4096; it += nblk) {
        const size_t row = (size_t)it * 4 + wave;
        const bf16_t* xb = (const bf16_t*)(p.ws + OFF_XB) + row * 1024 + 16 * lane;
        const uint4 a = *(const uint4*)xb, b = *(const uint4*)(xb + 8);
        float v[16] = {bflo(a.x), bfhi(a.x), bflo(a.y), bfhi(a.y), bflo(a.z), bfhi(a.z), bflo(a.w), bfhi(a.w),
                       bflo(b.x), bfhi(b.x), bflo(b.y), bfhi(b.y), bflo(b.z), bfhi(b.z), bflo(b.w), bfhi(b.w)};
#pragma unroll
        for (int i = 0; i < 16; ++i) v[i] = fminf(fmaxf(v[i] * 32.f, -400.f), 400.f);
        int w0 = 0, w1 = 0, w2 = 0, w3 = 0;
        w0 = __builtin_amdgcn_cvt_pk_fp8_f32(v[0], v[1], w0, false);   w0 = __builtin_amdgcn_cvt_pk_fp8_f32(v[2], v[3], w0, true);
        w1 = __builtin_amdgcn_cvt_pk_fp8_f32(v[4], v[5], w1, false);   w1 = __builtin_amdgcn_cvt_pk_fp8_f32(v[6], v[7], w1, true);
        w2 = __builtin_amdgcn_cvt_pk_fp8_f32(v[8], v[9], w2, false);   w2 = __builtin_amdgcn_cvt_pk_fp8_f32(v[10], v[11], w2, true);
        w3 = __builtin_amdgcn_cvt_pk_fp8_f32(v[12], v[13], w3, false); w3 = __builtin_amdgcn_cvt_pk_fp8_f32(v[14], v[15], w3, true);
        *(int4*)(p.ws + OFF_XB8 + row * 1024 + 16 * lane) = int4{w0, w1, w2, w3};
    }
}

typedef float f32x2v __attribute__((ext_vector_type(2)));
#define PEER_QWORD 80000
#define PEER_TPW 8
#define PEER_ITEMS (16384 / (4 * PEER_TPW))
DEVI int queue_pop(const Params& p, int q, char* smem) {
    int* sw = (int*)(smem + PEER_QWORD);
    __syncthreads();
    if (threadIdx.x == 0) *sw = (int)__hip_atomic_fetch_add((unsigned*)(p.ws + OFF_QCNT) + q * 16, 1u, __ATOMIC_RELAXED, __HIP_MEMORY_SCOPE_AGENT);
    __syncthreads();
    return *sw;
}
#define UFMA(ACC, W, X) asm volatile("v_fmac_f32 %0, %1, %2" : "+v"(ACC) : "v"(W), "v"(X))
DEVI void d_stream(size_t tok, int s, int lane, char* slot, const int* IDX, const char* XB8) {
    const unsigned o1 = (unsigned)tok * 512u + 4u * (unsigned)lane;
    __builtin_amdgcn_global_load_lds((const unsigned*)((const char*)IDX + o1),        (unsigned*)(slot),       4, 0, 0);
    __builtin_amdgcn_global_load_lds((const unsigned*)((const char*)IDX + o1 + 256u), (unsigned*)(slot + 256), 4, 0, 0);
    __builtin_amdgcn_global_load_lds((const unsigned*)(XB8 + (unsigned)tok * 1024u + (unsigned)(128 * s + 4 * (lane & 31))), (unsigned*)(slot + 512), 4, 0, 0);
}
template <int HLF>
DEVI void d_dma(const char* slot, char* buf, int s, int lane, const char* ED) {
    const int grp = lane >> 3, sub = lane & 7;
    unsigned e[8];
#pragma unroll
    for (int i = 0; i < 8; ++i) e[i] = *(const unsigned*)(slot + 256 * HLF + 4 * (8 * i + grp));
#pragma unroll
    for (int i = 0; i < 8; ++i) {
        const int pl_ = 8 * i + grp;
        const unsigned src = ((unsigned)s * 16384u + e[i]) * 128u + (unsigned)(16 * (sub ^ ((pl_ >> 1) & 7)));
        __builtin_amdgcn_global_load_lds((const unsigned*)(ED + src), (unsigned*)(buf + i * 1024), 16, 0, 0);
    }
}
template <int HLF>
DEVI void d_mma(const char* buf, const char* slot, size_t tok, int s, int lane, float* PART) {
    const int r = lane & 15, q = lane >> 4;
    const long b0 = *(const long*)(slot + 512 + 32 * q), b1 = *(const long*)(slot + 512 + 32 * q + 8), b2 = *(const long*)(slot + 512 + 32 * q + 16), b3 = *(const long*)(slot + 512 + 32 * q + 24);
    float* dst = PART + ((size_t)s * 16384 + tok) * 128 + 64 * HLF;
    long a[4][4];
#pragma unroll
    for (int t = 0; t < 4; ++t) {
        const int row = 16 * t + r, key = (row >> 1) & 7;
        const char* rp = buf + row * 128;
#pragma unroll
        for (int kk = 0; kk < 4; ++kk) a[t][kk] = *(const long*)(rp + ((((4 * q + kk) >> 1) ^ key) << 4) + 8 * ((4 * q + kk) & 1));
    }
    f32x4 acc[4];
#pragma unroll
    for (int t = 0; t < 4; ++t) { acc[t] = f32x4{0.f, 0.f, 0.f, 0.f}; acc[t] = __builtin_amdgcn_mfma_f32_16x16x32_fp8_fp8(a[t][0], b0, acc[t], 0, 0, 0); }
#pragma unroll
    for (int t = 0; t < 4; ++t) acc[t] = __builtin_amdgcn_mfma_f32_16x16x32_fp8_fp8(a[t][1], b1, acc[t], 0, 0, 0);
#pragma unroll
    for (int t = 0; t < 4; ++t) acc[t] = __builtin_amdgcn_mfma_f32_16x16x32_fp8_fp8(a[t][2], b2, acc[t], 0, 0, 0);
#pragma unroll
    for (int t = 0; t < 4; ++t) acc[t] = __builtin_amdgcn_mfma_f32_16x16x32_fp8_fp8(a[t][3], b3, acc[t], 0, 0, 0);
    if (r == 0) {
#pragma unroll
        for (int t = 0; t < 4; ++t) *(float4*)(dst + 16 * t + 4 * q) = float4{acc[t][0] * (1.f / 32.f), acc[t][1] * (1.f / 32.f), acc[t][2] * (1.f / 32.f), acc[t][3] * (1.f / 32.f)};
    }
}
DEVI void peer_down_phase(const Params& p, const float* __restrict__ gain, int qbase, int s0, char* smem) {
    const int tid = threadIdx.x, lane = tid & 63;
    const int wave = __builtin_amdgcn_readfirstlane(tid >> 6);
    const char* ED = p.ws + OFF_ED; const char* XB8 = p.ws + OFF_XB8;
    const int* IDX = (const int*)(p.ws + OFF_IDX);
    float* PART = (float*)(p.ws + OFF_PART);
    (void)gain;
    char* const img = smem + wave * 16384;
    char* const tb0 = smem + 65536 + wave * 3072;
#pragma unroll 1
    for (int sl = 0; sl < 8; ++sl) {
        const int s = (s0 + sl) & 7;
#pragma unroll 1
        for (;;) {
            const int g = queue_pop(p, qbase + s, smem);
            if (g >= PEER_ITEMS) break;
            const size_t t0 = (size_t)g * (4 * PEER_TPW) + wave * PEER_TPW;
            d_stream(t0, s, lane, tb0, IDX, XB8); d_stream(t0 + 1, s, lane, tb0 + 768, IDX, XB8);
            asm volatile("s_waitcnt vmcnt(0)" ::: "memory");
            d_dma<0>(tb0, img, s, lane, ED);
#pragma unroll 1
            for (int j = 0; j < PEER_TPW; ++j) {
                char* const slj = tb0 + 768 * (j & 3); char* const sln = tb0 + 768 * ((j + 1) & 3);
                if (j + 2 < PEER_TPW) d_stream(t0 + j + 2, s, lane, tb0 + 768 * ((j + 2) & 3), IDX, XB8);
                d_dma<1>(slj, img + 8192, s, lane, ED);
                if (j + 2 < PEER_TPW) asm volatile("s_waitcnt vmcnt(11)" ::: "memory"); else asm volatile("s_waitcnt vmcnt(8)" ::: "memory");
                if (!(PROBE_NOMMA && qbase >= 32)) d_mma<0>(img, slj, t0 + j, s, lane, PART);
                asm volatile("s_waitcnt lgkmcnt(0)" ::: "memory");
                if (j + 1 < PEER_TPW) { d_dma<0>(sln, img, s, lane, ED); asm volatile("s_waitcnt vmcnt(8)" ::: "memory"); }
                else asm volatile("s_waitcnt vmcnt(0)" ::: "memory");
                if (!(PROBE_NOMMA && qbase >= 32)) d_mma<1>(img + 8192, slj, t0 + j, s, lane, PART);
                asm volatile("s_waitcnt lgkmcnt(0)" ::: "memory");
            }
        }
    }
}
DEVI void peer_reduce_phase(const Params& p) {
    const int lane = threadIdx.x & 63, wave = threadIdx.x >> 6;
    const float* PART = (const float*)(p.ws + OFF_PART); const float* GATEU = (const float*)(p.ws + OFF_GATE); const float* SDN = (const float*)(p.ws + OFF_SDN);
    const float* SSQ16 = (const float*)(p.ws + OFF_SSQ16); float* ACTW = (float*)(p.ws + OFF_ACTW);
    for (int it = blockIdx.x; it < 4096; it += gridDim.x) {
        const size_t tok = (size_t)it * 4 + wave;
        float sq = (lane < 16) ? SSQ16[tok * 16 + lane] : 0.f;
        sq += __shfl_xor(sq, 1); sq += __shfl_xor(sq, 2); sq += __shfl_xor(sq, 4); sq += __shfl_xor(sq, 8);
        const float rstd = rsqrtf(__shfl(sq, 0) * (1.f / 1024.f) + 1e-6f);
        float a0 = 0.f, a1 = 0.f;
#pragma unroll
        for (int s = 0; s < 8; ++s) { a0 += PART[((size_t)s * 16384 + tok) * 128 + lane]; a1 += PART[((size_t)s * 16384 + tok) * 128 + 64 + lane]; }
        ACTW[tok * 128 + lane]      = GATEU[tok * 128 + lane]      * gelu_tanh(a0 * rstd * SDN[tok * 128 + lane]);
        ACTW[tok * 128 + 64 + lane] = GATEU[tok * 128 + 64 + lane] * gelu_tanh(a1 * rstd * SDN[tok * 128 + 64 + lane]);
    }
}
struct UL { int i0, i1; float w0, w1; f32x2v x2; };
struct UG { u32x4 u[8]; float w[8]; };
DEVI void u_load(UL& l, size_t tok, int s, int lane, const int* IDX, const float* ACTW, const float* X) {
    const unsigned o1 = (unsigned)tok * 512u + 4u * (unsigned)lane;
    l.i0 = *(const int*)((const char*)IDX + o1); l.i1 = *(const int*)((const char*)IDX + o1 + 256u);
    l.w0 = *(const float*)((const char*)ACTW + o1); l.w1 = *(const float*)((const char*)ACTW + o1 + 256u);
    const unsigned o2 = (unsigned)tok * 4096u + (unsigned)(512 * s + 64 * (lane & 7) + 8 * (lane >> 3));
    { const unsigned xb2 = *(const unsigned*)((const char*)X + (o2 >> 1)); l.x2 = f32x2v{bflo(xb2), bfhi(xb2)}; }
}
DEVI void u_publish(const UL& l, char* pt, int lane) {
    *(uint2*)(pt + 8 * lane) = uint2{(unsigned)l.i0, __float_as_uint(l.w0)};
    *(uint2*)(pt + 512 + 8 * lane) = uint2{(unsigned)l.i1, __float_as_uint(l.w1)};
}
template <int HLF>
DEVI void u_gather(UG& g, const char* pt, int s, int lane, const char* EU) {
    const int grp = lane >> 3, sub = lane & 7;
#pragma unroll
    for (int i = 0; i < 8; ++i) {
        const uint2 ew = *(const uint2*)(pt + 512 * HLF + 8 * (8 * i + grp));
        g.w[i] = __uint_as_float(ew.y);
        const unsigned off = ((unsigned)s * 16384u + ew.x) * 128u + (unsigned)(16 * sub);
        g.u[i] = *(const u32x4*)(EU + off);
    }
}
DEVI void u_fma(const UG& g, float (&acc)[16]) {
#pragma unroll
    for (int i = 0; i < 8; ++i) {
        const float w = g.w[i];
#pragma unroll
        for (int q = 0; q < 4; ++q) {
            const f32x2v lo = __builtin_amdgcn_cvt_pk_f32_fp8((int)g.u[i][q], false), hi = __builtin_amdgcn_cvt_pk_f32_fp8((int)g.u[i][q], true);
            UFMA(acc[4 * q], w, lo.x); UFMA(acc[4 * q + 1], w, lo.y); UFMA(acc[4 * q + 2], w, hi.x); UFMA(acc[4 * q + 3], w, hi.y);
        }
        if (i & 1) __builtin_amdgcn_sched_barrier(0);
    }
}
DEVI void u_finish(float (&acc)[16], const UL& l, char* ex, size_t tok, int s, int lane, float alpha, float* X, bf16_t* XB, float* SSQ8) {
    const int grp = lane >> 3, sub = lane & 7;
#pragma unroll
    for (int pp = 0; pp < 8; ++pp) *(float2*)(ex + 576 * pp + 8 * lane) = float2{acc[2 * pp], acc[2 * pp + 1]};
    float a0 = 0.f, a1 = 0.f;
#pragma unroll
    for (int g2 = 0; g2 < 8; ++g2) { const float2 v = *(const float2*)(ex + 576 * grp + 8 * (8 * g2 + sub)); a0 += v.x; a1 += v.y; }
    const float y0 = l.x2.x + alpha * a0, y1 = l.x2.y + alpha * a1;
    const unsigned col = (unsigned)tok * 1024u + (unsigned)(128 * s + 16 * sub + 2 * grp);
    if (X) *(f32x2v*)((char*)X + 4u * col) = f32x2v{y0, y1};
    const unsigned yb = pack2(y0, y1);
    *(unsigned*)((char*)XB + 2u * col) = yb;
    float sq = bflo(yb) * bflo(yb) + bfhi(yb) * bfhi(yb);
#pragma unroll
    for (int o = 1; o < 64; o <<= 1) sq += __shfl_xor(sq, o);
    if (lane == 0) *(float*)((char*)SSQ8 + ((unsigned)tok * 32u + 4u * (unsigned)s)) = sq;
#pragma unroll
    for (int i = 0; i < 16; ++i) acc[i] = 0.f;
}
DEVI void peer_up_phase(const Params& p, int qbase, int s0, float alpha, float* X, char* smem) {
    const int tid = threadIdx.x, lane = tid & 63, wave = tid >> 6;
    const char* EU = p.ws + OFF_EU;
    const int* IDX = (const int*)(p.ws + OFF_IDX); const float* ACTW = (const float*)(p.ws + OFF_ACTW);
    bf16_t* XB = (bf16_t*)(p.ws + OFF_XB); float* SSQ8 = (float*)(p.ws + OFF_SSQ8);
    char* const pt0 = smem + wave * 8192;
    char* const ex = pt0 + 2048;
#pragma unroll 1
    for (int sl = 0; sl < 8; ++sl) {
        const int s = (s0 + sl) & 7;
#pragma unroll 1
        for (;;) {
            const int g = queue_pop(p, qbase + s, smem);
            if (g >= PEER_ITEMS) break;
            const size_t t0 = (size_t)g * (4 * PEER_TPW) + wave * PEER_TPW;
            UL la, lb, lc; UG ga, gb;
            float acc[16];
#pragma unroll
            for (int i = 0; i < 16; ++i) acc[i] = 0.f;
            u_load(la, t0, s, lane, IDX, ACTW, (const float*)XB); u_load(lb, t0 + 1, s, lane, IDX, ACTW, (const float*)XB);
            u_publish(la, pt0, lane); u_publish(lb, pt0 + 1024, lane);
            u_gather<0>(ga, pt0, s, lane, EU);
#pragma unroll 1
            for (int j = 0; j < PEER_TPW; ++j) {
                char* const ptj = pt0 + 1024 * (j & 1); char* const ptn = pt0 + 1024 * ((j + 1) & 1);
                u_gather<1>(gb, ptj, s, lane, EU);
                u_fma(ga, acc);
                if (j + 2 < PEER_TPW) u_load(lc, t0 + j + 2, s, lane, IDX, ACTW, (const float*)XB);
                if (j + 1 < PEER_TPW) u_gather<0>(ga, ptn, s, lane, EU);
                u_fma(gb, acc);
                u_finish(acc, la, ex, t0 + j, s, lane, alpha, X, XB, SSQ8);
                la = lb; lb = lc;
                if (j + 2 < PEER_TPW) u_publish(lb, ptj, lane);
            }
        }
    }
}

DEVI void rope_cs(float pos, int i, float& c, float& s) {
    const float inv = exp2f(-(float)i * (13.287712379549449f / 32.f));
    const float ang = pos * inv;
    const float kf = rintf(ang * 0.15915494309189535f);
    float rr = fmaf(-kf, 6.2831854820251465f, ang);
    rr = fmaf(-kf, -1.7484555e-7f, rr);
    c = __cosf(rr); s = __sinf(rr);
}
#define QSCALE_MLA  (0.07216878364870322f * 1.4426950408889634f)
#define QSCALE_MOBA (0.08838834764831845f * 1.4426950408889634f)

DEVI void moba_prep_item(const Params& p, int item, char* smem) {
    const int tid = threadIdx.x;
    const int h = item & 3, tt = item >> 2;
    const size_t m0 = (size_t)tt * 64;
    const int b = (int)(m0 >> 13), s0 = (int)(m0 & 8191), bh = b * 4 + h;
    const bf16_t* Z1 = (const bf16_t*)(p.ws + OFF_Z1);
    bf16_t* Qd = (bf16_t*)(p.ws + OFF_QD); bf16_t* Kd = (bf16_t*)(p.ws + OFF_KD); bf16_t* VdT = (bf16_t*)(p.ws + OFF_VDT);
    const int row = tid >> 2, j = tid & 3;
    const bf16_t* zr = Z1 + (m0 + row) * 1984;
#pragma unroll
    for (int which = 0; which < 2; ++which) {
        const bf16_t* src = zr + (which ? 960 : 448) + h * 128 + 32 * j;
        const float* gn = (which ? p.l1_mk_norm : p.l1_mq_norm) + 32 * j;
        float v[32]; float ss = 0.f;
#pragma unroll
        for (int i = 0; i < 4; ++i) {
            uint4 u = *(const uint4*)(src + 8 * i);
            v[8 * i] = bflo(u.x); v[8 * i + 1] = bfhi(u.x); v[8 * i + 2] = bflo(u.y); v[8 * i + 3] = bfhi(u.y);
            v[8 * i + 4] = bflo(u.z); v[8 * i + 5] = bfhi(u.z); v[8 * i + 6] = bflo(u.w); v[8 * i + 7] = bfhi(u.w);
        }
#pragma unroll
        for (int i = 0; i < 32; ++i) ss += v[i] * v[i];
        ss += __shfl_xor(ss, 1); ss += __shfl_xor(ss, 2);
        const float sc = rsqrtf(ss * (1.f / 128.f) + 1e-6f) * (which ? 1.f : QSCALE_MOBA);
        bf16_t* dst = (which ? Kd : Qd) + ((size_t)bh * 8192 + s0 + row) * 128 + 32 * j;
#pragma unroll
        for (int i = 0; i < 4; ++i) {
            uint4 o;
            o.x = pack2(v[8 * i] * sc * gn[8 * i], v[8 * i + 1] * sc * gn[8 * i + 1]); o.y = pack2(v[8 * i + 2] * sc * gn[8 * i + 2], v[8 * i + 3] * sc * gn[8 * i + 3]);
            o.z = pack2(v[8 * i + 4] * sc * gn[8 * i + 4], v[8 * i + 5] * sc * gn[8 * i + 5]); o.w = pack2(v[8 * i + 6] * sc * gn[8 * i + 6], v[8 * i + 7] * sc * gn[8 * i + 7]);
            *(uint4*)(dst + 8 * i) = o;
        }
    }
    bf16_t* sT = (bf16_t*)smem;
    {
        const bf16_t* src = zr + 1472 + h * 128 + 32 * j;
#pragma unroll
        for (int i = 0; i < 4; ++i) {
            uint4 u = *(const uint4*)(src + 8 * i);
            const int d0 = 32 * j + 8 * i;
            sT[(d0 + 0) * 66 + row] = (bf16_t)(u.x & 0xffff); sT[(d0 + 1) * 66 + row] = (bf16_t)(u.x >> 16);
            sT[(d0 + 2) * 66 + row] = (bf16_t)(u.y & 0xffff); sT[(d0 + 3) * 66 + row] = (bf16_t)(u.y >> 16);
            sT[(d0 + 4) * 66 + row] = (bf16_t)(u.z & 0xffff); sT[(d0 + 5) * 66 + row] = (bf16_t)(u.z >> 16);
            sT[(d0 + 6) * 66 + row] = (bf16_t)(u.w & 0xffff); sT[(d0 + 7) * 66 + row] = (bf16_t)(u.w >> 16);
        }
    }
    __syncthreads();
    for (int e = tid; e < 128 * 32; e += NTHREADS) {
        const int d = e >> 5, tp = e & 31;
        const unsigned v = (unsigned)sT[d * 66 + 2 * tp] | ((unsigned)sT[d * 66 + 2 * tp + 1] << 16);
        *(unsigned*)(VdT + ((size_t)bh * 128 + d) * 8192 + s0 + (((2 * tp) & ~12) | (((2 * tp) & 4) << 1) | (((2 * tp) & 8) >> 1))) = v;
    }
    __syncthreads();
}

DEVI void moba_kmean_item(const Params& p, int item, char* smem) {
    const int tid = threadIdx.x;
    const int bh = item >> 5, blk = item & 31, b = bh >> 2, h = bh & 3;
    const bf16_t* Z1 = (const bf16_t*)(p.ws + OFF_Z1) + ((size_t)b * 8192 + blk * 256) * 1984 + 960 + h * 128;
    const int cc = tid & 15, rg = tid >> 4;
    float col[8];
#pragma unroll
    for (int i = 0; i < 8; ++i) col[i] = 0.f;
    for (int i = 0; i < 16; ++i) {
        const int row = rg * 16 + i;
        uint4 u = *(const uint4*)(Z1 + (size_t)row * 1984 + cc * 8);
        float v[8] = {bflo(u.x), bfhi(u.x), bflo(u.y), bfhi(u.y), bflo(u.z), bfhi(u.z), bflo(u.w), bfhi(u.w)};
        float ss = 0.f;
#pragma unroll
        for (int e = 0; e < 8; ++e) ss += v[e] * v[e];
        ss += __shfl_xor(ss, 1); ss += __shfl_xor(ss, 2); ss += __shfl_xor(ss, 4); ss += __shfl_xor(ss, 8);
        const float rstd = rsqrtf(ss * (1.f / 128.f) + 1e-6f);
#pragma unroll
        for (int e = 0; e < 8; ++e) col[e] += v[e] * rstd;
    }
    float* sR = (float*)smem;
#pragma unroll
    for (int e = 0; e < 8; ++e) sR[rg * 128 + cc * 8 + e] = col[e];
    __syncthreads();
    if (tid < 128) {
        float s = 0.f;
#pragma unroll
        for (int g = 0; g < 16; ++g) s += sR[g * 128 + tid];
        ((float*)(p.ws + OFF_KMEAN))[((size_t)bh * 32 + blk) * 128 + tid] = s * (1.f / 256.f) * p.l1_mk_norm[tid];
    }
    __syncthreads();
}

DEVI void mla_prep_item(const Params& p, int item, char* smem) {
    const int tid = threadIdx.x;
    const int h = item & 3, tt = item >> 2;
    const size_t m0 = (size_t)tt * 64;
    const int b = (int)(m0 >> 13), s0 = (int)(m0 & 8191), bh = b * 4 + h;
    const bf16_t* Z1 = (const bf16_t*)(p.ws + OFF_Z1);
    const bf16_t* QC = (const bf16_t*)(p.ws + OFF_QC);
    const bf16_t* KV = (const bf16_t*)(p.ws + OFF_KV);
    bf16_t* Q = (bf16_t*)(p.ws + OFF_Q); bf16_t* K = (bf16_t*)(p.ws + OFF_K); bf16_t* VT = (bf16_t*)(p.ws + OFF_VT);
    const int row = tid >> 2, j = tid & 3;
    const size_t m = m0 + row;
    const float pos = (float)p.pos[m];
#pragma unroll
    for (int which = 0; which < 2; ++which) {
        const bf16_t* nsrc = which ? (KV + m * 1024 + h * 256 + 32 * j) : (QC + m * 768 + h * 192 + 32 * j);
        const bf16_t* r1 = which ? (Z1 + m * 1984 + 384 + 8 * j) : (QC + m * 768 + h * 192 + 128 + 8 * j);
        const bf16_t* r2 = r1 + 32;
        const float* gn = which ? p.l1_k_norm : p.l1_q_norm;
        float v[32], a1[8], a2[8]; float ss = 0.f;
#pragma unroll
        for (int i = 0; i < 4; ++i) {
            uint4 u = *(const uint4*)(nsrc + 8 * i);
            v[8 * i] = bflo(u.x); v[8 * i + 1] = bfhi(u.x); v[8 * i + 2] = bflo(u.y); v[8 * i + 3] = bfhi(u.y);
            v[8 * i + 4] = bflo(u.z); v[8 * i + 5] = bfhi(u.z); v[8 * i + 6] = bflo(u.w); v[8 * i + 7] = bfhi(u.w);
        }
        { uint4 u = *(const uint4*)r1; a1[0] = bflo(u.x); a1[1] = bfhi(u.x); a1[2] = bflo(u.y); a1[3] = bfhi(u.y); a1[4] = bflo(u.z); a1[5] = bfhi(u.z); a1[6] = bflo(u.w); a1[7] = bfhi(u.w); }
        { uint4 u = *(const uint4*)r2; a2[0] = bflo(u.x); a2[1] = bfhi(u.x); a2[2] = bflo(u.y); a2[3] = bfhi(u.y); a2[4] = bflo(u.z); a2[5] = bfhi(u.z); a2[6] = bflo(u.w); a2[7] = bfhi(u.w); }
#pragma unroll
        for (int i = 0; i < 32; ++i) ss += v[i] * v[i];
#pragma unroll
        for (int i = 0; i < 8; ++i) ss += a1[i] * a1[i] + a2[i] * a2[i];
        ss += __shfl_xor(ss, 1); ss += __shfl_xor(ss, 2);
        const float rstd = rsqrtf(ss * (1.f / 192.f) + 1e-6f);
        const float sc = which ? 1.f : QSCALE_MLA;
        bf16_t* dst = (which ? K : Q) + ((size_t)bh * 8192 + s0 + row) * 192;
#pragma unroll
        for (int i = 0; i < 4; ++i) {
            const float* g = gn + 32 * j + 8 * i;
            uint4 o;
            o.x = pack2(v[8 * i] * rstd * g[0] * sc, v[8 * i + 1] * rstd * g[1] * sc); o.y = pack2(v[8 * i + 2] * rstd * g[2] * sc, v[8 * i + 3] * rstd * g[3] * sc);
            o.z = pack2(v[8 * i + 4] * rstd * g[4] * sc, v[8 * i + 5] * rstd * g[5] * sc); o.w = pack2(v[8 * i + 6] * rstd * g[6] * sc, v[8 * i + 7] * rstd * g[7] * sc);
            *(uint4*)(dst + 32 * j + 8 * i) = o;
        }
        float o1[8], o2[8];
#pragma unroll
        for (int i = 0; i < 8; ++i) {
            float c, s; rope_cs(pos, 8 * j + i, c, s);
            const float y1 = a1[i] * rstd * gn[128 + 8 * j + i], y2 = a2[i] * rstd * gn[160 + 8 * j + i];
            o1[i] = (y1 * c - y2 * s) * sc; o2[i] = (y2 * c + y1 * s) * sc;
        }
        uint4 w1, w2;
        w1.x = pack2(o1[0], o1[1]); w1.y = pack2(o1[2], o1[3]); w1.z = pack2(o1[4], o1[5]); w1.w = pack2(o1[6], o1[7]);
        w2.x = pack2(o2[0], o2[1]); w2.y = pack2(o2[2], o2[3]); w2.z = pack2(o2[4], o2[5]); w2.w = pack2(o2[6], o2[7]);
        *(uint4*)(dst + 128 + 8 * j) = w1; *(uint4*)(dst + 160 + 8 * j) = w2;
    }
    bf16_t* sT = (bf16_t*)smem;
    {
        const bf16_t* src = KV + m * 1024 + h * 256 + 128 + 32 * j;
#pragma unroll
        for (int i = 0; i < 4; ++i) {
            uint4 u = *(const uint4*)(src + 8 * i);
            const int d0 = 32 * j + 8 * i;
            sT[(d0 + 0) * 66 + row] = (bf16_t)(u.x & 0xffff); sT[(d0 + 1) * 66 + row] = (bf16_t)(u.x >> 16);
            sT[(d0 + 2) * 66 + row] = (bf16_t)(u.y & 0xffff); sT[(d0 + 3) * 66 + row] = (bf16_t)(u.y >> 16);
            sT[(d0 + 4) * 66 + row] = (bf16_t)(u.z & 0xffff); sT[(d0 + 5) * 66 + row] = (bf16_t)(u.z >> 16);
            sT[(d0 + 6) * 66 + row] = (bf16_t)(u.w & 0xffff); sT[(d0 + 7) * 66 + row] = (bf16_t)(u.w >> 16);
        }
    }
    __syncthreads();
    for (int e = tid; e < 128 * 32; e += NTHREADS) {
        const int d = e >> 5, tp = e & 31;
        const unsigned v = (unsigned)sT[d * 66 + 2 * tp] | ((unsigned)sT[d * 66 + 2 * tp + 1] << 16);
        *(unsigned*)(VT + ((size_t)bh * 128 + d) * 8192 + s0 + (((2 * tp) & ~12) | (((2 * tp) & 4) << 1) | (((2 * tp) & 8) >> 1))) = v;
    }
    __syncthreads();
}

template <int DQK, bool MOBA>
DEVI void attn_item(const Params& p, int bh, int qt, char* smem) {
    constexpr int NKS = DQK / 16, KCH = DQK / 8;
    const int tid = threadIdx.x, lane = tid & 63, wave = tid >> 6;
    const int r = lane & 31, hh = lane >> 5;
    char* const ws = opaque_ptr(p.ws);
    const bf16_t* Q  = (const bf16_t*)(ws + (MOBA ? OFF_QD : OFF_Q)) + (size_t)bh * 8192 * DQK;
    const bf16_t* Kg = (const bf16_t*)(ws + (MOBA ? OFF_KD : OFF_K)) + (size_t)bh * 8192 * DQK;
    const bf16_t* Vg = (const bf16_t*)(ws + (MOBA ? OFF_VDT : OFF_VT)) + (size_t)bh * 128 * 8192;
    const int q0 = qt * 128;
    const int qpos = q0 + wave * 32 + r;
    constexpr int KB = 32 * DQK * 2, VB = 8192, STG = KB + VB;
    constexpr int KI = KB / 4096;
    int*  sList = (int*)(smem + 61440);
    unsigned* sSel = (unsigned*)(smem + 62464);
    float* sTop = (float*)(smem + 63232);
    int ntiles;
    unsigned mysel = 0xffffffffu;
    if constexpr (MOBA) {
        const int jblk = q0 >> 8;
        float* sKm = (float*)smem;
        const float* km = (const float*)(ws + OFF_KMEAN) + (size_t)bh * 32 * 128;
        for (int e = tid; e < 1024; e += NTHREADS) ((float4*)sKm)[e] = ((const float4*)km)[e];
        unsigned* sAny = (unsigned*)(smem + 62976);
        if (tid < 32) sAny[tid] = 0u;
        __syncthreads();
        const int qq = tid & 127, par = tid >> 7;
        float ga[16];
#pragma unroll
        for (int i = 0; i < 16; ++i) ga[i] = 0.f;
        const bf16_t* qrow = Q + (size_t)(q0 + qq) * 128;
#pragma unroll 1
        for (int d0 = 0; d0 < 128; d0 += 8) {
            uint4 u = *(const uint4*)(qrow + d0);
            float qv[8] = {bflo(u.x), bfhi(u.x), bflo(u.y), bfhi(u.y), bflo(u.z), bfhi(u.z), bflo(u.w), bfhi(u.w)};
#pragma unroll
            for (int i = 0; i < 16; ++i) {
                const float4 ka = *(const float4*)(sKm + (2 * i + par) * 128 + d0), kb = *(const float4*)(sKm + (2 * i + par) * 128 + d0 + 4);
                ga[i] += qv[0] * ka.x + qv[1] * ka.y + qv[2] * ka.z + qv[3] * ka.w + qv[4] * kb.x + qv[5] * kb.y + qv[6] * kb.z + qv[7] * kb.w;
            }
        }
        float tv[3] = {-3e38f, -3e38f, -3e38f}; int ti[3] = {-1, -1, -1};
#pragma unroll
        for (int i = 0; i < 16; ++i) {
            const int n = 2 * i + par;
            if (n < jblk) {
                const float v = ga[i];
                if (v > tv[0]) { tv[2] = tv[1]; ti[2] = ti[1]; tv[1] = tv[0]; ti[1] = ti[0]; tv[0] = v; ti[0] = n; }
                else if (v > tv[1]) { tv[2] = tv[1]; ti[2] = ti[1]; tv[1] = v; ti[1] = n; }
                else if (v > tv[2]) { tv[2] = v; ti[2] = n; }
            }
        }
#pragma unroll
        for (int i = 0; i < 3; ++i) { sTop[tid * 6 + 2 * i] = tv[i]; sTop[tid * 6 + 2 * i + 1] = __int_as_float(ti[i]); }
        __syncthreads();
        if (par == 0) {
#pragma unroll
            for (int i = 0; i < 3; ++i) {
                const float v = sTop[(tid + 128) * 6 + 2 * i]; const int n = __float_as_int(sTop[(tid + 128) * 6 + 2 * i + 1]);
                if (n >= 0) {
                    if (v > tv[0]) { tv[2] = tv[1]; ti[2] = ti[1]; tv[1] = tv[0]; ti[1] = ti[0]; tv[0] = v; ti[0] = n; }
                    else if (v > tv[1]) { tv[2] = tv[1]; ti[2] = ti[1]; tv[1] = v; ti[1] = n; }
                    else if (v > tv[2]) { tv[2] = v; ti[2] = n; }
                }
            }
            unsigned m = 1u << jblk;
#pragma unroll
            for (int i = 0; i < 3; ++i) if (ti[i] >= 0) { m |= 1u << ti[i]; sAny[ti[i]] = 1u; }
            sSel[qq] = m;
        }
        __syncthreads();
        if (tid == 0) {
            int n = 0;
            for (int blk = 0; blk < jblk; ++blk) if (sAny[blk]) { for (int t = 0; t < 8; ++t) sList[n++] = blk * 8 + t; }
            for (int t = jblk * 8; t < (q0 + 128) / 32; ++t) sList[n++] = t;
            sSel[160] = (unsigned)n;
        }
        __syncthreads();
        ntiles = (int)sSel[160];
        mysel = sSel[wave * 32 + r];
        __syncthreads();
    } else {
        ntiles = 4 * qt + 4;
    }
    bf16x8 qf[NKS];
#pragma unroll
    for (int ks = 0; ks < NKS; ++ks) qf[ks] = *(const bf16x8*)(Q + (size_t)qpos * DQK + ks * 16 + hh * 8);
    f32x16 o[4];
#pragma unroll
    for (int dt = 0; dt < 4; ++dt)
#pragma unroll
        for (int e = 0; e < 16; ++e) o[dt][e] = 0.f;
    float lsum = 0.f;
    int koff[KI], voff[2];
#pragma unroll
    for (int i = 0; i < KI; ++i) {
        const int L = (wave * KI + i) * 64 + lane, row = L / KCH, cp = L % KCH;
        const int f = (DQK == 128) ? (row & 15) : ((row >> 1) & 7);
        koff[i] = row * DQK + (cp ^ f) * 8;
    }
#pragma unroll
    for (int i = 0; i < 2; ++i) {
        const int L = (wave * 2 + i) * 64 + lane, dv = L >> 2, cp = L & 3;
        voff[i] = dv * 8192 + (cp ^ ((dv >> 2) & 3)) * 8;
    }
    const int wv = __builtin_amdgcn_readfirstlane(wave);
#define ATT_ISSUE(LI) { const int u_ = tile_id(LI); char* st_ = smem + ((LI) % 3) * STG; \
        _Pragma("unroll") for (int i = 0; i < KI; ++i) __builtin_amdgcn_global_load_lds((const unsigned*)(Kg + (size_t)u_ * 32 * DQK + koff[i]), (unsigned*)(st_ + (wv * KI + i) * 1024), 16, 0, 0); \
        _Pragma("unroll") for (int i = 0; i < 2; ++i)  __builtin_amdgcn_global_load_lds((const unsigned*)(Vg + (size_t)u_ * 32 + voff[i]),       (unsigned*)(st_ + KB + (wv * 2 + i) * 1024), 16, 0, 0); }
    auto tile_id = [&](int li) -> int { if constexpr (MOBA) return sList[li]; else return li; };
    if (ntiles > 0) ATT_ISSUE(0)
    if (ntiles > 1) ATT_ISSUE(1)
    const int xk = ((DQK == 128) ? (r & 15) : ((r >> 1) & 7)) ^ hh;
    const int xv = (r >> 2) & 3;
#pragma unroll 1
    for (int li = 0; li < ntiles; ++li) {
        if (li + 1 < ntiles) asm volatile("s_waitcnt vmcnt(%0)" :: "n"(KI + 2) : "memory");
        else asm volatile("s_waitcnt vmcnt(0)" ::: "memory");
        G2_RAW_BARRIER();
        if (li + 2 < ntiles) ATT_ISSUE(li + 2)
        const int unit = tile_id(li);
        const int kbase = unit * 32;
        bool allowed = true;
        if constexpr (MOBA) allowed = (mysel >> (unit >> 3)) & 1u;
        const char* sK = smem + (li % 3) * STG;
        const char* sV = sK + KB;
        if (kbase <= q0 + wave * 32 + 31) {
            const char* kbase_l = sK + r * (DQK * 2);
            const char* vbase_l = sV + r * 64;
            f32x16 s;
#pragma unroll
            for (int e = 0; e < 16; ++e) s[e] = 0.f;
#pragma unroll
            for (int ks = 0; ks < NKS; ++ks) {
                const bf16x8 a = *(const bf16x8*)(kbase_l + (((2 * ks) ^ xk) << 4));
                s = mfma32(a, qf[ks], s);
            }
            const bool need_mask = (kbase + 31 > q0 + wave * 32);
            float pr[16];
            if (need_mask) {
                const int kofs = qpos - kbase - 4 * hh;
#pragma unroll
                for (int e = 0; e < 16; ++e) pr[e] = ((e & 3) + 8 * (e >> 2) <= kofs) ? __builtin_amdgcn_exp2f(s[e]) : 0.f;
            } else {
#pragma unroll
                for (int e = 0; e < 16; ++e) pr[e] = __builtin_amdgcn_exp2f(s[e]);
            }
            if constexpr (MOBA) {
                const float am = allowed ? 1.f : 0.f;
#pragma unroll
                for (int e = 0; e < 16; ++e) pr[e] *= am;
            }
            lsum += ((pr[0] + pr[1]) + (pr[2] + pr[3])) + ((pr[4] + pr[5]) + (pr[6] + pr[7])) + ((pr[8] + pr[9]) + (pr[10] + pr[11])) + ((pr[12] + pr[13]) + (pr[14] + pr[15]));
#pragma unroll
            for (int s2 = 0; s2 < 2; ++s2) {
                const u32x4 pbu = {pack2(pr[8 * s2 + 0], pr[8 * s2 + 1]), pack2(pr[8 * s2 + 2], pr[8 * s2 + 3]),
                                   pack2(pr[8 * s2 + 4], pr[8 * s2 + 5]), pack2(pr[8 * s2 + 6], pr[8 * s2 + 7])};
                const bf16x8 pbv = __builtin_bit_cast(bf16x8, pbu);
#pragma unroll
                for (int dt = 0; dt < 4; ++dt) {
                    const char* vb = vbase_l + dt * (32 * 64);
                    const u32x4 vau = *(const u32x4*)(vb + (((2 * s2 + hh) ^ xv) << 4));
                    o[dt] = mfma32(__builtin_bit_cast(bf16x8, vau), pbv, o[dt]);
                }
            }
        }
    }
#undef ATT_ISSUE
    G2_RAW_BARRIER();
    lsum += __shfl_xor(lsum, 32);
    const float inv = 1.f / lsum;
    char* sO = smem + wave * 8704;
#pragma unroll
    for (int dt = 0; dt < 4; ++dt)
#pragma unroll
        for (int e = 0; e < 16; e += 2) {
            const int dv = 32 * dt + (e & 3) + 8 * (e >> 2) + 4 * hh;
            *(unsigned*)(sO + r * 272 + dv * 2) = pack2(o[dt][e] * inv, o[dt][e + 1] * inv);
        }
    __builtin_amdgcn_s_waitcnt(0xc07f);
    __builtin_amdgcn_wave_barrier();
    bf16_t* MIX = (bf16_t*)(ws + OFF_MIX1);
    const int b = bh >> 2, h = bh & 3;
#pragma unroll
    for (int i = 0; i < 8; ++i) {
        const int id = lane + 64 * i, row = id >> 4, cc = id & 15;
        const uint4 v = *(const uint4*)(sO + row * 272 + cc * 16);
        *(uint4*)(MIX + ((size_t)b * 8192 + q0 + wave * 32 + row) * 1024 + (MOBA ? 512 : 0) + h * 128 + cc * 8) = v;
    }
    __syncthreads();
}

DEVI void attn_phase_all(const Params& p, char* smem) {
    const int G = gridDim.x;
#pragma unroll 1
    for (int v = blockIdx.x; v < 512; v += G) attn_item<192, false>(p, v & 7, 63 - (v >> 3), smem);
    __builtin_amdgcn_sched_barrier(0);
#pragma unroll 1
    for (int v = blockIdx.x; v < 512; v += G) attn_item<128, true>(p, v & 7, (v >> 3), smem);
}

#define XB_TMO      128
#define XB_XCNT(j)  (256  + 64 * (j))
#define XB_XSUB(j)  (1280 + 64 * (j))
#define XB_XGEN(j)  (2304 + 64 * (j))
#define XB_TOP      3328
#define XB_TOPGEN   3392
#define XCD_BAR_WORDS 3456
#define XB_SPIN_CAP (1u << 23)
#define LAS __attribute__((address_space(3)))
DEVI unsigned xb_ld(unsigned* p)              { return __hip_atomic_load(p, __ATOMIC_RELAXED, __HIP_MEMORY_SCOPE_AGENT); }
DEVI unsigned xb_add(unsigned* p, unsigned v) { return __hip_atomic_fetch_add(p, v, __ATOMIC_RELAXED, __HIP_MEMORY_SCOPE_AGENT); }
DEVI unsigned xb_xcc_id() { return (unsigned)__builtin_amdgcn_s_getreg((3 << 11) | 20) & 0xFu; }
#define XB_SPIN(cond, bar) do { unsigned _sp = 0; while (cond) { __builtin_amdgcn_s_sleep(1); \
    if ((++_sp & 255u) == 0u) { if (xb_ld(&(bar)[XB_TMO])) break; if (_sp > XB_SPIN_CAP) { atomicAdd(&(bar)[XB_TMO], 1u); break; } } } } while (0)
struct XcdBarrier { unsigned* bar; unsigned x; volatile LAS unsigned* st; };
DEVI XcdBarrier xcd_barrier_post(unsigned* bar, volatile LAS unsigned* st) {
    XcdBarrier b; b.bar = bar; b.x = xb_xcc_id(); b.st = st;
    if (threadIdx.x == 0) st[2] = xb_add(&bar[XB_XCNT(b.x)], 1u);
    return b;
}
DEVI void xcd_barrier_complete(unsigned* bar, unsigned x, unsigned& nloc, unsigned& nx, unsigned& dense) {
    const unsigned G = gridDim.x * gridDim.y * gridDim.z;
    unsigned sum, cnt, mine, sp = 0u;
    for (;;) {
        sum = 0u; cnt = 0u; mine = 0u; dense = 0u;
#pragma unroll
        for (unsigned j = 0; j < 16; ++j) { const unsigned c = xb_ld(&bar[XB_XCNT(j)]); sum += c; cnt += (c > 0u) ? 1u : 0u; mine = (j == x) ? c : mine; dense += (j < x && c > 0u) ? 1u : 0u; }
        if (sum == G) break;
        __builtin_amdgcn_s_sleep(1);
        if ((++sp & 255u) == 0u) { if (xb_ld(&bar[XB_TMO])) break; if (sp > XB_SPIN_CAP) { atomicAdd(&bar[XB_TMO], 1u); break; } }
    }
    nloc = mine > 0u ? mine : 1u; nx = cnt > 0u ? cnt : 1u;
}
DEVI void xcd_barrier(const XcdBarrier& b) {
    asm volatile("s_waitcnt vmcnt(0)" ::: "memory");
    __syncthreads();
    if (threadIdx.x == 0) {
        unsigned* bar = b.bar;
        __builtin_amdgcn_s_waitcnt(0);
        unsigned nloc = b.st[0], nx = b.st[1];
        if (nloc == 0u) { unsigned dense = 0u; xcd_barrier_complete(bar, b.x, nloc, nx, dense); b.st[0] = nloc; b.st[1] = nx; b.st[3] = dense; }
        const unsigned old = xb_add(&bar[XB_XSUB(b.x)], 1u);
        const unsigned gen = old / nloc;
        if (old + 1u == (gen + 1u) * nloc) {
            __builtin_amdgcn_fence(__ATOMIC_RELEASE, "agent");
            asm volatile("s_waitcnt vmcnt(0)" ::: "memory");
            const unsigned og = xb_add(&bar[XB_TOP], 1u);
            const unsigned tg = og / nx;
            if (og + 1u == (tg + 1u) * nx) xb_add(&bar[XB_TOPGEN], 1u);
            else XB_SPIN(xb_ld(&bar[XB_TOPGEN]) == tg, bar);
            __builtin_amdgcn_fence(__ATOMIC_ACQUIRE, "agent");
            xb_add(&bar[XB_XGEN(b.x)], 1u);
            asm volatile("s_waitcnt vmcnt(0)" ::: "memory");
        } else {
            XB_SPIN(xb_ld(&bar[XB_XGEN(b.x)]) == gen, bar);
            __builtin_amdgcn_fence(__ATOMIC_ACQUIRE, "agent");
            asm volatile("s_waitcnt vmcnt(0)" ::: "memory");
        }
    }
    __syncthreads();
}

enum { PH_CONV, PH_INPROJ0, PH_LOCAL, PH_SCAN, PH_HOUT, PH_OUTPROJ0, PH_Q0, PH_TOPK0, PH_PD0, PH_PR0, PH_PU0, PH_INPROJ1, PH_SMALL, PH_MLAPREP, PH_MLA,
       PH_OUTPROJ1, PH_Q1, PH_TOPK1, PH_PD1, PH_PR1, PH_PU1, N_PHASES };
DEVI void run_phase(const Params& p, int ph_in, char* smem, Placement pl) {
    const bool dup = ph_in >= 100; const int ph = dup ? ph_in - 100 : ph_in;
#ifdef ONLY_PHASE
    if (ph != ONLY_PHASE) return;
#endif
    char* ws = p.ws;
    const int bid = blockIdx.x, nb = gridDim.x;
    const int myslice = (pl.nloc > 0) ? (pl.xcc & 7) : (bid & 7);
    switch (ph) {
    case PH_CONV: phase_convert(p, smem); break;
    case PH_INPROJ0: gemm2_phase((const bf16_t*)(ws + OFF_XB), 1024, (const bf16_t*)(ws + OFF_W_IN0T), 128, 12, 1024, (const float*)(ws + OFF_SSQ1), 1,
                        Epi2In0{(bf16_t*)(ws + OFF_Z0), (float*)(ws + OFF_G), (const float*)(ws + OFF_LB), (bf16_t*)(ws + OFF_Z0), 3072, 3072, nullptr, nullptr}, smem, pl); break;
    case PH_LOCAL: for (int it = bid; it < 1024; it += nb) hgrn_local_item(p, it, smem);
            for (int it = nb - 1 - bid; it < 512; it += nb) gmlp_item(p, it, smem);
            break;
    case PH_SCAN: hgrn_scan_phase(p); break;
    case PH_HOUT: for (int it = bid; it < 1024; it += nb) hgrn_out_item(p, it, smem); break;
    case PH_OUTPROJ0: case PH_OUTPROJ1: {
        const bool l1 = (ph == PH_OUTPROJ1);
        gemm2_phase((const bf16_t*)(ws + (l1 ? OFF_MIX1 : OFF_MIX0)), 1024, (const bf16_t*)(ws + (l1 ? OFF_W_OUT1T : OFF_W_OUT0T)), 128, 4, 1024, nullptr, 0,
                    Epi2Resid{(bf16_t*)(ws + OFF_XB), (float*)(ws + OFF_SSQ16), dup ? 0.f : (l1 ? ALPHA_M1 : ALPHA_M0), nullptr, 0, 0, nullptr, nullptr}, smem, pl);
    } break;
    case PH_Q0: case PH_Q1: {
        const bool l1 = (ph == PH_Q1);
        gemm2_phase((const bf16_t*)(ws + OFF_XB), 1024, (const bf16_t*)(ws + (l1 ? OFF_W_Q1T : OFF_W_Q0T)), 128, 8, 1024, (const float*)(ws + OFF_SSQ16), 16,
                    Epi2Bf16{(bf16_t*)(ws + OFF_QP), 2048, 2048, nullptr, nullptr}, smem, pl);
    } break;
    case PH_TOPK0: case PH_TOPK1: peer_topk_phase(p, (const bf16_t*)(ws + (ph == PH_TOPK1 ? OFF_SK1 : OFF_SK0)), bid, nb, smem); break;
    case PH_PD0: case PH_PD1: peer_down_phase(p, (ph == PH_PD1) ? p.l1_norm_ffn : p.l0_norm_ffn, ((ph == PH_PD1) ? 16 : 0) + (dup ? 32 : 0), myslice, smem); break;
    case PH_PR0: case PH_PR1: peer_reduce_phase(p); break;
    case PH_PU0: case PH_PU1: peer_up_phase(p, ((ph == PH_PU1) ? 24 : 8) + (dup ? 32 : 0), myslice, dup ? 0.f : ((ph == PH_PU1) ? ALPHA_P1 : ALPHA_P0), (ph == PH_PU1 && !dup) ? p.out : nullptr, smem); break;
    case PH_INPROJ1: gemm2_phase((const bf16_t*)(ws + OFF_XB), 1024, (const bf16_t*)(ws + OFF_W_IN1T), 128, 8, 1024, (const float*)(ws + OFF_SSQ8), 8, Epi2Bf16{(bf16_t*)(ws + OFF_Z1), 1984, 1984, (float*)(ws + OFF_SSQCQ), (float*)(ws + OFF_SSQCKV)}, smem, pl);
            for (int it = bid; it < 8192; it += nb) conv_experts(p.l1_exp_down, p.l1_exp_up, p.l1_norm_ffn, ws, it);
            break;
    case PH_SMALL: {
        gemm2_phase((const bf16_t*)(ws + OFF_Z1), 1984, (const bf16_t*)(ws + OFF_W_UQT), 128, 3, 256, (const float*)(ws + OFF_SSQCQ), 1, Epi2Bf16{(bf16_t*)(ws + OFF_QC), 768, 768, nullptr, nullptr}, smem, pl);
        gemm2_phase((const bf16_t*)(ws + OFF_Z1) + 256, 1984, (const bf16_t*)(ws + OFF_W_UKVT), 128, 4, 128, (const float*)(ws + OFF_SSQCKV), 1, Epi2Bf16{(bf16_t*)(ws + OFF_KV), 1024, 1024, nullptr, nullptr}, smem, pl);
        for (int it = (bid + nb / 2) % nb; it < 1024 + 256; it += nb) { if (it < 1024) moba_prep_item(p, it, smem); else moba_kmean_item(p, it - 1024, smem); }
    } break;
    case PH_MLAPREP: for (int it = bid; it < 1024; it += nb) mla_prep_item(p, it, smem); break;
    case PH_MLA: attn_phase_all(p, smem); break;
    default: break;
    }
}

extern "C" __global__ void __launch_bounds__(NTHREADS, 2) fwd_kernel(Params p) {
    extern __shared__ __attribute__((aligned(16))) char smem[];
    __shared__ uint4 xb_words;
    XcdBarrier xb; xb.bar = nullptr; xb.x = 0; xb.st = (volatile LAS unsigned*)&xb_words;
    if (p.coop) {
        if (threadIdx.x == 0) xb_words = make_uint4(0u, 0u, 0u, 0u);
        __syncthreads();
        xb = xcd_barrier_post((unsigned*)(p.ws + OFF_BAR), (volatile LAS unsigned*)&xb_words);
    }
    if (p.coop == 2) cg::this_grid().sync();
#define RUN_PH(PH) if (p.ph_lo <= PH && PH < p.ph_hi) { \
        Placement pl_; pl_.xcc = p.coop ? (int)xb.st[3] : 0; pl_.rank = p.coop ? (int)xb.st[2] : 0; pl_.nloc = p.coop ? (int)xb.st[0] : 0; pl_.nx = p.coop ? (int)xb.st[1] : 0; \
        if (PROBE_DUP == PH) { run_phase(p, PH + 100, smem, pl_); if (p.coop) xcd_barrier(xb); } \
        run_phase(p, PH, smem, pl_); if (p.coop && PH + 1 < p.ph_hi) xcd_barrier(xb); }
    RUN_PH(0) RUN_PH(1) RUN_PH(2) RUN_PH(3) RUN_PH(4) RUN_PH(5) RUN_PH(6) RUN_PH(7) RUN_PH(8) RUN_PH(9)
    RUN_PH(10) RUN_PH(11) RUN_PH(12) RUN_PH(13) RUN_PH(14) RUN_PH(15) RUN_PH(16) RUN_PH(17) RUN_PH(18) RUN_PH(19) RUN_PH(20)
}

extern "C" void kernel_launch(void* const* d_in, const int* in_sizes, int n_in, void* d_out, int out_size, void* d_ws, size_t ws_size, hipStream_t stream) {
    static int grid = 0;
    if (grid == 0) {
        if (n_in != 31 || out_size != 16384 * 1024 || ws_size < WS_NEED) { fprintf(stderr, "kernel_launch: unexpected shapes (n_in %d out %d ws %zu need %zu)\n", n_in, out_size, ws_size, (size_t)WS_NEED); grid = -1; return; }
        int dev = 0, cus = 0, per_cu = 0;
        hipGetDevice(&dev);
        hipDeviceGetAttribute(&cus, hipDeviceAttributeMultiprocessorCount, dev);
        if (hipFuncSetAttribute((const void*)fwd_kernel, hipFuncAttributeMaxDynamicSharedMemorySize, LDS_BYTES) != hipSuccess) { fprintf(stderr, "kernel_launch: hipFuncSetAttribute failed\n"); grid = -1; return; }
        if (hipOccupancyMaxActiveBlocksPerMultiprocessor(&per_cu, (const void*)fwd_kernel, NTHREADS, LDS_BYTES) != hipSuccess || per_cu < 1) { fprintf(stderr, "kernel_launch: occupancy query failed (%d)\n", per_cu); per_cu = 1; }
        (void)hipGetLastError();
        if (per_cu > 2) per_cu = 2;
        grid = cus * per_cu;
        fprintf(stderr, "kernel_launch: grid %d (%d CUs x %d)\n", grid, cus, per_cu);
    }
    if (grid < 0) return;
    Params p; memset(&p, 0, sizeof(p));
    const float* const* f = (const float* const*)d_in;
    p.x = f[0]; p.pos = (const int*)d_in[1]; p.lb_logits = f[2];
    p.l0_norm_mix = f[3]; p.l0_w_in = f[4]; p.l0_hgrn_out_norm = f[5]; p.l0_gmlp_v_norm = f[6]; p.l0_gmlp_w_s = f[7]; p.l0_gmlp_b_s = f[8]; p.l0_w_out = f[9];
    p.l0_norm_ffn = f[10]; p.l0_w_query = f[11]; p.l0_sub_keys = f[12]; p.l0_exp_down = f[13]; p.l0_exp_up = f[14];
    p.l1_norm_mix = f[15]; p.l1_w_in = f[16]; p.l1_cq_norm = f[17]; p.l1_ckv_norm = f[18]; p.l1_w_uq = f[19]; p.l1_w_ukv = f[20];
    p.l1_q_norm = f[21]; p.l1_k_norm = f[22]; p.l1_mq_norm = f[23]; p.l1_mk_norm = f[24]; p.l1_w_out = f[25];
    p.l1_norm_ffn = f[26]; p.l1_w_query = f[27]; p.l1_sub_keys = f[28]; p.l1_exp_down = f[29]; p.l1_exp_up = f[30];
    p.out = (float*)d_out; p.ws = (char*)d_ws;
    if (hipMemsetAsync((char*)d_ws + OFF_BAR, 0, 16384 + 4096, stream) != hipSuccess) { fprintf(stderr, "kernel_launch: memset failed\n"); return; }
#if N_LAUNCH_MODE == 1
    p.ph_lo = 0; p.ph_hi = N_PHASES; p.coop = 1;
    void* args[] = {&p};
    hipError_t e = hipLaunchCooperativeKernel((const void*)fwd_kernel, dim3(grid), dim3(NTHREADS), args, LDS_BYTES, stream);
    if (e != hipSuccess) fprintf(stderr, "cooperative launch failed: %s (grid %d)\n", hipGetErrorString(e), grid);
#else
    for (int ph = 0; ph < N_PHASES; ++ph) {
#ifdef ABLATE_M1
        if (ph >= 10 && ph <= 14) continue;
#endif
        p.ph_lo = ph; p.ph_hi = ph + 1; p.coop = 0;
        hipLaunchKernelGGL(fwd_kernel, dim3(grid), dim3(NTHREADS), LDS_BYTES, stream, p);
    }
#endif
}
```

```cpp
#include <hip/hip_runtime.h>
#include <hip/hip_cooperative_groups.h>
#include <stdint.h>
#include <stdio.h>
#include <string.h>
namespace cg = cooperative_groups;

#ifndef ALPHA_P0
#define ALPHA_P0 1.0f
#endif
#ifndef ALPHA_P1
#define ALPHA_P1 1.0f
#endif
#ifndef ALPHA_M0
#define ALPHA_M0 1.0f
#endif
#ifndef ALPHA_M1
#define ALPHA_M1 1.0f
#endif
#define PROBE_TIME -1
#define PROBE_GEMM 0
#define PROBE_TIME_K 4
#ifndef PROBE_NOMMA
#define PROBE_NOMMA 0
#endif
#ifndef PROBE_DUP
#define PROBE_DUP -1
#endif
#ifndef N_LAUNCH_MODE
#define N_LAUNCH_MODE 1
#endif

typedef unsigned short bf16_t;
using bf16x8 = __attribute__((ext_vector_type(8))) short;
using f32x4  = __attribute__((ext_vector_type(4))) float;
using f32x16 = __attribute__((ext_vector_type(16))) float;
typedef float f32x4v __attribute__((ext_vector_type(4)));
typedef float f32x2_t __attribute__((ext_vector_type(2)));
typedef __bf16 bf16x2_t __attribute__((ext_vector_type(2)));
typedef unsigned u32x4 __attribute__((ext_vector_type(4)));

#define DEVI __device__ __forceinline__
#define NTHREADS 256
#define LDS_BYTES 80896

static constexpr size_t MB = 1024 * 1024;
static constexpr size_t OFF_W_IN0T  = 0;
static constexpr size_t OFF_W_OUT0T = OFF_W_IN0T  + 3072ull * 1024 * 2;
static constexpr size_t OFF_W_Q0T   = OFF_W_OUT0T + 1024ull * 1024 * 2;
static constexpr size_t OFF_SK0     = OFF_W_Q0T   + 2048ull * 1024 * 2;
static constexpr size_t OFF_WS0     = OFF_SK0     + 262144ull * 2;
static constexpr size_t OFF_W_IN1T  = OFF_WS0     + 65536ull * 2;
static constexpr size_t OFF_W_UQT   = OFF_W_IN1T  + 2048ull * 1024 * 2;
static constexpr size_t OFF_W_UKVT  = OFF_W_UQT   + 768ull * 256 * 2;
static constexpr size_t OFF_W_OUT1T = OFF_W_UKVT  + 1024ull * 128 * 2;
static constexpr size_t OFF_W_Q1T   = OFF_W_OUT1T + 1024ull * 1024 * 2;
static constexpr size_t OFF_SK1     = OFF_W_Q1T   + 2048ull * 1024 * 2;
static constexpr size_t OFF_LB      = OFF_SK1     + 262144ull * 2;
static constexpr size_t OFF_INVD    = OFF_LB + 4096;
static constexpr size_t OFF_INVU    = OFF_INVD + 65536;
static constexpr size_t OFF_BAR     = OFF_INVU + 65536;
static constexpr size_t OFF_QCNT    = OFF_BAR + 14336;
static constexpr size_t OFF_ED      = 26 * MB;
static constexpr size_t OFF_EU      = OFF_ED + 32 * MB;
static constexpr size_t OFF_ACT     = OFF_EU + 32 * MB;
static constexpr size_t OFF_Z0   = OFF_ACT;
static constexpr size_t OFF_G    = OFF_Z0  + 16384ull * 3072 * 2;
static constexpr size_t OFF_HST  = OFF_G   + 16384ull * 512 * 4;
static constexpr size_t OFF_DEC  = OFF_HST + 1024ull * 16384 * 4;
static constexpr size_t OFF_MIX0 = OFF_DEC + 1024ull * 128 * 4;
static constexpr size_t OFF_QP   = OFF_ACT;
static constexpr size_t OFF_IDX  = OFF_QP  + 16384ull * 2048 * 2;
static constexpr size_t OFF_GATE = OFF_IDX + 16384ull * 128 * 4;
static constexpr size_t OFF_ACTW = OFF_GATE + 16384ull * 128 * 4;
static constexpr size_t OFF_PART = OFF_QP;
static constexpr size_t OFF_SDN  = OFF_ACTW + 16384ull * 128 * 4;
static constexpr size_t OFF_UREC = OFF_SDN + 16384ull * 128 * 4;
static constexpr size_t OFF_Z1   = OFF_ACT;
static constexpr size_t OFF_MIX1 = OFF_ACT;
static constexpr size_t OFF_QC   = OFF_Z1  + 16384ull * 1984 * 2;
static constexpr size_t OFF_KV   = OFF_QC  + 16384ull * 768 * 2;
static constexpr size_t OFF_QD   = OFF_KV  + 16384ull * 1024 * 2;
static constexpr size_t OFF_KD   = OFF_QD  + 16384ull * 512 * 2;
static constexpr size_t OFF_VDT  = OFF_KD  + 16384ull * 512 * 2;
static constexpr size_t OFF_Q    = OFF_VDT + 16384ull * 512 * 2;
static constexpr size_t OFF_K    = OFF_Q   + 16384ull * 768 * 2;
static constexpr size_t OFF_VT   = OFF_K   + 16384ull * 768 * 2;
static constexpr size_t OFF_KMEAN= OFF_VT  + 16384ull * 512 * 2;
static constexpr size_t WS_END_L1 = OFF_KMEAN + 8ull * 32 * 128 * 4;
static constexpr size_t WS_END_L0 = OFF_MIX0 + 16384ull * 1024 * 2;
static constexpr size_t WS_END_ACT = (WS_END_L1 > WS_END_L0 ? WS_END_L1 : WS_END_L0);
static constexpr size_t OFF_XB    = (WS_END_ACT + 255) / 256 * 256;
static constexpr size_t OFF_SSQ1  = OFF_XB + 16384ull * 1024 * 2;
static constexpr size_t OFF_SSQ16 = OFF_SSQ1 + 16384ull * 4;
static constexpr size_t OFF_SSQ8  = OFF_SSQ16 + 16384ull * 16 * 4;
static constexpr size_t OFF_XB8   = OFF_ED + 16 * MB;
static constexpr size_t OFF_SSQCQ = OFF_SSQ8 + 16384ull * 8 * 4;
static constexpr size_t OFF_SSQCKV = OFF_SSQCQ + 16384ull * 4;
static constexpr size_t WS_NEED = OFF_SSQCKV + 16384ull * 4;
static_assert(OFF_BAR + 16384 + 4096 <= OFF_ED, "weights overflow");

struct Params {
    const float* x; const int* pos; const float* lb_logits;
    const float *l0_norm_mix, *l0_w_in, *l0_hgrn_out_norm, *l0_gmlp_v_norm, *l0_gmlp_w_s, *l0_gmlp_b_s, *l0_w_out,
                *l0_norm_ffn, *l0_w_query, *l0_sub_keys, *l0_exp_down, *l0_exp_up;
    const float *l1_norm_mix, *l1_w_in, *l1_cq_norm, *l1_ckv_norm, *l1_w_uq, *l1_w_ukv, *l1_q_norm, *l1_k_norm,
                *l1_mq_norm, *l1_mk_norm, *l1_w_out, *l1_norm_ffn, *l1_w_query, *l1_sub_keys, *l1_exp_down, *l1_exp_up;
    float* out;
    char* ws;
    int ph_lo, ph_hi, coop, pad0;
};

DEVI unsigned pack2(float lo, float hi) { f32x2_t v = {lo, hi}; bf16x2_t b = __builtin_convertvector(v, bf16x2_t); return __builtin_bit_cast(unsigned, b); }
DEVI bf16_t f2bf(float f) { return (bf16_t)(pack2(f, 0.f) & 0xffffu); }
DEVI float bf2f(bf16_t h) { return __uint_as_float(((unsigned)h) << 16); }
DEVI float bflo(unsigned u) { return __uint_as_float(u << 16); }
DEVI float bfhi(unsigned u) { return __uint_as_float(u & 0xffff0000u); }
DEVI float sigm(float x) { return 1.f / (1.f + __expf(-x)); }
DEVI float gelu_tanh(float x) {
    float y = 0.7978845608028654f * (x + 0.044715f * x * x * x);
    float e = __expf(2.f * y);
    float t = 1.f - 2.f / (1.f + e);
    return 0.5f * x * (1.f + t);
}
DEVI char* opaque_ptr(char* q) { asm volatile("" : "+s"(q)); return q; }
DEVI f32x4  mfma16(bf16x8 a, bf16x8 b, f32x4 c)  { return __builtin_amdgcn_mfma_f32_16x16x32_bf16(a, b, c, 0, 0, 0); }
DEVI f32x16 mfma32(bf16x8 a, bf16x8 b, f32x16 c) { return __builtin_amdgcn_mfma_f32_32x32x16_bf16(a, b, c, 0, 0, 0); }

template <int KW> DEVI int swz_off(int row, int c) {
    if constexpr (KW == 128) return row * 256 + ((c ^ (row & 15)) << 4);
    else return row * (KW * 2) + ((c ^ ((row >> 1) & 7)) << 4);
}
template <int KW> DEVI int swz_elem(int row, int k) { return swz_off<KW>(row, k >> 3) + ((k & 7) << 1); }

template <int MT, int NT, int KWA, int KWB>
DEVI void mma_nt(f32x4 (&acc)[MT][NT], const char* A, int a_row0, const char* B, int b_row0, int kc0, int nks, int lane) {
    const int r = lane & 15, q = lane >> 4;
#pragma unroll 1
    for (int ks = 0; ks < nks; ++ks) {
        bf16x8 a[MT], b[NT];
#pragma unroll
        for (int i = 0; i < MT; ++i) a[i] = *(const bf16x8*)(A + swz_off<KWA>(a_row0 + 16 * i + r, kc0 + ks * 4 + q));
#pragma unroll
        for (int j = 0; j < NT; ++j) b[j] = *(const bf16x8*)(B + swz_off<KWB>(b_row0 + 16 * j + r, kc0 + ks * 4 + q));
#pragma unroll
        for (int i = 0; i < MT; ++i)
#pragma unroll
            for (int j = 0; j < NT; ++j) acc[i][j] = mfma16(a[i], b[j], acc[i][j]);
    }
}

DEVI void conv_transpose_tile(const float* __restrict__ src, int K, int N, bf16_t* __restrict__ dst, int kt, int nt, char* smem, const float* __restrict__ kgain = nullptr) {
    float* s = (float*)smem;
    const int tid = threadIdx.x;
    for (int e = tid; e < 4096; e += NTHREADS) {
        int kk = e >> 6, nn = e & 63;
        int n = nt * 64 + nn;
        const float gk = kgain ? kgain[kt * 64 + kk] : 1.f;
        s[kk * 65 + nn] = (n < N) ? src[(size_t)(kt * 64 + kk) * N + n] * gk : 0.f;
    }
    __syncthreads();
    for (int e = tid; e < 2048; e += NTHREADS) {
        int nn = e >> 5, kp = e & 31;
        unsigned v = pack2(s[(2 * kp) * 65 + nn], s[(2 * kp + 1) * 65 + nn]);
        *(unsigned*)(dst + (size_t)(nt * 64 + nn) * K + kt * 64 + 2 * kp) = v;
    }
    __syncthreads();
}
DEVI void conv_plain_chunk(const float* __restrict__ src, bf16_t* __restrict__ dst, size_t chunk) {
    const int tid = threadIdx.x;
    size_t base = chunk * 4096 + (size_t)tid * 16;
    const float4* s4 = (const float4*)(src + base);
    float4 a = s4[0], b = s4[1], c = s4[2], d = s4[3];
    uint4 o0, o1;
    o0.x = pack2(a.x, a.y); o0.y = pack2(a.z, a.w); o0.z = pack2(b.x, b.y); o0.w = pack2(b.z, b.w);
    o1.x = pack2(c.x, c.y); o1.y = pack2(c.z, c.w); o1.z = pack2(d.x, d.y); o1.w = pack2(d.z, d.w);
    uint4* d4 = (uint4*)(dst + base);
    d4[0] = o0; d4[1] = o1;
}
DEVI void conv_experts(const float* down, const float* up, const float* __restrict__ dgain, char* ws, int it  ) {
    const int lane = threadIdx.x & 63, wave = threadIdx.x >> 6;
    const bool isup = it >= 4096;
    const int row = (isup ? it - 4096 : it) * 4 + wave;
    const float* src = (isup ? up : down) + (size_t)row * 1024 + 16 * lane;
    float4 a = *(const float4*)src, b = *(const float4*)(src + 4), c = *(const float4*)(src + 8), d = *(const float4*)(src + 12);
    if (!isup) {
        const float4 ga = *(const float4*)(dgain + 16 * lane), gb = *(const float4*)(dgain + 16 * lane + 4), gc = *(const float4*)(dgain + 16 * lane + 8), gd = *(const float4*)(dgain + 16 * lane + 12);
        a.x *= ga.x; a.y *= ga.y; a.z *= ga.z; a.w *= ga.w; b.x *= gb.x; b.y *= gb.y; b.z *= gb.z; b.w *= gb.w;
        c.x *= gc.x; c.y *= gc.y; c.z *= gc.z; c.w *= gc.w; d.x *= gd.x; d.y *= gd.y; d.z *= gd.z; d.w *= gd.w;
    }
    float mx = fmaxf(fmaxf(fmaxf(fabsf(a.x), fabsf(a.y)), fmaxf(fabsf(a.z), fabsf(a.w))), fmaxf(fmaxf(fabsf(b.x), fabsf(b.y)), fmaxf(fabsf(b.z), fabsf(b.w))));
    mx = fmaxf(mx, fmaxf(fmaxf(fmaxf(fabsf(c.x), fabsf(c.y)), fmaxf(fabsf(c.z), fabsf(c.w))), fmaxf(fmaxf(fabsf(d.x), fabsf(d.y)), fmaxf(fabsf(d.z), fabsf(d.w)))));
#pragma unroll
    for (int o = 1; o < 64; o <<= 1) mx = fmaxf(mx, __shfl_xor(mx, o));
    const float sc = (mx > 0.f) ? 416.f / mx : 1.f;
    const float inv = (mx > 0.f) ? mx / 416.f : 1.f;
    int w0 = 0, w1 = 0, w2 = 0, w3 = 0;
    w0 = __builtin_amdgcn_cvt_pk_fp8_f32(a.x * sc, a.y * sc, w0, false); w0 = __builtin_amdgcn_cvt_pk_fp8_f32(a.z * sc, a.w * sc, w0, true);
    w1 = __builtin_amdgcn_cvt_pk_fp8_f32(b.x * sc, b.y * sc, w1, false); w1 = __builtin_amdgcn_cvt_pk_fp8_f32(b.z * sc, b.w * sc, w1, true);
    w2 = __builtin_amdgcn_cvt_pk_fp8_f32(c.x * sc, c.y * sc, w2, false); w2 = __builtin_amdgcn_cvt_pk_fp8_f32(c.z * sc, c.w * sc, w2, true);
    w3 = __builtin_amdgcn_cvt_pk_fp8_f32(d.x * sc, d.y * sc, w3, false); w3 = __builtin_amdgcn_cvt_pk_fp8_f32(d.z * sc, d.w * sc, w3, true);
    *(int4*)(ws + (isup ? OFF_EU : OFF_ED) + ((size_t)(lane >> 3) * 16384 + row) * 128 + 16 * (lane & 7)) = int4{w0, w1, w2, w3};
    if (lane == 0) ((float*)(ws + (isup ? OFF_INVU : OFF_INVD)))[row] = inv;
}

DEVI void phase_convert(const Params& p, char* smem) {
    char* ws = p.ws;
    const int bid = blockIdx.x, nb = gridDim.x;
    for (int t = bid; t < 768; t += nb) conv_transpose_tile(p.l0_w_in,    1024, 3072, (bf16_t*)(ws + OFF_W_IN0T),  t / 48, t % 48, smem, p.l0_norm_mix);
    for (int t = (bid + nb - 256 % nb) % nb; t < 256; t += nb) conv_transpose_tile(p.l0_w_out,   1024, 1024, (bf16_t*)(ws + OFF_W_OUT0T), t / 16, t % 16, smem);
    for (int t = bid; t < 512; t += nb) conv_transpose_tile(p.l0_w_query, 1024, 2048, (bf16_t*)(ws + OFF_W_Q0T),   t / 32, t % 32, smem, p.l0_norm_ffn);
    for (int t = bid; t < 512; t += nb) conv_transpose_tile(p.l1_w_in,    1024, 1984, (bf16_t*)(ws + OFF_W_IN1T),  t / 32, t % 32, smem, p.l1_norm_mix);
    for (int t = bid; t < 48; t += nb)  conv_transpose_tile(p.l1_w_uq,     256,  768, (bf16_t*)(ws + OFF_W_UQT),   t / 12, t % 12, smem, p.l1_cq_norm);
    for (int t = nb - 1 - bid; t < 32; t += nb)  conv_transpose_tile(p.l1_w_ukv,    128, 1024, (bf16_t*)(ws + OFF_W_UKVT),  t / 16, t % 16, smem, p.l1_ckv_norm);
    for (int t = (bid + nb - 256 % nb) % nb; t < 256; t += nb) conv_transpose_tile(p.l1_w_out,   1024, 1024, (bf16_t*)(ws + OFF_W_OUT1T), t / 16, t % 16, smem);
    for (int t = bid; t < 512; t += nb) conv_transpose_tile(p.l1_w_query, 1024, 2048, (bf16_t*)(ws + OFF_W_Q1T),   t / 32, t % 32, smem, p.l1_norm_ffn);
    for (int t = bid - 64; t < 64; t += nb) if (t >= 0) conv_plain_chunk(p.l0_sub_keys, (bf16_t*)(ws + OFF_SK0), t);
    for (int t = bid - 128; t < 64; t += nb) if (t >= 0) conv_plain_chunk(p.l1_sub_keys, (bf16_t*)(ws + OFF_SK1), t);
    for (int chunk = bid - 192; chunk < 16; chunk += nb) if (chunk >= 0) {
        bf16_t* dst = (bf16_t*)(ws + OFF_WS0);
        for (int e = threadIdx.x; e < 4096; e += NTHREADS) {
            int idx = chunk * 4096 + e; int t = (idx >> 7) & 127, sI = idx & 127;
            dst[idx] = f2bf(sI <= t ? p.l0_gmlp_w_s[idx] : 0.f);
        }
    }
    if (bid == nb - 1) {
        float* lb = (float*)(ws + OFF_LB);
        for (int c = threadIdx.x; c < 512; c += NTHREADS) {
            float a0 = p.lb_logits[c], a1 = p.lb_logits[512 + c], a2 = p.lb_logits[1024 + c];
            float m = fmaxf(a0, fmaxf(a1, a2));
            float e0 = __expf(a0 - m), e1 = __expf(a1 - m), e2 = __expf(a2 - m);
            lb[c] = e0 / (e0 + e1 + e2);
        }
    }
    for (int it = bid; it < 8192; it += nb) conv_experts(p.l0_exp_down, p.l0_exp_up, p.l0_norm_ffn, ws, it);
    {
        const int lane = threadIdx.x & 63, wave = threadIdx.x >> 6;
        for (int it = bid; it < 4096; it += nb) {
            const size_t row = (size_t)it * 4 + wave;
            const float* xr = p.x + row * 1024 + 16 * lane;
            const float4 a = *(const float4*)xr, b = *(const float4*)(xr + 4), c = *(const float4*)(xr + 8), d = *(const float4*)(xr + 12);
            float ss = a.x * a.x + a.y * a.y + a.z * a.z + a.w * a.w + b.x * b.x + b.y * b.y + b.z * b.z + b.w * b.w
                     + c.x * c.x + c.y * c.y + c.z * c.z + c.w * c.w + d.x * d.x + d.y * d.y + d.z * d.z + d.w * d.w;
#pragma unroll
            for (int o = 1; o < 64; o <<= 1) ss += __shfl_xor(ss, o);
            uint4 o0, o1;
            o0.x = pack2(a.x, a.y); o0.y = pack2(a.z, a.w); o0.z = pack2(b.x, b.y); o0.w = pack2(b.z, b.w);
            o1.x = pack2(c.x, c.y); o1.y = pack2(c.z, c.w); o1.z = pack2(d.x, d.y); o1.w = pack2(d.z, d.w);
            bf16_t* xb = (bf16_t*)(ws + OFF_XB) + row * 1024 + 16 * lane;
            *(uint4*)xb = o0; *(uint4*)(xb + 8) = o1;
            if (lane == 0) ((float*)(ws + OFF_SSQ1))[row] = ss;
        }
    }
}

template <int AMODE, class Epi>
DEVI void gemm_phase(const void* __restrict__ Aptr, int lda, const float* __restrict__ gain, const bf16_t* __restrict__ Bt,
                           int M, int Npad, int K, Epi epi, char* smem, int blk0, int nblk) {
    const int tid = threadIdx.x, lane = tid & 63, wave = tid >> 6;
    const int wm = wave >> 1, wn = wave & 1;
    const int tn = Npad / 128, tm = M / 128, nkt = K / 64;
    float* sRstd = (float*)(smem + 65536);
    const int crow = tid >> 3, cc = tid & 7;
    for (int tile = blk0; tile < tm * tn; tile += nblk) {
        const int m0 = (tile / tn) * 128, n0 = (tile % tn) * 128;
        f32x4 acc[4][4];
#pragma unroll
        for (int i = 0; i < 4; ++i)
#pragma unroll
            for (int j = 0; j < 4; ++j) acc[i][j] = f32x4{0.f, 0.f, 0.f, 0.f};
        float ss[4] = {0.f, 0.f, 0.f, 0.f};
        f32x4v ra[4][2]; u32x4 rab[4]; u32x4 rb[4]; f32x4v g0, g1;
        auto gload = [&](int kt) {
            const int k0 = kt * 64 + cc * 8;
#pragma unroll
            for (int i = 0; i < 4; ++i) {
                const int row = crow + 32 * i;
                if constexpr (AMODE == 0) {
                    const float* pa = (const float*)Aptr + (size_t)(m0 + row) * lda + k0;
                    ra[i][0] = *(const f32x4v*)pa; ra[i][1] = *(const f32x4v*)(pa + 4);
                } else {
                    const bf16_t* pa = (const bf16_t*)Aptr + (size_t)(m0 + row) * lda + k0;
                    rab[i] = *(const u32x4*)pa;
                }
                rb[i] = *(const u32x4*)(Bt + (size_t)(n0 + row) * K + k0);
            }
            if constexpr (AMODE != 1) { g0 = *(const f32x4v*)(gain + k0); g1 = *(const f32x4v*)(gain + k0 + 4); }
        };
        auto lstore = [&](int buf) {
            char* sA = smem + buf * 32768; char* sB = sA + 16384;
#pragma unroll
            for (int i = 0; i < 4; ++i) {
                const int row = crow + 32 * i;
                u32x4 o;
                if constexpr (AMODE == 0) {
                    f32x4v a = ra[i][0], b = ra[i][1];
                    ss[i] += a.x * a.x + a.y * a.y + a.z * a.z + a.w * a.w + b.x * b.x + b.y * b.y + b.z * b.z + b.w * b.w;
                    o.x = pack2(a.x * g0.x, a.y * g0.y); o.y = pack2(a.z * g0.z, a.w * g0.w);
                    o.z = pack2(b.x * g1.x, b.y * g1.y); o.w = pack2(b.z * g1.z, b.w * g1.w);
                } else if constexpr (AMODE == 2) {
                    u32x4 u = rab[i];
                    float a0 = bflo(u.x), a1 = bfhi(u.x), a2 = bflo(u.y), a3 = bfhi(u.y), a4 = bflo(u.z), a5 = bfhi(u.z), a6 = bflo(u.w), a7 = bfhi(u.w);
                    ss[i] += a0 * a0 + a1 * a1 + a2 * a2 + a3 * a3 + a4 * a4 + a5 * a5 + a6 * a6 + a7 * a7;
                    o.x = pack2(a0 * g0.x, a1 * g0.y); o.y = pack2(a2 * g0.z, a3 * g0.w);
                    o.z = pack2(a4 * g1.x, a5 * g1.y); o.w = pack2(a6 * g1.z, a7 * g1.w);
                } else o = rab[i];
                *(u32x4*)(sA + swz_off<64>(row, cc)) = o;
                *(u32x4*)(sB + swz_off<64>(row, cc)) = rb[i];
            }
        };
        gload(0); lstore(0); __syncthreads();
#pragma unroll 1
        for (int kt = 0; kt < nkt; ++kt) {
            if (kt + 1 < nkt) gload(kt + 1);
            const char* sA = smem + (kt & 1) * 32768; const char* sB = sA + 16384;
            mma_nt<4, 4, 64, 64>(acc, sA, wm * 64, sB, wn * 64, 0, 2, lane);
            if (kt + 1 < nkt) lstore((kt + 1) & 1);
            __syncthreads();
        }
        if constexpr (AMODE != 1) {
#pragma unroll
            for (int i = 0; i < 4; ++i) {
                float s = ss[i];
                s += __shfl_xor(s, 1); s += __shfl_xor(s, 2); s += __shfl_xor(s, 4);
                if (cc == 0) sRstd[crow + 32 * i] = rsqrtf(s / (float)K + 1e-6f);
            }
            __syncthreads();
        }
#pragma unroll
        for (int i = 0; i < 4; ++i)
#pragma unroll
            for (int r = 0; r < 4; ++r) {
                const int rl = wm * 64 + i * 16 + (lane >> 4) * 4 + r;
                const float rs = (AMODE != 1) ? sRstd[rl] : 1.f;
#pragma unroll
                for (int j = 0; j < 4; ++j) epi(m0 + rl, n0 + wn * 64 + j * 16 + (lane & 15), acc[i][j][r] * rs);
                __builtin_amdgcn_sched_barrier(0);
            }
    }
}

struct Placement { int xcc, rank, nloc, nx; };
#define G2_RAW_BARRIER() do { asm volatile("s_waitcnt lgkmcnt(0)" ::: "memory"); __builtin_amdgcn_s_barrier(); } while (0)
template <class Epi>
DEVI void gemm2_phase(const bf16_t* __restrict__ A, int lda, const bf16_t* __restrict__ Bt, int tm, int tn, int K,
                      const float* __restrict__ ssq, int nss, Epi epi, char* smem, Placement pl) {
    const int tid = threadIdx.x, lane = tid & 63;
    const int wave = __builtin_amdgcn_readfirstlane(tid >> 6);
    const int wm = wave >> 1, wn = wave & 1;
    const int nkt = K / 32;
    constexpr int STG = 24576;
    float* sRstd = (float*)(smem + 3 * STG);
    int xcd = blockIdx.x & 7, slot = blockIdx.x >> 3, nslots = gridDim.x >> 3, nxc = 8;
    if (pl.nloc > 0) { xcd = pl.xcc; slot = pl.rank; nslots = pl.nloc; nxc = pl.nx; }
    const int np = (tm + nxc - 1) / nxc;
    const int per_xcd = ((np + 7) >> 3) * tn * 8;
    const int Rl = (lane >> 4) & 3, gl = (((Rl ^ (Rl >> 1)) & 1) << 1) | (Rl >> 1);
    const int Rr = (lane >> 2) & 3, gr = (((Rr ^ (Rr >> 1)) & 1) << 1) | (Rr >> 1);
    const int ld_row = lane >> 2, ld_c = (lane & 3) ^ gl;
    const int rd_off = (lane & 15) * 64 + (((lane >> 4) ^ gr) << 4);
    for (int t = slot; t < per_xcd; t += nslots) {
        const int mi = t & 7, rest = t >> 3, nt_ = rest % tn, mg = rest / tn;
        const int pidx = mg * 8 + mi, panel = xcd + nxc * pidx;
        if (pidx >= np || panel >= tm) continue;
        const int m0 = panel * 128, n0 = nt_ * 256;
        if (ssq) { if (tid < 128) { float sacc = 0.f; for (int i = 0; i < nss; ++i) sacc += ssq[(size_t)(m0 + tid) * nss + i]; sRstd[tid] = rsqrtf(sacc / (float)K + 1e-6f); } }
        else if (tid < 128) sRstd[tid] = 1.f;
        const bf16_t* ga = A  + (size_t)(m0 + 32 * wave + ld_row) * lda + ld_c * 8;
        const bf16_t* gb = Bt + (size_t)(n0 + 64 * wave + ld_row) * K   + ld_c * 8;
        f32x4 acc[4][8];
#pragma unroll
        for (int i = 0; i < 4; ++i)
#pragma unroll
            for (int j = 0; j < 8; ++j) acc[i][j] = f32x4{0.f, 0.f, 0.f, 0.f};
#define G2_ISSUE(KT) { char* st_ = smem + ((KT) % 3) * STG; const int ko_ = (KT) * 32; \
            __builtin_amdgcn_global_load_lds((const unsigned*)(ga + ko_),                    (unsigned*)(st_ + wave * 2048),               16, 0, 0); \
            __builtin_amdgcn_global_load_lds((const unsigned*)(ga + (size_t)16 * lda + ko_), (unsigned*)(st_ + wave * 2048 + 1024),        16, 0, 0); \
            __builtin_amdgcn_global_load_lds((const unsigned*)(gb + ko_),                    (unsigned*)(st_ + 8192 + wave * 4096),        16, 0, 0); \
            __builtin_amdgcn_global_load_lds((const unsigned*)(gb + (size_t)16 * K + ko_),   (unsigned*)(st_ + 8192 + wave * 4096 + 1024), 16, 0, 0); \
            __builtin_amdgcn_global_load_lds((const unsigned*)(gb + (size_t)32 * K + ko_),   (unsigned*)(st_ + 8192 + wave * 4096 + 2048), 16, 0, 0); \
            __builtin_amdgcn_global_load_lds((const unsigned*)(gb + (size_t)48 * K + ko_),   (unsigned*)(st_ + 8192 + wave * 4096 + 3072), 16, 0, 0); }
        int nkt0 = nkt;
        const bool pr_dup = epi.D == nullptr && epi.N == 2048, pr_nodma = (PROBE_GEMM == 2) && pr_dup, pr_nomma = (PROBE_GEMM == 1) && pr_dup;
#define G2_RD_LO(KT, RA, RB) { const char* sA_ = smem + ((KT) % 3) * STG + rd_off; const char* sB_ = sA_ + 8192; \
            _Pragma("unroll") for (int i = 0; i < 4; ++i) RA[i] = *(const bf16x8*)(sA_ + (wm * 64 + 16 * i) * 64); \
            _Pragma("unroll") for (int j = 0; j < 4; ++j) RB[j] = *(const bf16x8*)(sB_ + (wn * 128 + 16 * j) * 64); }
#define G2_RD_HI(KT, RB) { const char* sB_ = smem + ((KT) % 3) * STG + rd_off + 8192; \
            _Pragma("unroll") for (int j = 0; j < 4; ++j) RB[j] = *(const bf16x8*)(sB_ + (wn * 128 + 64 + 16 * j) * 64); }
#define G2_MMA(RA, RB, J0) { _Pragma("unroll") for (int i = 0; i < 4; ++i) _Pragma("unroll") for (int j = 0; j < 4; ++j) acc[i][(J0) + j] = mfma16(RB[j], RA[i], acc[i][(J0) + j]); }
#define G2_STEP(KT, CA, CB, NA, NB) { \
            if ((KT) + 2 < nkt) asm volatile("s_waitcnt vmcnt(6)" ::: "memory"); else asm volatile("s_waitcnt vmcnt(0)" ::: "memory"); \
            __builtin_amdgcn_s_waitcnt(0xc07f); __builtin_amdgcn_s_barrier();        \
            G2_RD_HI(KT, bh) \
            __builtin_amdgcn_sched_barrier(0);        \
            if (!pr_nomma) G2_MMA(CA, CB, 0) \
            __builtin_amdgcn_sched_barrier(0); \
            G2_RD_LO((KT) + 1, NA, NB)        \
            __builtin_amdgcn_s_waitcnt(0xc87f);        \
            __builtin_amdgcn_sched_barrier(0); \
            if ((KT) + 3 < nkt && !pr_nodma) G2_ISSUE((KT) + 3)        \
            __builtin_amdgcn_sched_barrier(0); \
            if (!pr_nomma) G2_MMA(CA, bh, 4) \
            __builtin_amdgcn_sched_barrier(0); }
        bf16x8 a0[4], b0[4], a1[4], b1[4], bh[4];
        if ((PROBE_GEMM == 3) && pr_dup) {
#pragma unroll
            for (int i = 0; i < 4; ++i) { a0[i] = __builtin_bit_cast(bf16x8, u32x4{(unsigned)tid, 1u, 2u, 3u}); b0[i] = a0[i]; bh[i] = a0[i]; }
#pragma unroll 1
            for (int kt = 0; kt < nkt; ++kt) { G2_MMA(a0, b0, 0) G2_MMA(a0, bh, 4) __builtin_amdgcn_sched_barrier(0); }
            nkt0 = 0;
        }
        if (!pr_nodma) { G2_ISSUE(0) G2_ISSUE(1) if (2 < nkt) G2_ISSUE(2) }
        if (2 < nkt) asm volatile("s_waitcnt vmcnt(12)" ::: "memory"); else asm volatile("s_waitcnt vmcnt(6)" ::: "memory");
        G2_RAW_BARRIER();
        G2_RD_LO(0, a0, b0)
#pragma unroll 1
        for (int kt = 0; kt < nkt0; kt += 2) {
            G2_STEP(kt, a0, b0, a1, b1)
            G2_STEP(kt + 1, a1, b1, a0, b0)
        }
#undef G2_STEP
#undef G2_MMA
#undef G2_RD_LO
#undef G2_RD_HI
#undef G2_ISSUE
        if (epi.staged(n0)) {
            G2_RAW_BARRIER();
#pragma unroll
            for (int i = 0; i < 4; ++i) {
                const int rl = wm * 64 + i * 16 + (lane & 15);
                const float rs = sRstd[rl];
                char* trow = smem + rl * 528 + (wn * 128 + 4 * (lane >> 4)) * 2;
#pragma unroll
                for (int j = 0; j < 8; ++j) {
                    const int nc = n0 + wn * 128 + 16 * j + 4 * (lane >> 4);
                    *(uint2*)(trow + 32 * j) = uint2{pack2(epi.map(nc, acc[i][j][0] * rs), epi.map(nc + 1, acc[i][j][1] * rs)), pack2(epi.map(nc + 2, acc[i][j][2] * rs), epi.map(nc + 3, acc[i][j][3] * rs))};
                }
            }
            __syncthreads();
            float* const sqp = (n0 == 0) ? epi.SQ0 : ((n0 == 256) ? epi.SQ1 : nullptr);
#pragma unroll 4
            for (int i = 0; i < 16; ++i) {
                const int e = tid + 256 * i, row = e >> 5, cc = e & 31;
                const uint4 v = *(const uint4*)(smem + row * 528 + cc * 16);
                if (epi.D && n0 + cc * 8 < epi.N) __builtin_nontemporal_store(u32x4{v.x, v.y, v.z, v.w}, (u32x4*)(epi.D + (size_t)(m0 + row) * epi.ldd + n0 + cc * 8));
                if (sqp) {
                    float q = bflo(v.x) * bflo(v.x) + bfhi(v.x) * bfhi(v.x) + bflo(v.y) * bflo(v.y) + bfhi(v.y) * bfhi(v.y)
                            + bflo(v.z) * bflo(v.z) + bfhi(v.z) * bfhi(v.z) + bflo(v.w) * bflo(v.w) + bfhi(v.w) * bfhi(v.w);
                    if (n0 == 256 && cc >= 16) q = 0.f;
                    q += __shfl_xor(q, 1); q += __shfl_xor(q, 2); q += __shfl_xor(q, 4); q += __shfl_xor(q, 8); q += __shfl_xor(q, 16);
                    if (cc == 0) sqp[m0 + row] = q;
                }
            }
        } else {
#pragma unroll
            for (int i = 0; i < 4; ++i) {
                const int rl = wm * 64 + i * 16 + (lane & 15);
                const float rs = sRstd[rl];
                epi.row(m0 + rl, n0 + wn * 128 + 4 * (lane >> 4), acc[i], rs, lane);
                __builtin_amdgcn_sched_barrier(0);
            }
        }
        __syncthreads();
    }
}

struct Epi2In0 {
    bf16_t* Z0; float* G; const float* lb; bf16_t* D; int ldd; int N; float* SQ0; float* SQ1;
    DEVI bool staged(int n0) const { return (n0 >> 9) != 1; }
    DEVI float map(int n, float v) const { const int blk = n >> 9; return (blk == 0) ? v : ((blk <= 3) ? v * sigm(v) : gelu_tanh(v)); }
    DEVI void row(int m, int n, const f32x4 (&a)[8], float rs, int) const {
#pragma unroll
        for (int j = 0; j < 8; ++j) {
            const int c = n + 16 * j - 512;
            const float4 l4 = *(const float4*)(lb + c);
            float4 o;
            o.x = logf(l4.x + (1.f - l4.x) * sigm(a[j][0] * rs)); o.y = logf(l4.y + (1.f - l4.y) * sigm(a[j][1] * rs));
            o.z = logf(l4.z + (1.f - l4.z) * sigm(a[j][2] * rs)); o.w = logf(l4.w + (1.f - l4.w) * sigm(a[j][3] * rs));
            *(float4*)(G + (size_t)m * 512 + c) = o;
        }
    }
};
struct Epi2Bf16 {
    bf16_t* D; int ldd; int N; float* SQ0; float* SQ1;
    DEVI bool staged(int) const { return true; }
    DEVI float map(int, float v) const { return v; }
    DEVI void row(int, int, const f32x4 (&)[8], float, int) const {}
};
struct Epi2Resid {
    bf16_t* XB; float* SSQ16; float alpha; bf16_t* D; int ldd; int N; float* SQ0; float* SQ1;
    DEVI bool staged(int) const { return false; }
    DEVI float map(int, float v) const { return v; }
    DEVI void row(int m, int n, const f32x4 (&a)[8], float, int lane) const {
        float sq[2] = {0.f, 0.f};
#pragma unroll
        for (int j = 0; j < 8; ++j) {
            bf16_t* px = XB + (size_t)m * 1024 + n + 16 * j;
            const uint2 r = *(const uint2*)px;
            const unsigned w0 = pack2(bflo(r.x) + alpha * a[j][0], bfhi(r.x) + alpha * a[j][1]), w1 = pack2(bflo(r.y) + alpha * a[j][2], bfhi(r.y) + alpha * a[j][3]);
            *(uint2*)px = uint2{w0, w1};
            sq[j >> 2] += bflo(w0) * bflo(w0) + bfhi(w0) * bfhi(w0) + bflo(w1) * bflo(w1) + bfhi(w1) * bfhi(w1);
        }
#pragma unroll
        for (int g = 0; g < 2; ++g) {
            float v = sq[g];
            v += __shfl_xor(v, 16); v += __shfl_xor(v, 32);
            if ((lane >> 4) == 0) SSQ16[(size_t)m * 16 + ((n + 64 * g) >> 6)] = v;
        }
    }
};

struct EpiBf16 { bf16_t* D; int ldd; int N; DEVI void operator()(int m, int n, float v) const { if (n < N) D[(size_t)m * ldd + n] = f2bf(v); } };

DEVI void hgrn_local_item(const Params& p, int item, char* smem) {
    const int tid = threadIdx.x, lane = tid & 63, wave = tid >> 6;
    const int bh = item >> 7, c = item & 127, b = bh >> 2, h = bh & 3;
    const size_t m0 = (size_t)b * 8192 + c * 64;
    const float* G = (const float*)(p.ws + OFF_G) + m0 * 512 + h * 128;
    const bf16_t* Zv = (const bf16_t*)(p.ws + OFF_Z0) + m0 * 3072 + 1024 + h * 128;
    char* sVT = smem; char* sKd = smem + 16384;
    const int k = tid & 127, hf = tid >> 7;
    float bl = 0.f, bmid = 0.f;
#pragma unroll 8
    for (int t = 0; t < 64; ++t) { bl += G[t * 512 + k]; if (t == 31) bmid = bl; }
    float bcur = hf ? bmid : 0.f;
#pragma unroll 1
    for (int ch = 0; ch < 4; ++ch) {
        float kd[8], vv[8];
#pragma unroll
        for (int j = 0; j < 8; ++j) {
            const int t = 32 * hf + 8 * ch + j;
            const float g = G[t * 512 + k];
            bcur += g;
            kd[j] = (1.f - __expf(g)) * __expf(bl - bcur);
            vv[j] = bf2f(Zv[(size_t)t * 3072 + k]);
        }
        uint4 o; o.x = pack2(kd[0], kd[1]); o.y = pack2(kd[2], kd[3]); o.z = pack2(kd[4], kd[5]); o.w = pack2(kd[6], kd[7]);
        *(uint4*)(sKd + swz_off<64>(k, 4 * hf + ch)) = o;
        uint4 w; w.x = pack2(vv[0], vv[1]); w.y = pack2(vv[2], vv[3]); w.z = pack2(vv[4], vv[5]); w.w = pack2(vv[6], vv[7]);
        *(uint4*)(sVT + swz_off<64>(k, 4 * hf + ch)) = w;
    }
    if (hf == 0) ((float*)(p.ws + OFF_DEC))[item * 128 + k] = __expf(bl);
    __syncthreads();
    f32x4 acc[2][8];
#pragma unroll
    for (int i = 0; i < 2; ++i)
#pragma unroll
        for (int j = 0; j < 8; ++j) acc[i][j] = f32x4{0.f, 0.f, 0.f, 0.f};
    mma_nt<2, 8, 64, 64>(acc, sVT, 32 * wave, sKd, 0, 0, 2, lane);
    float* H = (float*)(p.ws + OFF_HST) + (size_t)item * 16384;
#pragma unroll
    for (int i = 0; i < 2; ++i)
#pragma unroll
        for (int j = 0; j < 8; ++j)
#pragma unroll
            for (int r = 0; r < 4; ++r) {
                const int v = 32 * wave + 16 * i + (lane >> 4) * 4 + r, kk = 16 * j + (lane & 15);
                H[v * 128 + kk] = acc[i][j][r];
                if (r == 3) __builtin_amdgcn_sched_barrier(0);
            }
    __syncthreads();
}

DEVI void gmlp_item(const Params& p, int item, char* smem) {
    const int tid = threadIdx.x, lane = tid & 63, wave = tid >> 6;
    const int g = item & 3, chunk = item >> 2;
    const size_t m0 = (size_t)chunk * 128;
    const bf16_t* Z0 = (const bf16_t*)(p.ws + OFF_Z0);
    const bf16_t* Wc = (const bf16_t*)(p.ws + OFF_WS0) + g * 16384;
    char* sW = smem; char* sV = smem + 32768;
#pragma unroll
    for (int i = 0; i < 8; ++i) {
        const int e = tid + 256 * i, row = e >> 4, cc = e & 15;
        *(uint4*)(sW + swz_off<128>(row, cc)) = *(const uint4*)(Wc + row * 128 + cc * 8);
    }
    {
        const int t = tid >> 1, hf = tid & 1;
        const bf16_t* src = Z0 + (m0 + t) * 3072 + 2560 + g * 128 + 64 * hf;
        float vals[64]; float ss = 0.f;
#pragma unroll
        for (int i = 0; i < 8; ++i) {
            uint4 u = *(const uint4*)(src + 8 * i);
            vals[8 * i + 0] = bflo(u.x); vals[8 * i + 1] = bfhi(u.x); vals[8 * i + 2] = bflo(u.y); vals[8 * i + 3] = bfhi(u.y);
            vals[8 * i + 4] = bflo(u.z); vals[8 * i + 5] = bfhi(u.z); vals[8 * i + 6] = bflo(u.w); vals[8 * i + 7] = bfhi(u.w);
        }
#pragma unroll
        for (int i = 0; i < 64; ++i) ss += vals[i] * vals[i];
        ss += __shfl_xor(ss, 1);
        const float rstd = rsqrtf(ss * (1.f / 128.f) + 1e-6f);
        const float* gn = p.l0_gmlp_v_norm + g * 128 + 64 * hf;
#pragma unroll
        for (int i = 0; i < 64; ++i) {
            const int d = 64 * hf + i;
            *(bf16_t*)(sV + swz_elem<128>(d, t)) = f2bf(vals[i] * rstd * gn[i]);
        }
    }
    __syncthreads();
    const int wm = wave >> 1, wn = wave & 1;
    f32x4 acc[4][4];
#pragma unroll
    for (int i = 0; i < 4; ++i)
#pragma unroll
        for (int j = 0; j < 4; ++j) acc[i][j] = f32x4{0.f, 0.f, 0.f, 0.f};
    mma_nt<4, 4, 128, 128>(acc, sW, wm * 64, sV, wn * 64, 0, 4, lane);
    bf16_t* MIX = (bf16_t*)(p.ws + OFF_MIX0);
#pragma unroll
    for (int i = 0; i < 4; ++i)
#pragma unroll
        for (int r = 0; r < 4; ++r) {
            const int t = wm * 64 + i * 16 + (lane >> 4) * 4 + r;
            const float bias = p.l0_gmlp_b_s[g * 128 + t];
#pragma unroll
            for (int j = 0; j < 4; ++j) {
                const int d = wn * 64 + j * 16 + (lane & 15);
                const float u = bf2f(Z0[(m0 + t) * 3072 + 2048 + g * 128 + d]);
                MIX[(m0 + t) * 1024 + 512 + g * 128 + d] = f2bf(u * (acc[i][j][r] + bias));
            }
        }
    __syncthreads();
}

DEVI void hgrn_scan_phase(const Params& p) {
    float* H = (float*)(p.ws + OFF_HST);
    const float* D = (const float*)(p.ws + OFF_DEC);
    for (int e = blockIdx.x * NTHREADS + threadIdx.x; e < 8 * 16384; e += gridDim.x * NTHREADS) {
        const int bh = e >> 14, idx = e & 16383, k = idx & 127;
        float run = 0.f;
        for (int c0 = 0; c0 < 128; c0 += 8) {
            float L[8], d[8];
#pragma unroll
            for (int u = 0; u < 8; ++u) { L[u] = H[((size_t)(bh * 128 + c0 + u)) * 16384 + idx]; d[u] = D[(bh * 128 + c0 + u) * 128 + k]; }
#pragma unroll
            for (int u = 0; u < 8; ++u) { H[((size_t)(bh * 128 + c0 + u)) * 16384 + idx] = run; run = d[u] * run + L[u]; }
        }
    }
}

DEVI void hgrn_out_item(const Params& p, int item, char* smem) {
    const int tid = threadIdx.x, lane = tid & 63, wave = tid >> 6;
    const int bh = item >> 7, c = item & 127, b = bh >> 2, h = bh & 3;
    const size_t m0 = (size_t)b * 8192 + c * 64;
    const float* G = (const float*)(p.ws + OFF_G) + m0 * 512 + h * 128;
    const bf16_t* Z0 = (const bf16_t*)(p.ws + OFF_Z0) + m0 * 3072;
    float* sB  = (float*)smem;
    char*  sHT = smem;
    char*  sQe = smem + 32768;
    char*  sP  = smem + 49152;
    char*  sU  = smem + 57344;
    char*  sQs = sU; char* sKh = sU + 4096; char* sVT = sU;
    float* sRed = (float*)(smem + 77824);
    const int k = tid & 127, hf = tid >> 7;
    if (hf == 0) { float bc = 0.f;
#pragma unroll 8
        for (int t = 0; t < 64; ++t) { bc += G[t * 512 + k]; sB[t * 128 + k] = bc; } }
    __syncthreads();
#pragma unroll 4
    for (int t = 32 * hf; t < 32 * hf + 32; ++t) {
        const float q = bf2f(Z0[(size_t)t * 3072 + h * 128 + k]);
        *(bf16_t*)(sQe + swz_elem<128>(t, k)) = f2bf(q * __expf(sB[t * 128 + k]));
    }
#pragma unroll 1
    for (int i = 0; i < 4; ++i) {
        const float ri = (i == 0) ? 0.f : sB[(16 * i - 1) * 128 + k];
#pragma unroll 4
        for (int tt = 8 * hf; tt < 8 * hf + 8; ++tt) {
            const int t = 16 * i + tt;
            const float q = bf2f(Z0[(size_t)t * 3072 + h * 128 + k]);
            *(bf16_t*)(sQs + swz_elem<128>(tt, k)) = f2bf(q * __expf(sB[t * 128 + k] - ri));
        }
        const int ns = 16 * (i + 1), half = ns >> 1;
#pragma unroll 4
        for (int s = hf * half; s < hf * half + half; ++s) {
            const float bs = sB[s * 128 + k];
            const float gs = bs - (s ? sB[(s - 1) * 128 + k] : 0.f);
            const float kk = 1.f - __expf(gs);
            *(bf16_t*)(sKh + swz_elem<128>(s, k)) = f2bf(kk * __expf(fminf(ri - bs, 80.f)));
        }
        __syncthreads();
        {
            f32x4 acc[1][1]; acc[0][0] = f32x4{0.f, 0.f, 0.f, 0.f};
            if (wave <= i) mma_nt<1, 1, 128, 128>(acc, sQs, 0, sKh, 16 * wave, 0, 4, lane);
#pragma unroll
            for (int r = 0; r < 4; ++r) {
                const int row = (lane >> 4) * 4 + r, col = lane & 15;
                float v = acc[0][0][r];
                if (wave > i || (wave == i && col > row)) v = 0.f;
                *(bf16_t*)(sP + swz_elem<64>(16 * i + row, 16 * wave + col)) = f2bf(v);
            }
        }
        __syncthreads();
    }
    {
        const bf16_t* Zv = Z0 + 1024 + h * 128;
#pragma unroll 1
        for (int ch = 0; ch < 4; ++ch) {
            float vv[8];
#pragma unroll
            for (int j = 0; j < 8; ++j) vv[j] = bf2f(Zv[(size_t)(32 * hf + 8 * ch + j) * 3072 + k]);
            uint4 w; w.x = pack2(vv[0], vv[1]); w.y = pack2(vv[2], vv[3]); w.z = pack2(vv[4], vv[5]); w.w = pack2(vv[6], vv[7]);
            *(uint4*)(sVT + swz_off<64>(k, 4 * hf + ch)) = w;
        }
        const float* H = (const float*)(p.ws + OFF_HST) + (size_t)item * 16384;
#pragma unroll 2
        for (int i = 0; i < 8; ++i) {
            const int e = tid + 256 * i, row = e >> 4, cc = e & 15;
            const float4 a = *(const float4*)(H + row * 128 + cc * 8), bq = *(const float4*)(H + row * 128 + cc * 8 + 4);
            uint4 o; o.x = pack2(a.x, a.y); o.y = pack2(a.z, a.w); o.z = pack2(bq.x, bq.y); o.w = pack2(bq.z, bq.w);
            *(uint4*)(sHT + swz_off<128>(row, cc)) = o;
        }
    }
    __syncthreads();
    f32x4 acc[4][2];
#pragma unroll
    for (int i = 0; i < 4; ++i)
#pragma unroll
        for (int j = 0; j < 2; ++j) acc[i][j] = f32x4{0.f, 0.f, 0.f, 0.f};
    mma_nt<4, 2, 128, 128>(acc, sQe, 0, sHT, 32 * wave, 0, 4, lane);
    mma_nt<4, 2, 64, 64>(acc, sP, 0, sVT, 32 * wave, 0, 2, lane);
#pragma unroll
    for (int i = 0; i < 4; ++i)
#pragma unroll
        for (int r = 0; r < 4; ++r) {
            float s = acc[i][0][r] * acc[i][0][r] + acc[i][1][r] * acc[i][1][r];
            s += __shfl_xor(s, 1); s += __shfl_xor(s, 2); s += __shfl_xor(s, 4); s += __shfl_xor(s, 8);
            if ((lane & 15) == 0) sRed[wave * 64 + i * 16 + (lane >> 4) * 4 + r] = s;
        }
    __syncthreads();
    bf16_t* MIX = (bf16_t*)(p.ws + OFF_MIX0);
#pragma unroll
    for (int i = 0; i < 4; ++i)
#pragma unroll
        for (int r = 0; r < 4; ++r) {
            const int t = i * 16 + (lane >> 4) * 4 + r;
            const float tot = sRed[t] + sRed[64 + t] + sRed[128 + t] + sRed[192 + t];
            const float rstd = rsqrtf(tot * (1.f / 128.f) + 1e-6f);
#pragma unroll
            for (int j = 0; j < 2; ++j) {
                const int v = 32 * wave + 16 * j + (lane & 15);
                const float og = bf2f(Z0[(size_t)t * 3072 + 1536 + h * 128 + v]);
                MIX[(m0 + t) * 1024 + h * 128 + v] = f2bf(acc[i][j][r] * rstd * p.l0_hgrn_out_norm[h * 128 + v] * og);
            }
        }
    __syncthreads();
}

DEVI unsigned f2key(float f) { unsigned u = __float_as_uint(f); return (u & 0x80000000u) ? ~u : (u | 0x80000000u); }
DEVI float key2f(unsigned k) { unsigned u = (k & 0x80000000u) ? (k ^ 0x80000000u) : ~k; return __uint_as_float(u); }
#define CE_DESC(a, b) { unsigned _x = max(a, b), _y = min(a, b); a = _x; b = _y; }
DEVI void sort16_desc(unsigned (&a)[16]) {
#pragma unroll
    for (int k = 2; k <= 16; k <<= 1)
#pragma unroll
        for (int j = k >> 1; j > 0; j >>= 1)
#pragma unroll
            for (int i = 0; i < 16; ++i) {
                const int l = i ^ j;
                if (l > i) {
                    if ((i & k) == 0) { CE_DESC(a[i], a[l]); } else { CE_DESC(a[l], a[i]); }
                }
            }
}
DEVI void merge16_desc(unsigned (&a)[16], const unsigned (&b)[16]) {
#pragma unroll
    for (int i = 0; i < 16; ++i) a[i] = max(a[i], b[15 - i]);
#pragma unroll
    for (int j = 8; j > 0; j >>= 1)
#pragma unroll
        for (int i = 0; i < 16; ++i) { const int l = i ^ j; if (l > i) { CE_DESC(a[i], a[l]); } }
}

DEVI void peer_topk_phase(const Params& p, const bf16_t* __restrict__ SK, int blk0, int nblk, char* smem) {
    const int tid = threadIdx.x, lane = tid & 63, wave = tid >> 6;
    const int r = lane & 31, hh = lane >> 5;
    const bf16_t* QP = (const bf16_t*)(p.ws + OFF_QP);
    int* IDX = (int*)(p.ws + OFF_IDX); float* GATE = (float*)(p.ws + OFF_GATE);
    char* sKey = smem;
    char* sQ = smem + 32768 + wave * 8192;
    for (int item = blk0; item < 1024; item += nblk) {
        const int h = item & 7, tile = (item >> 3) * 4 + wave;
        const size_t tok = (size_t)tile * 32 + r;
        unsigned top[2][16];
#pragma unroll
        for (int ph = 0; ph < 2; ++ph) {
            __syncthreads();
            {
                const bf16_t* ksrc = SK + (size_t)(h * 2 + ph) * 128 * 128;
#pragma unroll
                for (int i = 0; i < 8; ++i) { const int e = tid + 256 * i, row = e >> 4, cc = e & 15; *(uint4*)(sKey + swz_off<128>(row, cc)) = *(const uint4*)(ksrc + row * 128 + cc * 8); }
                const bf16_t* qsrc = QP + (size_t)tile * 32 * 2048 + h * 256 + ph * 128;
#pragma unroll
                for (int i = 0; i < 8; ++i) { const int e = lane + 64 * i, row = e >> 4, cc = e & 15; *(uint4*)(sQ + swz_off<128>(row, cc)) = *(const uint4*)(qsrc + (size_t)row * 2048 + cc * 8); }
            }
            __syncthreads();
            bf16x8 qf[8];
#pragma unroll
            for (int ks = 0; ks < 8; ++ks) qf[ks] = *(const bf16x8*)(sQ + swz_off<128>(r, 2 * ks + hh));
#pragma unroll 1
            for (int rt = 0; rt < 4; ++rt) {
                f32x16 acc;
#pragma unroll
                for (int e = 0; e < 16; ++e) acc[e] = 0.f;
#pragma unroll
                for (int ks = 0; ks < 8; ++ks) {
                    const bf16x8 kf = *(const bf16x8*)(sKey + swz_off<128>(32 * rt + r, 2 * ks + hh));
                    acc = mfma32(kf, qf[ks], acc);
                }
                unsigned kk[16];
#pragma unroll
                for (int e = 0; e < 16; ++e) {
                    const unsigned n = 32 * rt + (e & 3) + 8 * (e >> 2) + 4 * hh;
                    kk[e] = (f2key(acc[e]) & ~127u) | n;
                }
                sort16_desc(kk);
                if (rt == 0) {
#pragma unroll
                    for (int e = 0; e < 16; ++e) top[ph][e] = kk[e];
                } else merge16_desc(top[ph], kk);
            }
            unsigned other[16];
#pragma unroll
            for (int e = 0; e < 16; ++e) other[e] = (unsigned)__shfl_xor((int)top[ph][e], 32);
            merge16_desc(top[ph], other);
        }
        unsigned best[16];
        {
            float s1[16], s2[16];
#pragma unroll
            for (int e = 0; e < 16; ++e) { s1[e] = key2f(top[0][e] & ~127u); s2[e] = key2f(top[1][e] & ~127u); }
            unsigned cand[64];
            unsigned ia[16], ib[16];
#pragma unroll
            for (int e = 0; e < 16; ++e) { ia[e] = (top[0][e] & 127u) << 7; ib[e] = top[1][e] & 127u; }
            int n = 0;
#pragma unroll
            for (int i = 0; i < 16; ++i)
#pragma unroll
                for (int j = 0; j < 16; ++j)
                    if ((i + 1) * (j + 1) <= 16) { cand[n] = (f2key(s1[i] + s2[j]) & ~0x3fffu) | ia[i] | ib[j]; ++n; }
#pragma unroll
            for (int e = 50; e < 64; ++e) cand[e] = 0u;
#pragma unroll
            for (int g = 0; g < 4; ++g) {
                unsigned kk[16];
#pragma unroll
                for (int e = 0; e < 16; ++e) kk[e] = cand[16 * g + e];
                sort16_desc(kk);
                if (g == 0) {
#pragma unroll
                    for (int e = 0; e < 16; ++e) best[e] = kk[e];
                } else merge16_desc(best, kk);
            }
        }
        float sv[16]; int id[16];
#pragma unroll
        for (int e = 0; e < 16; ++e) {
            sv[e] = key2f(best[e] & ~0x3fffu);
            id[e] = (int)(best[e] & 0x3fffu);
        }
        float den = 0.f; const float smax = sv[0];
#pragma unroll
        for (int e = 0; e < 16; ++e) { sv[e] = __expf(sv[e] - smax); den += sv[e]; }
        const float inv = 1.f / den;
        {
            const float* INVT = (const float*)(p.ws + (hh ? OFF_INVU : OFF_INVD));
            float sc[16];
#pragma unroll
            for (int e = 0; e < 16; ++e) sc[e] = INVT[id[e]];
            if (hh == 0) {
                int4* dst = (int4*)(IDX + tok * 128 + h * 16);
                float4* dst2 = (float4*)((float*)(p.ws + OFF_SDN) + tok * 128 + h * 16);
#pragma unroll
                for (int e = 0; e < 4; ++e) { dst[e] = int4{id[4 * e], id[4 * e + 1], id[4 * e + 2], id[4 * e + 3]}; dst2[e] = float4{sc[4 * e], sc[4 * e + 1], sc[4 * e + 2], sc[4 * e + 3]}; }
            } else {
                float4* dst = (float4*)(GATE + tok * 128 + h * 16);
#pragma unroll
                for (int e = 0; e < 4; ++e) dst[e] = float4{sv[4 * e] * inv * sc[4 * e], sv[4 * e + 1] * inv * sc[4 * e + 1], sv[4 * e + 2] * inv * sc[4 * e + 2], sv[4 * e + 3] * inv * sc[4 * e + 3]};
            }
        }
    }
    for (int it0 = blk0; it0 < 4096; it0 += 4 * nblk) {
        uint4 ra[4], rb[4];
#pragma unroll
        for (int u = 0; u < 4; ++u) {
            const int it = it0 + u * nblk;
            const bf16_t* xb = (const bf16_t*)(p.ws + OFF_XB) + ((size_t)(it < 4096 ? it : it0) * 4 + wave) * 1024 + 16 * lane;
            ra[u] = *(const uint4*)xb; rb[u] = *(const uint4*)(xb + 8);
        }
#pragma unroll
        for (int u = 0; u < 4; ++u) {
            const int it = it0 + u * nblk;
            const uint4 a = ra[u], b = rb[u];
            float v[16] = {bflo(a.x), bfhi(a.x), bflo(a.y), bfhi(a.y), bflo(a.z), bfhi(a.z), bflo(a.w), bfhi(a.w),
                           bflo(b.x), bfhi(b.x), bflo(b.y), bfhi(b.y), bflo(b.z), bfhi(b.z), bflo(b.w), bfhi(b.w)};
#pragma unroll
            for (int i = 0; i < 16; ++i) v[i] = fminf(fmaxf(v[i] * 32.f, -400.f), 400.f);
            int w0 = 0, w1 = 0, w2 = 0, w3 = 0;
            w0 = __builtin_amdgcn_cvt_pk_fp8_f32(v[0], v[1], w0, false);   w0 = __builtin_amdgcn_cvt_pk_fp8_f32(v[2], v[3], w0, true);
            w1 = __builtin_amdgcn_cvt_pk_fp8_f32(v[4], v[5], w1, false);   w1 = __builtin_amdgcn_cvt_pk_fp8_f32(v[6], v[7], w1, true);
            w2 = __builtin_amdgcn_cvt_pk_fp8_f32(v[8], v[9], w2, false);   w2 = __builtin_amdgcn_cvt_pk_fp8_f32(v[10], v[11], w2, true);
            w3 = __builtin_amdgcn_cvt_pk_fp8_f32(v[12], v[13], w3, false); w3 = __builtin_amdgcn_cvt_pk_fp8_f32(v[14], v[15], w3, true);
            if (it < 4096) *(int4*)(p.ws + OFF_XB8 + ((size_t)it * 4 + wave) * 1024 + 16 * lane) = int4{w0, w1, w2, w3};
        }
    }
}

typedef float f32x2v __attribute__((ext_vector_type(2)));
#define PEER_QWORD 80000
#define PEER_TPW 8
#define PEER_ITEMS (16384 / (4 * PEER_TPW))
DEVI int queue_pop(const Params& p, int q, char* smem) {
    int* sw = (int*)(smem + PEER_QWORD);
    __syncthreads();
    if (threadIdx.x == 0) *sw = (int)__hip_atomic_fetch_add((unsigned*)(p.ws + OFF_QCNT) + q * 16, 1u, __ATOMIC_RELAXED, __HIP_MEMORY_SCOPE_AGENT);
    __syncthreads();
    return *sw;
}
DEVI int queue_publish(int pending, char* smem) {
    int* sw = (int*)(smem + PEER_QWORD);
    __syncthreads();
    if (threadIdx.x == 0) *sw = pending;
    __syncthreads();
    return *sw;
}
DEVI unsigned queue_live(const Params& p, int qbase, int s0, char* smem) {
    unsigned* sw = (unsigned*)(smem + PEER_QWORD + 4);
    __syncthreads();
    if (threadIdx.x < 64) {
        unsigned c = 0xffffffffu;
        if (threadIdx.x < 8) c = __hip_atomic_load((unsigned*)(p.ws + OFF_QCNT) + (qbase + ((s0 + (int)threadIdx.x) & 7)) * 16, __ATOMIC_RELAXED, __HIP_MEMORY_SCOPE_AGENT);
        const unsigned long long m = __ballot(c < (unsigned)PEER_ITEMS);
        if (threadIdx.x == 0) *sw = (unsigned)m;
    }
    __syncthreads();
    return *sw;
}
#define UFMA(ACC, W, X) asm volatile("v_fmac_f32 %0, %1, %2" : "+v"(ACC) : "v"(W), "v"(X))
DEVI void d_stream(size_t tok, int s, int lane, char* slot, const int* IDX, const char* XB8) {
    const unsigned o1 = (unsigned)tok * 512u + 4u * (unsigned)lane;
    __builtin_amdgcn_global_load_lds((const unsigned*)((const char*)IDX + o1),        (unsigned*)(slot),       4, 0, 0);
    __builtin_amdgcn_global_load_lds((const unsigned*)((const char*)IDX + o1 + 256u), (unsigned*)(slot + 256), 4, 0, 0);
    __builtin_amdgcn_global_load_lds((const unsigned*)(XB8 + (unsigned)tok * 1024u + (unsigned)(128 * s + 4 * (lane & 31))), (unsigned*)(slot + 512), 4, 0, 0);
}
template <int HLF>
DEVI void d_dma(const char* slot, char* buf, int s, int lane, const char* ED) {
    const int grp = lane >> 3, sub = lane & 7;
    unsigned e[8];
#pragma unroll
    for (int i = 0; i < 8; ++i) e[i] = *(const unsigned*)(slot + 256 * HLF + 4 * (8 * i + grp));
#pragma unroll
    for (int i = 0; i < 8; ++i) {
        const int pl_ = 8 * i + grp;
        const unsigned src = ((unsigned)s * 16384u + e[i]) * 128u + (unsigned)(16 * (sub ^ ((pl_ >> 1) & 7)));
        __builtin_amdgcn_global_load_lds((const unsigned*)(ED + src), (unsigned*)(buf + i * 1024), 16, 0, 0);
    }
}
template <int HLF>
DEVI void d_mma(const char* buf, const char* slot, size_t tok, int s, int lane, float* PART) {
    const int r = lane & 15, q = lane >> 4;
    const long b0 = *(const long*)(slot + 512 + 32 * q), b1 = *(const long*)(slot + 512 + 32 * q + 8), b2 = *(const long*)(slot + 512 + 32 * q + 16), b3 = *(const long*)(slot + 512 + 32 * q + 24);
    float* dst = PART + ((size_t)s * 16384 + tok) * 128 + 64 * HLF;
    long a[4][4];
#pragma unroll
    for (int t = 0; t < 4; ++t) {
        const int row = 16 * t + r, key = (row >> 1) & 7;
        const char* rp = buf + row * 128;
#pragma unroll
        for (int kk = 0; kk < 4; ++kk) a[t][kk] = *(const long*)(rp + ((((4 * q + kk) >> 1) ^ key) << 4) + 8 * ((4 * q + kk) & 1));
    }
    f32x4 acc[4];
#pragma unroll
    for (int t = 0; t < 4; ++t) { acc[t] = f32x4{0.f, 0.f, 0.f, 0.f}; acc[t] = __builtin_amdgcn_mfma_f32_16x16x32_fp8_fp8(a[t][0], b0, acc[t], 0, 0, 0); }
#pragma unroll
    for (int t = 0; t < 4; ++t) acc[t] = __builtin_amdgcn_mfma_f32_16x16x32_fp8_fp8(a[t][1], b1, acc[t], 0, 0, 0);
#pragma unroll
    for (int t = 0; t < 4; ++t) acc[t] = __builtin_amdgcn_mfma_f32_16x16x32_fp8_fp8(a[t][2], b2, acc[t], 0, 0, 0);
#pragma unroll
    for (int t = 0; t < 4; ++t) acc[t] = __builtin_amdgcn_mfma_f32_16x16x32_fp8_fp8(a[t][3], b3, acc[t], 0, 0, 0);
    if (r == 0) {
#pragma unroll
        for (int t = 0; t < 4; ++t) __builtin_nontemporal_store(f32x4{acc[t][0] * (1.f / 32.f), acc[t][1] * (1.f / 32.f), acc[t][2] * (1.f / 32.f), acc[t][3] * (1.f / 32.f)}, (f32x4*)(dst + 16 * t + 4 * q));
    }
}
DEVI void peer_down_phase(const Params& p, const float* __restrict__ gain, int qbase, int s0, char* smem) {
    const int tid = threadIdx.x, lane = tid & 63;
    const int wave = __builtin_amdgcn_readfirstlane(tid >> 6);
    const char* ED = p.ws + OFF_ED; const char* XB8 = p.ws + OFF_XB8;
    const int* IDX = (const int*)(p.ws + OFF_IDX);
    float* PART = (float*)(p.ws + OFF_PART);
    (void)gain;
    char* const img = smem + wave * 16384;
    char* const tb0 = smem + 65536 + wave * 3072;
    unsigned live = 0xffu; int pending = 0;
#pragma unroll 1
    for (int sl = 0; sl < 8; ++sl) {
        const int s = (s0 + sl) & 7;
        if (sl == 1) live = queue_live(p, qbase, s0, smem);
        if (!((live >> sl) & 1u)) continue;
#pragma unroll 1
        for (int g = queue_pop(p, qbase + s, smem); g < PEER_ITEMS; g = queue_publish(pending, smem)) {
            if (threadIdx.x == 0) {
                const unsigned* qp_ = (const unsigned*)(p.ws + OFF_QCNT) + (qbase + s) * 16; const unsigned zo_ = 0u, one_ = 1u;
                asm volatile("global_atomic_add %0, %1, %2, %3 sc0" : "+v"(pending) : "v"(zo_), "v"(one_), "s"(qp_) : "memory");
            }
            const size_t t0 = (size_t)g * (4 * PEER_TPW) + wave * PEER_TPW;
            d_stream(t0, s, lane, tb0, IDX, XB8); d_stream(t0 + 1, s, lane, tb0 + 768, IDX, XB8);
            asm volatile("s_waitcnt vmcnt(0)" ::: "memory");
            d_dma<0>(tb0, img, s, lane, ED);
#pragma unroll 1
            for (int j = 0; j < PEER_TPW; ++j) {
                char* const slj = tb0 + 768 * (j & 3); char* const sln = tb0 + 768 * ((j + 1) & 3);
                if (j + 2 < PEER_TPW) d_stream(t0 + j + 2, s, lane, tb0 + 768 * ((j + 2) & 3), IDX, XB8);
                d_dma<1>(slj, img + 8192, s, lane, ED);
                if (j + 2 < PEER_TPW) asm volatile("s_waitcnt vmcnt(11)" ::: "memory"); else asm volatile("s_waitcnt vmcnt(8)" ::: "memory");
                if (!(PROBE_NOMMA && qbase >= 32)) d_mma<0>(img, slj, t0 + j, s, lane, PART);
                asm volatile("s_waitcnt lgkmcnt(0)" ::: "memory");
                if (j + 1 < PEER_TPW) { d_dma<0>(sln, img, s, lane, ED); asm volatile("s_waitcnt vmcnt(8)" ::: "memory"); }
                else asm volatile("s_waitcnt vmcnt(0)" ::: "memory");
                if (!(PROBE_NOMMA && qbase >= 32)) d_mma<1>(img + 8192, slj, t0 + j, s, lane, PART);
                asm volatile("s_waitcnt lgkmcnt(0)" ::: "memory");
            }
        }
    }
}
struct RedL { float sq, pa[8], pb[8], g0, g1, d0, d1; int i0, i1; };
DEVI void red_load(RedL& L, const Params& p, size_t tok, int lane) {
    const float* PART = (const float*)(p.ws + OFF_PART); const float* GATEU = (const float*)(p.ws + OFF_GATE); const float* SDN = (const float*)(p.ws + OFF_SDN);
    const float* SSQ16 = (const float*)(p.ws + OFF_SSQ16); const int* IDX = (const int*)(p.ws + OFF_IDX);
    L.sq = SSQ16[tok * 16 + (lane & 15)];
#pragma unroll
    for (int s = 0; s < 8; ++s) { L.pa[s] = PART[((size_t)s * 16384 + tok) * 128 + lane]; L.pb[s] = PART[((size_t)s * 16384 + tok) * 128 + 64 + lane]; }
    L.g0 = GATEU[tok * 128 + lane]; L.g1 = GATEU[tok * 128 + 64 + lane]; L.d0 = SDN[tok * 128 + lane]; L.d1 = SDN[tok * 128 + 64 + lane];
    L.i0 = IDX[tok * 128 + lane]; L.i1 = IDX[tok * 128 + 64 + lane];
}
DEVI void red_finish(const RedL& L, const Params& p, size_t tok, int lane) {
    float sq = L.sq;
    sq += __shfl_xor(sq, 1); sq += __shfl_xor(sq, 2); sq += __shfl_xor(sq, 4); sq += __shfl_xor(sq, 8);
    const float rstd = rsqrtf(sq * (1.f / 1024.f) + 1e-6f);
    float a0 = 0.f, a1 = 0.f;
#pragma unroll
    for (int s = 0; s < 8; ++s) { a0 += L.pa[s]; a1 += L.pb[s]; }
    const float w0 = L.g0 * gelu_tanh(a0 * rstd * L.d0);
    const float w1 = L.g1 * gelu_tanh(a1 * rstd * L.d1);
    float m = fmaxf(fabsf(w0), fabsf(w1));
#pragma unroll
    for (int o = 1; o < 64; o <<= 1) m = fmaxf(m, __shfl_xor(m, o));
    const unsigned e = (__float_as_uint(m) >> 23) & 255u;
    const bool tiny = e < 16u;
    const float S = tiny ? 1.f : __uint_as_float((261u - e) << 23), invS = tiny ? 1.f : __uint_as_float((e - 7u) << 23);
    const float s0 = w0 * S, s1 = w1 * S;
    const int hi = __builtin_amdgcn_cvt_pk_fp8_f32(s0, s1, 0, false);
    const float r0 = s0 - __builtin_amdgcn_cvt_f32_fp8(hi, 0), r1 = s1 - __builtin_amdgcn_cvt_f32_fp8(hi, 1);
    const int lo = __builtin_amdgcn_cvt_pk_fp8_f32(r0, r1, 0, false);
    char* rec = p.ws + OFF_UREC + tok * 768;
    *(unsigned short*)(rec + 2 * lane) = (unsigned short)L.i0;
    *(unsigned short*)(rec + 128 + 2 * lane) = (unsigned short)L.i1;
    *(unsigned char*)(rec + 256 + lane) = (unsigned char)(hi & 255);       *(unsigned char*)(rec + 320 + lane) = (unsigned char)((hi >> 8) & 255);
    *(unsigned char*)(rec + 384 + lane) = (unsigned char)(lo & 255);       *(unsigned char*)(rec + 448 + lane) = (unsigned char)((lo >> 8) & 255);
    *(float*)(rec + 512 + 4 * lane) = invS;
}
DEVI void peer_reduce_phase(const Params& p) {
    const int lane = threadIdx.x & 63, wave = threadIdx.x >> 6;
    const int G = gridDim.x;
    for (int it = blockIdx.x; it < 4096; it += 2 * G) {
        const bool two = it + G < 4096;
        const size_t tokA = (size_t)it * 4 + wave, tokB = (size_t)(two ? it + G : it) * 4 + wave;
        RedL A, B;
        red_load(A, p, tokA, lane); red_load(B, p, tokB, lane);
        red_finish(A, p, tokA, lane);
        if (two) red_finish(B, p, tokB, lane);
    }
}
DEVI void u_stream(size_t tok, int s, int lane, char* slot, const char* UREC, const char* XB) {
    const unsigned o1 = (unsigned)tok * 768u + 4u * (unsigned)lane;
    __builtin_amdgcn_global_load_lds((const unsigned*)(UREC + o1),        (unsigned*)(slot),       4, 0, 0);
    __builtin_amdgcn_global_load_lds((const unsigned*)(UREC + o1 + 256u), (unsigned*)(slot + 256), 4, 0, 0);
    __builtin_amdgcn_global_load_lds((const unsigned*)(UREC + o1 + 512u), (unsigned*)(slot + 512), 4, 0, 0);
    __builtin_amdgcn_global_load_lds((const unsigned*)(XB + (unsigned)tok * 2048u + (unsigned)(256 * s + 4 * lane)), (unsigned*)(slot + 768), 4, 0, 0);
}
template <int HLF>
DEVI void u_dma(const char* slot, char* buf, int s, int lane, const char* EU) {
    const int grp = lane >> 3, sub = lane & 7;
    unsigned e[8];
#pragma unroll
    for (int i = 0; i < 8; ++i) e[i] = *(const unsigned short*)(slot + 128 * HLF + 2 * (8 * i + grp));
#pragma unroll
    for (int i = 0; i < 8; ++i) {
        const int pl_ = 8 * i + grp;
        const unsigned src = ((unsigned)s * 16384u + e[i]) * 128u + (unsigned)(16 * (sub ^ ((pl_ >> 1) & 7)));
        __builtin_amdgcn_global_load_lds((const unsigned*)(EU + src), (unsigned*)(buf + i * 1024), 16, 0, 0);
    }
}
#define TR8(DST, ADDR, OFF) asm volatile("ds_read_b64_tr_b8 %0, %1 offset:%2" : "=v"(DST) : "v"(ADDR), "i"(OFF))
#define TR8_WAIT4(N, A, B, C, D) asm volatile("s_waitcnt lgkmcnt(" #N ")" : "+v"(A), "+v"(B), "+v"(C), "+v"(D))
template <int HLF>
DEVI void u_mma(const char* buf, const char* slot, int lane, f32x4 (&acc)[8]) {
    const int i16 = lane & 15, g = lane >> 4;
    const int row0 = 8 * g + (i16 >> 1), key = (row0 >> 1) & 7;
    const unsigned ab = (unsigned)(size_t)(__attribute__((address_space(3))) const char*)(buf + row0 * 128 + 8 * (i16 & 1));
    const long b0 = *(const long*)(slot + 256 + 128 * (i16 & 1) + 64 * HLF + 8 * g), b1 = *(const long*)(slot + 256 + 128 * (i16 & 1) + 64 * HLF + 32 + 8 * g);
    long a0[8], a1[8];
#pragma unroll
    for (int ct = 0; ct < 8; ++ct) { const unsigned ad = ab + (unsigned)((ct ^ key) << 4); TR8(a0[ct], ad, 0); }
#pragma unroll
    for (int ct = 0; ct < 8; ++ct) { const unsigned ad = ab + (unsigned)((ct ^ key) << 4); TR8(a1[ct], ad, 4096); }
    TR8_WAIT4(12, a0[0], a0[1], a0[2], a0[3]);
#pragma unroll
    for (int ct = 0; ct < 4; ++ct) acc[ct] = __builtin_amdgcn_mfma_f32_16x16x32_fp8_fp8(a0[ct], b0, acc[ct], 0, 0, 0);
    TR8_WAIT4(8, a0[4], a0[5], a0[6], a0[7]);
#pragma unroll
    for (int ct = 4; ct < 8; ++ct) acc[ct] = __builtin_amdgcn_mfma_f32_16x16x32_fp8_fp8(a0[ct], b0, acc[ct], 0, 0, 0);
    TR8_WAIT4(4, a1[0], a1[1], a1[2], a1[3]);
#pragma unroll
    for (int ct = 0; ct < 4; ++ct) acc[ct] = __builtin_amdgcn_mfma_f32_16x16x32_fp8_fp8(a1[ct], b1, acc[ct], 0, 0, 0);
    TR8_WAIT4(0, a1[4], a1[5], a1[6], a1[7]);
#pragma unroll
    for (int ct = 4; ct < 8; ++ct) acc[ct] = __builtin_amdgcn_mfma_f32_16x16x32_fp8_fp8(a1[ct], b1, acc[ct], 0, 0, 0);
}
DEVI void u_finish(f32x4 (&acc)[8], const char* slot, char* ex, size_t tok, int s, int lane, float alpha, float* X, bf16_t* XB, float* SSQ8) {
    const int i16 = lane & 15, g = lane >> 4;
    if (i16 < 2) {
#pragma unroll
        for (int ct = 0; ct < 8; ++ct) *(f32x4*)(ex + 576 * i16 + 4 * (16 * ct + 4 * g)) = acc[ct];
    }
    const float2 vh = *(const float2*)(ex + 8 * lane), vl = *(const float2*)(ex + 576 + 8 * lane);
    const float sc = alpha * *(const float*)(slot + 512);
    const unsigned xb2 = *(const unsigned*)(slot + 768 + 4 * lane);
    const float y0 = bflo(xb2) + sc * (vh.x + vl.x), y1 = bfhi(xb2) + sc * (vh.y + vl.y);
    const unsigned col = (unsigned)tok * 1024u + (unsigned)(128 * s + 2 * lane);
    if (X) __builtin_nontemporal_store(f32x2v{y0, y1}, (f32x2v*)((char*)X + 4u * col));
    const unsigned yb = pack2(y0, y1);
    *(unsigned*)((char*)XB + 2u * col) = yb;
    float sq = bflo(yb) * bflo(yb) + bfhi(yb) * bfhi(yb);
#pragma unroll
    for (int o = 1; o < 64; o <<= 1) sq += __shfl_xor(sq, o);
    if (lane == 0) *(float*)((char*)SSQ8 + ((unsigned)tok * 32u + 4u * (unsigned)s)) = sq;
#pragma unroll
    for (int ct = 0; ct < 8; ++ct) acc[ct] = f32x4{0.f, 0.f, 0.f, 0.f};
}
DEVI void peer_up_phase(const Params& p, int qbase, int s0, float alpha, float* X, char* smem) {
    const int tid = threadIdx.x, lane = tid & 63;
    const int wave = __builtin_amdgcn_readfirstlane(tid >> 6);
    const char* EU = p.ws + OFF_EU; const char* UREC = p.ws + OFF_UREC;
    bf16_t* XB = (bf16_t*)(p.ws + OFF_XB); float* SSQ8 = (float*)(p.ws + OFF_SSQ8);
    char* const img = smem + wave * 16384;
    char* const tb0 = smem + 65536 + wave * 3072;
    unsigned live = 0xffu; int pending = 0;
#pragma unroll 1
    for (int sl = 0; sl < 8; ++sl) {
        const int s = (s0 + sl) & 7;
        if (sl == 1) live = queue_live(p, qbase, s0, smem);
        if (!((live >> sl) & 1u)) continue;
#pragma unroll 1
        for (int g = queue_pop(p, qbase + s, smem); g < PEER_ITEMS; g = queue_publish(pending, smem)) {
            if (threadIdx.x == 0) {
                const unsigned* qp_ = (const unsigned*)(p.ws + OFF_QCNT) + (qbase + s) * 16; const unsigned zo_ = 0u, one_ = 1u;
                asm volatile("global_atomic_add %0, %1, %2, %3 sc0" : "+v"(pending) : "v"(zo_), "v"(one_), "s"(qp_) : "memory");
            }
            const size_t t0 = (size_t)g * (4 * PEER_TPW) + wave * PEER_TPW;
            f32x4 acc[8];
#pragma unroll
            for (int ct = 0; ct < 8; ++ct) acc[ct] = f32x4{0.f, 0.f, 0.f, 0.f};
            char* slj = tb0; char* sln = tb0 + 1024; char* slf = tb0 + 2048;
            u_stream(t0, s, lane, slj, UREC, (const char*)XB); u_stream(t0 + 1, s, lane, sln, UREC, (const char*)XB);
            asm volatile("s_waitcnt vmcnt(0)" ::: "memory");
            u_dma<0>(slj, img, s, lane, EU);
#pragma unroll 1
            for (int j = 0; j < PEER_TPW; ++j) {
                if (j + 2 < PEER_TPW) u_stream(t0 + j + 2, s, lane, slf, UREC, (const char*)XB);
                u_dma<1>(slj, img + 8192, s, lane, EU);
                if (j + 2 < PEER_TPW) asm volatile("s_waitcnt vmcnt(12)" ::: "memory"); else asm volatile("s_waitcnt vmcnt(8)" ::: "memory");
                u_mma<0>(img, slj, lane, acc);
                asm volatile("s_waitcnt lgkmcnt(0)" ::: "memory");
                if (j + 1 < PEER_TPW) { u_dma<0>(sln, img, s, lane, EU); asm volatile("s_waitcnt vmcnt(8)" ::: "memory"); }
                else asm volatile("s_waitcnt vmcnt(0)" ::: "memory");
                u_mma<1>(img + 8192, slj, lane, acc);
                asm volatile("s_waitcnt lgkmcnt(0)" ::: "memory");
                u_finish(acc, slj, img + 8192, t0 + j, s, lane, alpha, X, XB, SSQ8);
                asm volatile("s_waitcnt lgkmcnt(0)" ::: "memory");
                char* const t_ = slj; slj = sln; sln = slf; slf = t_;
            }
        }
    }
}

DEVI void rope_cs(float pos, int i, float& c, float& s) {
    const float inv = exp2f(-(float)i * (13.287712379549449f / 32.f));
    const float ang = pos * inv;
    const float kf = rintf(ang * 0.15915494309189535f);
    float rr = fmaf(-kf, 6.2831854820251465f, ang);
    rr = fmaf(-kf, -1.7484555e-7f, rr);
    c = __cosf(rr); s = __sinf(rr);
}
#define QSCALE_MLA  (0.07216878364870322f * 1.4426950408889634f)
#define QSCALE_MOBA (0.08838834764831845f * 1.4426950408889634f)

DEVI void moba_prep_item(const Params& p, int item, char* smem) {
    const int tid = threadIdx.x;
    const int h = item & 3, tt = item >> 2;
    const size_t m0 = (size_t)tt * 64;
    const int b = (int)(m0 >> 13), s0 = (int)(m0 & 8191), bh = b * 4 + h;
    const bf16_t* Z1 = (const bf16_t*)(p.ws + OFF_Z1);
    bf16_t* Qd = (bf16_t*)(p.ws + OFF_QD); bf16_t* Kd = (bf16_t*)(p.ws + OFF_KD); bf16_t* VdT = (bf16_t*)(p.ws + OFF_VDT);
    const int row = tid >> 2, j = tid & 3;
    const bf16_t* zr = Z1 + (m0 + row) * 1984;
#pragma unroll
    for (int which = 0; which < 2; ++which) {
        const bf16_t* src = zr + (which ? 960 : 448) + h * 128 + 32 * j;
        const float* gn = (which ? p.l1_mk_norm : p.l1_mq_norm) + 32 * j;
        float v[32]; float ss = 0.f;
#pragma unroll
        for (int i = 0; i < 4; ++i) {
            uint4 u = *(const uint4*)(src + 8 * i);
            v[8 * i] = bflo(u.x); v[8 * i + 1] = bfhi(u.x); v[8 * i + 2] = bflo(u.y); v[8 * i + 3] = bfhi(u.y);
            v[8 * i + 4] = bflo(u.z); v[8 * i + 5] = bfhi(u.z); v[8 * i + 6] = bflo(u.w); v[8 * i + 7] = bfhi(u.w);
        }
#pragma unroll
        for (int i = 0; i < 32; ++i) ss += v[i] * v[i];
        ss += __shfl_xor(ss, 1); ss += __shfl_xor(ss, 2);
        const float sc = rsqrtf(ss * (1.f / 128.f) + 1e-6f) * (which ? 1.f : QSCALE_MOBA);
        bf16_t* dst = (which ? Kd : Qd) + ((size_t)bh * 8192 + s0 + row) * 128 + 32 * j;
#pragma unroll
        for (int i = 0; i < 4; ++i) {
            uint4 o;
            o.x = pack2(v[8 * i] * sc * gn[8 * i], v[8 * i + 1] * sc * gn[8 * i + 1]); o.y = pack2(v[8 * i + 2] * sc * gn[8 * i + 2], v[8 * i + 3] * sc * gn[8 * i + 3]);
            o.z = pack2(v[8 * i + 4] * sc * gn[8 * i + 4], v[8 * i + 5] * sc * gn[8 * i + 5]); o.w = pack2(v[8 * i + 6] * sc * gn[8 * i + 6], v[8 * i + 7] * sc * gn[8 * i + 7]);
            *(uint4*)(dst + 8 * i) = o;
        }
    }
    bf16_t* sT = (bf16_t*)smem;
    {
        const bf16_t* src = zr + 1472 + h * 128 + 32 * j;
#pragma unroll
        for (int i = 0; i < 4; ++i) {
            uint4 u = *(const uint4*)(src + 8 * i);
            const int d0 = 32 * j + 8 * i;
            sT[(d0 + 0) * 66 + row] = (bf16_t)(u.x & 0xffff); sT[(d0 + 1) * 66 + row] = (bf16_t)(u.x >> 16);
            sT[(d0 + 2) * 66 + row] = (bf16_t)(u.y & 0xffff); sT[(d0 + 3) * 66 + row] = (bf16_t)(u.y >> 16);
            sT[(d0 + 4) * 66 + row] = (bf16_t)(u.z & 0xffff); sT[(d0 + 5) * 66 + row] = (bf16_t)(u.z >> 16);
            sT[(d0 + 6) * 66 + row] = (bf16_t)(u.w & 0xffff); sT[(d0 + 7) * 66 + row] = (bf16_t)(u.w >> 16);
        }
    }
    __syncthreads();
    for (int e = tid; e < 128 * 32; e += NTHREADS) {
        const int d = e >> 5, tp = e & 31;
        const unsigned v = (unsigned)sT[d * 66 + 2 * tp] | ((unsigned)sT[d * 66 + 2 * tp + 1] << 16);
        *(unsigned*)(VdT + ((size_t)bh * 128 + d) * 8192 + s0 + (((2 * tp) & ~12) | (((2 * tp) & 4) << 1) | (((2 * tp) & 8) >> 1))) = v;
    }
    __syncthreads();
}

DEVI void moba_kmean_item(const Params& p, int item, char* smem) {
    const int tid = threadIdx.x;
    const int bh = item >> 5, blk = item & 31, b = bh >> 2, h = bh & 3;
    const bf16_t* Z1 = (const bf16_t*)(p.ws + OFF_Z1) + ((size_t)b * 8192 + blk * 256) * 1984 + 960 + h * 128;
    const int cc = tid & 15, rg = tid >> 4;
    float col[8];
#pragma unroll
    for (int i = 0; i < 8; ++i) col[i] = 0.f;
    for (int i = 0; i < 16; ++i) {
        const int row = rg * 16 + i;
        uint4 u = *(const uint4*)(Z1 + (size_t)row * 1984 + cc * 8);
        float v[8] = {bflo(u.x), bfhi(u.x), bflo(u.y), bfhi(u.y), bflo(u.z), bfhi(u.z), bflo(u.w), bfhi(u.w)};
        float ss = 0.f;
#pragma unroll
        for (int e = 0; e < 8; ++e) ss += v[e] * v[e];
        ss += __shfl_xor(ss, 1); ss += __shfl_xor(ss, 2); ss += __shfl_xor(ss, 4); ss += __shfl_xor(ss, 8);
        const float rstd = rsqrtf(ss * (1.f / 128.f) + 1e-6f);
#pragma unroll
        for (int e = 0; e < 8; ++e) col[e] += v[e] * rstd;
    }
    float* sR = (float*)smem;
#pragma unroll
    for (int e = 0; e < 8; ++e) sR[rg * 128 + cc * 8 + e] = col[e];
    __syncthreads();
    if (tid < 128) {
        float s = 0.f;
#pragma unroll
        for (int g = 0; g < 16; ++g) s += sR[g * 128 + tid];
        ((float*)(p.ws + OFF_KMEAN))[((size_t)bh * 32 + blk) * 128 + tid] = s * (1.f / 256.f) * p.l1_mk_norm[tid];
    }
    __syncthreads();
}

DEVI void mla_prep_item(const Params& p, int item, char* smem) {
    const int tid = threadIdx.x;
    const int h = item & 3, tt = item >> 2;
    const size_t m0 = (size_t)tt * 64;
    const int b = (int)(m0 >> 13), s0 = (int)(m0 & 8191), bh = b * 4 + h;
    const bf16_t* Z1 = (const bf16_t*)(p.ws + OFF_Z1);
    const bf16_t* QC = (const bf16_t*)(p.ws + OFF_QC);
    const bf16_t* KV = (const bf16_t*)(p.ws + OFF_KV);
    bf16_t* Q = (bf16_t*)(p.ws + OFF_Q); bf16_t* K = (bf16_t*)(p.ws + OFF_K); bf16_t* VT = (bf16_t*)(p.ws + OFF_VT);
    const int row = tid >> 2, j = tid & 3;
    const size_t m = m0 + row;
    const float pos = (float)p.pos[m];
#pragma unroll
    for (int which = 0; which < 2; ++which) {
        const bf16_t* nsrc = which ? (KV + m * 1024 + h * 256 + 32 * j) : (QC + m * 768 + h * 192 + 32 * j);
        const bf16_t* r1 = which ? (Z1 + m * 1984 + 384 + 8 * j) : (QC + m * 768 + h * 192 + 128 + 8 * j);
        const bf16_t* r2 = r1 + 32;
        const float* gn = which ? p.l1_k_norm : p.l1_q_norm;
        float v[32], a1[8], a2[8]; float ss = 0.f;
#pragma unroll
        for (int i = 0; i < 4; ++i) {
            uint4 u = *(const uint4*)(nsrc + 8 * i);
            v[8 * i] = bflo(u.x); v[8 * i + 1] = bfhi(u.x); v[8 * i + 2] = bflo(u.y); v[8 * i + 3] = bfhi(u.y);
            v[8 * i + 4] = bflo(u.z); v[8 * i + 5] = bfhi(u.z); v[8 * i + 6] = bflo(u.w); v[8 * i + 7] = bfhi(u.w);
        }
        { uint4 u = *(const uint4*)r1; a1[0] = bflo(u.x); a1[1] = bfhi(u.x); a1[2] = bflo(u.y); a1[3] = bfhi(u.y); a1[4] = bflo(u.z); a1[5] = bfhi(u.z); a1[6] = bflo(u.w); a1[7] = bfhi(u.w); }
        { uint4 u = *(const uint4*)r2; a2[0] = bflo(u.x); a2[1] = bfhi(u.x); a2[2] = bflo(u.y); a2[3] = bfhi(u.y); a2[4] = bflo(u.z); a2[5] = bfhi(u.z); a2[6] = bflo(u.w); a2[7] = bfhi(u.w); }
#pragma unroll
        for (int i = 0; i < 32; ++i) ss += v[i] * v[i];
#pragma unroll
        for (int i = 0; i < 8; ++i) ss += a1[i] * a1[i] + a2[i] * a2[i];
        ss += __shfl_xor(ss, 1); ss += __shfl_xor(ss, 2);
        const float rstd = rsqrtf(ss * (1.f / 192.f) + 1e-6f);
        const float sc = which ? 1.f : QSCALE_MLA;
        bf16_t* dst = (which ? K : Q) + ((size_t)bh * 8192 + s0 + row) * 192;
#pragma unroll
        for (int i = 0; i < 4; ++i) {
            const float* g = gn + 32 * j + 8 * i;
            uint4 o;
            o.x = pack2(v[8 * i] * rstd * g[0] * sc, v[8 * i + 1] * rstd * g[1] * sc); o.y = pack2(v[8 * i + 2] * rstd * g[2] * sc, v[8 * i + 3] * rstd * g[3] * sc);
            o.z = pack2(v[8 * i + 4] * rstd * g[4] * sc, v[8 * i + 5] * rstd * g[5] * sc); o.w = pack2(v[8 * i + 6] * rstd * g[6] * sc, v[8 * i + 7] * rstd * g[7] * sc);
            *(uint4*)(dst + 32 * j + 8 * i) = o;
        }
        float o1[8], o2[8];
#pragma unroll
        for (int i = 0; i < 8; ++i) {
            float c, s; rope_cs(pos, 8 * j + i, c, s);
            const float y1 = a1[i] * rstd * gn[128 + 8 * j + i], y2 = a2[i] * rstd * gn[160 + 8 * j + i];
            o1[i] = (y1 * c - y2 * s) * sc; o2[i] = (y2 * c + y1 * s) * sc;
        }
        uint4 w1, w2;
        w1.x = pack2(o1[0], o1[1]); w1.y = pack2(o1[2], o1[3]); w1.z = pack2(o1[4], o1[5]); w1.w = pack2(o1[6], o1[7]);
        w2.x = pack2(o2[0], o2[1]); w2.y = pack2(o2[2], o2[3]); w2.z = pack2(o2[4], o2[5]); w2.w = pack2(o2[6], o2[7]);
        *(uint4*)(dst + 128 + 8 * j) = w1; *(uint4*)(dst + 160 + 8 * j) = w2;
    }
    bf16_t* sT = (bf16_t*)smem;
    {
        const bf16_t* src = KV + m * 1024 + h * 256 + 128 + 32 * j;
#pragma unroll
        for (int i = 0; i < 4; ++i) {
            uint4 u = *(const uint4*)(src + 8 * i);
            const int d0 = 32 * j + 8 * i;
            sT[(d0 + 0) * 66 + row] = (bf16_t)(u.x & 0xffff); sT[(d0 + 1) * 66 + row] = (bf16_t)(u.x >> 16);
            sT[(d0 + 2) * 66 + row] = (bf16_t)(u.y & 0xffff); sT[(d0 + 3) * 66 + row] = (bf16_t)(u.y >> 16);
            sT[(d0 + 4) * 66 + row] = (bf16_t)(u.z & 0xffff); sT[(d0 + 5) * 66 + row] = (bf16_t)(u.z >> 16);
            sT[(d0 + 6) * 66 + row] = (bf16_t)(u.w & 0xffff); sT[(d0 + 7) * 66 + row] = (bf16_t)(u.w >> 16);
        }
    }
    __syncthreads();
    for (int e = tid; e < 128 * 32; e += NTHREADS) {
        const int d = e >> 5, tp = e & 31;
        const unsigned v = (unsigned)sT[d * 66 + 2 * tp] | ((unsigned)sT[d * 66 + 2 * tp + 1] << 16);
        *(unsigned*)(VT + ((size_t)bh * 128 + d) * 8192 + s0 + (((2 * tp) & ~12) | (((2 * tp) & 4) << 1) | (((2 * tp) & 8) >> 1))) = v;
    }
    __syncthreads();
}

template <int DQK, bool MOBA>
DEVI void attn_item(const Params& p, int bh, int qt, char* smem) {
    constexpr int NKS = DQK / 16, KCH = DQK / 8;
    const int tid = threadIdx.x, lane = tid & 63, wave = tid >> 6;
    const int r = lane & 31, hh = lane >> 5;
    char* const ws = opaque_ptr(p.ws);
    const bf16_t* Q  = (const bf16_t*)(ws + (MOBA ? OFF_QD : OFF_Q)) + (size_t)bh * 8192 * DQK;
    const bf16_t* Kg = (const bf16_t*)(ws + (MOBA ? OFF_KD : OFF_K)) + (size_t)bh * 8192 * DQK;
    const bf16_t* Vg = (const bf16_t*)(ws + (MOBA ? OFF_VDT : OFF_VT)) + (size_t)bh * 128 * 8192;
    const int q0 = qt * 128;
    const int qpos = q0 + wave * 32 + r;
    constexpr int KB = 32 * DQK * 2, VB = 8192, STG = KB + VB;
    constexpr int KI = KB / 4096;
    int*  sList = (int*)(smem + 61440);
    unsigned* sSel = (unsigned*)(smem + 62464);
    float* sTop = (float*)(smem + 63232);
    int ntiles;
    unsigned mysel = 0xffffffffu;
    if constexpr (MOBA) {
        const int jblk = q0 >> 8;
        float* sKm = (float*)smem;
        const float* km = (const float*)(ws + OFF_KMEAN) + (size_t)bh * 32 * 128;
        for (int e = tid; e < 1024; e += NTHREADS) ((float4*)sKm)[e] = ((const float4*)km)[e];
        unsigned* sAny = (unsigned*)(smem + 62976);
        if (tid < 32) sAny[tid] = 0u;
        __syncthreads();
        const int qq = tid & 127, par = tid >> 7;
        float ga[16];
#pragma unroll
        for (int i = 0; i < 16; ++i) ga[i] = 0.f;
        const bf16_t* qrow = Q + (size_t)(q0 + qq) * 128;
#pragma unroll 1
        for (int d0 = 0; d0 < 128; d0 += 8) {
            uint4 u = *(const uint4*)(qrow + d0);
            float qv[8] = {bflo(u.x), bfhi(u.x), bflo(u.y), bfhi(u.y), bflo(u.z), bfhi(u.z), bflo(u.w), bfhi(u.w)};
#pragma unroll
            for (int i = 0; i < 16; ++i) {
                const float4 ka = *(const float4*)(sKm + (2 * i + par) * 128 + d0), kb = *(const float4*)(sKm + (2 * i + par) * 128 + d0 + 4);
                ga[i] += qv[0] * ka.x + qv[1] * ka.y + qv[2] * ka.z + qv[3] * ka.w + qv[4] * kb.x + qv[5] * kb.y + qv[6] * kb.z + qv[7] * kb.w;
            }
        }
        float tv[3] = {-3e38f, -3e38f, -3e38f}; int ti[3] = {-1, -1, -1};
#pragma unroll
        for (int i = 0; i < 16; ++i) {
            const int n = 2 * i + par;
            if (n < jblk) {
                const float v = ga[i];
                if (v > tv[0]) { tv[2] = tv[1]; ti[2] = ti[1]; tv[1] = tv[0]; ti[1] = ti[0]; tv[0] = v; ti[0] = n; }
                else if (v > tv[1]) { tv[2] = tv[1]; ti[2] = ti[1]; tv[1] = v; ti[1] = n; }
                else if (v > tv[2]) { tv[2] = v; ti[2] = n; }
            }
        }
#pragma unroll
        for (int i = 0; i < 3; ++i) { sTop[tid * 6 + 2 * i] = tv[i]; sTop[tid * 6 + 2 * i + 1] = __int_as_float(ti[i]); }
        __syncthreads();
        if (par == 0) {
#pragma unroll
            for (int i = 0; i < 3; ++i) {
                const float v = sTop[(tid + 128) * 6 + 2 * i]; const int n = __float_as_int(sTop[(tid + 128) * 6 + 2 * i + 1]);
                if (n >= 0) {
                    if (v > tv[0]) { tv[2] = tv[1]; ti[2] = ti[1]; tv[1] = tv[0]; ti[1] = ti[0]; tv[0] = v; ti[0] = n; }
                    else if (v > tv[1]) { tv[2] = tv[1]; ti[2] = ti[1]; tv[1] = v; ti[1] = n; }
                    else if (v > tv[2]) { tv[2] = v; ti[2] = n; }
                }
            }
            unsigned m = 1u << jblk;
#pragma unroll
            for (int i = 0; i < 3; ++i) if (ti[i] >= 0) { m |= 1u << ti[i]; sAny[ti[i]] = 1u; }
            sSel[qq] = m;
        }
        __syncthreads();
        if (tid == 0) {
            int n = 0;
            for (int blk = 0; blk < jblk; ++blk) if (sAny[blk]) { for (int t = 0; t < 8; ++t) sList[n++] = blk * 8 + t; }
            for (int t = jblk * 8; t < (q0 + 128) / 32; ++t) sList[n++] = t;
            sSel[160] = (unsigned)n;
        }
        __syncthreads();
        ntiles = (int)sSel[160];
        mysel = sSel[wave * 32 + r];
        __syncthreads();
    } else {
        ntiles = 4 * qt + 4;
    }
    bf16x8 qf[NKS];
#pragma unroll
    for (int ks = 0; ks < NKS; ++ks) qf[ks] = *(const bf16x8*)(Q + (size_t)qpos * DQK + ks * 16 + hh * 8);
    f32x16 o[4];
#pragma unroll
    for (int dt = 0; dt < 4; ++dt)
#pragma unroll
        for (int e = 0; e < 16; ++e) o[dt][e] = 0.f;
    float lsum = 0.f;
    int koff[KI], voff[2];
#pragma unroll
    for (int i = 0; i < KI; ++i) {
        const int L = (wave * KI + i) * 64 + lane, row = L / KCH, cp = L % KCH;
        const int f = (DQK == 128) ? (row & 15) : ((row >> 1) & 7);
        koff[i] = row * DQK + (cp ^ f) * 8;
    }
#pragma unroll
    for (int i = 0; i < 2; ++i) {
        const int L = (wave * 2 + i) * 64 + lane, dv = L >> 2, cp = L & 3;
        voff[i] = dv * 8192 + (cp ^ ((dv >> 2) & 3)) * 8;
    }
    const int wv = __builtin_amdgcn_readfirstlane(wave);
#define ATT_ISSUE(LI) { const int u_ = tile_id(LI); char* st_ = smem + ((LI) % 3) * STG; \
        _Pragma("unroll") for (int i = 0; i < KI; ++i) __builtin_amdgcn_global_load_lds((const unsigned*)(Kg + (size_t)u_ * 32 * DQK + koff[i]), (unsigned*)(st_ + (wv * KI + i) * 1024), 16, 0, 0); \
        _Pragma("unroll") for (int i = 0; i < 2; ++i)  __builtin_amdgcn_global_load_lds((const unsigned*)(Vg + (size_t)u_ * 32 + voff[i]),       (unsigned*)(st_ + KB + (wv * 2 + i) * 1024), 16, 0, 0); }
    auto tile_id = [&](int li) -> int { if constexpr (MOBA) return sList[li]; else return li; };
    if (ntiles > 0) ATT_ISSUE(0)
    if (ntiles > 1) ATT_ISSUE(1)
    const int xk = ((DQK == 128) ? (r & 15) : ((r >> 1) & 7)) ^ hh;
    const int xv = (r >> 2) & 3;
#pragma unroll 1
    for (int li = 0; li < ntiles; ++li) {
        if (li + 1 < ntiles) asm volatile("s_waitcnt vmcnt(%0)" :: "n"(KI + 2) : "memory");
        else asm volatile("s_waitcnt vmcnt(0)" ::: "memory");
        G2_RAW_BARRIER();
        if (li + 2 < ntiles) ATT_ISSUE(li + 2)
        const int unit = tile_id(li);
        const int kbase = unit * 32;
        bool allowed = true;
        if constexpr (MOBA) allowed = (mysel >> (unit >> 3)) & 1u;
        const char* sK = smem + (li % 3) * STG;
        const char* sV = sK + KB;
        if (kbase <= q0 + wave * 32 + 31) {
            const char* kbase_l = sK + r * (DQK * 2);
            const char* vbase_l = sV + r * 64;
            f32x16 s;
#pragma unroll
            for (int e = 0; e < 16; ++e) s[e] = 0.f;
#pragma unroll
            for (int ks = 0; ks < NKS; ++ks) {
                const bf16x8 a = *(const bf16x8*)(kbase_l + (((2 * ks) ^ xk) << 4));
                s = mfma32(a, qf[ks], s);
            }
            const bool need_mask = (kbase + 31 > q0 + wave * 32);
            float pr[16];
            if (need_mask) {
                const int kofs = qpos - kbase - 4 * hh;
#pragma unroll
                for (int e = 0; e < 16; ++e) pr[e] = ((e & 3) + 8 * (e >> 2) <= kofs) ? __builtin_amdgcn_exp2f(s[e]) : 0.f;
            } else {
#pragma unroll
                for (int e = 0; e < 16; ++e) pr[e] = __builtin_amdgcn_exp2f(s[e]);
            }
            if constexpr (MOBA) {
                const float am = allowed ? 1.f : 0.f;
#pragma unroll
                for (int e = 0; e < 16; ++e) pr[e] *= am;
            }
            lsum += ((pr[0] + pr[1]) + (pr[2] + pr[3])) + ((pr[4] + pr[5]) + (pr[6] + pr[7])) + ((pr[8] + pr[9]) + (pr[10] + pr[11])) + ((pr[12] + pr[13]) + (pr[14] + pr[15]));
#pragma unroll
            for (int s2 = 0; s2 < 2; ++s2) {
                const u32x4 pbu = {pack2(pr[8 * s2 + 0], pr[8 * s2 + 1]), pack2(pr[8 * s2 + 2], pr[8 * s2 + 3]),
                                   pack2(pr[8 * s2 + 4], pr[8 * s2 + 5]), pack2(pr[8 * s2 + 6], pr[8 * s2 + 7])};
                const bf16x8 pbv = __builtin_bit_cast(bf16x8, pbu);
#pragma unroll
                for (int dt = 0; dt < 4; ++dt) {
                    const char* vb = vbase_l + dt * (32 * 64);
                    const u32x4 vau = *(const u32x4*)(vb + (((2 * s2 + hh) ^ xv) << 4));
                    o[dt] = mfma32(__builtin_bit_cast(bf16x8, vau), pbv, o[dt]);
                }
            }
        }
    }
#undef ATT_ISSUE
    G2_RAW_BARRIER();
    lsum += __shfl_xor(lsum, 32);
    const float inv = 1.f / lsum;
    char* sO = smem + wave * 8704;
#pragma unroll
    for (int dt = 0; dt < 4; ++dt)
#pragma unroll
        for (int e = 0; e < 16; e += 2) {
            const int dv = 32 * dt + (e & 3) + 8 * (e >> 2) + 4 * hh;
            *(unsigned*)(sO + r * 272 + dv * 2) = pack2(o[dt][e] * inv, o[dt][e + 1] * inv);
        }
    __builtin_amdgcn_s_waitcnt(0xc07f);
    __builtin_amdgcn_wave_barrier();
    bf16_t* MIX = (bf16_t*)(ws + OFF_MIX1);
    const int b = bh >> 2, h = bh & 3;
#pragma unroll
    for (int i = 0; i < 8; ++i) {
        const int id = lane + 64 * i, row = id >> 4, cc = id & 15;
        const uint4 v = *(const uint4*)(sO + row * 272 + cc * 16);
        *(uint4*)(MIX + ((size_t)b * 8192 + q0 + wave * 32 + row) * 1024 + (MOBA ? 512 : 0) + h * 128 + cc * 8) = v;
    }
    __syncthreads();
}

DEVI void attn_phase_all(const Params& p, char* smem) {
    const int G = gridDim.x;
#pragma unroll 1
    for (int v = blockIdx.x; v < 512; v += G) attn_item<192, false>(p, v & 7, 63 - (v >> 3), smem);
    __builtin_amdgcn_sched_barrier(0);
#pragma unroll 1
    for (int v = blockIdx.x; v < 512; v += G) attn_item<128, true>(p, v & 7, (v >> 3), smem);
}

#define XB_TMO      128
#define XB_XCNT(j)  (256  + 64 * (j))
#define XB_XSUB(j)  (1280 + 64 * (j))
#define XB_XGEN(j)  (2304 + 64 * (j))
#define XB_TOP      3328
#define XB_TOPGEN   3392
#define XCD_BAR_WORDS 3456
#define XB_SPIN_CAP (1u << 23)
#define LAS __attribute__((address_space(3)))
DEVI unsigned xb_ld(unsigned* p)              { return __hip_atomic_load(p, __ATOMIC_RELAXED, __HIP_MEMORY_SCOPE_AGENT); }
DEVI unsigned xb_add(unsigned* p, unsigned v) { return __hip_atomic_fetch_add(p, v, __ATOMIC_RELAXED, __HIP_MEMORY_SCOPE_AGENT); }
DEVI unsigned xb_xcc_id() { return (unsigned)__builtin_amdgcn_s_getreg((3 << 11) | 20) & 0xFu; }
#define XB_SPIN(cond, bar) do { unsigned _sp = 0; while (cond) { __builtin_amdgcn_s_sleep(1); \
    if ((++_sp & 255u) == 0u) { if (xb_ld(&(bar)[XB_TMO])) break; if (_sp > XB_SPIN_CAP) { atomicAdd(&(bar)[XB_TMO], 1u); break; } } } } while (0)
struct XcdBarrier { unsigned* bar; unsigned x; volatile LAS unsigned* st; };
DEVI XcdBarrier xcd_barrier_post(unsigned* bar, volatile LAS unsigned* st) {
    XcdBarrier b; b.bar = bar; b.x = xb_xcc_id(); b.st = st;
    if (threadIdx.x == 0) st[2] = xb_add(&bar[XB_XCNT(b.x)], 1u);
    return b;
}
DEVI void xcd_barrier_complete(unsigned* bar, unsigned x, unsigned& nloc, unsigned& nx, unsigned& dense) {
    const unsigned G = gridDim.x * gridDim.y * gridDim.z;
    unsigned sum, cnt, mine, sp = 0u;
    for (;;) {
        sum = 0u; cnt = 0u; mine = 0u; dense = 0u;
#pragma unroll
        for (unsigned j = 0; j < 16; ++j) { const unsigned c = xb_ld(&bar[XB_XCNT(j)]); sum += c; cnt += (c > 0u) ? 1u : 0u; mine = (j == x) ? c : mine; dense += (j < x && c > 0u) ? 1u : 0u; }
        if (sum == G) break;
        __builtin_amdgcn_s_sleep(1);
        if ((++sp & 255u) == 0u) { if (xb_ld(&bar[XB_TMO])) break; if (sp > XB_SPIN_CAP) { atomicAdd(&bar[XB_TMO], 1u); break; } }
    }
    nloc = mine > 0u ? mine : 1u; nx = cnt > 0u ? cnt : 1u;
}
DEVI void xcd_barrier(const XcdBarrier& b) {
    asm volatile("s_waitcnt vmcnt(0)" ::: "memory");
    __syncthreads();
    if (threadIdx.x == 0) {
        unsigned* bar = b.bar;
        __builtin_amdgcn_s_waitcnt(0);
        unsigned nloc = b.st[0], nx = b.st[1];
        if (nloc == 0u) { unsigned dense = 0u; xcd_barrier_complete(bar, b.x, nloc, nx, dense); b.st[0] = nloc; b.st[1] = nx; b.st[3] = dense; }
        const unsigned old = xb_add(&bar[XB_XSUB(b.x)], 1u);
        const unsigned gen = old / nloc;
        if (old + 1u == (gen + 1u) * nloc) {
            __builtin_amdgcn_fence(__ATOMIC_RELEASE, "agent");
            asm volatile("s_waitcnt vmcnt(0)" ::: "memory");
            const unsigned og = xb_add(&bar[XB_TOP], 1u);
            const unsigned tg = og / nx;
            if (og + 1u == (tg + 1u) * nx) xb_add(&bar[XB_TOPGEN], 1u);
            else XB_SPIN(xb_ld(&bar[XB_TOPGEN]) == tg, bar);
            __builtin_amdgcn_fence(__ATOMIC_ACQUIRE, "agent");
            xb_add(&bar[XB_XGEN(b.x)], 1u);
            asm volatile("s_waitcnt vmcnt(0)" ::: "memory");
        } else {
            XB_SPIN(xb_ld(&bar[XB_XGEN(b.x)]) == gen, bar);
            __builtin_amdgcn_fence(__ATOMIC_ACQUIRE, "agent");
            asm volatile("s_waitcnt vmcnt(0)" ::: "memory");
        }
    }
    __syncthreads();
}

enum { PH_CONV, PH_INPROJ0, PH_LOCAL, PH_SCAN, PH_HOUT, PH_OUTPROJ0, PH_Q0, PH_TOPK0, PH_PD0, PH_PR0, PH_PU0, PH_INPROJ1, PH_SMALL, PH_MLAPREP, PH_MLA,
       PH_OUTPROJ1, PH_Q1, PH_TOPK1, PH_PD1, PH_PR1, PH_PU1, N_PHASES };
DEVI void run_phase(const Params& p, int ph_in, char* smem, Placement pl) {
    const bool dup = ph_in >= 100; const int ph = dup ? ph_in - 100 : ph_in;
#ifdef ONLY_PHASE
    if (ph != ONLY_PHASE) return;
#endif
    char* ws = p.ws;
    const int bid = blockIdx.x, nb = gridDim.x;
    const int myslice = (pl.nloc > 0) ? (pl.xcc & 7) : (bid & 7);
    switch (ph) {
    case PH_CONV: phase_convert(p, smem); break;
    case PH_INPROJ0: gemm2_phase((const bf16_t*)(ws + OFF_XB), 1024, (const bf16_t*)(ws + OFF_W_IN0T), 128, 12, 1024, (const float*)(ws + OFF_SSQ1), 1,
                        Epi2In0{(bf16_t*)(ws + OFF_Z0), (float*)(ws + OFF_G), (const float*)(ws + OFF_LB), (bf16_t*)(ws + OFF_Z0), 3072, 3072, nullptr, nullptr}, smem, pl); break;
    case PH_LOCAL: for (int it = bid; it < 1024; it += nb) hgrn_local_item(p, it, smem);
            for (int it = nb - 1 - bid; it < 512; it += nb) gmlp_item(p, it, smem);
            break;
    case PH_SCAN: hgrn_scan_phase(p); break;
    case PH_HOUT: for (int it = bid; it < 1024; it += nb) hgrn_out_item(p, it, smem); break;
    case PH_OUTPROJ0: case PH_OUTPROJ1: {
        const bool l1 = (ph == PH_OUTPROJ1);
        gemm2_phase((const bf16_t*)(ws + (l1 ? OFF_MIX1 : OFF_MIX0)), 1024, (const bf16_t*)(ws + (l1 ? OFF_W_OUT1T : OFF_W_OUT0T)), 128, 4, 1024, nullptr, 0,
                    Epi2Resid{(bf16_t*)(ws + OFF_XB), (float*)(ws + OFF_SSQ16), dup ? 0.f : (l1 ? ALPHA_M1 : ALPHA_M0), nullptr, 0, 0, nullptr, nullptr}, smem, pl);
    } break;
    case PH_Q0: case PH_Q1: {
        const bool l1 = (ph == PH_Q1);
        gemm2_phase((const bf16_t*)(ws + OFF_XB), 1024, (const bf16_t*)(ws + (l1 ? OFF_W_Q1T : OFF_W_Q0T)), 128, 8, 1024, (const float*)(ws + OFF_SSQ16), 16,
                    Epi2Bf16{dup ? (bf16_t*)nullptr : (bf16_t*)(ws + OFF_QP), 2048, 2048, nullptr, nullptr}, smem, pl);
    } break;
    case PH_TOPK0: case PH_TOPK1: peer_topk_phase(p, (const bf16_t*)(ws + (ph == PH_TOPK1 ? OFF_SK1 : OFF_SK0)), bid, nb, smem); break;
    case PH_PD0: case PH_PD1: peer_down_phase(p, (ph == PH_PD1) ? p.l1_norm_ffn : p.l0_norm_ffn, ((ph == PH_PD1) ? 16 : 0) + (dup ? 32 : 0), myslice, smem); break;
    case PH_PR0: case PH_PR1: peer_reduce_phase(p); break;
    case PH_PU0: case PH_PU1: peer_up_phase(p, ((ph == PH_PU1) ? 24 : 8) + (dup ? 32 : 0), myslice, dup ? 0.f : ((ph == PH_PU1) ? ALPHA_P1 : ALPHA_P0), (ph == PH_PU1 && !dup) ? p.out : nullptr, smem); break;
    case PH_INPROJ1: gemm2_phase((const bf16_t*)(ws + OFF_XB), 1024, (const bf16_t*)(ws + OFF_W_IN1T), 128, 8, 1024, (const float*)(ws + OFF_SSQ8), 8, Epi2Bf16{(bf16_t*)(ws + OFF_Z1), 1984, 1984, (float*)(ws + OFF_SSQCQ), (float*)(ws + OFF_SSQCKV)}, smem, pl);
            for (int it = bid; it < 8192; it += nb) conv_experts(p.l1_exp_down, p.l1_exp_up, p.l1_norm_ffn, ws, it);
            break;
    case PH_SMALL: {
        gemm2_phase((const bf16_t*)(ws + OFF_Z1), 1984, (const bf16_t*)(ws + OFF_W_UQT), 128, 3, 256, (const float*)(ws + OFF_SSQCQ), 1, Epi2Bf16{(bf16_t*)(ws + OFF_QC), 768, 768, nullptr, nullptr}, smem, pl);
        gemm2_phase((const bf16_t*)(ws + OFF_Z1) + 256, 1984, (const bf16_t*)(ws + OFF_W_UKVT), 128, 4, 128, (const float*)(ws + OFF_SSQCKV), 1, Epi2Bf16{(bf16_t*)(ws + OFF_KV), 1024, 1024, nullptr, nullptr}, smem, pl);
        for (int it = (bid + nb / 2) % nb; it < 1024 + 256; it += nb) { if (it < 1024) moba_prep_item(p, it, smem); else moba_kmean_item(p, it - 1024, smem); }
    } break;
    case PH_MLAPREP: for (int it = bid; it < 1024; it += nb) mla_prep_item(p, it, smem); break;
    case PH_MLA: attn_phase_all(p, smem); break;
    default: break;
    }
}

extern "C" __global__ void __launch_bounds__(NTHREADS, 2) fwd_kernel(Params p) {
    extern __shared__ __attribute__((aligned(16))) char smem[];
    __shared__ uint4 xb_words;
    XcdBarrier xb; xb.bar = nullptr; xb.x = 0; xb.st = (volatile LAS unsigned*)&xb_words;
    if (p.coop) {
        if (threadIdx.x == 0) xb_words = make_uint4(0u, 0u, 0u, 0u);
        __syncthreads();
        xb = xcd_barrier_post((unsigned*)(p.ws + OFF_BAR), (volatile LAS unsigned*)&xb_words);
    }
    if (p.coop == 2) cg::this_grid().sync();
    long long tp0 = 0, tp1 = 0;
#define RUN_PH(PH) if (p.ph_lo <= PH && PH < p.ph_hi) { \
        Placement pl_; pl_.xcc = p.coop ? (int)xb.st[3] : 0; pl_.rank = p.coop ? (int)xb.st[2] : 0; pl_.nloc = p.coop ? (int)xb.st[0] : 0; pl_.nx = p.coop ? (int)xb.st[1] : 0; \
        if (PROBE_DUP == PH) { run_phase(p, PH + 100, smem, pl_); if (p.coop) xcd_barrier(xb); } \
        if (PROBE_TIME == PH) tp0 = wall_clock64(); \
        run_phase(p, PH, smem, pl_); if (p.coop && PH + 1 < p.ph_hi) xcd_barrier(xb); \
        if (PROBE_TIME == PH) tp1 = wall_clock64(); }
    RUN_PH(0) RUN_PH(1) RUN_PH(2) RUN_PH(3) RUN_PH(4) RUN_PH(5) RUN_PH(6) RUN_PH(7) RUN_PH(8) RUN_PH(9)
    RUN_PH(10) RUN_PH(11) RUN_PH(12) RUN_PH(13) RUN_PH(14) RUN_PH(15) RUN_PH(16) RUN_PH(17) RUN_PH(18) RUN_PH(19) RUN_PH(20)
    if (PROBE_TIME >= 0) { const long long te = wall_clock64(), dt = (tp1 - tp0) * PROBE_TIME_K; while (wall_clock64() - te < dt) __builtin_amdgcn_s_sleep(20); }
}

extern "C" void kernel_launch(void* const* d_in, const int* in_sizes, int n_in, void* d_out, int out_size, void* d_ws, size_t ws_size, hipStream_t stream) {
    static int grid = 0;
    if (grid == 0) {
        if (n_in != 31 || out_size != 16384 * 1024 || ws_size < WS_NEED) { fprintf(stderr, "kernel_launch: unexpected shapes (n_in %d out %d ws %zu need %zu)\n", n_in, out_size, ws_size, (size_t)WS_NEED); grid = -1; return; }
        int dev = 0, cus = 0, per_cu = 0;
        hipGetDevice(&dev);
        hipDeviceGetAttribute(&cus, hipDeviceAttributeMultiprocessorCount, dev);
        if (hipFuncSetAttribute((const void*)fwd_kernel, hipFuncAttributeMaxDynamicSharedMemorySize, LDS_BYTES) != hipSuccess) { fprintf(stderr, "kernel_launch: hipFuncSetAttribute failed\n"); grid = -1; return; }
        if (hipOccupancyMaxActiveBlocksPerMultiprocessor(&per_cu, (const void*)fwd_kernel, NTHREADS, LDS_BYTES) != hipSuccess || per_cu < 1) { fprintf(stderr, "kernel_launch: occupancy query failed (%d)\n", per_cu); per_cu = 1; }
        (void)hipGetLastError();
        if (per_cu > 2) per_cu = 2;
        grid = cus * per_cu;
        fprintf(stderr, "kernel_launch: grid %d (%d CUs x %d)\n", grid, cus, per_cu);
    }
    if (grid < 0) return;
    Params p; memset(&p, 0, sizeof(p));
    const float* const* f = (const float* const*)d_in;
    p.x = f[0]; p.pos = (const int*)d_in[1]; p.lb_logits = f[2];
    p.l0_norm_mix = f[3]; p.l0_w_in = f[4]; p.l0_hgrn_out_norm = f[5]; p.l0_gmlp_v_norm = f[6]; p.l0_gmlp_w_s = f[7]; p.l0_gmlp_b_s = f[8]; p.l0_w_out = f[9];
    p.l0_norm_ffn = f[10]; p.l0_w_query = f[11]; p.l0_sub_keys = f[12]; p.l0_exp_down = f[13]; p.l0_exp_up = f[14];
    p.l1_norm_mix = f[15]; p.l1_w_in = f[16]; p.l1_cq_norm = f[17]; p.l1_ckv_norm = f[18]; p.l1_w_uq = f[19]; p.l1_w_ukv = f[20];
    p.l1_q_norm = f[21]; p.l1_k_norm = f[22]; p.l1_mq_norm = f[23]; p.l1_mk_norm = f[24]; p.l1_w_out = f[25];
    p.l1_norm_ffn = f[26]; p.l1_w_query = f[27]; p.l1_sub_keys = f[28]; p.l1_exp_down = f[29]; p.l1_exp_up = f[30];
    p.out = (float*)d_out; p.ws = (char*)d_ws;
    if (hipMemsetAsync((char*)d_ws + OFF_BAR, 0, 16384 + 4096, stream) != hipSuccess) { fprintf(stderr, "kernel_launch: memset failed\n"); return; }
#if N_LAUNCH_MODE == 1
    p.ph_lo = 0; p.ph_hi = N_PHASES; p.coop = 1;
    void* args[] = {&p};
    hipError_t e = hipLaunchCooperativeKernel((const void*)fwd_kernel, dim3(grid), dim3(NTHREADS), args, LDS_BYTES, stream);
    if (e != hipSuccess) fprintf(stderr, "cooperative launch failed: %s (grid %d)\n", hipGetErrorString(e), grid);
#else
    for (int ph = 0; ph < N_PHASES; ++ph) {
#ifdef ABLATE_M1
        if (ph >= 10 && ph <= 14) continue;
#endif
        p.ph_lo = ph; p.ph_hi = ph + 1; p.coop = 0;
        hipLaunchKernelGGL(fwd_kernel, dim3(grid), dim3(NTHREADS), LDS_BYTES, stream, p);
    }
#endif
}
```

```cpp
#include <hip/hip_runtime.h>
#include <hip/hip_cooperative_groups.h>
#include <stdint.h>
#include <stdio.h>
#include <string.h>
namespace cg = cooperative_groups;

#ifndef ALPHA_P0
#define ALPHA_P0 1.0f
#endif
#ifndef ALPHA_P1
#define ALPHA_P1 1.0f
#endif
#ifndef ALPHA_M0
#define ALPHA_M0 1.0f
#endif
#ifndef ALPHA_M1
#define ALPHA_M1 1.0f
#endif
#define PROBE_TIME -1
#define PROBE_GEMM 0
#define PROBE_TIME_K 4
#ifndef PROBE_NOMMA
#define PROBE_NOMMA 0
#endif
#ifndef PROBE_DUP
#define PROBE_DUP -1
#endif
#ifndef N_LAUNCH_MODE
#define N_LAUNCH_MODE 1
#endif

typedef unsigned short bf16_t;
using bf16x8 = __attribute__((ext_vector_type(8))) short;
using f32x4  = __attribute__((ext_vector_type(4))) float;
using f32x16 = __attribute__((ext_vector_type(16))) float;
typedef float f32x4v __attribute__((ext_vector_type(4)));
typedef float f32x2_t __attribute__((ext_vector_type(2)));
typedef __bf16 bf16x2_t __attribute__((ext_vector_type(2)));
typedef unsigned u32x4 __attribute__((ext_vector_type(4)));

#define DEVI __device__ __forceinline__
#define NTHREADS 256
#define LDS_BYTES 80896

static constexpr size_t MB = 1024 * 1024;
static constexpr size_t OFF_W_IN0T  = 0;
static constexpr size_t OFF_W_OUT0T = OFF_W_IN0T  + 3072ull * 1024 * 2;
static constexpr size_t OFF_W_Q0T   = OFF_W_OUT0T + 1024ull * 1024 * 2;
static constexpr size_t OFF_SK0     = OFF_W_Q0T   + 2048ull * 1024 * 2;
static constexpr size_t OFF_WS0     = OFF_SK0     + 262144ull * 2;
static constexpr size_t OFF_W_IN1T  = OFF_WS0     + 65536ull * 2;
static constexpr size_t OFF_W_UQT   = OFF_W_IN1T  + 2048ull * 1024 * 2;
static constexpr size_t OFF_W_UKVT  = OFF_W_UQT   + 768ull * 256 * 2;
static constexpr size_t OFF_W_OUT1T = OFF_W_UKVT  + 1024ull * 128 * 2;
static constexpr size_t OFF_W_Q1T   = OFF_W_OUT1T + 1024ull * 1024 * 2;
static constexpr size_t OFF_SK1     = OFF_W_Q1T   + 2048ull * 1024 * 2;
static constexpr size_t OFF_LB      = OFF_SK1     + 262144ull * 2;
static constexpr size_t OFF_INVD    = OFF_LB + 4096;
static constexpr size_t OFF_INVU    = OFF_INVD + 65536;
static constexpr size_t OFF_BAR     = OFF_INVU + 65536;
static constexpr size_t OFF_QCNT    = OFF_BAR + 14336;
static constexpr size_t OFF_ED      = 26 * MB;
static constexpr size_t OFF_EU      = OFF_ED + 32 * MB;
static constexpr size_t OFF_ACT     = OFF_EU + 32 * MB;
static constexpr size_t OFF_Z0   = OFF_ACT;
static constexpr size_t OFF_G    = OFF_Z0  + 16384ull * 3072 * 2;
static constexpr size_t OFF_HST  = OFF_G   + 16384ull * 512 * 4;
static constexpr size_t OFF_DEC  = OFF_HST + 1024ull * 16384 * 4;
static constexpr size_t OFF_MIX0 = OFF_DEC + 1024ull * 128 * 4;
static constexpr size_t OFF_QP   = OFF_ACT;
static constexpr size_t OFF_IDX  = OFF_QP  + 16384ull * 2048 * 2;
static constexpr size_t OFF_GATE = OFF_IDX + 16384ull * 128 * 4;
static constexpr size_t OFF_ACTW = OFF_GATE + 16384ull * 128 * 4;
static constexpr size_t OFF_PART = OFF_QP;
static constexpr size_t OFF_SDN  = OFF_ACTW + 16384ull * 128 * 4;
static constexpr size_t OFF_UREC = OFF_SDN + 16384ull * 128 * 4;
static constexpr size_t OFF_Z1   = OFF_ACT;
static constexpr size_t OFF_MIX1 = OFF_ACT;
static constexpr size_t OFF_QC   = OFF_Z1  + 16384ull * 1984 * 2;
static constexpr size_t OFF_KV   = OFF_QC  + 16384ull * 768 * 2;
static constexpr size_t OFF_QD   = OFF_KV  + 16384ull * 1024 * 2;
static constexpr size_t OFF_KD   = OFF_QD  + 16384ull * 512 * 2;
static constexpr size_t OFF_VDT  = OFF_KD  + 16384ull * 512 * 2;
static constexpr size_t OFF_Q    = OFF_VDT + 16384ull * 512 * 2;
static constexpr size_t OFF_K    = OFF_Q   + 16384ull * 768 * 2;
static constexpr size_t OFF_VT   = OFF_K   + 16384ull * 768 * 2;
static constexpr size_t OFF_KMEAN= OFF_VT  + 16384ull * 512 * 2;
static constexpr size_t WS_END_L1 = OFF_KMEAN + 8ull * 32 * 128 * 4;
static constexpr size_t WS_END_L0 = OFF_MIX0 + 16384ull * 1024 * 2;
static constexpr size_t WS_END_ACT = (WS_END_L1 > WS_END_L0 ? WS_END_L1 : WS_END_L0);
static constexpr size_t OFF_XB    = (WS_END_ACT + 255) / 256 * 256;
static constexpr size_t OFF_SSQ1  = OFF_XB + 16384ull * 1024 * 2;
static constexpr size_t OFF_SSQ16 = OFF_SSQ1 + 16384ull * 4;
static constexpr size_t OFF_SSQ8  = OFF_SSQ16 + 16384ull * 16 * 4;
static constexpr size_t OFF_XB8   = OFF_ED + 16 * MB;
static constexpr size_t OFF_SSQCQ = OFF_SSQ8 + 16384ull * 8 * 4;
static constexpr size_t OFF_SSQCKV = OFF_SSQCQ + 16384ull * 4;
static constexpr size_t WS_NEED = OFF_SSQCKV + 16384ull * 4;
static_assert(OFF_BAR + 16384 + 4096 <= OFF_ED, "weights overflow");

struct Params {
    const float* x; const int* pos; const float* lb_logits;
    const float *l0_norm_mix, *l0_w_in, *l0_hgrn_out_norm, *l0_gmlp_v_norm, *l0_gmlp_w_s, *l0_gmlp_b_s, *l0_w_out,
                *l0_norm_ffn, *l0_w_query, *l0_sub_keys, *l0_exp_down, *l0_exp_up;
    const float *l1_norm_mix, *l1_w_in, *l1_cq_norm, *l1_ckv_norm, *l1_w_uq, *l1_w_ukv, *l1_q_norm, *l1_k_norm,
                *l1_mq_norm, *l1_mk_norm, *l1_w_out, *l1_norm_ffn, *l1_w_query, *l1_sub_keys, *l1_exp_down, *l1_exp_up;
    float* out;
    char* ws;
    int ph_lo, ph_hi, coop, pad0;
};

DEVI unsigned pack2(float lo, float hi) { f32x2_t v = {lo, hi}; bf16x2_t b = __builtin_convertvector(v, bf16x2_t); return __builtin_bit_cast(unsigned, b); }
DEVI bf16_t f2bf(float f) { return (bf16_t)(pack2(f, 0.f) & 0xffffu); }
DEVI float bf2f(bf16_t h) { return __uint_as_float(((unsigned)h) << 16); }
DEVI float bflo(unsigned u) { return __uint_as_float(u << 16); }
DEVI float bfhi(unsigned u) { return __uint_as_float(u & 0xffff0000u); }
#define DPP_F(V, CTRL) __builtin_bit_cast(float, __builtin_amdgcn_update_dpp(0, __builtin_bit_cast(int, (V)), (CTRL), 0xF, 0xF, true))
DEVI float wave_sum_dpp(float v) {
    v += DPP_F(v, 0xB1);
    v += DPP_F(v, 0x4E);
    v += DPP_F(v, 0x141);
    v += DPP_F(v, 0x140);
    return __builtin_bit_cast(float, __builtin_amdgcn_readlane(__builtin_bit_cast(int, v), 0)) + __builtin_bit_cast(float, __builtin_amdgcn_readlane(__builtin_bit_cast(int, v), 16))
         + __builtin_bit_cast(float, __builtin_amdgcn_readlane(__builtin_bit_cast(int, v), 32)) + __builtin_bit_cast(float, __builtin_amdgcn_readlane(__builtin_bit_cast(int, v), 48));
}
DEVI float wave_max_dpp(float v) {
    v = fmaxf(v, DPP_F(v, 0xB1)); v = fmaxf(v, DPP_F(v, 0x4E)); v = fmaxf(v, DPP_F(v, 0x141)); v = fmaxf(v, DPP_F(v, 0x140));
    return fmaxf(fmaxf(__builtin_bit_cast(float, __builtin_amdgcn_readlane(__builtin_bit_cast(int, v), 0)), __builtin_bit_cast(float, __builtin_amdgcn_readlane(__builtin_bit_cast(int, v), 16))),
                 fmaxf(__builtin_bit_cast(float, __builtin_amdgcn_readlane(__builtin_bit_cast(int, v), 32)), __builtin_bit_cast(float, __builtin_amdgcn_readlane(__builtin_bit_cast(int, v), 48))));
}
DEVI float sigm(float x) { return 1.f / (1.f + __expf(-x)); }
DEVI float gelu_tanh(float x) {
    float y = 0.7978845608028654f * (x + 0.044715f * x * x * x);
    float e = __expf(2.f * y);
    float t = 1.f - 2.f / (1.f + e);
    return 0.5f * x * (1.f + t);
}
DEVI char* opaque_ptr(char* q) { asm volatile("" : "+s"(q)); return q; }
DEVI f32x4  mfma16(bf16x8 a, bf16x8 b, f32x4 c)  { return __builtin_amdgcn_mfma_f32_16x16x32_bf16(a, b, c, 0, 0, 0); }
DEVI f32x16 mfma32(bf16x8 a, bf16x8 b, f32x16 c) { return __builtin_amdgcn_mfma_f32_32x32x16_bf16(a, b, c, 0, 0, 0); }

template <int KW> DEVI int swz_off(int row, int c) {
    if constexpr (KW == 128) return row * 256 + ((c ^ (row & 15)) << 4);
    else return row * (KW * 2) + ((c ^ ((row >> 1) & 7)) << 4);
}
template <int KW> DEVI int swz_elem(int row, int k) { return swz_off<KW>(row, k >> 3) + ((k & 7) << 1); }

template <int MT, int NT, int KWA, int KWB>
DEVI void mma_nt(f32x4 (&acc)[MT][NT], const char* A, int a_row0, const char* B, int b_row0, int kc0, int nks, int lane) {
    const int r = lane & 15, q = lane >> 4;
#pragma unroll 1
    for (int ks = 0; ks < nks; ++ks) {
        bf16x8 a[MT], b[NT];
#pragma unroll
        for (int i = 0; i < MT; ++i) a[i] = *(const bf16x8*)(A + swz_off<KWA>(a_row0 + 16 * i + r, kc0 + ks * 4 + q));
#pragma unroll
        for (int j = 0; j < NT; ++j) b[j] = *(const bf16x8*)(B + swz_off<KWB>(b_row0 + 16 * j + r, kc0 + ks * 4 + q));
#pragma unroll
        for (int i = 0; i < MT; ++i)
#pragma unroll
            for (int j = 0; j < NT; ++j) acc[i][j] = mfma16(a[i], b[j], acc[i][j]);
    }
}

DEVI void conv_transpose_tile(const float* __restrict__ src, int K, int N, bf16_t* __restrict__ dst, int kt, int nt, char* smem, const float* __restrict__ kgain = nullptr) {
    float* s = (float*)smem;
    const int tid = threadIdx.x;
    for (int e = tid; e < 4096; e += NTHREADS) {
        int kk = e >> 6, nn = e & 63;
        int n = nt * 64 + nn;
        const float gk = kgain ? kgain[kt * 64 + kk] : 1.f;
        s[kk * 65 + nn] = (n < N) ? src[(size_t)(kt * 64 + kk) * N + n] * gk : 0.f;
    }
    __syncthreads();
    for (int e = tid; e < 2048; e += NTHREADS) {
        int nn = e >> 5, kp = e & 31;
        unsigned v = pack2(s[(2 * kp) * 65 + nn], s[(2 * kp + 1) * 65 + nn]);
        *(unsigned*)(dst + (size_t)(nt * 64 + nn) * K + kt * 64 + 2 * kp) = v;
    }
    __syncthreads();
}
DEVI void conv_plain_chunk(const float* __restrict__ src, bf16_t* __restrict__ dst, size_t chunk) {
    const int tid = threadIdx.x;
    size_t base = chunk * 4096 + (size_t)tid * 16;
    const float4* s4 = (const float4*)(src + base);
    float4 a = s4[0], b = s4[1], c = s4[2], d = s4[3];
    uint4 o0, o1;
    o0.x = pack2(a.x, a.y); o0.y = pack2(a.z, a.w); o0.z = pack2(b.x, b.y); o0.w = pack2(b.z, b.w);
    o1.x = pack2(c.x, c.y); o1.y = pack2(c.z, c.w); o1.z = pack2(d.x, d.y); o1.w = pack2(d.z, d.w);
    uint4* d4 = (uint4*)(dst + base);
    d4[0] = o0; d4[1] = o1;
}
DEVI void conv_experts(const float* down, const float* up, const float* __restrict__ dgain, char* ws, int it  ) {
    const int lane = threadIdx.x & 63, wave = threadIdx.x >> 6;
    const bool isup = it >= 4096;
    const int row = (isup ? it - 4096 : it) * 4 + wave;
    const float* src = (isup ? up : down) + (size_t)row * 1024 + 16 * lane;
    float4 a = *(const float4*)src, b = *(const float4*)(src + 4), c = *(const float4*)(src + 8), d = *(const float4*)(src + 12);
    if (!isup) {
        const float4 ga = *(const float4*)(dgain + 16 * lane), gb = *(const float4*)(dgain + 16 * lane + 4), gc = *(const float4*)(dgain + 16 * lane + 8), gd = *(const float4*)(dgain + 16 * lane + 12);
        a.x *= ga.x; a.y *= ga.y; a.z *= ga.z; a.w *= ga.w; b.x *= gb.x; b.y *= gb.y; b.z *= gb.z; b.w *= gb.w;
        c.x *= gc.x; c.y *= gc.y; c.z *= gc.z; c.w *= gc.w; d.x *= gd.x; d.y *= gd.y; d.z *= gd.z; d.w *= gd.w;
    }
    float mx = fmaxf(fmaxf(fmaxf(fabsf(a.x), fabsf(a.y)), fmaxf(fabsf(a.z), fabsf(a.w))), fmaxf(fmaxf(fabsf(b.x), fabsf(b.y)), fmaxf(fabsf(b.z), fabsf(b.w))));
    mx = fmaxf(mx, fmaxf(fmaxf(fmaxf(fabsf(c.x), fabsf(c.y)), fmaxf(fabsf(c.z), fabsf(c.w))), fmaxf(fmaxf(fabsf(d.x), fabsf(d.y)), fmaxf(fabsf(d.z), fabsf(d.w)))));
    mx = wave_max_dpp(mx);
    const float sc = (mx > 0.f) ? 416.f / mx : 1.f;
    const float inv = (mx > 0.f) ? mx / 416.f : 1.f;
    int w0 = 0, w1 = 0, w2 = 0, w3 = 0;
    w0 = __builtin_amdgcn_cvt_pk_fp8_f32(a.x * sc, a.y * sc, w0, false); w0 = __builtin_amdgcn_cvt_pk_fp8_f32(a.z * sc, a.w * sc, w0, true);
    w1 = __builtin_amdgcn_cvt_pk_fp8_f32(b.x * sc, b.y * sc, w1, false); w1 = __builtin_amdgcn_cvt_pk_fp8_f32(b.z * sc, b.w * sc, w1, true);
    w2 = __builtin_amdgcn_cvt_pk_fp8_f32(c.x * sc, c.y * sc, w2, false); w2 = __builtin_amdgcn_cvt_pk_fp8_f32(c.z * sc, c.w * sc, w2, true);
    w3 = __builtin_amdgcn_cvt_pk_fp8_f32(d.x * sc, d.y * sc, w3, false); w3 = __builtin_amdgcn_cvt_pk_fp8_f32(d.z * sc, d.w * sc, w3, true);
    *(int4*)(ws + (isup ? OFF_EU : OFF_ED) + ((size_t)(lane >> 3) * 16384 + row) * 128 + 16 * (lane & 7)) = int4{w0, w1, w2, w3};
    if (lane == 0) ((float*)(ws + (isup ? OFF_INVU : OFF_INVD)))[row] = inv;
}

DEVI void phase_convert(const Params& p, char* smem) {
    char* ws = p.ws;
    const int bid = blockIdx.x, nb = gridDim.x;
    for (int t = bid; t < 768; t += nb) conv_transpose_tile(p.l0_w_in,    1024, 3072, (bf16_t*)(ws + OFF_W_IN0T),  t / 48, t % 48, smem, p.l0_norm_mix);
    for (int t = (bid + nb - 256 % nb) % nb; t < 256; t += nb) conv_transpose_tile(p.l0_w_out,   1024, 1024, (bf16_t*)(ws + OFF_W_OUT0T), t / 16, t % 16, smem);
    for (int t = bid; t < 512; t += nb) conv_transpose_tile(p.l0_w_query, 1024, 2048, (bf16_t*)(ws + OFF_W_Q0T),   t / 32, t % 32, smem, p.l0_norm_ffn);
    for (int t = bid; t < 512; t += nb) conv_transpose_tile(p.l1_w_in,    1024, 1984, (bf16_t*)(ws + OFF_W_IN1T),  t / 32, t % 32, smem, p.l1_norm_mix);
    for (int t = bid; t < 48; t += nb)  conv_transpose_tile(p.l1_w_uq,     256,  768, (bf16_t*)(ws + OFF_W_UQT),   t / 12, t % 12, smem, p.l1_cq_norm);
    for (int t = nb - 1 - bid; t < 32; t += nb)  conv_transpose_tile(p.l1_w_ukv,    128, 1024, (bf16_t*)(ws + OFF_W_UKVT),  t / 16, t % 16, smem, p.l1_ckv_norm);
    for (int t = (bid + nb - 256 % nb) % nb; t < 256; t += nb) conv_transpose_tile(p.l1_w_out,   1024, 1024, (bf16_t*)(ws + OFF_W_OUT1T), t / 16, t % 16, smem);
    for (int t = bid; t < 512; t += nb) conv_transpose_tile(p.l1_w_query, 1024, 2048, (bf16_t*)(ws + OFF_W_Q1T),   t / 32, t % 32, smem, p.l1_norm_ffn);
    for (int t = bid - 64; t < 64; t += nb) if (t >= 0) conv_plain_chunk(p.l0_sub_keys, (bf16_t*)(ws + OFF_SK0), t);
    for (int t = bid - 128; t < 64; t += nb) if (t >= 0) conv_plain_chunk(p.l1_sub_keys, (bf16_t*)(ws + OFF_SK1), t);
    for (int chunk = bid - 192; chunk < 16; chunk += nb) if (chunk >= 0) {
        bf16_t* dst = (bf16_t*)(ws + OFF_WS0);
        for (int e = threadIdx.x; e < 4096; e += NTHREADS) {
            int idx = chunk * 4096 + e; int t = (idx >> 7) & 127, sI = idx & 127;
            dst[idx] = f2bf(sI <= t ? p.l0_gmlp_w_s[idx] : 0.f);
        }
    }
    if (bid == nb - 1) {
        float* lb = (float*)(ws + OFF_LB);
        for (int c = threadIdx.x; c < 512; c += NTHREADS) {
            float a0 = p.lb_logits[c], a1 = p.lb_logits[512 + c], a2 = p.lb_logits[1024 + c];
            float m = fmaxf(a0, fmaxf(a1, a2));
            float e0 = __expf(a0 - m), e1 = __expf(a1 - m), e2 = __expf(a2 - m);
            lb[c] = e0 / (e0 + e1 + e2);
        }
    }
    for (int it = bid; it < 8192; it += nb) conv_experts(p.l0_exp_down, p.l0_exp_up, p.l0_norm_ffn, ws, it);
    {
        const int lane = threadIdx.x & 63, wave = threadIdx.x >> 6;
        for (int it = bid; it < 4096; it += nb) {
            const size_t row = (size_t)it * 4 + wave;
            const float* xr = p.x + row * 1024 + 16 * lane;
            const float4 a = *(const float4*)xr, b = *(const float4*)(xr + 4), c = *(const float4*)(xr + 8), d = *(const float4*)(xr + 12);
            float ss = a.x * a.x + a.y * a.y + a.z * a.z + a.w * a.w + b.x * b.x + b.y * b.y + b.z * b.z + b.w * b.w
                     + c.x * c.x + c.y * c.y + c.z * c.z + c.w * c.w + d.x * d.x + d.y * d.y + d.z * d.z + d.w * d.w;
            ss = wave_sum_dpp(ss);
            uint4 o0, o1;
            o0.x = pack2(a.x, a.y); o0.y = pack2(a.z, a.w); o0.z = pack2(b.x, b.y); o0.w = pack2(b.z, b.w);
            o1.x = pack2(c.x, c.y); o1.y = pack2(c.z, c.w); o1.z = pack2(d.x, d.y); o1.w = pack2(d.z, d.w);
            bf16_t* xb = (bf16_t*)(ws + OFF_XB) + row * 1024 + 16 * lane;
            *(uint4*)xb = o0; *(uint4*)(xb + 8) = o1;
            if (lane == 0) ((float*)(ws + OFF_SSQ1))[row] = ss;
        }
    }
}

template <int AMODE, class Epi>
DEVI void gemm_phase(const void* __restrict__ Aptr, int lda, const float* __restrict__ gain, const bf16_t* __restrict__ Bt,
                           int M, int Npad, int K, Epi epi, char* smem, int blk0, int nblk) {
    const int tid = threadIdx.x, lane = tid & 63, wave = tid >> 6;
    const int wm = wave >> 1, wn = wave & 1;
    const int tn = Npad / 128, tm = M / 128, nkt = K / 64;
    float* sRstd = (float*)(smem + 65536);
    const int crow = tid >> 3, cc = tid & 7;
    for (int tile = blk0; tile < tm * tn; tile += nblk) {
        const int m0 = (tile / tn) * 128, n0 = (tile % tn) * 128;
        f32x4 acc[4][4];
#pragma unroll
        for (int i = 0; i < 4; ++i)
#pragma unroll
            for (int j = 0; j < 4; ++j) acc[i][j] = f32x4{0.f, 0.f, 0.f, 0.f};
        float ss[4] = {0.f, 0.f, 0.f, 0.f};
        f32x4v ra[4][2]; u32x4 rab[4]; u32x4 rb[4]; f32x4v g0, g1;
        auto gload = [&](int kt) {
            const int k0 = kt * 64 + cc * 8;
#pragma unroll
            for (int i = 0; i < 4; ++i) {
                const int row = crow + 32 * i;
                if constexpr (AMODE == 0) {
                    const float* pa = (const float*)Aptr + (size_t)(m0 + row) * lda + k0;
                    ra[i][0] = *(const f32x4v*)pa; ra[i][1] = *(const f32x4v*)(pa + 4);
                } else {
                    const bf16_t* pa = (const bf16_t*)Aptr + (size_t)(m0 + row) * lda + k0;
                    rab[i] = *(const u32x4*)pa;
                }
                rb[i] = *(const u32x4*)(Bt + (size_t)(n0 + row) * K + k0);
            }
            if constexpr (AMODE != 1) { g0 = *(const f32x4v*)(gain + k0); g1 = *(const f32x4v*)(gain + k0 + 4); }
        };
        auto lstore = [&](int buf) {
            char* sA = smem + buf * 32768; char* sB = sA + 16384;
#pragma unroll
            for (int i = 0; i < 4; ++i) {
                const int row = crow + 32 * i;
                u32x4 o;
                if constexpr (AMODE == 0) {
                    f32x4v a = ra[i][0], b = ra[i][1];
                    ss[i] += a.x * a.x + a.y * a.y + a.z * a.z + a.w * a.w + b.x * b.x + b.y * b.y + b.z * b.z + b.w * b.w;
                    o.x = pack2(a.x * g0.x, a.y * g0.y); o.y = pack2(a.z * g0.z, a.w * g0.w);
                    o.z = pack2(b.x * g1.x, b.y * g1.y); o.w = pack2(b.z * g1.z, b.w * g1.w);
                } else if constexpr (AMODE == 2) {
                    u32x4 u = rab[i];
                    float a0 = bflo(u.x), a1 = bfhi(u.x), a2 = bflo(u.y), a3 = bfhi(u.y), a4 = bflo(u.z), a5 = bfhi(u.z), a6 = bflo(u.w), a7 = bfhi(u.w);
                    ss[i] += a0 * a0 + a1 * a1 + a2 * a2 + a3 * a3 + a4 * a4 + a5 * a5 + a6 * a6 + a7 * a7;
                    o.x = pack2(a0 * g0.x, a1 * g0.y); o.y = pack2(a2 * g0.z, a3 * g0.w);
                    o.z = pack2(a4 * g1.x, a5 * g1.y); o.w = pack2(a6 * g1.z, a7 * g1.w);
                } else o = rab[i];
                *(u32x4*)(sA + swz_off<64>(row, cc)) = o;
                *(u32x4*)(sB + swz_off<64>(row, cc)) = rb[i];
            }
        };
        gload(0); lstore(0); __syncthreads();
#pragma unroll 1
        for (int kt = 0; kt < nkt; ++kt) {
            if (kt + 1 < nkt) gload(kt + 1);
            const char* sA = smem + (kt & 1) * 32768; const char* sB = sA + 16384;
            mma_nt<4, 4, 64, 64>(acc, sA, wm * 64, sB, wn * 64, 0, 2, lane);
            if (kt + 1 < nkt) lstore((kt + 1) & 1);
            __syncthreads();
        }
        if constexpr (AMODE != 1) {
#pragma unroll
            for (int i = 0; i < 4; ++i) {
                float s = ss[i];
                s += __shfl_xor(s, 1); s += __shfl_xor(s, 2); s += __shfl_xor(s, 4);
                if (cc == 0) sRstd[crow + 32 * i] = rsqrtf(s / (float)K + 1e-6f);
            }
            __syncthreads();
        }
#pragma unroll
        for (int i = 0; i < 4; ++i)
#pragma unroll
            for (int r = 0; r < 4; ++r) {
                const int rl = wm * 64 + i * 16 + (lane >> 4) * 4 + r;
                const float rs = (AMODE != 1) ? sRstd[rl] : 1.f;
#pragma unroll
                for (int j = 0; j < 4; ++j) epi(m0 + rl, n0 + wn * 64 + j * 16 + (lane & 15), acc[i][j][r] * rs);
                __builtin_amdgcn_sched_barrier(0);
            }
    }
}

struct Placement { int xcc, rank, nloc, nx; };
#define G2_RAW_BARRIER() do { asm volatile("s_waitcnt lgkmcnt(0)" ::: "memory"); __builtin_amdgcn_s_barrier(); } while (0)
template <class Epi>
DEVI void gemm2_phase(const bf16_t* __restrict__ A, int lda, const bf16_t* __restrict__ Bt, int tm, int tn, int K,
                      const float* __restrict__ ssq, int nss, Epi epi, char* smem, Placement pl) {
    const int tid = threadIdx.x, lane = tid & 63;
    const int wave = __builtin_amdgcn_readfirstlane(tid >> 6);
    const int wm = wave >> 1, wn = wave & 1;
    const int nkt = K / 32;
    constexpr int STG = 24576;
    float* sRstd = (float*)(smem + 3 * STG);
    int xcd = blockIdx.x & 7, slot = blockIdx.x >> 3, nslots = gridDim.x >> 3, nxc = 8;
    if (pl.nloc > 0) { xcd = pl.xcc; slot = pl.rank; nslots = pl.nloc; nxc = pl.nx; }
    const int np = (tm + nxc - 1) / nxc;
    const int per_xcd = ((np + 7) >> 3) * tn * 8;
    const int Rl = (lane >> 4) & 3, gl = (((Rl ^ (Rl >> 1)) & 1) << 1) | (Rl >> 1);
    const int Rr = (lane >> 2) & 3, gr = (((Rr ^ (Rr >> 1)) & 1) << 1) | (Rr >> 1);
    const int ld_row = lane >> 2, ld_c = (lane & 3) ^ gl;
    const int rd_off = (lane & 15) * 64 + (((lane >> 4) ^ gr) << 4);
    for (int t = slot; t < per_xcd; t += nslots) {
        const int mi = t & 7, rest = t >> 3, nt_ = rest % tn, mg = rest / tn;
        const int pidx = mg * 8 + mi, panel = xcd + nxc * pidx;
        if (pidx >= np || panel >= tm) continue;
        const int m0 = panel * 128, n0 = nt_ * 256;
        if (ssq) { if (tid < 128) { float sacc = 0.f; for (int i = 0; i < nss; ++i) sacc += ssq[(size_t)(m0 + tid) * nss + i]; sRstd[tid] = rsqrtf(sacc / (float)K + 1e-6f); } }
        else if (tid < 128) sRstd[tid] = 1.f;
        const bf16_t* ga = A  + (size_t)(m0 + 32 * wave + ld_row) * lda + ld_c * 8;
        const bf16_t* gb = Bt + (size_t)(n0 + 64 * wave + ld_row) * K   + ld_c * 8;
        f32x4 acc[4][8];
#pragma unroll
        for (int i = 0; i < 4; ++i)
#pragma unroll
            for (int j = 0; j < 8; ++j) acc[i][j] = f32x4{0.f, 0.f, 0.f, 0.f};
#define G2_ISSUE(KT) { char* st_ = smem + ((KT) % 3) * STG; const int ko_ = (KT) * 32; \
            __builtin_amdgcn_global_load_lds((const unsigned*)(ga + ko_),                    (unsigned*)(st_ + wave * 2048),               16, 0, 0); \
            __builtin_amdgcn_global_load_lds((const unsigned*)(ga + (size_t)16 * lda + ko_), (unsigned*)(st_ + wave * 2048 + 1024),        16, 0, 0); \
            __builtin_amdgcn_global_load_lds((const unsigned*)(gb + ko_),                    (unsigned*)(st_ + 8192 + wave * 4096),        16, 0, 0); \
            __builtin_amdgcn_global_load_lds((const unsigned*)(gb + (size_t)16 * K + ko_),   (unsigned*)(st_ + 8192 + wave * 4096 + 1024), 16, 0, 0); \
            __builtin_amdgcn_global_load_lds((const unsigned*)(gb + (size_t)32 * K + ko_),   (unsigned*)(st_ + 8192 + wave * 4096 + 2048), 16, 0, 0); \
            __builtin_amdgcn_global_load_lds((const unsigned*)(gb + (size_t)48 * K + ko_),   (unsigned*)(st_ + 8192 + wave * 4096 + 3072), 16, 0, 0); }
        int nkt0 = nkt;
        const bool pr_dup = epi.D == nullptr && epi.N == 2048, pr_nodma = (PROBE_GEMM == 2) && pr_dup, pr_nomma = (PROBE_GEMM == 1) && pr_dup;
#define G2_RD_LO(KT, RA, RB) { const char* sA_ = smem + ((KT) % 3) * STG + rd_off; const char* sB_ = sA_ + 8192; \
            _Pragma("unroll") for (int i = 0; i < 4; ++i) RA[i] = *(const bf16x8*)(sA_ + (wm * 64 + 16 * i) * 64); \
            _Pragma("unroll") for (int j = 0; j < 4; ++j) RB[j] = *(const bf16x8*)(sB_ + (wn * 128 + 16 * j) * 64); }
#define G2_RD_HI(KT, RB) { const char* sB_ = smem + ((KT) % 3) * STG + rd_off + 8192; \
            _Pragma("unroll") for (int j = 0; j < 4; ++j) RB[j] = *(const bf16x8*)(sB_ + (wn * 128 + 64 + 16 * j) * 64); }
#define G2_MMA(RA, RB, J0) { _Pragma("unroll") for (int i = 0; i < 4; ++i) _Pragma("unroll") for (int j = 0; j < 4; ++j) acc[i][(J0) + j] = mfma16(RB[j], RA[i], acc[i][(J0) + j]); }
#define G2_STEP(KT, CA, CB, NA, NB) { \
            if ((KT) + 2 < nkt) asm volatile("s_waitcnt vmcnt(6)" ::: "memory"); else asm volatile("s_waitcnt vmcnt(0)" ::: "memory"); \
            __builtin_amdgcn_s_waitcnt(0xc07f); __builtin_amdgcn_s_barrier();        \
            G2_RD_HI(KT, bh) \
            __builtin_amdgcn_sched_barrier(0);        \
            if (!pr_nomma) G2_MMA(CA, CB, 0) \
            __builtin_amdgcn_sched_barrier(0); \
            G2_RD_LO((KT) + 1, NA, NB)        \
            __builtin_amdgcn_s_waitcnt(0xc87f);        \
            __builtin_amdgcn_sched_barrier(0); \
            if ((KT) + 3 < nkt && !pr_nodma) G2_ISSUE((KT) + 3)        \
            __builtin_amdgcn_sched_barrier(0); \
            if (!pr_nomma) G2_MMA(CA, bh, 4) \
            __builtin_amdgcn_sched_barrier(0); }
        bf16x8 a0[4], b0[4], a1[4], b1[4], bh[4];
        if ((PROBE_GEMM == 3) && pr_dup) {
#pragma unroll
            for (int i = 0; i < 4; ++i) { a0[i] = __builtin_bit_cast(bf16x8, u32x4{(unsigned)tid, 1u, 2u, 3u}); b0[i] = a0[i]; bh[i] = a0[i]; }
#pragma unroll 1
            for (int kt = 0; kt < nkt; ++kt) { G2_MMA(a0, b0, 0) G2_MMA(a0, bh, 4) __builtin_amdgcn_sched_barrier(0); }
            nkt0 = 0;
        }
        if (!pr_nodma) { G2_ISSUE(0) G2_ISSUE(1) if (2 < nkt) G2_ISSUE(2) }
        if (2 < nkt) asm volatile("s_waitcnt vmcnt(12)" ::: "memory"); else asm volatile("s_waitcnt vmcnt(6)" ::: "memory");
        G2_RAW_BARRIER();
        G2_RD_LO(0, a0, b0)
#pragma unroll 1
        for (int kt = 0; kt < nkt0; kt += 2) {
            G2_STEP(kt, a0, b0, a1, b1)
            G2_STEP(kt + 1, a1, b1, a0, b0)
        }
#undef G2_STEP
#undef G2_MMA
#undef G2_RD_LO
#undef G2_RD_HI
#undef G2_ISSUE
        if (epi.staged(n0)) {
            G2_RAW_BARRIER();
#pragma unroll
            for (int i = 0; i < 4; ++i) {
                const int rl = wm * 64 + i * 16 + (lane & 15);
                const float rs = sRstd[rl];
                char* trow = smem + rl * 528 + (wn * 128 + 4 * (lane >> 4)) * 2;
#pragma unroll
                for (int j = 0; j < 8; ++j) {
                    const int nc = n0 + wn * 128 + 16 * j + 4 * (lane >> 4);
                    *(uint2*)(trow + 32 * j) = uint2{pack2(epi.map(nc, acc[i][j][0] * rs), epi.map(nc + 1, acc[i][j][1] * rs)), pack2(epi.map(nc + 2, acc[i][j][2] * rs), epi.map(nc + 3, acc[i][j][3] * rs))};
                }
            }
            __syncthreads();
            float* const sqp = (n0 == 0) ? epi.SQ0 : ((n0 == 256) ? epi.SQ1 : nullptr);
#pragma unroll 4
            for (int i = 0; i < 16; ++i) {
                const int e = tid + 256 * i, row = e >> 5, cc = e & 31;
                const uint4 v = *(const uint4*)(smem + row * 528 + cc * 16);
                if (epi.D && n0 + cc * 8 < epi.N) *(uint4*)(epi.D + (size_t)(m0 + row) * epi.ldd + n0 + cc * 8) = v;
                if (sqp) {
                    float q = bflo(v.x) * bflo(v.x) + bfhi(v.x) * bfhi(v.x) + bflo(v.y) * bflo(v.y) + bfhi(v.y) * bfhi(v.y)
                            + bflo(v.z) * bflo(v.z) + bfhi(v.z) * bfhi(v.z) + bflo(v.w) * bflo(v.w) + bfhi(v.w) * bfhi(v.w);
                    if (n0 == 256 && cc >= 16) q = 0.f;
                    q += __shfl_xor(q, 1); q += __shfl_xor(q, 2); q += __shfl_xor(q, 4); q += __shfl_xor(q, 8); q += __shfl_xor(q, 16);
                    if (cc == 0) sqp[m0 + row] = q;
                }
            }
        } else {
#pragma unroll
            for (int i = 0; i < 4; ++i) {
                const int rl = wm * 64 + i * 16 + (lane & 15);
                const float rs = sRstd[rl];
                epi.row(m0 + rl, n0 + wn * 128 + 4 * (lane >> 4), acc[i], rs, lane);
                __builtin_amdgcn_sched_barrier(0);
            }
        }
        __syncthreads();
    }
}

struct Epi2In0 {
    bf16_t* Z0; float* G; const float* lb; bf16_t* D; int ldd; int N; float* SQ0; float* SQ1;
    DEVI bool staged(int n0) const { return (n0 >> 9) != 1; }
    DEVI float map(int n, float v) const { const int blk = n >> 9; return (blk == 0) ? v : ((blk <= 3) ? v * sigm(v) : gelu_tanh(v)); }
    DEVI void row(int m, int n, const f32x4 (&a)[8], float rs, int) const {
#pragma unroll
        for (int j = 0; j < 8; ++j) {
            const int c = n + 16 * j - 512;
            const float4 l4 = *(const float4*)(lb + c);
            float4 o;
            o.x = logf(l4.x + (1.f - l4.x) * sigm(a[j][0] * rs)); o.y = logf(l4.y + (1.f - l4.y) * sigm(a[j][1] * rs));
            o.z = logf(l4.z + (1.f - l4.z) * sigm(a[j][2] * rs)); o.w = logf(l4.w + (1.f - l4.w) * sigm(a[j][3] * rs));
            *(float4*)(G + (size_t)m * 512 + c) = o;
        }
    }
};
struct Epi2Bf16 {
    bf16_t* D; int ldd; int N; float* SQ0; float* SQ1;
    DEVI bool staged(int) const { return true; }
    DEVI float map(int, float v) const { return v; }
    DEVI void row(int, int, const f32x4 (&)[8], float, int) const {}
};
struct Epi2Resid {
    bf16_t* XB; float* SSQ16; float alpha; bf16_t* D; int ldd; int N; float* SQ0; float* SQ1;
    DEVI bool staged(int) const { return false; }
    DEVI float map(int, float v) const { return v; }
    DEVI void row(int m, int n, const f32x4 (&a)[8], float, int lane) const {
        float sq[2] = {0.f, 0.f};
#pragma unroll
        for (int j = 0; j < 8; ++j) {
            bf16_t* px = XB + (size_t)m * 1024 + n + 16 * j;
            const uint2 r = *(const uint2*)px;
            const unsigned w0 = pack2(bflo(r.x) + alpha * a[j][0], bfhi(r.x) + alpha * a[j][1]), w1 = pack2(bflo(r.y) + alpha * a[j][2], bfhi(r.y) + alpha * a[j][3]);
            *(uint2*)px = uint2{w0, w1};
            sq[j >> 2] += bflo(w0) * bflo(w0) + bfhi(w0) * bfhi(w0) + bflo(w1) * bflo(w1) + bfhi(w1) * bfhi(w1);
        }
#pragma unroll
        for (int g = 0; g < 2; ++g) {
            float v = sq[g];
            v += __shfl_xor(v, 16); v += __shfl_xor(v, 32);
            if ((lane >> 4) == 0) SSQ16[(size_t)m * 16 + ((n + 64 * g) >> 6)] = v;
        }
    }
};

struct EpiBf16 { bf16_t* D; int ldd; int N; DEVI void operator()(int m, int n, float v) const { if (n < N) D[(size_t)m * ldd + n] = f2bf(v); } };

DEVI void hgrn_local_item(const Params& p, int item, char* smem) {
    const int tid = threadIdx.x, lane = tid & 63, wave = tid >> 6;
    const int bh = item >> 7, c = item & 127, b = bh >> 2, h = bh & 3;
    const size_t m0 = (size_t)b * 8192 + c * 64;
    const float* G = (const float*)(p.ws + OFF_G) + m0 * 512 + h * 128;
    const bf16_t* Zv = (const bf16_t*)(p.ws + OFF_Z0) + m0 * 3072 + 1024 + h * 128;
    char* sVT = smem; char* sKd = smem + 16384;
    const int k = tid & 127, hf = tid >> 7;
    float bl = 0.f, bmid = 0.f;
#pragma unroll 8
    for (int t = 0; t < 64; ++t) { bl += G[t * 512 + k]; if (t == 31) bmid = bl; }
    float bcur = hf ? bmid : 0.f;
#pragma unroll 1
    for (int ch = 0; ch < 4; ++ch) {
        float kd[8], vv[8];
#pragma unroll
        for (int j = 0; j < 8; ++j) {
            const int t = 32 * hf + 8 * ch + j;
            const float g = G[t * 512 + k];
            bcur += g;
            kd[j] = (1.f - __expf(g)) * __expf(bl - bcur);
            vv[j] = bf2f(Zv[(size_t)t * 3072 + k]);
        }
        uint4 o; o.x = pack2(kd[0], kd[1]); o.y = pack2(kd[2], kd[3]); o.z = pack2(kd[4], kd[5]); o.w = pack2(kd[6], kd[7]);
        *(uint4*)(sKd + swz_off<64>(k, 4 * hf + ch)) = o;
        uint4 w; w.x = pack2(vv[0], vv[1]); w.y = pack2(vv[2], vv[3]); w.z = pack2(vv[4], vv[5]); w.w = pack2(vv[6], vv[7]);
        *(uint4*)(sVT + swz_off<64>(k, 4 * hf + ch)) = w;
    }
    if (hf == 0) ((float*)(p.ws + OFF_DEC))[item * 128 + k] = __expf(bl);
    __syncthreads();
    f32x4 acc[2][8];
#pragma unroll
    for (int i = 0; i < 2; ++i)
#pragma unroll
        for (int j = 0; j < 8; ++j) acc[i][j] = f32x4{0.f, 0.f, 0.f, 0.f};
    mma_nt<2, 8, 64, 64>(acc, sVT, 32 * wave, sKd, 0, 0, 2, lane);
    float* H = (float*)(p.ws + OFF_HST) + (size_t)item * 16384;
#pragma unroll
    for (int i = 0; i < 2; ++i)
#pragma unroll
        for (int j = 0; j < 8; ++j)
#pragma unroll
            for (int r = 0; r < 4; ++r) {
                const int v = 32 * wave + 16 * i + (lane >> 4) * 4 + r, kk = 16 * j + (lane & 15);
                H[v * 128 + kk] = acc[i][j][r];
                if (r == 3) __builtin_amdgcn_sched_barrier(0);
            }
    __syncthreads();
}

DEVI void gmlp_item(const Params& p, int item, char* smem) {
    const int tid = threadIdx.x, lane = tid & 63, wave = tid >> 6;
    const int g = item & 3, chunk = item >> 2;
    const size_t m0 = (size_t)chunk * 128;
    const bf16_t* Z0 = (const bf16_t*)(p.ws + OFF_Z0);
    const bf16_t* Wc = (const bf16_t*)(p.ws + OFF_WS0) + g * 16384;
    char* sW = smem; char* sV = smem + 32768;
#pragma unroll
    for (int i = 0; i < 8; ++i) {
        const int e = tid + 256 * i, row = e >> 4, cc = e & 15;
        *(uint4*)(sW + swz_off<128>(row, cc)) = *(const uint4*)(Wc + row * 128 + cc * 8);
    }
    {
        const int t = tid >> 1, hf = tid & 1;
        const bf16_t* src = Z0 + (m0 + t) * 3072 + 2560 + g * 128 + 64 * hf;
        float vals[64]; float ss = 0.f;
#pragma unroll
        for (int i = 0; i < 8; ++i) {
            uint4 u = *(const uint4*)(src + 8 * i);
            vals[8 * i + 0] = bflo(u.x); vals[8 * i + 1] = bfhi(u.x); vals[8 * i + 2] = bflo(u.y); vals[8 * i + 3] = bfhi(u.y);
            vals[8 * i + 4] = bflo(u.z); vals[8 * i + 5] = bfhi(u.z); vals[8 * i + 6] = bflo(u.w); vals[8 * i + 7] = bfhi(u.w);
        }
#pragma unroll
        for (int i = 0; i < 64; ++i) ss += vals[i] * vals[i];
        ss += __shfl_xor(ss, 1);
        const float rstd = rsqrtf(ss * (1.f / 128.f) + 1e-6f);
        const float* gn = p.l0_gmlp_v_norm + g * 128 + 64 * hf;
#pragma unroll
        for (int i = 0; i < 64; ++i) {
            const int d = 64 * hf + i;
            *(bf16_t*)(sV + swz_elem<128>(d, t)) = f2bf(vals[i] * rstd * gn[i]);
        }
    }
    __syncthreads();
    const int wm = wave >> 1, wn = wave & 1;
    f32x4 acc[4][4];
#pragma unroll
    for (int i = 0; i < 4; ++i)
#pragma unroll
        for (int j = 0; j < 4; ++j) acc[i][j] = f32x4{0.f, 0.f, 0.f, 0.f};
    mma_nt<4, 4, 128, 128>(acc, sW, wm * 64, sV, wn * 64, 0, 4, lane);
    bf16_t* MIX = (bf16_t*)(p.ws + OFF_MIX0);
#pragma unroll
    for (int i = 0; i < 4; ++i)
#pragma unroll
        for (int r = 0; r < 4; ++r) {
            const int t = wm * 64 + i * 16 + (lane >> 4) * 4 + r;
            const float bias = p.l0_gmlp_b_s[g * 128 + t];
#pragma unroll
            for (int j = 0; j < 4; ++j) {
                const int d = wn * 64 + j * 16 + (lane & 15);
                const float u = bf2f(Z0[(m0 + t) * 3072 + 2048 + g * 128 + d]);
                MIX[(m0 + t) * 1024 + 512 + g * 128 + d] = f2bf(u * (acc[i][j][r] + bias));
            }
        }
    __syncthreads();
}

DEVI void hgrn_scan_phase(const Params& p) {
    float* H = (float*)(p.ws + OFF_HST);
    const float* D = (const float*)(p.ws + OFF_DEC);
    for (int e = blockIdx.x * NTHREADS + threadIdx.x; e < 8 * 16384; e += gridDim.x * NTHREADS) {
        const int bh = e >> 14, idx = e & 16383, k = idx & 127;
        float run = 0.f;
        for (int c0 = 0; c0 < 128; c0 += 8) {
            float L[8], d[8];
#pragma unroll
            for (int u = 0; u < 8; ++u) { L[u] = H[((size_t)(bh * 128 + c0 + u)) * 16384 + idx]; d[u] = D[(bh * 128 + c0 + u) * 128 + k]; }
#pragma unroll
            for (int u = 0; u < 8; ++u) { H[((size_t)(bh * 128 + c0 + u)) * 16384 + idx] = run; run = d[u] * run + L[u]; }
        }
    }
}

DEVI void hgrn_out_item(const Params& p, int item, char* smem) {
    const int tid = threadIdx.x, lane = tid & 63, wave = tid >> 6;
    const int bh = item >> 7, c = item & 127, b = bh >> 2, h = bh & 3;
    const size_t m0 = (size_t)b * 8192 + c * 64;
    const float* G = (const float*)(p.ws + OFF_G) + m0 * 512 + h * 128;
    const bf16_t* Z0 = (const bf16_t*)(p.ws + OFF_Z0) + m0 * 3072;
    float* sB  = (float*)smem;
    char*  sHT = smem;
    char*  sQe = smem + 32768;
    char*  sP  = smem + 49152;
    char*  sU  = smem + 57344;
    char*  sQs = sU; char* sKh = sU + 4096; char* sVT = sU;
    float* sRed = (float*)(smem + 77824);
    const int k = tid & 127, hf = tid >> 7;
    if (hf == 0) { float bc = 0.f;
#pragma unroll 8
        for (int t = 0; t < 64; ++t) { bc += G[t * 512 + k]; sB[t * 128 + k] = bc; } }
    __syncthreads();
#pragma unroll 4
    for (int t = 32 * hf; t < 32 * hf + 32; ++t) {
        const float q = bf2f(Z0[(size_t)t * 3072 + h * 128 + k]);
        *(bf16_t*)(sQe + swz_elem<128>(t, k)) = f2bf(q * __expf(sB[t * 128 + k]));
    }
#pragma unroll 1
    for (int i = 0; i < 4; ++i) {
        const float ri = (i == 0) ? 0.f : sB[(16 * i - 1) * 128 + k];
#pragma unroll 4
        for (int tt = 8 * hf; tt < 8 * hf + 8; ++tt) {
            const int t = 16 * i + tt;
            const float q = bf2f(Z0[(size_t)t * 3072 + h * 128 + k]);
            *(bf16_t*)(sQs + swz_elem<128>(tt, k)) = f2bf(q * __expf(sB[t * 128 + k] - ri));
        }
        const int ns = 16 * (i + 1), half = ns >> 1;
#pragma unroll 4
        for (int s = hf * half; s < hf * half + half; ++s) {
            const float bs = sB[s * 128 + k];
            const float gs = bs - (s ? sB[(s - 1) * 128 + k] : 0.f);
            const float kk = 1.f - __expf(gs);
            *(bf16_t*)(sKh + swz_elem<128>(s, k)) = f2bf(kk * __expf(fminf(ri - bs, 80.f)));
        }
        __syncthreads();
        {
            f32x4 acc[1][1]; acc[0][0] = f32x4{0.f, 0.f, 0.f, 0.f};
            if (wave <= i) mma_nt<1, 1, 128, 128>(acc, sQs, 0, sKh, 16 * wave, 0, 4, lane);
#pragma unroll
            for (int r = 0; r < 4; ++r) {
                const int row = (lane >> 4) * 4 + r, col = lane & 15;
                float v = acc[0][0][r];
                if (wave > i || (wave == i && col > row)) v = 0.f;
                *(bf16_t*)(sP + swz_elem<64>(16 * i + row, 16 * wave + col)) = f2bf(v);
            }
        }
        __syncthreads();
    }
    {
        const bf16_t* Zv = Z0 + 1024 + h * 128;
#pragma unroll 1
        for (int ch = 0; ch < 4; ++ch) {
            float vv[8];
#pragma unroll
            for (int j = 0; j < 8; ++j) vv[j] = bf2f(Zv[(size_t)(32 * hf + 8 * ch + j) * 3072 + k]);
            uint4 w; w.x = pack2(vv[0], vv[1]); w.y = pack2(vv[2], vv[3]); w.z = pack2(vv[4], vv[5]); w.w = pack2(vv[6], vv[7]);
            *(uint4*)(sVT + swz_off<64>(k, 4 * hf + ch)) = w;
        }
        const float* H = (const float*)(p.ws + OFF_HST) + (size_t)item * 16384;
#pragma unroll 2
        for (int i = 0; i < 8; ++i) {
            const int e = tid + 256 * i, row = e >> 4, cc = e & 15;
            const float4 a = *(const float4*)(H + row * 128 + cc * 8), bq = *(const float4*)(H + row * 128 + cc * 8 + 4);
            uint4 o; o.x = pack2(a.x, a.y); o.y = pack2(a.z, a.w); o.z = pack2(bq.x, bq.y); o.w = pack2(bq.z, bq.w);
            *(uint4*)(sHT + swz_off<128>(row, cc)) = o;
        }
    }
    __syncthreads();
    f32x4 acc[4][2];
#pragma unroll
    for (int i = 0; i < 4; ++i)
#pragma unroll
        for (int j = 0; j < 2; ++j) acc[i][j] = f32x4{0.f, 0.f, 0.f, 0.f};
    mma_nt<4, 2, 128, 128>(acc, sQe, 0, sHT, 32 * wave, 0, 4, lane);
    mma_nt<4, 2, 64, 64>(acc, sP, 0, sVT, 32 * wave, 0, 2, lane);
#pragma unroll
    for (int i = 0; i < 4; ++i)
#pragma unroll
        for (int r = 0; r < 4; ++r) {
            float s = acc[i][0][r] * acc[i][0][r] + acc[i][1][r] * acc[i][1][r];
            s += __shfl_xor(s, 1); s += __shfl_xor(s, 2); s += __shfl_xor(s, 4); s += __shfl_xor(s, 8);
            if ((lane & 15) == 0) sRed[wave * 64 + i * 16 + (lane >> 4) * 4 + r] = s;
        }
    __syncthreads();
    bf16_t* MIX = (bf16_t*)(p.ws + OFF_MIX0);
#pragma unroll
    for (int i = 0; i < 4; ++i)
#pragma unroll
        for (int r = 0; r < 4; ++r) {
            const int t = i * 16 + (lane >> 4) * 4 + r;
            const float tot = sRed[t] + sRed[64 + t] + sRed[128 + t] + sRed[192 + t];
            const float rstd = rsqrtf(tot * (1.f / 128.f) + 1e-6f);
#pragma unroll
            for (int j = 0; j < 2; ++j) {
                const int v = 32 * wave + 16 * j + (lane & 15);
                const float og = bf2f(Z0[(size_t)t * 3072 + 1536 + h * 128 + v]);
                MIX[(m0 + t) * 1024 + h * 128 + v] = f2bf(acc[i][j][r] * rstd * p.l0_hgrn_out_norm[h * 128 + v] * og);
            }
        }
    __syncthreads();
}

DEVI unsigned f2key(float f) { unsigned u = __float_as_uint(f); return (u & 0x80000000u) ? ~u : (u | 0x80000000u); }
DEVI float key2f(unsigned k) { unsigned u = (k & 0x80000000u) ? (k ^ 0x80000000u) : ~k; return __uint_as_float(u); }
#define CE_DESC(a, b) { unsigned _x = max(a, b), _y = min(a, b); a = _x; b = _y; }
DEVI void sort16_desc(unsigned (&a)[16]) {
#pragma unroll
    for (int k = 2; k <= 16; k <<= 1)
#pragma unroll
        for (int j = k >> 1; j > 0; j >>= 1)
#pragma unroll
            for (int i = 0; i < 16; ++i) {
                const int l = i ^ j;
                if (l > i) {
                    if ((i & k) == 0) { CE_DESC(a[i], a[l]); } else { CE_DESC(a[l], a[i]); }
                }
            }
}
DEVI void merge16_desc(unsigned (&a)[16], const unsigned (&b)[16]) {
#pragma unroll
    for (int i = 0; i < 16; ++i) a[i] = max(a[i], b[15 - i]);
#pragma unroll
    for (int j = 8; j > 0; j >>= 1)
#pragma unroll
        for (int i = 0; i < 16; ++i) { const int l = i ^ j; if (l > i) { CE_DESC(a[i], a[l]); } }
}

DEVI void peer_topk_phase(const Params& p, const bf16_t* __restrict__ SK, int blk0, int nblk, char* smem) {
    const int tid = threadIdx.x, lane = tid & 63, wave = tid >> 6;
    const int r = lane & 31, hh = lane >> 5;
    const bf16_t* QP = (const bf16_t*)(p.ws + OFF_QP);
    int* IDX = (int*)(p.ws + OFF_IDX); float* GATE = (float*)(p.ws + OFF_GATE);
    char* sKey = smem;
    char* sQ = smem + 32768 + wave * 8192;
    for (int item = blk0; item < 1024; item += nblk) {
        const int h = item & 7, tile = (item >> 3) * 4 + wave;
        const size_t tok = (size_t)tile * 32 + r;
        unsigned top[2][16];
#pragma unroll
        for (int ph = 0; ph < 2; ++ph) {
            __syncthreads();
            {
                const bf16_t* ksrc = SK + (size_t)(h * 2 + ph) * 128 * 128;
#pragma unroll
                for (int i = 0; i < 8; ++i) { const int e = tid + 256 * i, row = e >> 4, cc = e & 15; *(uint4*)(sKey + swz_off<128>(row, cc)) = *(const uint4*)(ksrc + row * 128 + cc * 8); }
                const bf16_t* qsrc = QP + (size_t)tile * 32 * 2048 + h * 256 + ph * 128;
#pragma unroll
                for (int i = 0; i < 8; ++i) { const int e = lane + 64 * i, row = e >> 4, cc = e & 15; *(uint4*)(sQ + swz_off<128>(row, cc)) = *(const uint4*)(qsrc + (size_t)row * 2048 + cc * 8); }
            }
            __syncthreads();
            bf16x8 qf[8];
#pragma unroll
            for (int ks = 0; ks < 8; ++ks) qf[ks] = *(const bf16x8*)(sQ + swz_off<128>(r, 2 * ks + hh));
#pragma unroll 1
            for (int rt = 0; rt < 4; ++rt) {
                f32x16 acc;
#pragma unroll
                for (int e = 0; e < 16; ++e) acc[e] = 0.f;
#pragma unroll
                for (int ks = 0; ks < 8; ++ks) {
                    const bf16x8 kf = *(const bf16x8*)(sKey + swz_off<128>(32 * rt + r, 2 * ks + hh));
                    acc = mfma32(kf, qf[ks], acc);
                }
                unsigned kk[16];
#pragma unroll
                for (int e = 0; e < 16; ++e) {
                    const unsigned n = 32 * rt + (e & 3) + 8 * (e >> 2) + 4 * hh;
                    kk[e] = (f2key(acc[e]) & ~127u) | n;
                }
                sort16_desc(kk);
                if (rt == 0) {
#pragma unroll
                    for (int e = 0; e < 16; ++e) top[ph][e] = kk[e];
                } else merge16_desc(top[ph], kk);
            }
            unsigned other[16];
#pragma unroll
            for (int e = 0; e < 16; ++e) other[e] = (unsigned)__shfl_xor((int)top[ph][e], 32);
            merge16_desc(top[ph], other);
        }
        unsigned best[16];
        {
            float s1[16], s2[16];
#pragma unroll
            for (int e = 0; e < 16; ++e) { s1[e] = key2f(top[0][e] & ~127u); s2[e] = key2f(top[1][e] & ~127u); }
            unsigned cand[64];
            unsigned ia[16], ib[16];
#pragma unroll
            for (int e = 0; e < 16; ++e) { ia[e] = (top[0][e] & 127u) << 7; ib[e] = top[1][e] & 127u; }
            int n = 0;
#pragma unroll
            for (int i = 0; i < 16; ++i)
#pragma unroll
                for (int j = 0; j < 16; ++j)
                    if ((i + 1) * (j + 1) <= 16) { cand[n] = (f2key(s1[i] + s2[j]) & ~0x3fffu) | ia[i] | ib[j]; ++n; }
#pragma unroll
            for (int e = 50; e < 64; ++e) cand[e] = 0u;
#pragma unroll
            for (int g = 0; g < 4; ++g) {
                unsigned kk[16];
#pragma unroll
                for (int e = 0; e < 16; ++e) kk[e] = cand[16 * g + e];
                sort16_desc(kk);
                if (g == 0) {
#pragma unroll
                    for (int e = 0; e < 16; ++e) best[e] = kk[e];
                } else merge16_desc(best, kk);
            }
        }
        float sv[16]; int id[16];
#pragma unroll
        for (int e = 0; e < 16; ++e) {
            sv[e] = key2f(best[e] & ~0x3fffu);
            id[e] = (int)(best[e] & 0x3fffu);
        }
        float den = 0.f; const float smax = sv[0];
#pragma unroll
        for (int e = 0; e < 16; ++e) { sv[e] = __expf(sv[e] - smax); den += sv[e]; }
        const float inv = 1.f / den;
        {
            const float* INVT = (const float*)(p.ws + (hh ? OFF_INVU : OFF_INVD));
            float sc[16];
#pragma unroll
            for (int e = 0; e < 16; ++e) sc[e] = INVT[id[e]];
            if (hh == 0) {
                int4* dst = (int4*)(IDX + tok * 128 + h * 16);
                float4* dst2 = (float4*)((float*)(p.ws + OFF_SDN) + tok * 128 + h * 16);
#pragma unroll
                for (int e = 0; e < 4; ++e) { dst[e] = int4{id[4 * e], id[4 * e + 1], id[4 * e + 2], id[4 * e + 3]}; dst2[e] = float4{sc[4 * e], sc[4 * e + 1], sc[4 * e + 2], sc[4 * e + 3]}; }
            } else {
                float4* dst = (float4*)(GATE + tok * 128 + h * 16);
#pragma unroll
                for (int e = 0; e < 4; ++e) dst[e] = float4{sv[4 * e] * inv * sc[4 * e], sv[4 * e + 1] * inv * sc[4 * e + 1], sv[4 * e + 2] * inv * sc[4 * e + 2], sv[4 * e + 3] * inv * sc[4 * e + 3]};
            }
        }
    }
    for (int it0 = blk0; it0 < 4096; it0 += 4 * nblk) {
        uint4 ra[4], rb[4];
#pragma unroll
        for (int u = 0; u < 4; ++u) {
            const int it = it0 + u * nblk;
            const bf16_t* xb = (const bf16_t*)(p.ws + OFF_XB) + ((size_t)(it < 4096 ? it : it0) * 4 + wave) * 1024 + 16 * lane;
            ra[u] = *(const uint4*)xb; rb[u] = *(const uint4*)(xb + 8);
        }
#pragma unroll
        for (int u = 0; u < 4; ++u) {
            const int it = it0 + u * nblk;
            const uint4 a = ra[u], b = rb[u];
            float v[16] = {bflo(a.x), bfhi(a.x), bflo(a.y), bfhi(a.y), bflo(a.z), bfhi(a.z), bflo(a.w), bfhi(a.w),
                           bflo(b.x), bfhi(b.x), bflo(b.y), bfhi(b.y), bflo(b.z), bfhi(b.z), bflo(b.w), bfhi(b.w)};
#pragma unroll
            for (int i = 0; i < 16; ++i) v[i] = fminf(fmaxf(v[i] * 32.f, -400.f), 400.f);
            int w0 = 0, w1 = 0, w2 = 0, w3 = 0;
            w0 = __builtin_amdgcn_cvt_pk_fp8_f32(v[0], v[1], w0, false);   w0 = __builtin_amdgcn_cvt_pk_fp8_f32(v[2], v[3], w0, true);
            w1 = __builtin_amdgcn_cvt_pk_fp8_f32(v[4], v[5], w1, false);   w1 = __builtin_amdgcn_cvt_pk_fp8_f32(v[6], v[7], w1, true);
            w2 = __builtin_amdgcn_cvt_pk_fp8_f32(v[8], v[9], w2, false);   w2 = __builtin_amdgcn_cvt_pk_fp8_f32(v[10], v[11], w2, true);
            w3 = __builtin_amdgcn_cvt_pk_fp8_f32(v[12], v[13], w3, false); w3 = __builtin_amdgcn_cvt_pk_fp8_f32(v[14], v[15], w3, true);
            if (it < 4096) *(int4*)(p.ws + OFF_XB8 + ((size_t)it * 4 + wave) * 1024 + 16 * lane) = int4{w0, w1, w2, w3};
        }
    }
}

typedef float f32x2v __attribute__((ext_vector_type(2)));
#define PEER_QWORD 80000
#define PEER_TPW 8
#define PEER_ITEMS (16384 / (4 * PEER_TPW))
DEVI int queue_pop(const Params& p, int q, char* smem) {
    int* sw = (int*)(smem + PEER_QWORD);
    __syncthreads();
    if (threadIdx.x == 0) *sw = (int)__hip_atomic_fetch_add((unsigned*)(p.ws + OFF_QCNT) + q * 16, 1u, __ATOMIC_RELAXED, __HIP_MEMORY_SCOPE_AGENT);
    __syncthreads();
    return *sw;
}
DEVI int queue_publish(int pending, char* smem) {
    int* sw = (int*)(smem + PEER_QWORD);
    __syncthreads();
    if (threadIdx.x == 0) *sw = pending;
    __syncthreads();
    return *sw;
}
DEVI unsigned queue_live(const Params& p, int qbase, int s0, char* smem) {
    unsigned* sw = (unsigned*)(smem + PEER_QWORD + 4);
    __syncthreads();
    if (threadIdx.x < 64) {
        unsigned c = 0xffffffffu;
        if (threadIdx.x < 8) c = __hip_atomic_load((unsigned*)(p.ws + OFF_QCNT) + (qbase + ((s0 + (int)threadIdx.x) & 7)) * 16, __ATOMIC_RELAXED, __HIP_MEMORY_SCOPE_AGENT);
        const unsigned long long m = __ballot(c < (unsigned)PEER_ITEMS);
        if (threadIdx.x == 0) *sw = (unsigned)m;
    }
    __syncthreads();
    return *sw;
}
#define UFMA(ACC, W, X) asm volatile("v_fmac_f32 %0, %1, %2" : "+v"(ACC) : "v"(W), "v"(X))
DEVI void d_stream(size_t tok, int s, int lane, char* slot, const int* IDX, const char* XB8) {
    const unsigned o1 = (unsigned)tok * 512u + 4u * (unsigned)lane;
    __builtin_amdgcn_global_load_lds((const unsigned*)((const char*)IDX + o1),        (unsigned*)(slot),       4, 0, 0);
    __builtin_amdgcn_global_load_lds((const unsigned*)((const char*)IDX + o1 + 256u), (unsigned*)(slot + 256), 4, 0, 0);
    __builtin_amdgcn_global_load_lds((const unsigned*)(XB8 + (unsigned)tok * 1024u + (unsigned)(128 * s + 4 * (lane & 31))), (unsigned*)(slot + 512), 4, 0, 0);
}
template <int HLF>
DEVI void d_dma(const char* slot, char* buf, int s, int lane, const char* ED) {
    const int grp = lane >> 3, sub = lane & 7;
    unsigned e[8];
#pragma unroll
    for (int i = 0; i < 8; ++i) e[i] = *(const unsigned*)(slot + 256 * HLF + 4 * (8 * i + grp));
#pragma unroll
    for (int i = 0; i < 8; ++i) {
        const int pl_ = 8 * i + grp;
        const unsigned src = ((unsigned)s * 16384u + e[i]) * 128u + (unsigned)(16 * (sub ^ ((pl_ >> 1) & 7)));
        __builtin_amdgcn_global_load_lds((const unsigned*)(ED + src), (unsigned*)(buf + i * 1024), 16, 0, 0);
    }
}
template <int HLF>
DEVI void d_mma(const char* buf, const char* slot, size_t tok, int s, int lane, float* PART) {
    const int r = lane & 15, q = lane >> 4;
    const long b0 = *(const long*)(slot + 512 + 32 * q), b1 = *(const long*)(slot + 512 + 32 * q + 8), b2 = *(const long*)(slot + 512 + 32 * q + 16), b3 = *(const long*)(slot + 512 + 32 * q + 24);
    float* dst = PART + ((size_t)s * 16384 + tok) * 128 + 64 * HLF;
    long a[4][4];
#pragma unroll
    for (int t = 0; t < 4; ++t) {
        const int row = 16 * t + r, key = (row >> 1) & 7;
        const char* rp = buf + row * 128;
#pragma unroll
        for (int kk = 0; kk < 4; ++kk) a[t][kk] = *(const long*)(rp + ((((4 * q + kk) >> 1) ^ key) << 4) + 8 * ((4 * q + kk) & 1));
    }
    f32x4 acc[4];
#pragma unroll
    for (int t = 0; t < 4; ++t) { acc[t] = f32x4{0.f, 0.f, 0.f, 0.f}; acc[t] = __builtin_amdgcn_mfma_f32_16x16x32_fp8_fp8(a[t][0], b0, acc[t], 0, 0, 0); }
#pragma unroll
    for (int t = 0; t < 4; ++t) acc[t] = __builtin_amdgcn_mfma_f32_16x16x32_fp8_fp8(a[t][1], b1, acc[t], 0, 0, 0);
#pragma unroll
    for (int t = 0; t < 4; ++t) acc[t] = __builtin_amdgcn_mfma_f32_16x16x32_fp8_fp8(a[t][2], b2, acc[t], 0, 0, 0);
#pragma unroll
    for (int t = 0; t < 4; ++t) acc[t] = __builtin_amdgcn_mfma_f32_16x16x32_fp8_fp8(a[t][3], b3, acc[t], 0, 0, 0);
    if (r == 0) {
#pragma unroll
        for (int t = 0; t < 4; ++t) *(float4*)(dst + 16 * t + 4 * q) = float4{acc[t][0] * (1.f / 32.f), acc[t][1] * (1.f / 32.f), acc[t][2] * (1.f / 32.f), acc[t][3] * (1.f / 32.f)};
    }
}
DEVI void peer_down_phase(const Params& p, const float* __restrict__ gain, int qbase, int s0, char* smem) {
    const int tid = threadIdx.x, lane = tid & 63;
    const int wave = __builtin_amdgcn_readfirstlane(tid >> 6);
    const char* ED = p.ws + OFF_ED; const char* XB8 = p.ws + OFF_XB8;
    const int* IDX = (const int*)(p.ws + OFF_IDX);
    float* PART = (float*)(p.ws + OFF_PART);
    (void)gain;
    char* const img = smem + wave * 16384;
    char* const tb0 = smem + 65536 + wave * 3072;
    unsigned live = 0xffu; int pending = 0;
#pragma unroll 1
    for (int sl = 0; sl < 8; ++sl) {
        const int s = (s0 + sl) & 7;
        if (sl == 1) live = queue_live(p, qbase, s0, smem);
        if (!((live >> sl) & 1u)) continue;
#pragma unroll 1
        for (int g = queue_pop(p, qbase + s, smem); g < PEER_ITEMS; g = queue_publish(pending, smem)) {
            if (threadIdx.x == 0) {
                const unsigned* qp_ = (const unsigned*)(p.ws + OFF_QCNT) + (qbase + s) * 16; const unsigned zo_ = 0u, one_ = 1u;
                asm volatile("global_atomic_add %0, %1, %2, %3 sc0" : "+v"(pending) : "v"(zo_), "v"(one_), "s"(qp_) : "memory");
            }
            const size_t t0 = (size_t)g * (4 * PEER_TPW) + wave * PEER_TPW;
            d_stream(t0, s, lane, tb0, IDX, XB8); d_stream(t0 + 1, s, lane, tb0 + 768, IDX, XB8);
            asm volatile("s_waitcnt vmcnt(0)" ::: "memory");
            d_dma<0>(tb0, img, s, lane, ED);
#pragma unroll 1
            for (int j = 0; j < PEER_TPW; ++j) {
                char* const slj = tb0 + 768 * (j & 3); char* const sln = tb0 + 768 * ((j + 1) & 3);
                if (j + 2 < PEER_TPW) d_stream(t0 + j + 2, s, lane, tb0 + 768 * ((j + 2) & 3), IDX, XB8);
                d_dma<1>(slj, img + 8192, s, lane, ED);
                if (j + 2 < PEER_TPW) asm volatile("s_waitcnt vmcnt(11)" ::: "memory"); else asm volatile("s_waitcnt vmcnt(8)" ::: "memory");
                if (!(PROBE_NOMMA && qbase >= 32)) d_mma<0>(img, slj, t0 + j, s, lane, PART);
                asm volatile("s_waitcnt lgkmcnt(0)" ::: "memory");
                if (j + 1 < PEER_TPW) { d_dma<0>(sln, img, s, lane, ED); asm volatile("s_waitcnt vmcnt(8)" ::: "memory"); }
                else asm volatile("s_waitcnt vmcnt(0)" ::: "memory");
                if (!(PROBE_NOMMA && qbase >= 32)) d_mma<1>(img + 8192, slj, t0 + j, s, lane, PART);
                asm volatile("s_waitcnt lgkmcnt(0)" ::: "memory");
            }
        }
    }
}
struct RedL { float sq, pa[8], pb[8], g0, g1, d0, d1; int i0, i1; };
DEVI void red_load(RedL& L, const Params& p, size_t tok, int lane) {
    const float* PART = (const float*)(p.ws + OFF_PART); const float* GATEU = (const float*)(p.ws + OFF_GATE); const float* SDN = (const float*)(p.ws + OFF_SDN);
    const float* SSQ16 = (const float*)(p.ws + OFF_SSQ16); const int* IDX = (const int*)(p.ws + OFF_IDX);
    L.sq = SSQ16[tok * 16 + (lane & 15)];
#pragma unroll
    for (int s = 0; s < 8; ++s) { L.pa[s] = PART[((size_t)s * 16384 + tok) * 128 + lane]; L.pb[s] = PART[((size_t)s * 16384 + tok) * 128 + 64 + lane]; }
    L.g0 = GATEU[tok * 128 + lane]; L.g1 = GATEU[tok * 128 + 64 + lane]; L.d0 = SDN[tok * 128 + lane]; L.d1 = SDN[tok * 128 + 64 + lane];
    L.i0 = IDX[tok * 128 + lane]; L.i1 = IDX[tok * 128 + 64 + lane];
}
DEVI void red_finish(const RedL& L, const Params& p, size_t tok, int lane) {
    float sq = L.sq;
    sq += DPP_F(sq, 0xB1); sq += DPP_F(sq, 0x4E); sq += DPP_F(sq, 0x141); sq += DPP_F(sq, 0x140);
    const float rstd = rsqrtf(sq * (1.f / 1024.f) + 1e-6f);
    float a0 = 0.f, a1 = 0.f;
#pragma unroll
    for (int s = 0; s < 8; ++s) { a0 += L.pa[s]; a1 += L.pb[s]; }
    const float w0 = L.g0 * gelu_tanh(a0 * rstd * L.d0);
    const float w1 = L.g1 * gelu_tanh(a1 * rstd * L.d1);
    float m = fmaxf(fabsf(w0), fabsf(w1));
    m = wave_max_dpp(m);
    const unsigned e = (__float_as_uint(m) >> 23) & 255u;
    const bool tiny = e < 16u;
    const float S = tiny ? 1.f : __uint_as_float((261u - e) << 23), invS = tiny ? 1.f : __uint_as_float((e - 7u) << 23);
    const float s0 = w0 * S, s1 = w1 * S;
    const int hi = __builtin_amdgcn_cvt_pk_fp8_f32(s0, s1, 0, false);
    const float r0 = s0 - __builtin_amdgcn_cvt_f32_fp8(hi, 0), r1 = s1 - __builtin_amdgcn_cvt_f32_fp8(hi, 1);
    const int lo = __builtin_amdgcn_cvt_pk_fp8_f32(r0, r1, 0, false);
    char* rec = p.ws + OFF_UREC + tok * 768;
    *(unsigned short*)(rec + 2 * lane) = (unsigned short)L.i0;
    *(unsigned short*)(rec + 128 + 2 * lane) = (unsigned short)L.i1;
    *(unsigned char*)(rec + 256 + lane) = (unsigned char)(hi & 255);       *(unsigned char*)(rec + 320 + lane) = (unsigned char)((hi >> 8) & 255);
    *(unsigned char*)(rec + 384 + lane) = (unsigned char)(lo & 255);       *(unsigned char*)(rec + 448 + lane) = (unsigned char)((lo >> 8) & 255);
    *(float*)(rec + 512 + 4 * lane) = invS;
}
DEVI void peer_reduce_phase(const Params& p) {
    const int lane = threadIdx.x & 63, wave = threadIdx.x >> 6;
    const int G = gridDim.x;
    for (int it = blockIdx.x; it < 4096; it += 2 * G) {
        const bool two = it + G < 4096;
        const size_t tokA = (size_t)it * 4 + wave, tokB = (size_t)(two ? it + G : it) * 4 + wave;
        RedL A, B;
        red_load(A, p, tokA, lane); red_load(B, p, tokB, lane);
        red_finish(A, p, tokA, lane);
        if (two) red_finish(B, p, tokB, lane);
    }
}
DEVI void u_stream(size_t tok, int s, int lane, char* slot, const char* UREC, const char* XB) {
    const unsigned o1 = (unsigned)tok * 768u + 4u * (unsigned)lane;
    __builtin_amdgcn_global_load_lds((const unsigned*)(UREC + o1),        (unsigned*)(slot),       4, 0, 0);
    __builtin_amdgcn_global_load_lds((const unsigned*)(UREC + o1 + 256u), (unsigned*)(slot + 256), 4, 0, 0);
    __builtin_amdgcn_global_load_lds((const unsigned*)(UREC + o1 + 512u), (unsigned*)(slot + 512), 4, 0, 0);
    __builtin_amdgcn_global_load_lds((const unsigned*)(XB + (unsigned)tok * 2048u + (unsigned)(256 * s + 4 * lane)), (unsigned*)(slot + 768), 4, 0, 0);
}
template <int HLF>
DEVI void u_dma(const char* slot, char* buf, int s, int lane, const char* EU) {
    const int grp = lane >> 3, sub = lane & 7;
    unsigned e[8];
#pragma unroll
    for (int i = 0; i < 8; ++i) e[i] = *(const unsigned short*)(slot + 128 * HLF + 2 * (8 * i + grp));
#pragma unroll
    for (int i = 0; i < 8; ++i) {
        const int pl_ = 8 * i + grp;
        const unsigned src = ((unsigned)s * 16384u + e[i]) * 128u + (unsigned)(16 * (sub ^ ((pl_ >> 1) & 7)));
        __builtin_amdgcn_global_load_lds((const unsigned*)(EU + src), (unsigned*)(buf + i * 1024), 16, 0, 0);
    }
}
#define TR8(DST, ADDR, OFF) asm volatile("ds_read_b64_tr_b8 %0, %1 offset:%2" : "=v"(DST) : "v"(ADDR), "i"(OFF))
#define TR8_WAIT4(N, A, B, C, D) asm volatile("s_waitcnt lgkmcnt(" #N ")" : "+v"(A), "+v"(B), "+v"(C), "+v"(D))
template <int HLF>
DEVI void u_mma(const char* buf, const char* slot, int lane, f32x4 (&acc)[8]) {
    const int i16 = lane & 15, g = lane >> 4;
    const int row0 = 8 * g + (i16 >> 1), key = (row0 >> 1) & 7;
    const unsigned ab = (unsigned)(size_t)(__attribute__((address_space(3))) const char*)(buf + row0 * 128 + 8 * (i16 & 1));
    const long b0 = *(const long*)(slot + 256 + 128 * (i16 & 1) + 64 * HLF + 8 * g), b1 = *(const long*)(slot + 256 + 128 * (i16 & 1) + 64 * HLF + 32 + 8 * g);
    long a0[8], a1[8];
#pragma unroll
    for (int ct = 0; ct < 8; ++ct) { const unsigned ad = ab + (unsigned)((ct ^ key) << 4); TR8(a0[ct], ad, 0); }
#pragma unroll
    for (int ct = 0; ct < 8; ++ct) { const unsigned ad = ab + (unsigned)((ct ^ key) << 4); TR8(a1[ct], ad, 4096); }
    TR8_WAIT4(12, a0[0], a0[1], a0[2], a0[3]);
#pragma unroll
    for (int ct = 0; ct < 4; ++ct) acc[ct] = __builtin_amdgcn_mfma_f32_16x16x32_fp8_fp8(a0[ct], b0, acc[ct], 0, 0, 0);
    TR8_WAIT4(8, a0[4], a0[5], a0[6], a0[7]);
#pragma unroll
    for (int ct = 4; ct < 8; ++ct) acc[ct] = __builtin_amdgcn_mfma_f32_16x16x32_fp8_fp8(a0[ct], b0, acc[ct], 0, 0, 0);
    TR8_WAIT4(4, a1[0], a1[1], a1[2], a1[3]);
#pragma unroll
    for (int ct = 0; ct < 4; ++ct) acc[ct] = __builtin_amdgcn_mfma_f32_16x16x32_fp8_fp8(a1[ct], b1, acc[ct], 0, 0, 0);
    TR8_WAIT4(0, a1[4], a1[5], a1[6], a1[7]);
#pragma unroll
    for (int ct = 4; ct < 8; ++ct) acc[ct] = __builtin_amdgcn_mfma_f32_16x16x32_fp8_fp8(a1[ct], b1, acc[ct], 0, 0, 0);
}
DEVI void u_finish(f32x4 (&acc)[8], const char* slot, char* ex, size_t tok, int s, int lane, float alpha, float* X, bf16_t* XB, float* SSQ8) {
    const int i16 = lane & 15, g = lane >> 4;
    if (i16 < 2) {
#pragma unroll
        for (int ct = 0; ct < 8; ++ct) *(f32x4*)(ex + 576 * i16 + 4 * (16 * ct + 4 * g)) = acc[ct];
    }
    const float2 vh = *(const float2*)(ex + 8 * lane), vl = *(const float2*)(ex + 576 + 8 * lane);
    const float sc = alpha * *(const float*)(slot + 512);
    const unsigned xb2 = *(const unsigned*)(slot + 768 + 4 * lane);
    const float y0 = bflo(xb2) + sc * (vh.x + vl.x), y1 = bfhi(xb2) + sc * (vh.y + vl.y);
    const unsigned col = (unsigned)tok * 1024u + (unsigned)(128 * s + 2 * lane);
    if (X) *(f32x2v*)((char*)X + 4u * col) = f32x2v{y0, y1};
    const unsigned yb = pack2(y0, y1);
    *(unsigned*)((char*)XB + 2u * col) = yb;
    float sq = bflo(yb) * bflo(yb) + bfhi(yb) * bfhi(yb);
    sq = wave_sum_dpp(sq);
    if (lane == 0) *(float*)((char*)SSQ8 + ((unsigned)tok * 32u + 4u * (unsigned)s)) = sq;
#pragma unroll
    for (int ct = 0; ct < 8; ++ct) acc[ct] = f32x4{0.f, 0.f, 0.f, 0.f};
}
DEVI void peer_up_phase(const Params& p, int qbase, int s0, float alpha, float* X, char* smem) {
    const int tid = threadIdx.x, lane = tid & 63;
    const int wave = __builtin_amdgcn_readfirstlane(tid >> 6);
    const char* EU = p.ws + OFF_EU; const char* UREC = p.ws + OFF_UREC;
    bf16_t* XB = (bf16_t*)(p.ws + OFF_XB); float* SSQ8 = (float*)(p.ws + OFF_SSQ8);
    char* const img = smem + wave * 16384;
    char* const tb0 = smem + 65536 + wave * 3072;
    unsigned live = 0xffu; int pending = 0;
#pragma unroll 1
    for (int sl = 0; sl < 8; ++sl) {
        const int s = (s0 + sl) & 7;
        if (sl == 1) live = queue_live(p, qbase, s0, smem);
        if (!((live >> sl) & 1u)) continue;
#pragma unroll 1
        for (int g = queue_pop(p, qbase + s, smem); g < PEER_ITEMS; g = queue_publish(pending, smem)) {
            if (threadIdx.x == 0) {
                const unsigned* qp_ = (const unsigned*)(p.ws + OFF_QCNT) + (qbase + s) * 16; const unsigned zo_ = 0u, one_ = 1u;
                asm volatile("global_atomic_add %0, %1, %2, %3 sc0" : "+v"(pending) : "v"(zo_), "v"(one_), "s"(qp_) : "memory");
            }
            const size_t t0 = (size_t)g * (4 * PEER_TPW) + wave * PEER_TPW;
            f32x4 acc[8];
#pragma unroll
            for (int ct = 0; ct < 8; ++ct) acc[ct] = f32x4{0.f, 0.f, 0.f, 0.f};
            char* slj = tb0; char* sln = tb0 + 1024; char* slf = tb0 + 2048;
            u_stream(t0, s, lane, slj, UREC, (const char*)XB); u_stream(t0 + 1, s, lane, sln, UREC, (const char*)XB);
            asm volatile("s_waitcnt vmcnt(0)" ::: "memory");
            u_dma<0>(slj, img, s, lane, EU);
#pragma unroll 1
            for (int j = 0; j < PEER_TPW; ++j) {
                if (j + 2 < PEER_TPW) u_stream(t0 + j + 2, s, lane, slf, UREC, (const char*)XB);
                u_dma<1>(slj, img + 8192, s, lane, EU);
                if (j + 2 < PEER_TPW) asm volatile("s_waitcnt vmcnt(12)" ::: "memory"); else asm volatile("s_waitcnt vmcnt(8)" ::: "memory");
                u_mma<0>(img, slj, lane, acc);
                asm volatile("s_waitcnt lgkmcnt(0)" ::: "memory");
                if (j + 1 < PEER_TPW) { u_dma<0>(sln, img, s, lane, EU); asm volatile("s_waitcnt vmcnt(8)" ::: "memory"); }
                else asm volatile("s_waitcnt vmcnt(0)" ::: "memory");
                u_mma<1>(img + 8192, slj, lane, acc);
                asm volatile("s_waitcnt lgkmcnt(0)" ::: "memory");
                u_finish(acc, slj, img + 8192, t0 + j, s, lane, alpha, X, XB, SSQ8);
                asm volatile("s_waitcnt lgkmcnt(0)" ::: "memory");
                char* const t_ = slj; slj = sln; sln = slf; slf = t_;
            }
        }
    }
}

DEVI void rope_cs(float pos, int i, float& c, float& s) {
    const float inv = exp2f(-(float)i * (13.287712379549449f / 32.f));
    const float ang = pos * inv;
    const float kf = rintf(ang * 0.15915494309189535f);
    float rr = fmaf(-kf, 6.2831854820251465f, ang);
    rr = fmaf(-kf, -1.7484555e-7f, rr);
    c = __cosf(rr); s = __sinf(rr);
}
#define QSCALE_MLA  (0.07216878364870322f * 1.4426950408889634f)
#define QSCALE_MOBA (0.08838834764831845f * 1.4426950408889634f)

DEVI void moba_prep_item(const Params& p, int item, char* smem) {
    const int tid = threadIdx.x;
    const int h = item & 3, tt = item >> 2;
    const size_t m0 = (size_t)tt * 64;
    const int b = (int)(m0 >> 13), s0 = (int)(m0 & 8191), bh = b * 4 + h;
    const bf16_t* Z1 = (const bf16_t*)(p.ws + OFF_Z1);
    bf16_t* Qd = (bf16_t*)(p.ws + OFF_QD); bf16_t* Kd = (bf16_t*)(p.ws + OFF_KD); bf16_t* VdT = (bf16_t*)(p.ws + OFF_VDT);
    const int row = tid >> 2, j = tid & 3;
    const bf16_t* zr = Z1 + (m0 + row) * 1984;
#pragma unroll
    for (int which = 0; which < 2; ++which) {
        const bf16_t* src = zr + (which ? 960 : 448) + h * 128 + 32 * j;
        const float* gn = (which ? p.l1_mk_norm : p.l1_mq_norm) + 32 * j;
        float v[32]; float ss = 0.f;
#pragma unroll
        for (int i = 0; i < 4; ++i) {
            uint4 u = *(const uint4*)(src + 8 * i);
            v[8 * i] = bflo(u.x); v[8 * i + 1] = bfhi(u.x); v[8 * i + 2] = bflo(u.y); v[8 * i + 3] = bfhi(u.y);
            v[8 * i + 4] = bflo(u.z); v[8 * i + 5] = bfhi(u.z); v[8 * i + 6] = bflo(u.w); v[8 * i + 7] = bfhi(u.w);
        }
#pragma unroll
        for (int i = 0; i < 32; ++i) ss += v[i] * v[i];
        ss += __shfl_xor(ss, 1); ss += __shfl_xor(ss, 2);
        const float sc = rsqrtf(ss * (1.f / 128.f) + 1e-6f) * (which ? 1.f : QSCALE_MOBA);
        bf16_t* dst = (which ? Kd : Qd) + ((size_t)bh * 8192 + s0 + row) * 128 + 32 * j;
#pragma unroll
        for (int i = 0; i < 4; ++i) {
            uint4 o;
            o.x = pack2(v[8 * i] * sc * gn[8 * i], v[8 * i + 1] * sc * gn[8 * i + 1]); o.y = pack2(v[8 * i + 2] * sc * gn[8 * i + 2], v[8 * i + 3] * sc * gn[8 * i + 3]);
            o.z = pack2(v[8 * i + 4] * sc * gn[8 * i + 4], v[8 * i + 5] * sc * gn[8 * i + 5]); o.w = pack2(v[8 * i + 6] * sc * gn[8 * i + 6], v[8 * i + 7] * sc * gn[8 * i + 7]);
            *(uint4*)(dst + 8 * i) = o;
        }
    }
    bf16_t* sT = (bf16_t*)smem;
    {
        const bf16_t* src = zr + 1472 + h * 128 + 32 * j;
#pragma unroll
        for (int i = 0; i < 4; ++i) {
            uint4 u = *(const uint4*)(src + 8 * i);
            const int d0 = 32 * j + 8 * i;
            sT[(d0 + 0) * 66 + row] = (bf16_t)(u.x & 0xffff); sT[(d0 + 1) * 66 + row] = (bf16_t)(u.x >> 16);
            sT[(d0 + 2) * 66 + row] = (bf16_t)(u.y & 0xffff); sT[(d0 + 3) * 66 + row] = (bf16_t)(u.y >> 16);
            sT[(d0 + 4) * 66 + row] = (bf16_t)(u.z & 0xffff); sT[(d0 + 5) * 66 + row] = (bf16_t)(u.z >> 16);
            sT[(d0 + 6) * 66 + row] = (bf16_t)(u.w & 0xffff); sT[(d0 + 7) * 66 + row] = (bf16_t)(u.w >> 16);
        }
    }
    __syncthreads();
    for (int e = tid; e < 128 * 32; e += NTHREADS) {
        const int d = e >> 5, tp = e & 31;
        const unsigned v = (unsigned)sT[d * 66 + 2 * tp] | ((unsigned)sT[d * 66 + 2 * tp + 1] << 16);
        *(unsigned*)(VdT + ((size_t)bh * 128 + d) * 8192 + s0 + (((2 * tp) & ~12) | (((2 * tp) & 4) << 1) | (((2 * tp) & 8) >> 1))) = v;
    }
    __syncthreads();
}

DEVI void moba_kmean_item(const Params& p, int item, char* smem) {
    const int tid = threadIdx.x;
    const int bh = item >> 5, blk = item & 31, b = bh >> 2, h = bh & 3;
    const bf16_t* Z1 = (const bf16_t*)(p.ws + OFF_Z1) + ((size_t)b * 8192 + blk * 256) * 1984 + 960 + h * 128;
    const int cc = tid & 15, rg = tid >> 4;
    float col[8];
#pragma unroll
    for (int i = 0; i < 8; ++i) col[i] = 0.f;
    for (int i = 0; i < 16; ++i) {
        const int row = rg * 16 + i;
        uint4 u = *(const uint4*)(Z1 + (size_t)row * 1984 + cc * 8);
        float v[8] = {bflo(u.x), bfhi(u.x), bflo(u.y), bfhi(u.y), bflo(u.z), bfhi(u.z), bflo(u.w), bfhi(u.w)};
        float ss = 0.f;
#pragma unroll
        for (int e = 0; e < 8; ++e) ss += v[e] * v[e];
        ss += __shfl_xor(ss, 1); ss += __shfl_xor(ss, 2); ss += __shfl_xor(ss, 4); ss += __shfl_xor(ss, 8);
        const float rstd = rsqrtf(ss * (1.f / 128.f) + 1e-6f);
#pragma unroll
        for (int e = 0; e < 8; ++e) col[e] += v[e] * rstd;
    }
    float* sR = (float*)smem;
#pragma unroll
    for (int e = 0; e < 8; ++e) sR[rg * 128 + cc * 8 + e] = col[e];
    __syncthreads();
    if (tid < 128) {
        float s = 0.f;
#pragma unroll
        for (int g = 0; g < 16; ++g) s += sR[g * 128 + tid];
        ((float*)(p.ws + OFF_KMEAN))[((size_t)bh * 32 + blk) * 128 + tid] = s * (1.f / 256.f) * p.l1_mk_norm[tid];
    }
    __syncthreads();
}

DEVI void mla_prep_item(const Params& p, int item, char* smem) {
    const int tid = threadIdx.x;
    const int h = item & 3, tt = item >> 2;
    const size_t m0 = (size_t)tt * 64;
    const int b = (int)(m0 >> 13), s0 = (int)(m0 & 8191), bh = b * 4 + h;
    const bf16_t* Z1 = (const bf16_t*)(p.ws + OFF_Z1);
    const bf16_t* QC = (const bf16_t*)(p.ws + OFF_QC);
    const bf16_t* KV = (const bf16_t*)(p.ws + OFF_KV);
    bf16_t* Q = (bf16_t*)(p.ws + OFF_Q); bf16_t* K = (bf16_t*)(p.ws + OFF_K); bf16_t* VT = (bf16_t*)(p.ws + OFF_VT);
    const int row = tid >> 2, j = tid & 3;
    const size_t m = m0 + row;
    const float pos = (float)p.pos[m];
#pragma unroll
    for (int which = 0; which < 2; ++which) {
        const bf16_t* nsrc = which ? (KV + m * 1024 + h * 256 + 32 * j) : (QC + m * 768 + h * 192 + 32 * j);
        const bf16_t* r1 = which ? (Z1 + m * 1984 + 384 + 8 * j) : (QC + m * 768 + h * 192 + 128 + 8 * j);
        const bf16_t* r2 = r1 + 32;
        const float* gn = which ? p.l1_k_norm : p.l1_q_norm;
        float v[32], a1[8], a2[8]; float ss = 0.f;
#pragma unroll
        for (int i = 0; i < 4; ++i) {
            uint4 u = *(const uint4*)(nsrc + 8 * i);
            v[8 * i] = bflo(u.x); v[8 * i + 1] = bfhi(u.x); v[8 * i + 2] = bflo(u.y); v[8 * i + 3] = bfhi(u.y);
            v[8 * i + 4] = bflo(u.z); v[8 * i + 5] = bfhi(u.z); v[8 * i + 6] = bflo(u.w); v[8 * i + 7] = bfhi(u.w);
        }
        { uint4 u = *(const uint4*)r1; a1[0] = bflo(u.x); a1[1] = bfhi(u.x); a1[2] = bflo(u.y); a1[3] = bfhi(u.y); a1[4] = bflo(u.z); a1[5] = bfhi(u.z); a1[6] = bflo(u.w); a1[7] = bfhi(u.w); }
        { uint4 u = *(const uint4*)r2; a2[0] = bflo(u.x); a2[1] = bfhi(u.x); a2[2] = bflo(u.y); a2[3] = bfhi(u.y); a2[4] = bflo(u.z); a2[5] = bfhi(u.z); a2[6] = bflo(u.w); a2[7] = bfhi(u.w); }
#pragma unroll
        for (int i = 0; i < 32; ++i) ss += v[i] * v[i];
#pragma unroll
        for (int i = 0; i < 8; ++i) ss += a1[i] * a1[i] + a2[i] * a2[i];
        ss += __shfl_xor(ss, 1); ss += __shfl_xor(ss, 2);
        const float rstd = rsqrtf(ss * (1.f / 192.f) + 1e-6f);
        const float sc = which ? 1.f : QSCALE_MLA;
        bf16_t* dst = (which ? K : Q) + ((size_t)bh * 8192 + s0 + row) * 192;
#pragma unroll
        for (int i = 0; i < 4; ++i) {
            const float* g = gn + 32 * j + 8 * i;
            uint4 o;
            o.x = pack2(v[8 * i] * rstd * g[0] * sc, v[8 * i + 1] * rstd * g[1] * sc); o.y = pack2(v[8 * i + 2] * rstd * g[2] * sc, v[8 * i + 3] * rstd * g[3] * sc);
            o.z = pack2(v[8 * i + 4] * rstd * g[4] * sc, v[8 * i + 5] * rstd * g[5] * sc); o.w = pack2(v[8 * i + 6] * rstd * g[6] * sc, v[8 * i + 7] * rstd * g[7] * sc);
            *(uint4*)(dst + 32 * j + 8 * i) = o;
        }
        float o1[8], o2[8];
#pragma unroll
        for (int i = 0; i < 8; ++i) {
            float c, s; rope_cs(pos, 8 * j + i, c, s);
            const float y1 = a1[i] * rstd * gn[128 + 8 * j + i], y2 = a2[i] * rstd * gn[160 + 8 * j + i];
            o1[i] = (y1 * c - y2 * s) * sc; o2[i] = (y2 * c + y1 * s) * sc;
        }
        uint4 w1, w2;
        w1.x = pack2(o1[0], o1[1]); w1.y = pack2(o1[2], o1[3]); w1.z = pack2(o1[4], o1[5]); w1.w = pack2(o1[6], o1[7]);
        w2.x = pack2(o2[0], o2[1]); w2.y = pack2(o2[2], o2[3]); w2.z = pack2(o2[4], o2[5]); w2.w = pack2(o2[6], o2[7]);
        *(uint4*)(dst + 128 + 8 * j) = w1; *(uint4*)(dst + 160 + 8 * j) = w2;
    }
    bf16_t* sT = (bf16_t*)smem;
    {
        const bf16_t* src = KV + m * 1024 + h * 256 + 128 + 32 * j;
#pragma unroll
        for (int i = 0; i < 4; ++i) {
            uint4 u = *(const uint4*)(src + 8 * i);
            const int d0 = 32 * j + 8 * i;
            sT[(d0 + 0) * 66 + row] = (bf16_t)(u.x & 0xffff); sT[(d0 + 1) * 66 + row] = (bf16_t)(u.x >> 16);
            sT[(d0 + 2) * 66 + row] = (bf16_t)(u.y & 0xffff); sT[(d0 + 3) * 66 + row] = (bf16_t)(u.y >> 16);
            sT[(d0 + 4) * 66 + row] = (bf16_t)(u.z & 0xffff); sT[(d0 + 5) * 66 + row] = (bf16_t)(u.z >> 16);
            sT[(d0 + 6) * 66 + row] = (bf16_t)(u.w & 0xffff); sT[(d0 + 7) * 66 + row] = (bf16_t)(u.w >> 16);
        }
    }
    __syncthreads();
    for (int e = tid; e < 128 * 32; e += NTHREADS) {
        const int d = e >> 5, tp = e & 31;
        const unsigned v = (unsigned)sT[d * 66 + 2 * tp] | ((unsigned)sT[d * 66 + 2 * tp + 1] << 16);
        *(unsigned*)(VT + ((size_t)bh * 128 + d) * 8192 + s0 + (((2 * tp) & ~12) | (((2 * tp) & 4) << 1) | (((2 * tp) & 8) >> 1))) = v;
    }
    __syncthreads();
}

template <int DQK, bool MOBA>
DEVI void attn_item(const Params& p, int bh, int qt, char* smem) {
    constexpr int NKS = DQK / 16, KCH = DQK / 8;
    const int tid = threadIdx.x, lane = tid & 63, wave = tid >> 6;
    const int r = lane & 31, hh = lane >> 5;
    char* const ws = opaque_ptr(p.ws);
    const bf16_t* Q  = (const bf16_t*)(ws + (MOBA ? OFF_QD : OFF_Q)) + (size_t)bh * 8192 * DQK;
    const bf16_t* Kg = (const bf16_t*)(ws + (MOBA ? OFF_KD : OFF_K)) + (size_t)bh * 8192 * DQK;
    const bf16_t* Vg = (const bf16_t*)(ws + (MOBA ? OFF_VDT : OFF_VT)) + (size_t)bh * 128 * 8192;
    const int q0 = qt * 128;
    const int qpos = q0 + wave * 32 + r;
    constexpr int KB = 32 * DQK * 2, VB = 8192, STG = KB + VB;
    constexpr int KI = KB / 4096;
    int*  sList = (int*)(smem + 61440);
    unsigned* sSel = (unsigned*)(smem + 62464);
    float* sTop = (float*)(smem + 63232);
    int ntiles;
    unsigned mysel = 0xffffffffu;
    if constexpr (MOBA) {
        const int jblk = q0 >> 8;
        float* sKm = (float*)smem;
        const float* km = (const float*)(ws + OFF_KMEAN) + (size_t)bh * 32 * 128;
        for (int e = tid; e < 1024; e += NTHREADS) ((float4*)sKm)[e] = ((const float4*)km)[e];
        unsigned* sAny = (unsigned*)(smem + 62976);
        if (tid < 32) sAny[tid] = 0u;
        __syncthreads();
        const int qq = tid & 127, par = tid >> 7;
        float ga[16];
#pragma unroll
        for (int i = 0; i < 16; ++i) ga[i] = 0.f;
        const bf16_t* qrow = Q + (size_t)(q0 + qq) * 128;
#pragma unroll 1
        for (int d0 = 0; d0 < 128; d0 += 8) {
            uint4 u = *(const uint4*)(qrow + d0);
            float qv[8] = {bflo(u.x), bfhi(u.x), bflo(u.y), bfhi(u.y), bflo(u.z), bfhi(u.z), bflo(u.w), bfhi(u.w)};
#pragma unroll
            for (int i = 0; i < 16; ++i) {
                const float4 ka = *(const float4*)(sKm + (2 * i + par) * 128 + d0), kb = *(const float4*)(sKm + (2 * i + par) * 128 + d0 + 4);
                ga[i] += qv[0] * ka.x + qv[1] * ka.y + qv[2] * ka.z + qv[3] * ka.w + qv[4] * kb.x + qv[5] * kb.y + qv[6] * kb.z + qv[7] * kb.w;
            }
        }
        float tv[3] = {-3e38f, -3e38f, -3e38f}; int ti[3] = {-1, -1, -1};
#pragma unroll
        for (int i = 0; i < 16; ++i) {
            const int n = 2 * i + par;
            if (n < jblk) {
                const float v = ga[i];
                if (v > tv[0]) { tv[2] = tv[1]; ti[2] = ti[1]; tv[1] = tv[0]; ti[1] = ti[0]; tv[0] = v; ti[0] = n; }
                else if (v > tv[1]) { tv[2] = tv[1]; ti[2] = ti[1]; tv[1] = v; ti[1] = n; }
                else if (v > tv[2]) { tv[2] = v; ti[2] = n; }
            }
        }
#pragma unroll
        for (int i = 0; i < 3; ++i) { sTop[tid * 6 + 2 * i] = tv[i]; sTop[tid * 6 + 2 * i + 1] = __int_as_float(ti[i]); }
        __syncthreads();
        if (par == 0) {
#pragma unroll
            for (int i = 0; i < 3; ++i) {
                const float v = sTop[(tid + 128) * 6 + 2 * i]; const int n = __float_as_int(sTop[(tid + 128) * 6 + 2 * i + 1]);
                if (n >= 0) {
                    if (v > tv[0]) { tv[2] = tv[1]; ti[2] = ti[1]; tv[1] = tv[0]; ti[1] = ti[0]; tv[0] = v; ti[0] = n; }
                    else if (v > tv[1]) { tv[2] = tv[1]; ti[2] = ti[1]; tv[1] = v; ti[1] = n; }
                    else if (v > tv[2]) { tv[2] = v; ti[2] = n; }
                }
            }
            unsigned m = 1u << jblk;
#pragma unroll
            for (int i = 0; i < 3; ++i) if (ti[i] >= 0) { m |= 1u << ti[i]; sAny[ti[i]] = 1u; }
            sSel[qq] = m;
        }
        __syncthreads();
        if (tid == 0) {
            int n = 0;
            for (int blk = 0; blk < jblk; ++blk) if (sAny[blk]) { for (int t = 0; t < 8; ++t) sList[n++] = blk * 8 + t; }
            for (int t = jblk * 8; t < (q0 + 128) / 32; ++t) sList[n++] = t;
            sSel[160] = (unsigned)n;
        }
        __syncthreads();
        ntiles = (int)sSel[160];
        mysel = sSel[wave * 32 + r];
        __syncthreads();
    } else {
        ntiles = 4 * qt + 4;
    }
    bf16x8 qf[NKS];
#pragma unroll
    for (int ks = 0; ks < NKS; ++ks) qf[ks] = *(const bf16x8*)(Q + (size_t)qpos * DQK + ks * 16 + hh * 8);
    f32x16 o[4];
#pragma unroll
    for (int dt = 0; dt < 4; ++dt)
#pragma unroll
        for (int e = 0; e < 16; ++e) o[dt][e] = 0.f;
    float lsum = 0.f;
    int koff[KI], voff[2];
#pragma unroll
    for (int i = 0; i < KI; ++i) {
        const int L = (wave * KI + i) * 64 + lane, row = L / KCH, cp = L % KCH;
        const int f = (DQK == 128) ? (row & 15) : ((row >> 1) & 7);
        koff[i] = row * DQK + (cp ^ f) * 8;
    }
#pragma unroll
    for (int i = 0; i < 2; ++i) {
        const int L = (wave * 2 + i) * 64 + lane, dv = L >> 2, cp = L & 3;
        voff[i] = dv * 8192 + (cp ^ ((dv >> 2) & 3)) * 8;
    }
    const int wv = __builtin_amdgcn_readfirstlane(wave);
#define ATT_ISSUE(LI) { const int u_ = tile_id(LI); char* st_ = smem + ((LI) % 3) * STG; \
        _Pragma("unroll") for (int i = 0; i < KI; ++i) __builtin_amdgcn_global_load_lds((const unsigned*)(Kg + (size_t)u_ * 32 * DQK + koff[i]), (unsigned*)(st_ + (wv * KI + i) * 1024), 16, 0, 0); \
        _Pragma("unroll") for (int i = 0; i < 2; ++i)  __builtin_amdgcn_global_load_lds((const unsigned*)(Vg + (size_t)u_ * 32 + voff[i]),       (unsigned*)(st_ + KB + (wv * 2 + i) * 1024), 16, 0, 0); }
    auto tile_id = [&](int li) -> int { if constexpr (MOBA) return sList[li]; else return li; };
    if (ntiles > 0) ATT_ISSUE(0)
    if (ntiles > 1) ATT_ISSUE(1)
    const int xk = ((DQK == 128) ? (r & 15) : ((r >> 1) & 7)) ^ hh;
    const int xv = (r >> 2) & 3;
#pragma unroll 1
    for (int li = 0; li < ntiles; ++li) {
        if (li + 1 < ntiles) asm volatile("s_waitcnt vmcnt(%0)" :: "n"(KI + 2) : "memory");
        else asm volatile("s_waitcnt vmcnt(0)" ::: "memory");
        G2_RAW_BARRIER();
        if (li + 2 < ntiles) ATT_ISSUE(li + 2)
        const int unit = tile_id(li);
        const int kbase = unit * 32;
        bool allowed = true;
        if constexpr (MOBA) allowed = (mysel >> (unit >> 3)) & 1u;
        const char* sK = smem + (li % 3) * STG;
        const char* sV = sK + KB;
        if (kbase <= q0 + wave * 32 + 31) {
            const char* kbase_l = sK + r * (DQK * 2);
            const char* vbase_l = sV + r * 64;
            f32x16 s;
#pragma unroll
            for (int e = 0; e < 16; ++e) s[e] = 0.f;
#pragma unroll
            for (int ks = 0; ks < NKS; ++ks) {
                const bf16x8 a = *(const bf16x8*)(kbase_l + (((2 * ks) ^ xk) << 4));
                s = mfma32(a, qf[ks], s);
            }
            const bool need_mask = (kbase + 31 > q0 + wave * 32);
            float pr[16];
            if (need_mask) {
                const int kofs = qpos - kbase - 4 * hh;
#pragma unroll
                for (int e = 0; e < 16; ++e) pr[e] = ((e & 3) + 8 * (e >> 2) <= kofs) ? __builtin_amdgcn_exp2f(s[e]) : 0.f;
            } else {
#pragma unroll
                for (int e = 0; e < 16; ++e) pr[e] = __builtin_amdgcn_exp2f(s[e]);
            }
            if constexpr (MOBA) {
                const float am = allowed ? 1.f : 0.f;
#pragma unroll
                for (int e = 0; e < 16; ++e) pr[e] *= am;
            }
            lsum += ((pr[0] + pr[1]) + (pr[2] + pr[3])) + ((pr[4] + pr[5]) + (pr[6] + pr[7])) + ((pr[8] + pr[9]) + (pr[10] + pr[11])) + ((pr[12] + pr[13]) + (pr[14] + pr[15]));
#pragma unroll
            for (int s2 = 0; s2 < 2; ++s2) {
                const u32x4 pbu = {pack2(pr[8 * s2 + 0], pr[8 * s2 + 1]), pack2(pr[8 * s2 + 2], pr[8 * s2 + 3]),
                                   pack2(pr[8 * s2 + 4], pr[8 * s2 + 5]), pack2(pr[8 * s2 + 6], pr[8 * s2 + 7])};
                const bf16x8 pbv = __builtin_bit_cast(bf16x8, pbu);
#pragma unroll
                for (int dt = 0; dt < 4; ++dt) {
                    const char* vb = vbase_l + dt * (32 * 64);
                    const u32x4 vau = *(const u32x4*)(vb + (((2 * s2 + hh) ^ xv) << 4));
                    o[dt] = mfma32(__builtin_bit_cast(bf16x8, vau), pbv, o[dt]);
                }
            }
        }
    }
#undef ATT_ISSUE
    G2_RAW_BARRIER();
    lsum += __shfl_xor(lsum, 32);
    const float inv = 1.f / lsum;
    char* sO = smem + wave * 8704;
#pragma unroll
    for (int dt = 0; dt < 4; ++dt)
#pragma unroll
        for (int e = 0; e < 16; e += 2) {
            const int dv = 32 * dt + (e & 3) + 8 * (e >> 2) + 4 * hh;
            *(unsigned*)(sO + r * 272 + dv * 2) = pack2(o[dt][e] * inv, o[dt][e + 1] * inv);
        }
    __builtin_amdgcn_s_waitcnt(0xc07f);
    __builtin_amdgcn_wave_barrier();
    bf16_t* MIX = (bf16_t*)(ws + OFF_MIX1);
    const int b = bh >> 2, h = bh & 3;
#pragma unroll
    for (int i = 0; i < 8; ++i) {
        const int id = lane + 64 * i, row = id >> 4, cc = id & 15;
        const uint4 v = *(const uint4*)(sO + row * 272 + cc * 16);
        *(uint4*)(MIX + ((size_t)b * 8192 + q0 + wave * 32 + row) * 1024 + (MOBA ? 512 : 0) + h * 128 + cc * 8) = v;
    }
    __syncthreads();
}

DEVI void attn_phase_all(const Params& p, char* smem) {
    const int G = gridDim.x;
#pragma unroll 1
    for (int v = blockIdx.x; v < 512; v += G) attn_item<192, false>(p, v & 7, 63 - (v >> 3), smem);
    __builtin_amdgcn_sched_barrier(0);
#pragma unroll 1
    for (int v = blockIdx.x; v < 512; v += G) attn_item<128, true>(p, v & 7, (v >> 3), smem);
}

#define XB_TMO      128
#define XB_XCNT(j)  (256  + 64 * (j))
#define XB_XSUB(j)  (1280 + 64 * (j))
#define XB_XGEN(j)  (2304 + 64 * (j))
#define XB_TOP      3328
#define XB_TOPGEN   3392
#define XCD_BAR_WORDS 3456
#define XB_SPIN_CAP (1u << 23)
#define LAS __attribute__((address_space(3)))
DEVI unsigned xb_ld(unsigned* p)              { return __hip_atomic_load(p, __ATOMIC_RELAXED, __HIP_MEMORY_SCOPE_AGENT); }
DEVI unsigned xb_add(unsigned* p, unsigned v) { return __hip_atomic_fetch_add(p, v, __ATOMIC_RELAXED, __HIP_MEMORY_SCOPE_AGENT); }
DEVI unsigned xb_xcc_id() { return (unsigned)__builtin_amdgcn_s_getreg((3 << 11) | 20) & 0xFu; }
#define XB_SPIN(cond, bar) do { unsigned _sp = 0; while (cond) { __builtin_amdgcn_s_sleep(1); \
    if ((++_sp & 255u) == 0u) { if (xb_ld(&(bar)[XB_TMO])) break; if (_sp > XB_SPIN_CAP) { atomicAdd(&(bar)[XB_TMO], 1u); break; } } } } while (0)
struct XcdBarrier { unsigned* bar; unsigned x; volatile LAS unsigned* st; };
DEVI XcdBarrier xcd_barrier_post(unsigned* bar, volatile LAS unsigned* st) {
    XcdBarrier b; b.bar = bar; b.x = xb_xcc_id(); b.st = st;
    if (threadIdx.x == 0) st[2] = xb_add(&bar[XB_XCNT(b.x)], 1u);
    return b;
}
DEVI void xcd_barrier_complete(unsigned* bar, unsigned x, unsigned& nloc, unsigned& nx, unsigned& dense) {
    const unsigned G = gridDim.x * gridDim.y * gridDim.z;
    unsigned sum, cnt, mine, sp = 0u;
    for (;;) {
        sum = 0u; cnt = 0u; mine = 0u; dense = 0u;
#pragma unroll
        for (unsigned j = 0; j < 16; ++j) { const unsigned c = xb_ld(&bar[XB_XCNT(j)]); sum += c; cnt += (c > 0u) ? 1u : 0u; mine = (j == x) ? c : mine; dense += (j < x && c > 0u) ? 1u : 0u; }
        if (sum == G) break;
        __builtin_amdgcn_s_sleep(1);
        if ((++sp & 255u) == 0u) { if (xb_ld(&bar[XB_TMO])) break; if (sp > XB_SPIN_CAP) { atomicAdd(&bar[XB_TMO], 1u); break; } }
    }
    nloc = mine > 0u ? mine : 1u; nx = cnt > 0u ? cnt : 1u;
}
DEVI void xcd_barrier(const XcdBarrier& b) {
    asm volatile("s_waitcnt vmcnt(0)" ::: "memory");
    __syncthreads();
    if (threadIdx.x == 0) {
        unsigned* bar = b.bar;
        __builtin_amdgcn_s_waitcnt(0);
        unsigned nloc = b.st[0], nx = b.st[1];
        if (nloc == 0u) { unsigned dense = 0u; xcd_barrier_complete(bar, b.x, nloc, nx, dense); b.st[0] = nloc; b.st[1] = nx; b.st[3] = dense; }
        const unsigned old = xb_add(&bar[XB_XSUB(b.x)], 1u);
        const unsigned gen = old / nloc;
        if (old + 1u == (gen + 1u) * nloc) {
            __builtin_amdgcn_fence(__ATOMIC_RELEASE, "agent");
            asm volatile("s_waitcnt vmcnt(0)" ::: "memory");
            const unsigned og = xb_add(&bar[XB_TOP], 1u);
            const unsigned tg = og / nx;
            if (og + 1u == (tg + 1u) * nx) xb_add(&bar[XB_TOPGEN], 1u);
            else XB_SPIN(xb_ld(&bar[XB_TOPGEN]) == tg, bar);
            __builtin_amdgcn_fence(__ATOMIC_ACQUIRE, "agent");
            xb_add(&bar[XB_XGEN(b.x)], 1u);
            asm volatile("s_waitcnt vmcnt(0)" ::: "memory");
        } else {
            XB_SPIN(xb_ld(&bar[XB_XGEN(b.x)]) == gen, bar);
            __builtin_amdgcn_fence(__ATOMIC_ACQUIRE, "agent");
            asm volatile("s_waitcnt vmcnt(0)" ::: "memory");
        }
    }
    __syncthreads();
}

enum { PH_CONV, PH_INPROJ0, PH_LOCAL, PH_SCAN, PH_HOUT, PH_OUTPROJ0, PH_Q0, PH_TOPK0, PH_PD0, PH_PR0, PH_PU0, PH_INPROJ1, PH_SMALL, PH_MLAPREP, PH_MLA,
       PH_OUTPROJ1, PH_Q1, PH_TOPK1, PH_PD1, PH_PR1, PH_PU1, N_PHASES };
DEVI void run_phase(const Params& p, int ph_in, char* smem, Placement pl) {
    const bool dup = ph_in >= 100; const int ph = dup ? ph_in - 100 : ph_in;
#ifdef ONLY_PHASE
    if (ph != ONLY_PHASE) return;
#endif
    char* ws = p.ws;
    const int bid = blockIdx.x, nb = gridDim.x;
    const int myslice = (pl.nloc > 0) ? (pl.xcc & 7) : (bid & 7);
    switch (ph) {
    case PH_CONV: phase_convert(p, smem); break;
    case PH_INPROJ0: gemm2_phase((const bf16_t*)(ws + OFF_XB), 1024, (const bf16_t*)(ws + OFF_W_IN0T), 128, 12, 1024, (const float*)(ws + OFF_SSQ1), 1,
                        Epi2In0{(bf16_t*)(ws + OFF_Z0), (float*)(ws + OFF_G), (const float*)(ws + OFF_LB), (bf16_t*)(ws + OFF_Z0), 3072, 3072, nullptr, nullptr}, smem, pl); break;
    case PH_LOCAL: for (int it = bid; it < 1024; it += nb) hgrn_local_item(p, it, smem);
            for (int it = nb - 1 - bid; it < 512; it += nb) gmlp_item(p, it, smem);
            break;
    case PH_SCAN: hgrn_scan_phase(p); break;
    case PH_HOUT: for (int it = bid; it < 1024; it += nb) hgrn_out_item(p, it, smem); break;
    case PH_OUTPROJ0: case PH_OUTPROJ1: {
        const bool l1 = (ph == PH_OUTPROJ1);
        gemm2_phase((const bf16_t*)(ws + (l1 ? OFF_MIX1 : OFF_MIX0)), 1024, (const bf16_t*)(ws + (l1 ? OFF_W_OUT1T : OFF_W_OUT0T)), 128, 4, 1024, nullptr, 0,
                    Epi2Resid{(bf16_t*)(ws + OFF_XB), (float*)(ws + OFF_SSQ16), dup ? 0.f : (l1 ? ALPHA_M1 : ALPHA_M0), nullptr, 0, 0, nullptr, nullptr}, smem, pl);
    } break;
    case PH_Q0: case PH_Q1: {
        const bool l1 = (ph == PH_Q1);
        gemm2_phase((const bf16_t*)(ws + OFF_XB), 1024, (const bf16_t*)(ws + (l1 ? OFF_W_Q1T : OFF_W_Q0T)), 128, 8, 1024, (const float*)(ws + OFF_SSQ16), 16,
                    Epi2Bf16{dup ? (bf16_t*)nullptr : (bf16_t*)(ws + OFF_QP), 2048, 2048, nullptr, nullptr}, smem, pl);
    } break;
    case PH_TOPK0: case PH_TOPK1: peer_topk_phase(p, (const bf16_t*)(ws + (ph == PH_TOPK1 ? OFF_SK1 : OFF_SK0)), bid, nb, smem); break;
    case PH_PD0: case PH_PD1: peer_down_phase(p, (ph == PH_PD1) ? p.l1_norm_ffn : p.l0_norm_ffn, ((ph == PH_PD1) ? 16 : 0) + (dup ? 32 : 0), myslice, smem); break;
    case PH_PR0: case PH_PR1: peer_reduce_phase(p); break;
    case PH_PU0: case PH_PU1: peer_up_phase(p, ((ph == PH_PU1) ? 24 : 8) + (dup ? 32 : 0), myslice, dup ? 0.f : ((ph == PH_PU1) ? ALPHA_P1 : ALPHA_P0), (ph == PH_PU1 && !dup) ? p.out : nullptr, smem); break;
    case PH_INPROJ1: gemm2_phase((const bf16_t*)(ws + OFF_XB), 1024, (const bf16_t*)(ws + OFF_W_IN1T), 128, 8, 1024, (const float*)(ws + OFF_SSQ8), 8, Epi2Bf16{(bf16_t*)(ws + OFF_Z1), 1984, 1984, (float*)(ws + OFF_SSQCQ), (float*)(ws + OFF_SSQCKV)}, smem, pl);
            for (int it = bid; it < 8192; it += nb) conv_experts(p.l1_exp_down, p.l1_exp_up, p.l1_norm_ffn, ws, it);
            break;
    case PH_SMALL: {
        gemm2_phase((const bf16_t*)(ws + OFF_Z1), 1984, (const bf16_t*)(ws + OFF_W_UQT), 128, 3, 256, (const float*)(ws + OFF_SSQCQ), 1, Epi2Bf16{(bf16_t*)(ws + OFF_QC), 768, 768, nullptr, nullptr}, smem, pl);
        gemm2_phase((const bf16_t*)(ws + OFF_Z1) + 256, 1984, (const bf16_t*)(ws + OFF_W_UKVT), 128, 4, 128, (const float*)(ws + OFF_SSQCKV), 1, Epi2Bf16{(bf16_t*)(ws + OFF_KV), 1024, 1024, nullptr, nullptr}, smem, pl);
        for (int it = (bid + nb / 2) % nb; it < 1024 + 256; it += nb) { if (it < 1024) moba_prep_item(p, it, smem); else moba_kmean_item(p, it - 1024, smem); }
    } break;
    case PH_MLAPREP: for (int it = bid; it < 1024; it += nb) mla_prep_item(p, it, smem); break;
    case PH_MLA: attn_phase_all(p, smem); break;
    default: break;
    }
}

extern "C" __global__ void __launch_bounds__(NTHREADS, 2) fwd_kernel(Params p) {
    extern __shared__ __attribute__((aligned(16))) char smem[];
    __shared__ uint4 xb_words;
    XcdBarrier xb; xb.bar = nullptr; xb.x = 0; xb.st = (volatile LAS unsigned*)&xb_words;
    if (p.coop) {
        if (threadIdx.x == 0) xb_words = make_uint4(0u, 0u, 0u, 0u);
        __syncthreads();
        xb = xcd_barrier_post((unsigned*)(p.ws + OFF_BAR), (volatile LAS unsigned*)&xb_words);
    }
    if (p.coop == 2) cg::this_grid().sync();
    long long tp0 = 0, tp1 = 0;
#define RUN_PH(PH) if (p.ph_lo <= PH && PH < p.ph_hi) { \
        Placement pl_; pl_.xcc = p.coop ? (int)xb.st[3] : 0; pl_.rank = p.coop ? (int)xb.st[2] : 0; pl_.nloc = p.coop ? (int)xb.st[0] : 0; pl_.nx = p.coop ? (int)xb.st[1] : 0; \
        if (PROBE_DUP == PH) { run_phase(p, PH + 100, smem, pl_); if (p.coop) xcd_barrier(xb); } \
        if (PROBE_TIME == PH) tp0 = wall_clock64(); \
        run_phase(p, PH, smem, pl_); if (p.coop && PH + 1 < p.ph_hi) xcd_barrier(xb); \
        if (PROBE_TIME == PH) tp1 = wall_clock64(); }
    RUN_PH(0) RUN_PH(1) RUN_PH(2) RUN_PH(3) RUN_PH(4) RUN_PH(5) RUN_PH(6) RUN_PH(7) RUN_PH(8) RUN_PH(9)
    RUN_PH(10) RUN_PH(11) RUN_PH(12) RUN_PH(13) RUN_PH(14) RUN_PH(15) RUN_PH(16) RUN_PH(17) RUN_PH(18) RUN_PH(19) RUN_PH(20)
    if (PROBE_TIME >= 0) { const long long te = wall_clock64(), dt = (tp1 - tp0) * PROBE_TIME_K; while (wall_clock64() - te < dt) __builtin_amdgcn_s_sleep(20); }
}

extern "C" void kernel_launch(void* const* d_in, const int* in_sizes, int n_in, void* d_out, int out_size, void* d_ws, size_t ws_size, hipStream_t stream) {
    static int grid = 0;
    if (grid == 0) {
        if (n_in != 31 || out_size != 16384 * 1024 || ws_size < WS_NEED) { fprintf(stderr, "kernel_launch: unexpected shapes (n_in %d out %d ws %zu need %zu)\n", n_in, out_size, ws_size, (size_t)WS_NEED); grid = -1; return; }
        int dev = 0, cus = 0, per_cu = 0;
        hipGetDevice(&dev);
        hipDeviceGetAttribute(&cus, hipDeviceAttributeMultiprocessorCount, dev);
        if (hipFuncSetAttribute((const void*)fwd_kernel, hipFuncAttributeMaxDynamicSharedMemorySize, LDS_BYTES) != hipSuccess) { fprintf(stderr, "kernel_launch: hipFuncSetAttribute failed\n"); grid = -1; return; }
        if (hipOccupancyMaxActiveBlocksPerMultiprocessor(&per_cu, (const void*)fwd_kernel, NTHREADS, LDS_BYTES) != hipSuccess || per_cu < 1) { fprintf(stderr, "kernel_launch: occupancy query failed (%d)\n", per_cu); per_cu = 1; }
        (void)hipGetLastError();
        if (per_cu > 2) per_cu = 2;
        grid = cus * per_cu;
        fprintf(stderr, "kernel_launch: grid %d (%d CUs x %d)\n", grid, cus, per_cu);
    }
    if (grid < 0) return;
    Params p; memset(&p, 0, sizeof(p));
    const float* const* f = (const float* const*)d_in;
    p.x = f[0]; p.pos = (const int*)d_in[1]; p.lb_logits = f[2];
    p.l0_norm_mix = f[3]; p.l0_w_in = f[4]; p.l0_hgrn_out_norm = f[5]; p.l0_gmlp_v_norm = f[6]; p.l0_gmlp_w_s = f[7]; p.l0_gmlp_b_s = f[8]; p.l0_w_out = f[9];
    p.l0_norm_ffn = f[10]; p.l0_w_query = f[11]; p.l0_sub_keys = f[12]; p.l0_exp_down = f[13]; p.l0_exp_up = f[14];
    p.l1_norm_mix = f[15]; p.l1_w_in = f[16]; p.l1_cq_norm = f[17]; p.l1_ckv_norm = f[18]; p.l1_w_uq = f[19]; p.l1_w_ukv = f[20];
    p.l1_q_norm = f[21]; p.l1_k_norm = f[22]; p.l1_mq_norm = f[23]; p.l1_mk_norm = f[24]; p.l1_w_out = f[25];
    p.l1_norm_ffn = f[26]; p.l1_w_query = f[27]; p.l1_sub_keys = f[28]; p.l1_exp_down = f[29]; p.l1_exp_up = f[30];
    p.out = (float*)d_out; p.ws = (char*)d_ws;
    if (hipMemsetAsync((char*)d_ws + OFF_BAR, 0, 16384 + 4096, stream) != hipSuccess) { fprintf(stderr, "kernel_launch: memset failed\n"); return; }
#if N_LAUNCH_MODE == 1
    p.ph_lo = 0; p.ph_hi = N_PHASES; p.coop = 1;
    void* args[] = {&p};
    hipError_t e = hipLaunchCooperativeKernel((const void*)fwd_kernel, dim3(grid), dim3(NTHREADS), args, LDS_BYTES, stream);
    if (e != hipSuccess) fprintf(stderr, "cooperative launch failed: %s (grid %d)\n", hipGetErrorString(e), grid);
#else
    for (int ph = 0; ph < N_PHASES; ++ph) {
#ifdef ABLATE_M1
        if (ph >= 10 && ph <= 14) continue;
#endif
        p.ph_lo = ph; p.ph_hi = ph + 1; p.coop = 0;
        hipLaunchKernelGGL(fwd_kernel, dim3(grid), dim3(NTHREADS), LDS_BYTES, stream, p);
    }
#endif
}
```

```cpp
#include <hip/hip_runtime.h>
#include <hip/hip_cooperative_groups.h>
#include <stdint.h>
#include <stdio.h>
#include <string.h>
namespace cg = cooperative_groups;

#ifndef ALPHA_P0
#define ALPHA_P0 1.0f
#endif
#ifndef ALPHA_P1
#define ALPHA_P1 1.0f
#endif
#ifndef ALPHA_M0
#define ALPHA_M0 1.0f
#endif
#ifndef ALPHA_M1
#define ALPHA_M1 1.0f
#endif
#define PROBE_TIME -1
#define PROBE_GEMM 0
#define PROBE_TIME_K 4
#ifndef PROBE_NOMMA
#define PROBE_NOMMA 0
#endif
#ifndef PROBE_DUP
#define PROBE_DUP -1
#endif
#ifndef N_LAUNCH_MODE
#define N_LAUNCH_MODE 1
#endif

typedef unsigned short bf16_t;
using bf16x8 = __attribute__((ext_vector_type(8))) short;
using f32x4  = __attribute__((ext_vector_type(4))) float;
using f32x16 = __attribute__((ext_vector_type(16))) float;
typedef float f32x4v __attribute__((ext_vector_type(4)));
typedef float f32x2_t __attribute__((ext_vector_type(2)));
typedef __bf16 bf16x2_t __attribute__((ext_vector_type(2)));
typedef unsigned u32x4 __attribute__((ext_vector_type(4)));

#define DEVI __device__ __forceinline__
#define NTHREADS 256
#define LDS_BYTES 80896

static constexpr size_t MB = 1024 * 1024;
static constexpr size_t OFF_W_IN0T  = 0;
static constexpr size_t OFF_W_OUT0T = OFF_W_IN0T  + 3072ull * 1024 * 2;
static constexpr size_t OFF_W_Q0T   = OFF_W_OUT0T + 1024ull * 1024 * 2;
static constexpr size_t OFF_SK0     = OFF_W_Q0T   + 2048ull * 1024 * 2;
static constexpr size_t OFF_WS0     = OFF_SK0     + 262144ull * 2;
static constexpr size_t OFF_W_IN1T  = OFF_WS0     + 65536ull * 2;
static constexpr size_t OFF_W_UQT   = OFF_W_IN1T  + 2048ull * 1024 * 2;
static constexpr size_t OFF_W_UKVT  = OFF_W_UQT   + 768ull * 256 * 2;
static constexpr size_t OFF_W_OUT1T = OFF_W_UKVT  + 1024ull * 128 * 2;
static constexpr size_t OFF_W_Q1T   = OFF_W_OUT1T + 1024ull * 1024 * 2;
static constexpr size_t OFF_SK1     = OFF_W_Q1T   + 2048ull * 1024 * 2;
static constexpr size_t OFF_LB      = OFF_SK1     + 262144ull * 2;
static constexpr size_t OFF_INVD    = OFF_LB + 4096;
static constexpr size_t OFF_INVU    = OFF_INVD + 65536;
static constexpr size_t OFF_BAR     = OFF_INVU + 65536;
static constexpr size_t OFF_QCNT    = OFF_BAR + 14336;
static constexpr size_t OFF_ED      = 26 * MB;
static constexpr size_t OFF_EU      = OFF_ED + 32 * MB;
static constexpr size_t OFF_ACT     = OFF_EU + 32 * MB;
static constexpr size_t OFF_Z0   = OFF_ACT;
static constexpr size_t OFF_G    = OFF_Z0  + 16384ull * 3072 * 2;
static constexpr size_t OFF_HST  = OFF_G   + 16384ull * 512 * 4;
static constexpr size_t OFF_DEC  = OFF_HST + 1024ull * 16384 * 4;
static constexpr size_t OFF_MIX0 = OFF_DEC + 1024ull * 128 * 4;
static constexpr size_t OFF_QP   = OFF_ACT;
static constexpr size_t OFF_IDX  = OFF_QP  + 16384ull * 2048 * 2;
static constexpr size_t OFF_GATE = OFF_IDX + 16384ull * 128 * 4;
static constexpr size_t OFF_ACTW = OFF_GATE + 16384ull * 128 * 4;
static constexpr size_t OFF_PART = OFF_QP;
static constexpr size_t OFF_SDN  = OFF_ACTW + 16384ull * 128 * 4;
static constexpr size_t OFF_UREC = OFF_SDN + 16384ull * 128 * 4;
static constexpr size_t OFF_Z1   = OFF_ACT;
static constexpr size_t OFF_MIX1 = OFF_ACT;
static constexpr size_t OFF_QC   = OFF_Z1  + 16384ull * 1984 * 2;
static constexpr size_t OFF_KV   = OFF_QC  + 16384ull * 768 * 2;
static constexpr size_t OFF_QD   = OFF_KV  + 16384ull * 1024 * 2;
static constexpr size_t OFF_KD   = OFF_QD  + 16384ull * 512 * 2;
static constexpr size_t OFF_VDT  = OFF_KD  + 16384ull * 512 * 2;
static constexpr size_t OFF_Q    = OFF_VDT + 16384ull * 512 * 2;
static constexpr size_t OFF_K    = OFF_Q   + 16384ull * 768 * 2;
static constexpr size_t OFF_VT   = OFF_K   + 16384ull * 768 * 2;
static constexpr size_t OFF_KMEAN= OFF_VT  + 16384ull * 512 * 2;
static constexpr size_t WS_END_L1 = OFF_KMEAN + 8ull * 32 * 128 * 4;
static constexpr size_t WS_END_L0 = OFF_MIX0 + 16384ull * 1024 * 2;
static constexpr size_t WS_END_ACT = (WS_END_L1 > WS_END_L0 ? WS_END_L1 : WS_END_L0);
static constexpr size_t OFF_XB    = (WS_END_ACT + 255) / 256 * 256;
static constexpr size_t OFF_SSQ1  = OFF_XB + 16384ull * 1024 * 2;
static constexpr size_t OFF_SSQ16 = OFF_SSQ1 + 16384ull * 4;
static constexpr size_t OFF_SSQ8  = OFF_SSQ16 + 16384ull * 16 * 4;
static constexpr size_t OFF_XB8   = OFF_ED + 16 * MB;
static constexpr size_t OFF_SSQCQ = OFF_SSQ8 + 16384ull * 8 * 4;
static constexpr size_t OFF_SSQCKV = OFF_SSQCQ + 16384ull * 4;
static constexpr size_t WS_NEED = OFF_SSQCKV + 16384ull * 4;
static_assert(OFF_BAR + 16384 + 4096 <= OFF_ED, "weights overflow");

struct Params {
    const float* x; const int* pos; const float* lb_logits;
    const float *l0_norm_mix, *l0_w_in, *l0_hgrn_out_norm, *l0_gmlp_v_norm, *l0_gmlp_w_s, *l0_gmlp_b_s, *l0_w_out,
                *l0_norm_ffn, *l0_w_query, *l0_sub_keys, *l0_exp_down, *l0_exp_up;
    const float *l1_norm_mix, *l1_w_in, *l1_cq_norm, *l1_ckv_norm, *l1_w_uq, *l1_w_ukv, *l1_q_norm, *l1_k_norm,
                *l1_mq_norm, *l1_mk_norm, *l1_w_out, *l1_norm_ffn, *l1_w_query, *l1_sub_keys, *l1_exp_down, *l1_exp_up;
    float* out;
    char* ws;
    int ph_lo, ph_hi, coop, pad0;
};

DEVI unsigned pack2(float lo, float hi) { f32x2_t v = {lo, hi}; bf16x2_t b = __builtin_convertvector(v, bf16x2_t); return __builtin_bit_cast(unsigned, b); }
DEVI bf16_t f2bf(float f) { return (bf16_t)(pack2(f, 0.f) & 0xffffu); }
DEVI float bf2f(bf16_t h) { return __uint_as_float(((unsigned)h) << 16); }
DEVI float bflo(unsigned u) { return __uint_as_float(u << 16); }
DEVI float bfhi(unsigned u) { return __uint_as_float(u & 0xffff0000u); }
#define DPP_F(V, CTRL) __builtin_bit_cast(float, __builtin_amdgcn_update_dpp(0, __builtin_bit_cast(int, (V)), (CTRL), 0xF, 0xF, true))
DEVI float wave_sum_dpp(float v) {
    v += DPP_F(v, 0xB1);
    v += DPP_F(v, 0x4E);
    v += DPP_F(v, 0x141);
    v += DPP_F(v, 0x140);
    return __builtin_bit_cast(float, __builtin_amdgcn_readlane(__builtin_bit_cast(int, v), 0)) + __builtin_bit_cast(float, __builtin_amdgcn_readlane(__builtin_bit_cast(int, v), 16))
         + __builtin_bit_cast(float, __builtin_amdgcn_readlane(__builtin_bit_cast(int, v), 32)) + __builtin_bit_cast(float, __builtin_amdgcn_readlane(__builtin_bit_cast(int, v), 48));
}
DEVI float wave_max_dpp(float v) {
    v = fmaxf(v, DPP_F(v, 0xB1)); v = fmaxf(v, DPP_F(v, 0x4E)); v = fmaxf(v, DPP_F(v, 0x141)); v = fmaxf(v, DPP_F(v, 0x140));
    return fmaxf(fmaxf(__builtin_bit_cast(float, __builtin_amdgcn_readlane(__builtin_bit_cast(int, v), 0)), __builtin_bit_cast(float, __builtin_amdgcn_readlane(__builtin_bit_cast(int, v), 16))),
                 fmaxf(__builtin_bit_cast(float, __builtin_amdgcn_readlane(__builtin_bit_cast(int, v), 32)), __builtin_bit_cast(float, __builtin_amdgcn_readlane(__builtin_bit_cast(int, v), 48))));
}
DEVI float sigm(float x) { return 1.f / (1.f + __expf(-x)); }
DEVI float gelu_tanh(float x) {
    float y = 0.7978845608028654f * (x + 0.044715f * x * x * x);
    float e = __expf(2.f * y);
    float t = 1.f - 2.f / (1.f + e);
    return 0.5f * x * (1.f + t);
}
DEVI char* opaque_ptr(char* q) { asm volatile("" : "+s"(q)); return q; }
DEVI f32x4  mfma16(bf16x8 a, bf16x8 b, f32x4 c)  { return __builtin_amdgcn_mfma_f32_16x16x32_bf16(a, b, c, 0, 0, 0); }
DEVI f32x16 mfma32(bf16x8 a, bf16x8 b, f32x16 c) { return __builtin_amdgcn_mfma_f32_32x32x16_bf16(a, b, c, 0, 0, 0); }

template <int KW> DEVI int swz_off(int row, int c) {
    if constexpr (KW == 128) return row * 256 + ((c ^ (row & 15)) << 4);
    else return row * (KW * 2) + ((c ^ ((row >> 1) & 7)) << 4);
}
template <int KW> DEVI int swz_elem(int row, int k) { return swz_off<KW>(row, k >> 3) + ((k & 7) << 1); }

template <int MT, int NT, int KWA, int KWB>
DEVI void mma_nt(f32x4 (&acc)[MT][NT], const char* A, int a_row0, const char* B, int b_row0, int kc0, int nks, int lane) {
    const int r = lane & 15, q = lane >> 4;
#pragma unroll 1
    for (int ks = 0; ks < nks; ++ks) {
        bf16x8 a[MT], b[NT];
#pragma unroll
        for (int i = 0; i < MT; ++i) a[i] = *(const bf16x8*)(A + swz_off<KWA>(a_row0 + 16 * i + r, kc0 + ks * 4 + q));
#pragma unroll
        for (int j = 0; j < NT; ++j) b[j] = *(const bf16x8*)(B + swz_off<KWB>(b_row0 + 16 * j + r, kc0 + ks * 4 + q));
#pragma unroll
        for (int i = 0; i < MT; ++i)
#pragma unroll
            for (int j = 0; j < NT; ++j) acc[i][j] = mfma16(a[i], b[j], acc[i][j]);
    }
}

DEVI void conv_transpose_tile(const float* __restrict__ src, int K, int N, bf16_t* __restrict__ dst, int kt, int nt, char* smem, const float* __restrict__ kgain = nullptr) {
    float* s = (float*)smem;
    const int tid = threadIdx.x;
    for (int e = tid; e < 4096; e += NTHREADS) {
        int kk = e >> 6, nn = e & 63;
        int n = nt * 64 + nn;
        const float gk = kgain ? kgain[kt * 64 + kk] : 1.f;
        s[kk * 65 + nn] = (n < N) ? src[(size_t)(kt * 64 + kk) * N + n] * gk : 0.f;
    }
    __syncthreads();
    for (int e = tid; e < 2048; e += NTHREADS) {
        int nn = e >> 5, kp = e & 31;
        unsigned v = pack2(s[(2 * kp) * 65 + nn], s[(2 * kp + 1) * 65 + nn]);
        *(unsigned*)(dst + (size_t)(nt * 64 + nn) * K + kt * 64 + 2 * kp) = v;
    }
    __syncthreads();
}
DEVI void conv_plain_chunk(const float* __restrict__ src, bf16_t* __restrict__ dst, size_t chunk) {
    const int tid = threadIdx.x;
    size_t base = chunk * 4096 + (size_t)tid * 16;
    const float4* s4 = (const float4*)(src + base);
    float4 a = s4[0], b = s4[1], c = s4[2], d = s4[3];
    uint4 o0, o1;
    o0.x = pack2(a.x, a.y); o0.y = pack2(a.z, a.w); o0.z = pack2(b.x, b.y); o0.w = pack2(b.z, b.w);
    o1.x = pack2(c.x, c.y); o1.y = pack2(c.z, c.w); o1.z = pack2(d.x, d.y); o1.w = pack2(d.z, d.w);
    uint4* d4 = (uint4*)(dst + base);
    d4[0] = o0; d4[1] = o1;
}
DEVI void conv_experts(const float* down, const float* up, const float* __restrict__ dgain, char* ws, int it  ) {
    const int lane = threadIdx.x & 63, wave = threadIdx.x >> 6;
    const bool isup = it >= 4096;
    const int row = (isup ? it - 4096 : it) * 4 + wave;
    const float* src = (isup ? up : down) + (size_t)row * 1024 + 16 * lane;
    float4 a = *(const float4*)src, b = *(const float4*)(src + 4), c = *(const float4*)(src + 8), d = *(const float4*)(src + 12);
    if (!isup) {
        const float4 ga = *(const float4*)(dgain + 16 * lane), gb = *(const float4*)(dgain + 16 * lane + 4), gc = *(const float4*)(dgain + 16 * lane + 8), gd = *(const float4*)(dgain + 16 * lane + 12);
        a.x *= ga.x; a.y *= ga.y; a.z *= ga.z; a.w *= ga.w; b.x *= gb.x; b.y *= gb.y; b.z *= gb.z; b.w *= gb.w;
        c.x *= gc.x; c.y *= gc.y; c.z *= gc.z; c.w *= gc.w; d.x *= gd.x; d.y *= gd.y; d.z *= gd.z; d.w *= gd.w;
    }
    float mx = fmaxf(fmaxf(fmaxf(fabsf(a.x), fabsf(a.y)), fmaxf(fabsf(a.z), fabsf(a.w))), fmaxf(fmaxf(fabsf(b.x), fabsf(b.y)), fmaxf(fabsf(b.z), fabsf(b.w))));
    mx = fmaxf(mx, fmaxf(fmaxf(fmaxf(fabsf(c.x), fabsf(c.y)), fmaxf(fabsf(c.z), fabsf(c.w))), fmaxf(fmaxf(fabsf(d.x), fabsf(d.y)), fmaxf(fabsf(d.z), fabsf(d.w)))));
    mx = wave_max_dpp(mx);
    const float sc = (mx > 0.f) ? 416.f / mx : 1.f;
    const float inv = (mx > 0.f) ? mx / 416.f : 1.f;
    int w0 = 0, w1 = 0, w2 = 0, w3 = 0;
    w0 = __builtin_amdgcn_cvt_pk_fp8_f32(a.x * sc, a.y * sc, w0, false); w0 = __builtin_amdgcn_cvt_pk_fp8_f32(a.z * sc, a.w * sc, w0, true);
    w1 = __builtin_amdgcn_cvt_pk_fp8_f32(b.x * sc, b.y * sc, w1, false); w1 = __builtin_amdgcn_cvt_pk_fp8_f32(b.z * sc, b.w * sc, w1, true);
    w2 = __builtin_amdgcn_cvt_pk_fp8_f32(c.x * sc, c.y * sc, w2, false); w2 = __builtin_amdgcn_cvt_pk_fp8_f32(c.z * sc, c.w * sc, w2, true);
    w3 = __builtin_amdgcn_cvt_pk_fp8_f32(d.x * sc, d.y * sc, w3, false); w3 = __builtin_amdgcn_cvt_pk_fp8_f32(d.z * sc, d.w * sc, w3, true);
    *(int4*)(ws + (isup ? OFF_EU : OFF_ED) + ((size_t)(lane >> 3) * 16384 + row) * 128 + 16 * (lane & 7)) = int4{w0, w1, w2, w3};
    if (lane == 0) ((float*)(ws + (isup ? OFF_INVU : OFF_INVD)))[row] = inv;
}

DEVI void phase_convert(const Params& p, char* smem) {
    char* ws = p.ws;
    const int bid = blockIdx.x, nb = gridDim.x;
    for (int t = bid; t < 768; t += nb) conv_transpose_tile(p.l0_w_in,    1024, 3072, (bf16_t*)(ws + OFF_W_IN0T),  t / 48, t % 48, smem, p.l0_norm_mix);
    for (int t = (bid + nb - 256 % nb) % nb; t < 256; t += nb) conv_transpose_tile(p.l0_w_out,   1024, 1024, (bf16_t*)(ws + OFF_W_OUT0T), t / 16, t % 16, smem);
    for (int t = bid; t < 512; t += nb) conv_transpose_tile(p.l0_w_query, 1024, 2048, (bf16_t*)(ws + OFF_W_Q0T),   t / 32, t % 32, smem, p.l0_norm_ffn);
    for (int t = bid; t < 512; t += nb) conv_transpose_tile(p.l1_w_in,    1024, 1984, (bf16_t*)(ws + OFF_W_IN1T),  t / 32, t % 32, smem, p.l1_norm_mix);
    for (int t = bid; t < 48; t += nb)  conv_transpose_tile(p.l1_w_uq,     256,  768, (bf16_t*)(ws + OFF_W_UQT),   t / 12, t % 12, smem, p.l1_cq_norm);
    for (int t = nb - 1 - bid; t < 32; t += nb)  conv_transpose_tile(p.l1_w_ukv,    128, 1024, (bf16_t*)(ws + OFF_W_UKVT),  t / 16, t % 16, smem, p.l1_ckv_norm);
    for (int t = (bid + nb - 256 % nb) % nb; t < 256; t += nb) conv_transpose_tile(p.l1_w_out,   1024, 1024, (bf16_t*)(ws + OFF_W_OUT1T), t / 16, t % 16, smem);
    for (int t = bid; t < 512; t += nb) conv_transpose_tile(p.l1_w_query, 1024, 2048, (bf16_t*)(ws + OFF_W_Q1T),   t / 32, t % 32, smem, p.l1_norm_ffn);
    for (int t = bid - 64; t < 64; t += nb) if (t >= 0) conv_plain_chunk(p.l0_sub_keys, (bf16_t*)(ws + OFF_SK0), t);
    for (int t = bid - 128; t < 64; t += nb) if (t >= 0) conv_plain_chunk(p.l1_sub_keys, (bf16_t*)(ws + OFF_SK1), t);
    for (int chunk = bid - 192; chunk < 16; chunk += nb) if (chunk >= 0) {
        bf16_t* dst = (bf16_t*)(ws + OFF_WS0);
        for (int e = threadIdx.x; e < 4096; e += NTHREADS) {
            int idx = chunk * 4096 + e; int t = (idx >> 7) & 127, sI = idx & 127;
            dst[idx] = f2bf(sI <= t ? p.l0_gmlp_w_s[idx] : 0.f);
        }
    }
    if (bid == nb - 1) {
        float* lb = (float*)(ws + OFF_LB);
        for (int c = threadIdx.x; c < 512; c += NTHREADS) {
            float a0 = p.lb_logits[c], a1 = p.lb_logits[512 + c], a2 = p.lb_logits[1024 + c];
            float m = fmaxf(a0, fmaxf(a1, a2));
            float e0 = __expf(a0 - m), e1 = __expf(a1 - m), e2 = __expf(a2 - m);
            lb[c] = e0 / (e0 + e1 + e2);
        }
    }
    for (int it = bid; it < 8192; it += nb) conv_experts(p.l0_exp_down, p.l0_exp_up, p.l0_norm_ffn, ws, it);
    {
        const int lane = threadIdx.x & 63, wave = threadIdx.x >> 6;
        for (int it = bid; it < 4096; it += nb) {
            const size_t row = (size_t)it * 4 + wave;
            const float* xr = p.x + row * 1024 + 16 * lane;
            const float4 a = *(const float4*)xr, b = *(const float4*)(xr + 4), c = *(const float4*)(xr + 8), d = *(const float4*)(xr + 12);
            float ss = a.x * a.x + a.y * a.y + a.z * a.z + a.w * a.w + b.x * b.x + b.y * b.y + b.z * b.z + b.w * b.w
                     + c.x * c.x + c.y * c.y + c.z * c.z + c.w * c.w + d.x * d.x + d.y * d.y + d.z * d.z + d.w * d.w;
            ss = wave_sum_dpp(ss);
            uint4 o0, o1;
            o0.x = pack2(a.x, a.y); o0.y = pack2(a.z, a.w); o0.z = pack2(b.x, b.y); o0.w = pack2(b.z, b.w);
            o1.x = pack2(c.x, c.y); o1.y = pack2(c.z, c.w); o1.z = pack2(d.x, d.y); o1.w = pack2(d.z, d.w);
            bf16_t* xb = (bf16_t*)(ws + OFF_XB) + row * 1024 + 16 * lane;
            *(uint4*)xb = o0; *(uint4*)(xb + 8) = o1;
            if (lane == 0) ((float*)(ws + OFF_SSQ1))[row] = ss;
        }
    }
}

template <int AMODE, class Epi>
DEVI void gemm_phase(const void* __restrict__ Aptr, int lda, const float* __restrict__ gain, const bf16_t* __restrict__ Bt,
                           int M, int Npad, int K, Epi epi, char* smem, int blk0, int nblk) {
    const int tid = threadIdx.x, lane = tid & 63, wave = tid >> 6;
    const int wm = wave >> 1, wn = wave & 1;
    const int tn = Npad / 128, tm = M / 128, nkt = K / 64;
    float* sRstd = (float*)(smem + 65536);
    const int crow = tid >> 3, cc = tid & 7;
    for (int tile = blk0; tile < tm * tn; tile += nblk) {
        const int m0 = (tile / tn) * 128, n0 = (tile % tn) * 128;
        f32x4 acc[4][4];
#pragma unroll
        for (int i = 0; i < 4; ++i)
#pragma unroll
            for (int j = 0; j < 4; ++j) acc[i][j] = f32x4{0.f, 0.f, 0.f, 0.f};
        float ss[4] = {0.f, 0.f, 0.f, 0.f};
        f32x4v ra[4][2]; u32x4 rab[4]; u32x4 rb[4]; f32x4v g0, g1;
        auto gload = [&](int kt) {
            const int k0 = kt * 64 + cc * 8;
#pragma unroll
            for (int i = 0; i < 4; ++i) {
                const int row = crow + 32 * i;
                if constexpr (AMODE == 0) {
                    const float* pa = (const float*)Aptr + (size_t)(m0 + row) * lda + k0;
                    ra[i][0] = *(const f32x4v*)pa; ra[i][1] = *(const f32x4v*)(pa + 4);
                } else {
                    const bf16_t* pa = (const bf16_t*)Aptr + (size_t)(m0 + row) * lda + k0;
                    rab[i] = *(const u32x4*)pa;
                }
                rb[i] = *(const u32x4*)(Bt + (size_t)(n0 + row) * K + k0);
            }
            if constexpr (AMODE != 1) { g0 = *(const f32x4v*)(gain + k0); g1 = *(const f32x4v*)(gain + k0 + 4); }
        };
        auto lstore = [&](int buf) {
            char* sA = smem + buf * 32768; char* sB = sA + 16384;
#pragma unroll
            for (int i = 0; i < 4; ++i) {
                const int row = crow + 32 * i;
                u32x4 o;
                if constexpr (AMODE == 0) {
                    f32x4v a = ra[i][0], b = ra[i][1];
                    ss[i] += a.x * a.x + a.y * a.y + a.z * a.z + a.w * a.w + b.x * b.x + b.y * b.y + b.z * b.z + b.w * b.w;
                    o.x = pack2(a.x * g0.x, a.y * g0.y); o.y = pack2(a.z * g0.z, a.w * g0.w);
                    o.z = pack2(b.x * g1.x, b.y * g1.y); o.w = pack2(b.z * g1.z, b.w * g1.w);
                } else if constexpr (AMODE == 2) {
                    u32x4 u = rab[i];
                    float a0 = bflo(u.x), a1 = bfhi(u.x), a2 = bflo(u.y), a3 = bfhi(u.y), a4 = bflo(u.z), a5 = bfhi(u.z), a6 = bflo(u.w), a7 = bfhi(u.w);
                    ss[i] += a0 * a0 + a1 * a1 + a2 * a2 + a3 * a3 + a4 * a4 + a5 * a5 + a6 * a6 + a7 * a7;
                    o.x = pack2(a0 * g0.x, a1 * g0.y); o.y = pack2(a2 * g0.z, a3 * g0.w);
                    o.z = pack2(a4 * g1.x, a5 * g1.y); o.w = pack2(a6 * g1.z, a7 * g1.w);
                } else o = rab[i];
                *(u32x4*)(sA + swz_off<64>(row, cc)) = o;
                *(u32x4*)(sB + swz_off<64>(row, cc)) = rb[i];
            }
        };
        gload(0); lstore(0); __syncthreads();
#pragma unroll 1
        for (int kt = 0; kt < nkt; ++kt) {
            if (kt + 1 < nkt) gload(kt + 1);
            const char* sA = smem + (kt & 1) * 32768; const char* sB = sA + 16384;
            mma_nt<4, 4, 64, 64>(acc, sA, wm * 64, sB, wn * 64, 0, 2, lane);
            if (kt + 1 < nkt) lstore((kt + 1) & 1);
            __syncthreads();
        }
        if constexpr (AMODE != 1) {
#pragma unroll
            for (int i = 0; i < 4; ++i) {
                float s = ss[i];
                s += __shfl_xor(s, 1); s += __shfl_xor(s, 2); s += __shfl_xor(s, 4);
                if (cc == 0) sRstd[crow + 32 * i] = rsqrtf(s / (float)K + 1e-6f);
            }
            __syncthreads();
        }
#pragma unroll
        for (int i = 0; i < 4; ++i)
#pragma unroll
            for (int r = 0; r < 4; ++r) {
                const int rl = wm * 64 + i * 16 + (lane >> 4) * 4 + r;
                const float rs = (AMODE != 1) ? sRstd[rl] : 1.f;
#pragma unroll
                for (int j = 0; j < 4; ++j) epi(m0 + rl, n0 + wn * 64 + j * 16 + (lane & 15), acc[i][j][r] * rs);
                __builtin_amdgcn_sched_barrier(0);
            }
    }
}

struct Placement { int xcc, rank, nloc, nx; };
#define G2_RAW_BARRIER() do { asm volatile("s_waitcnt lgkmcnt(0)" ::: "memory"); __builtin_amdgcn_s_barrier(); } while (0)
template <class Epi>
DEVI void gemm2_phase(const bf16_t* __restrict__ A, int lda, const bf16_t* __restrict__ Bt, int tm, int tn, int K,
                      const float* __restrict__ ssq, int nss, Epi epi, char* smem, Placement pl) {
    const int tid = threadIdx.x, lane = tid & 63;
    const int wave = __builtin_amdgcn_readfirstlane(tid >> 6);
    const int wm = wave >> 1, wn = wave & 1;
    const int nkt = K / 32;
    constexpr int STG = 24576;
    float* sRstd = (float*)(smem + 3 * STG);
    int xcd = blockIdx.x & 7, slot = blockIdx.x >> 3, nslots = gridDim.x >> 3, nxc = 8;
    if (pl.nloc > 0) { xcd = pl.xcc; slot = pl.rank; nslots = pl.nloc; nxc = pl.nx; }
    const int np = (tm + nxc - 1) / nxc;
    const int per_xcd = ((np + 7) >> 3) * tn * 8;
    const int Rl = (lane >> 4) & 3, gl = (((Rl ^ (Rl >> 1)) & 1) << 1) | (Rl >> 1);
    const int Rr = (lane >> 2) & 3, gr = (((Rr ^ (Rr >> 1)) & 1) << 1) | (Rr >> 1);
    const int ld_row = lane >> 2, ld_c = (lane & 3) ^ gl;
    const int rd_off = (lane & 15) * 64 + (((lane >> 4) ^ gr) << 4);
    for (int t = slot; t < per_xcd; t += nslots) {
        const int mi = t & 7, rest = t >> 3, nt_ = rest % tn, mg = rest / tn;
        const int pidx = mg * 8 + mi, panel = xcd + nxc * pidx;
        if (pidx >= np || panel >= tm) continue;
        const int m0 = panel * 128, n0 = nt_ * 256;
        if (ssq) { if (tid < 128) { float sacc = 0.f; for (int i = 0; i < nss; ++i) sacc += ssq[(size_t)(m0 + tid) * nss + i]; sRstd[tid] = rsqrtf(sacc / (float)K + 1e-6f); } }
        else if (tid < 128) sRstd[tid] = 1.f;
        const bf16_t* ga = A  + (size_t)(m0 + 32 * wave + ld_row) * lda + ld_c * 8;
        const bf16_t* gb = Bt + (size_t)(n0 + 64 * wave + ld_row) * K   + ld_c * 8;
        f32x4 acc[4][8];
#pragma unroll
        for (int i = 0; i < 4; ++i)
#pragma unroll
            for (int j = 0; j < 8; ++j) acc[i][j] = f32x4{0.f, 0.f, 0.f, 0.f};
#define G2_ISSUE(KT) { char* st_ = smem + ((KT) % 3) * STG; const int ko_ = (KT) * 32; \
            __builtin_amdgcn_global_load_lds((const unsigned*)(ga + ko_),                    (unsigned*)(st_ + wave * 2048),               16, 0, 0); \
            __builtin_amdgcn_global_load_lds((const unsigned*)(ga + (size_t)16 * lda + ko_), (unsigned*)(st_ + wave * 2048 + 1024),        16, 0, 0); \
            __builtin_amdgcn_global_load_lds((const unsigned*)(gb + ko_),                    (unsigned*)(st_ + 8192 + wave * 4096),        16, 0, 0); \
            __builtin_amdgcn_global_load_lds((const unsigned*)(gb + (size_t)16 * K + ko_),   (unsigned*)(st_ + 8192 + wave * 4096 + 1024), 16, 0, 0); \
            __builtin_amdgcn_global_load_lds((const unsigned*)(gb + (size_t)32 * K + ko_),   (unsigned*)(st_ + 8192 + wave * 4096 + 2048), 16, 0, 0); \
            __builtin_amdgcn_global_load_lds((const unsigned*)(gb + (size_t)48 * K + ko_),   (unsigned*)(st_ + 8192 + wave * 4096 + 3072), 16, 0, 0); }
        int nkt0 = nkt;
        const bool pr_dup = epi.D == nullptr && epi.N == 2048, pr_nodma = (PROBE_GEMM == 2) && pr_dup, pr_nomma = (PROBE_GEMM == 1) && pr_dup;
#define G2_RD_LO(KT, RA, RB) { const char* sA_ = smem + ((KT) % 3) * STG + rd_off; const char* sB_ = sA_ + 8192; \
            _Pragma("unroll") for (int i = 0; i < 4; ++i) RA[i] = *(const bf16x8*)(sA_ + (wm * 64 + 16 * i) * 64); \
            _Pragma("unroll") for (int j = 0; j < 4; ++j) RB[j] = *(const bf16x8*)(sB_ + (wn * 128 + 16 * j) * 64); }
#define G2_RD_HI(KT, RB) { const char* sB_ = smem + ((KT) % 3) * STG + rd_off + 8192; \
            _Pragma("unroll") for (int j = 0; j < 4; ++j) RB[j] = *(const bf16x8*)(sB_ + (wn * 128 + 64 + 16 * j) * 64); }
#define G2_MMA(RA, RB, J0) { _Pragma("unroll") for (int i = 0; i < 4; ++i) _Pragma("unroll") for (int j = 0; j < 4; ++j) acc[i][(J0) + j] = mfma16(RB[j], RA[i], acc[i][(J0) + j]); }
#define G2_STEP(KT, CA, CB, NA, NB) { \
            if ((KT) + 2 < nkt) asm volatile("s_waitcnt vmcnt(6)" ::: "memory"); else asm volatile("s_waitcnt vmcnt(0)" ::: "memory"); \
            __builtin_amdgcn_s_waitcnt(0xc07f); __builtin_amdgcn_s_barrier();        \
            G2_RD_HI(KT, bh) \
            __builtin_amdgcn_sched_barrier(0);        \
            if (!pr_nomma) G2_MMA(CA, CB, 0) \
            __builtin_amdgcn_sched_barrier(0); \
            G2_RD_LO((KT) + 1, NA, NB)        \
            __builtin_amdgcn_s_waitcnt(0xc87f);        \
            __builtin_amdgcn_sched_barrier(0); \
            if ((KT) + 3 < nkt && !pr_nodma) G2_ISSUE((KT) + 3)        \
            __builtin_amdgcn_sched_barrier(0); \
            if (!pr_nomma) G2_MMA(CA, bh, 4) \
            __builtin_amdgcn_sched_barrier(0); }
        bf16x8 a0[4], b0[4], a1[4], b1[4], bh[4];
        if ((PROBE_GEMM == 3) && pr_dup) {
#pragma unroll
            for (int i = 0; i < 4; ++i) { a0[i] = __builtin_bit_cast(bf16x8, u32x4{(unsigned)tid, 1u, 2u, 3u}); b0[i] = a0[i]; bh[i] = a0[i]; }
#pragma unroll 1
            for (int kt = 0; kt < nkt; ++kt) { G2_MMA(a0, b0, 0) G2_MMA(a0, bh, 4) __builtin_amdgcn_sched_barrier(0); }
            nkt0 = 0;
        }
        if (!pr_nodma) { G2_ISSUE(0) G2_ISSUE(1) if (2 < nkt) G2_ISSUE(2) }
        if (2 < nkt) asm volatile("s_waitcnt vmcnt(12)" ::: "memory"); else asm volatile("s_waitcnt vmcnt(6)" ::: "memory");
        G2_RAW_BARRIER();
        G2_RD_LO(0, a0, b0)
#pragma unroll 1
        for (int kt = 0; kt < nkt0; kt += 2) {
            G2_STEP(kt, a0, b0, a1, b1)
            G2_STEP(kt + 1, a1, b1, a0, b0)
        }
#undef G2_STEP
#undef G2_MMA
#undef G2_RD_LO
#undef G2_RD_HI
#undef G2_ISSUE
        if (epi.staged(n0)) {
            G2_RAW_BARRIER();
#pragma unroll
            for (int i = 0; i < 4; ++i) {
                const int rl = wm * 64 + i * 16 + (lane & 15);
                const float rs = sRstd[rl];
                char* trow = smem + rl * 528 + (wn * 128 + 4 * (lane >> 4)) * 2;
#pragma unroll
                for (int j = 0; j < 8; ++j) {
                    const int nc = n0 + wn * 128 + 16 * j + 4 * (lane >> 4);
                    *(uint2*)(trow + 32 * j) = uint2{pack2(epi.map(nc, acc[i][j][0] * rs), epi.map(nc + 1, acc[i][j][1] * rs)), pack2(epi.map(nc + 2, acc[i][j][2] * rs), epi.map(nc + 3, acc[i][j][3] * rs))};
                }
            }
            __syncthreads();
            float* const sqp = (n0 == 0) ? epi.SQ0 : ((n0 == 256) ? epi.SQ1 : nullptr);
#pragma unroll 4
            for (int i = 0; i < 16; ++i) {
                const int e = tid + 256 * i, row = e >> 5, cc = e & 31;
                const uint4 v = *(const uint4*)(smem + row * 528 + cc * 16);
                if (epi.D && n0 + cc * 8 < epi.N) *(uint4*)(epi.D + (size_t)(m0 + row) * epi.ldd + n0 + cc * 8) = v;
                if (sqp) {
                    float q = bflo(v.x) * bflo(v.x) + bfhi(v.x) * bfhi(v.x) + bflo(v.y) * bflo(v.y) + bfhi(v.y) * bfhi(v.y)
                            + bflo(v.z) * bflo(v.z) + bfhi(v.z) * bfhi(v.z) + bflo(v.w) * bflo(v.w) + bfhi(v.w) * bfhi(v.w);
                    if (n0 == 256 && cc >= 16) q = 0.f;
                    q += DPP_F(q, 0xB1); q += DPP_F(q, 0x4E); q += DPP_F(q, 0x141); q += DPP_F(q, 0x140); q += __shfl_xor(q, 16);
                    if (cc == 0) sqp[m0 + row] = q;
                }
            }
        } else {
#pragma unroll
            for (int i = 0; i < 4; ++i) {
                const int rl = wm * 64 + i * 16 + (lane & 15);
                const float rs = sRstd[rl];
                epi.row(m0 + rl, n0 + wn * 128 + 4 * (lane >> 4), acc[i], rs, lane);
                __builtin_amdgcn_sched_barrier(0);
            }
        }
        __syncthreads();
    }
}

struct Epi2In0 {
    bf16_t* Z0; float* G; const float* lb; bf16_t* D; int ldd; int N; float* SQ0; float* SQ1;
    DEVI bool staged(int n0) const { return (n0 >> 9) != 1; }
    DEVI float map(int n, float v) const { const int blk = n >> 9; return (blk == 0) ? v : ((blk <= 3) ? v * sigm(v) : gelu_tanh(v)); }
    DEVI void row(int m, int n, const f32x4 (&a)[8], float rs, int) const {
#pragma unroll
        for (int j = 0; j < 8; ++j) {
            const int c = n + 16 * j - 512;
            const float4 l4 = *(const float4*)(lb + c);
            float4 o;
            o.x = logf(l4.x + (1.f - l4.x) * sigm(a[j][0] * rs)); o.y = logf(l4.y + (1.f - l4.y) * sigm(a[j][1] * rs));
            o.z = logf(l4.z + (1.f - l4.z) * sigm(a[j][2] * rs)); o.w = logf(l4.w + (1.f - l4.w) * sigm(a[j][3] * rs));
            *(float4*)(G + (size_t)m * 512 + c) = o;
        }
    }
};
struct Epi2Bf16 {
    bf16_t* D; int ldd; int N; float* SQ0; float* SQ1;
    DEVI bool staged(int) const { return true; }
    DEVI float map(int, float v) const { return v; }
    DEVI void row(int, int, const f32x4 (&)[8], float, int) const {}
};
struct Epi2Resid {
    bf16_t* XB; float* SSQ16; float alpha; bf16_t* D; int ldd; int N; float* SQ0; float* SQ1;
    DEVI bool staged(int) const { return false; }
    DEVI float map(int, float v) const { return v; }
    DEVI void row(int m, int n, const f32x4 (&a)[8], float, int lane) const {
        float sq[2] = {0.f, 0.f};
#pragma unroll
        for (int j = 0; j < 8; ++j) {
            bf16_t* px = XB + (size_t)m * 1024 + n + 16 * j;
            const uint2 r = *(const uint2*)px;
            const unsigned w0 = pack2(bflo(r.x) + alpha * a[j][0], bfhi(r.x) + alpha * a[j][1]), w1 = pack2(bflo(r.y) + alpha * a[j][2], bfhi(r.y) + alpha * a[j][3]);
            *(uint2*)px = uint2{w0, w1};
            sq[j >> 2] += bflo(w0) * bflo(w0) + bfhi(w0) * bfhi(w0) + bflo(w1) * bflo(w1) + bfhi(w1) * bfhi(w1);
        }
#pragma unroll
        for (int g = 0; g < 2; ++g) {
            float v = sq[g];
            v += __shfl_xor(v, 16); v += __shfl_xor(v, 32);
            if ((lane >> 4) == 0) SSQ16[(size_t)m * 16 + ((n + 64 * g) >> 6)] = v;
        }
    }
};

struct EpiBf16 { bf16_t* D; int ldd; int N; DEVI void operator()(int m, int n, float v) const { if (n < N) D[(size_t)m * ldd + n] = f2bf(v); } };

DEVI void hgrn_local_item(const Params& p, int item, char* smem) {
    const int tid = threadIdx.x, lane = tid & 63, wave = tid >> 6;
    const int bh = item >> 7, c = item & 127, b = bh >> 2, h = bh & 3;
    const size_t m0 = (size_t)b * 8192 + c * 64;
    const float* G = (const float*)(p.ws + OFF_G) + m0 * 512 + h * 128;
    const bf16_t* Zv = (const bf16_t*)(p.ws + OFF_Z0) + m0 * 3072 + 1024 + h * 128;
    char* sVT = smem; char* sKd = smem + 16384;
    const int k = tid & 127, hf = tid >> 7;
    float bl = 0.f, bmid = 0.f;
#pragma unroll 8
    for (int t = 0; t < 64; ++t) { bl += G[t * 512 + k]; if (t == 31) bmid = bl; }
    float bcur = hf ? bmid : 0.f;
#pragma unroll 1
    for (int ch = 0; ch < 4; ++ch) {
        float kd[8], vv[8];
#pragma unroll
        for (int j = 0; j < 8; ++j) {
            const int t = 32 * hf + 8 * ch + j;
            const float g = G[t * 512 + k];
            bcur += g;
            kd[j] = (1.f - __expf(g)) * __expf(bl - bcur);
            vv[j] = bf2f(Zv[(size_t)t * 3072 + k]);
        }
        uint4 o; o.x = pack2(kd[0], kd[1]); o.y = pack2(kd[2], kd[3]); o.z = pack2(kd[4], kd[5]); o.w = pack2(kd[6], kd[7]);
        *(uint4*)(sKd + swz_off<64>(k, 4 * hf + ch)) = o;
        uint4 w; w.x = pack2(vv[0], vv[1]); w.y = pack2(vv[2], vv[3]); w.z = pack2(vv[4], vv[5]); w.w = pack2(vv[6], vv[7]);
        *(uint4*)(sVT + swz_off<64>(k, 4 * hf + ch)) = w;
    }
    if (hf == 0) ((float*)(p.ws + OFF_DEC))[item * 128 + k] = __expf(bl);
    __syncthreads();
    f32x4 acc[2][8];
#pragma unroll
    for (int i = 0; i < 2; ++i)
#pragma unroll
        for (int j = 0; j < 8; ++j) acc[i][j] = f32x4{0.f, 0.f, 0.f, 0.f};
    mma_nt<2, 8, 64, 64>(acc, sVT, 32 * wave, sKd, 0, 0, 2, lane);
    float* H = (float*)(p.ws + OFF_HST) + (size_t)item * 16384;
#pragma unroll
    for (int i = 0; i < 2; ++i)
#pragma unroll
        for (int j = 0; j < 8; ++j)
#pragma unroll
            for (int r = 0; r < 4; ++r) {
                const int v = 32 * wave + 16 * i + (lane >> 4) * 4 + r, kk = 16 * j + (lane & 15);
                H[v * 128 + kk] = acc[i][j][r];
                if (r == 3) __builtin_amdgcn_sched_barrier(0);
            }
    __syncthreads();
}

DEVI void gmlp_item(const Params& p, int item, char* smem) {
    const int tid = threadIdx.x, lane = tid & 63, wave = tid >> 6;
    const int g = item & 3, chunk = item >> 2;
    const size_t m0 = (size_t)chunk * 128;
    const bf16_t* Z0 = (const bf16_t*)(p.ws + OFF_Z0);
    const bf16_t* Wc = (const bf16_t*)(p.ws + OFF_WS0) + g * 16384;
    char* sW = smem; char* sV = smem + 32768;
#pragma unroll
    for (int i = 0; i < 8; ++i) {
        const int e = tid + 256 * i, row = e >> 4, cc = e & 15;
        *(uint4*)(sW + swz_off<128>(row, cc)) = *(const uint4*)(Wc + row * 128 + cc * 8);
    }
    {
        const int t = tid >> 1, hf = tid & 1;
        const bf16_t* src = Z0 + (m0 + t) * 3072 + 2560 + g * 128 + 64 * hf;
        float vals[64]; float ss = 0.f;
#pragma unroll
        for (int i = 0; i < 8; ++i) {
            uint4 u = *(const uint4*)(src + 8 * i);
            vals[8 * i + 0] = bflo(u.x); vals[8 * i + 1] = bfhi(u.x); vals[8 * i + 2] = bflo(u.y); vals[8 * i + 3] = bfhi(u.y);
            vals[8 * i + 4] = bflo(u.z); vals[8 * i + 5] = bfhi(u.z); vals[8 * i + 6] = bflo(u.w); vals[8 * i + 7] = bfhi(u.w);
        }
#pragma unroll
        for (int i = 0; i < 64; ++i) ss += vals[i] * vals[i];
        ss += DPP_F(ss, 0xB1);
        const float rstd = rsqrtf(ss * (1.f / 128.f) + 1e-6f);
        const float* gn = p.l0_gmlp_v_norm + g * 128 + 64 * hf;
#pragma unroll
        for (int i = 0; i < 64; ++i) {
            const int d = 64 * hf + i;
            *(bf16_t*)(sV + swz_elem<128>(d, t)) = f2bf(vals[i] * rstd * gn[i]);
        }
    }
    __syncthreads();
    const int wm = wave >> 1, wn = wave & 1;
    f32x4 acc[4][4];
#pragma unroll
    for (int i = 0; i < 4; ++i)
#pragma unroll
        for (int j = 0; j < 4; ++j) acc[i][j] = f32x4{0.f, 0.f, 0.f, 0.f};
    mma_nt<4, 4, 128, 128>(acc, sW, wm * 64, sV, wn * 64, 0, 4, lane);
    bf16_t* MIX = (bf16_t*)(p.ws + OFF_MIX0);
#pragma unroll
    for (int i = 0; i < 4; ++i)
#pragma unroll
        for (int r = 0; r < 4; ++r) {
            const int t = wm * 64 + i * 16 + (lane >> 4) * 4 + r;
            const float bias = p.l0_gmlp_b_s[g * 128 + t];
#pragma unroll
            for (int j = 0; j < 4; ++j) {
                const int d = wn * 64 + j * 16 + (lane & 15);
                const float u = bf2f(Z0[(m0 + t) * 3072 + 2048 + g * 128 + d]);
                MIX[(m0 + t) * 1024 + 512 + g * 128 + d] = f2bf(u * (acc[i][j][r] + bias));
            }
        }
    __syncthreads();
}

DEVI void hgrn_scan_phase(const Params& p) {
    float* H = (float*)(p.ws + OFF_HST);
    const float* D = (const float*)(p.ws + OFF_DEC);
    for (int e = blockIdx.x * NTHREADS + threadIdx.x; e < 8 * 16384; e += gridDim.x * NTHREADS) {
        const int bh = e >> 14, idx = e & 16383, k = idx & 127;
        float run = 0.f;
        for (int c0 = 0; c0 < 128; c0 += 8) {
            float L[8], d[8];
#pragma unroll
            for (int u = 0; u < 8; ++u) { L[u] = H[((size_t)(bh * 128 + c0 + u)) * 16384 + idx]; d[u] = D[(bh * 128 + c0 + u) * 128 + k]; }
#pragma unroll
            for (int u = 0; u < 8; ++u) { H[((size_t)(bh * 128 + c0 + u)) * 16384 + idx] = run; run = d[u] * run + L[u]; }
        }
    }
}

DEVI void hgrn_out_item(const Params& p, int item, char* smem) {
    const int tid = threadIdx.x, lane = tid & 63, wave = tid >> 6;
    const int bh = item >> 7, c = item & 127, b = bh >> 2, h = bh & 3;
    const size_t m0 = (size_t)b * 8192 + c * 64;
    const float* G = (const float*)(p.ws + OFF_G) + m0 * 512 + h * 128;
    const bf16_t* Z0 = (const bf16_t*)(p.ws + OFF_Z0) + m0 * 3072;
    float* sB  = (float*)smem;
    char*  sHT = smem;
    char*  sQe = smem + 32768;
    char*  sP  = smem + 49152;
    char*  sU  = smem + 57344;
    char*  sQs = sU; char* sKh = sU + 4096; char* sVT = sU;
    float* sRed = (float*)(smem + 77824);
    const int k = tid & 127, hf = tid >> 7;
    if (hf == 0) { float bc = 0.f;
#pragma unroll 8
        for (int t = 0; t < 64; ++t) { bc += G[t * 512 + k]; sB[t * 128 + k] = bc; } }
    __syncthreads();
#pragma unroll 4
    for (int t = 32 * hf; t < 32 * hf + 32; ++t) {
        const float q = bf2f(Z0[(size_t)t * 3072 + h * 128 + k]);
        *(bf16_t*)(sQe + swz_elem<128>(t, k)) = f2bf(q * __expf(sB[t * 128 + k]));
    }
#pragma unroll 1
    for (int i = 0; i < 4; ++i) {
        const float ri = (i == 0) ? 0.f : sB[(16 * i - 1) * 128 + k];
#pragma unroll 4
        for (int tt = 8 * hf; tt < 8 * hf + 8; ++tt) {
            const int t = 16 * i + tt;
            const float q = bf2f(Z0[(size_t)t * 3072 + h * 128 + k]);
            *(bf16_t*)(sQs + swz_elem<128>(tt, k)) = f2bf(q * __expf(sB[t * 128 + k] - ri));
        }
        const int ns = 16 * (i + 1), half = ns >> 1;
#pragma unroll 4
        for (int s = hf * half; s < hf * half + half; ++s) {
            const float bs = sB[s * 128 + k];
            const float gs = bs - (s ? sB[(s - 1) * 128 + k] : 0.f);
            const float kk = 1.f - __expf(gs);
            *(bf16_t*)(sKh + swz_elem<128>(s, k)) = f2bf(kk * __expf(fminf(ri - bs, 80.f)));
        }
        __syncthreads();
        {
            f32x4 acc[1][1]; acc[0][0] = f32x4{0.f, 0.f, 0.f, 0.f};
            if (wave <= i) mma_nt<1, 1, 128, 128>(acc, sQs, 0, sKh, 16 * wave, 0, 4, lane);
#pragma unroll
            for (int r = 0; r < 4; ++r) {
                const int row = (lane >> 4) * 4 + r, col = lane & 15;
                float v = acc[0][0][r];
                if (wave > i || (wave == i && col > row)) v = 0.f;
                *(bf16_t*)(sP + swz_elem<64>(16 * i + row, 16 * wave + col)) = f2bf(v);
            }
        }
        __syncthreads();
    }
    {
        const bf16_t* Zv = Z0 + 1024 + h * 128;
#pragma unroll 1
        for (int ch = 0; ch < 4; ++ch) {
            float vv[8];
#pragma unroll
            for (int j = 0; j < 8; ++j) vv[j] = bf2f(Zv[(size_t)(32 * hf + 8 * ch + j) * 3072 + k]);
            uint4 w; w.x = pack2(vv[0], vv[1]); w.y = pack2(vv[2], vv[3]); w.z = pack2(vv[4], vv[5]); w.w = pack2(vv[6], vv[7]);
            *(uint4*)(sVT + swz_off<64>(k, 4 * hf + ch)) = w;
        }
        const float* H = (const float*)(p.ws + OFF_HST) + (size_t)item * 16384;
#pragma unroll 2
        for (int i = 0; i < 8; ++i) {
            const int e = tid + 256 * i, row = e >> 4, cc = e & 15;
            const float4 a = *(const float4*)(H + row * 128 + cc * 8), bq = *(const float4*)(H + row * 128 + cc * 8 + 4);
            uint4 o; o.x = pack2(a.x, a.y); o.y = pack2(a.z, a.w); o.z = pack2(bq.x, bq.y); o.w = pack2(bq.z, bq.w);
            *(uint4*)(sHT + swz_off<128>(row, cc)) = o;
        }
    }
    __syncthreads();
    f32x4 acc[4][2];
#pragma unroll
    for (int i = 0; i < 4; ++i)
#pragma unroll
        for (int j = 0; j < 2; ++j) acc[i][j] = f32x4{0.f, 0.f, 0.f, 0.f};
    mma_nt<4, 2, 128, 128>(acc, sQe, 0, sHT, 32 * wave, 0, 4, lane);
    mma_nt<4, 2, 64, 64>(acc, sP, 0, sVT, 32 * wave, 0, 2, lane);
#pragma unroll
    for (int i = 0; i < 4; ++i)
#pragma unroll
        for (int r = 0; r < 4; ++r) {
            float s = acc[i][0][r] * acc[i][0][r] + acc[i][1][r] * acc[i][1][r];
            s += DPP_F(s, 0xB1); s += DPP_F(s, 0x4E); s += DPP_F(s, 0x141); s += DPP_F(s, 0x140);
            if ((lane & 15) == 0) sRed[wave * 64 + i * 16 + (lane >> 4) * 4 + r] = s;
        }
    __syncthreads();
    bf16_t* MIX = (bf16_t*)(p.ws + OFF_MIX0);
#pragma unroll
    for (int i = 0; i < 4; ++i)
#pragma unroll
        for (int r = 0; r < 4; ++r) {
            const int t = i * 16 + (lane >> 4) * 4 + r;
            const float tot = sRed[t] + sRed[64 + t] + sRed[128 + t] + sRed[192 + t];
            const float rstd = rsqrtf(tot * (1.f / 128.f) + 1e-6f);
#pragma unroll
            for (int j = 0; j < 2; ++j) {
                const int v = 32 * wave + 16 * j + (lane & 15);
                const float og = bf2f(Z0[(size_t)t * 3072 + 1536 + h * 128 + v]);
                MIX[(m0 + t) * 1024 + h * 128 + v] = f2bf(acc[i][j][r] * rstd * p.l0_hgrn_out_norm[h * 128 + v] * og);
            }
        }
    __syncthreads();
}

DEVI unsigned f2key(float f) { unsigned u = __float_as_uint(f); return (u & 0x80000000u) ? ~u : (u | 0x80000000u); }
DEVI float key2f(unsigned k) { unsigned u = (k & 0x80000000u) ? (k ^ 0x80000000u) : ~k; return __uint_as_float(u); }
#define CE_DESC(a, b) { unsigned _x = max(a, b), _y = min(a, b); a = _x; b = _y; }
DEVI void sort16_desc(unsigned (&a)[16]) {
#pragma unroll
    for (int k = 2; k <= 16; k <<= 1)
#pragma unroll
        for (int j = k >> 1; j > 0; j >>= 1)
#pragma unroll
            for (int i = 0; i < 16; ++i) {
                const int l = i ^ j;
                if (l > i) {
                    if ((i & k) == 0) { CE_DESC(a[i], a[l]); } else { CE_DESC(a[l], a[i]); }
                }
            }
}
DEVI void merge16_desc(unsigned (&a)[16], const unsigned (&b)[16]) {
#pragma unroll
    for (int i = 0; i < 16; ++i) a[i] = max(a[i], b[15 - i]);
#pragma unroll
    for (int j = 8; j > 0; j >>= 1)
#pragma unroll
        for (int i = 0; i < 16; ++i) { const int l = i ^ j; if (l > i) { CE_DESC(a[i], a[l]); } }
}

DEVI void peer_topk_phase(const Params& p, const bf16_t* __restrict__ SK, int blk0, int nblk, char* smem) {
    const int tid = threadIdx.x, lane = tid & 63, wave = tid >> 6;
    const int r = lane & 31, hh = lane >> 5;
    const bf16_t* QP = (const bf16_t*)(p.ws + OFF_QP);
    int* IDX = (int*)(p.ws + OFF_IDX); float* GATE = (float*)(p.ws + OFF_GATE);
    char* sKey = smem;
    char* sQ = smem + 32768 + wave * 8192;
    for (int item = blk0; item < 1024; item += nblk) {
        const int h = item & 7, tile = (item >> 3) * 4 + wave;
        const size_t tok = (size_t)tile * 32 + r;
        unsigned top[2][16];
#pragma unroll
        for (int ph = 0; ph < 2; ++ph) {
            __syncthreads();
            {
                const bf16_t* ksrc = SK + (size_t)(h * 2 + ph) * 128 * 128;
#pragma unroll
                for (int i = 0; i < 8; ++i) { const int e = tid + 256 * i, row = e >> 4, cc = e & 15; *(uint4*)(sKey + swz_off<128>(row, cc)) = *(const uint4*)(ksrc + row * 128 + cc * 8); }
                const bf16_t* qsrc = QP + (size_t)tile * 32 * 2048 + h * 256 + ph * 128;
#pragma unroll
                for (int i = 0; i < 8; ++i) { const int e = lane + 64 * i, row = e >> 4, cc = e & 15; *(uint4*)(sQ + swz_off<128>(row, cc)) = *(const uint4*)(qsrc + (size_t)row * 2048 + cc * 8); }
            }
            __syncthreads();
            bf16x8 qf[8];
#pragma unroll
            for (int ks = 0; ks < 8; ++ks) qf[ks] = *(const bf16x8*)(sQ + swz_off<128>(r, 2 * ks + hh));
#pragma unroll 1
            for (int rt = 0; rt < 4; ++rt) {
                f32x16 acc;
#pragma unroll
                for (int e = 0; e < 16; ++e) acc[e] = 0.f;
#pragma unroll
                for (int ks = 0; ks < 8; ++ks) {
                    const bf16x8 kf = *(const bf16x8*)(sKey + swz_off<128>(32 * rt + r, 2 * ks + hh));
                    acc = mfma32(kf, qf[ks], acc);
                }
                unsigned kk[16];
#pragma unroll
                for (int e = 0; e < 16; ++e) {
                    const unsigned n = 32 * rt + (e & 3) + 8 * (e >> 2) + 4 * hh;
                    kk[e] = (f2key(acc[e]) & ~127u) | n;
                }
                sort16_desc(kk);
                if (rt == 0) {
#pragma unroll
                    for (int e = 0; e < 16; ++e) top[ph][e] = kk[e];
                } else merge16_desc(top[ph], kk);
            }
            unsigned other[16];
#pragma unroll
            for (int e = 0; e < 16; ++e) { const auto sw_ = __builtin_amdgcn_permlane32_swap(top[ph][e], top[ph][e], false, false); other[e] = hh ? sw_[0] : sw_[1]; }
            merge16_desc(top[ph], other);
        }
        unsigned best[16];
        {
            float s1[16], s2[16];
#pragma unroll
            for (int e = 0; e < 16; ++e) { s1[e] = key2f(top[0][e] & ~127u); s2[e] = key2f(top[1][e] & ~127u); }
            unsigned cand[64];
            unsigned ia[16], ib[16];
#pragma unroll
            for (int e = 0; e < 16; ++e) { ia[e] = (top[0][e] & 127u) << 7; ib[e] = top[1][e] & 127u; }
            int n = 0;
#pragma unroll
            for (int i = 0; i < 16; ++i)
#pragma unroll
                for (int j = 0; j < 16; ++j)
                    if ((i + 1) * (j + 1) <= 16) { cand[n] = (f2key(s1[i] + s2[j]) & ~0x3fffu) | ia[i] | ib[j]; ++n; }
#pragma unroll
            for (int e = 50; e < 64; ++e) cand[e] = 0u;
#pragma unroll
            for (int g = 0; g < 4; ++g) {
                unsigned kk[16];
#pragma unroll
                for (int e = 0; e < 16; ++e) kk[e] = cand[16 * g + e];
                sort16_desc(kk);
                if (g == 0) {
#pragma unroll
                    for (int e = 0; e < 16; ++e) best[e] = kk[e];
                } else merge16_desc(best, kk);
            }
        }
        float sv[16]; int id[16];
#pragma unroll
        for (int e = 0; e < 16; ++e) {
            sv[e] = key2f(best[e] & ~0x3fffu);
            id[e] = (int)(best[e] & 0x3fffu);
        }
        float den = 0.f; const float smax = sv[0];
#pragma unroll
        for (int e = 0; e < 16; ++e) { sv[e] = __expf(sv[e] - smax); den += sv[e]; }
        const float inv = 1.f / den;
        {
            const float* INVT = (const float*)(p.ws + (hh ? OFF_INVU : OFF_INVD));
            float sc[16];
#pragma unroll
            for (int e = 0; e < 16; ++e) sc[e] = INVT[id[e]];
            if (hh == 0) {
                int4* dst = (int4*)(IDX + tok * 128 + h * 16);
                float4* dst2 = (float4*)((float*)(p.ws + OFF_SDN) + tok * 128 + h * 16);
#pragma unroll
                for (int e = 0; e < 4; ++e) { dst[e] = int4{id[4 * e], id[4 * e + 1], id[4 * e + 2], id[4 * e + 3]}; dst2[e] = float4{sc[4 * e], sc[4 * e + 1], sc[4 * e + 2], sc[4 * e + 3]}; }
            } else {
                float4* dst = (float4*)(GATE + tok * 128 + h * 16);
#pragma unroll
                for (int e = 0; e < 4; ++e) dst[e] = float4{sv[4 * e] * inv * sc[4 * e], sv[4 * e + 1] * inv * sc[4 * e + 1], sv[4 * e + 2] * inv * sc[4 * e + 2], sv[4 * e + 3] * inv * sc[4 * e + 3]};
            }
        }
    }
    for (int it0 = blk0; it0 < 4096; it0 += 4 * nblk) {
        uint4 ra[4], rb[4];
#pragma unroll
        for (int u = 0; u < 4; ++u) {
            const int it = it0 + u * nblk;
            const bf16_t* xb = (const bf16_t*)(p.ws + OFF_XB) + ((size_t)(it < 4096 ? it : it0) * 4 + wave) * 1024 + 16 * lane;
            ra[u] = *(const uint4*)xb; rb[u] = *(const uint4*)(xb + 8);
        }
#pragma unroll
        for (int u = 0; u < 4; ++u) {
            const int it = it0 + u * nblk;
            const uint4 a = ra[u], b = rb[u];
            float v[16] = {bflo(a.x), bfhi(a.x), bflo(a.y), bfhi(a.y), bflo(a.z), bfhi(a.z), bflo(a.w), bfhi(a.w),
                           bflo(b.x), bfhi(b.x), bflo(b.y), bfhi(b.y), bflo(b.z), bfhi(b.z), bflo(b.w), bfhi(b.w)};
#pragma unroll
            for (int i = 0; i < 16; ++i) v[i] = fminf(fmaxf(v[i] * 32.f, -400.f), 400.f);
            int w0 = 0, w1 = 0, w2 = 0, w3 = 0;
            w0 = __builtin_amdgcn_cvt_pk_fp8_f32(v[0], v[1], w0, false);   w0 = __builtin_amdgcn_cvt_pk_fp8_f32(v[2], v[3], w0, true);
            w1 = __builtin_amdgcn_cvt_pk_fp8_f32(v[4], v[5], w1, false);   w1 = __builtin_amdgcn_cvt_pk_fp8_f32(v[6], v[7], w1, true);
            w2 = __builtin_amdgcn_cvt_pk_fp8_f32(v[8], v[9], w2, false);   w2 = __builtin_amdgcn_cvt_pk_fp8_f32(v[10], v[11], w2, true);
            w3 = __builtin_amdgcn_cvt_pk_fp8_f32(v[12], v[13], w3, false); w3 = __builtin_amdgcn_cvt_pk_fp8_f32(v[14], v[15], w3, true);
            if (it < 4096) *(int4*)(p.ws + OFF_XB8 + ((size_t)it * 4 + wave) * 1024 + 16 * lane) = int4{w0, w1, w2, w3};
        }
    }
}

typedef float f32x2v __attribute__((ext_vector_type(2)));
#define PEER_QWORD 80000
#define PEER_TPW 8
#define PEER_ITEMS (16384 / (4 * PEER_TPW))
DEVI int queue_pop(const Params& p, int q, char* smem) {
    int* sw = (int*)(smem + PEER_QWORD);
    __syncthreads();
    if (threadIdx.x == 0) *sw = (int)__hip_atomic_fetch_add((unsigned*)(p.ws + OFF_QCNT) + q * 16, 1u, __ATOMIC_RELAXED, __HIP_MEMORY_SCOPE_AGENT);
    __syncthreads();
    return *sw;
}
DEVI int queue_publish(int pending, char* smem) {
    int* sw = (int*)(smem + PEER_QWORD);
    __syncthreads();
    if (threadIdx.x == 0) *sw = pending;
    __syncthreads();
    return *sw;
}
DEVI unsigned queue_live(const Params& p, int qbase, int s0, char* smem) {
    unsigned* sw = (unsigned*)(smem + PEER_QWORD + 4);
    __syncthreads();
    if (threadIdx.x < 64) {
        unsigned c = 0xffffffffu;
        if (threadIdx.x < 8) c = __hip_atomic_load((unsigned*)(p.ws + OFF_QCNT) + (qbase + ((s0 + (int)threadIdx.x) & 7)) * 16, __ATOMIC_RELAXED, __HIP_MEMORY_SCOPE_AGENT);
        const unsigned long long m = __ballot(c < (unsigned)PEER_ITEMS);
        if (threadIdx.x == 0) *sw = (unsigned)m;
    }
    __syncthreads();
    return *sw;
}
#define UFMA(ACC, W, X) asm volatile("v_fmac_f32 %0, %1, %2" : "+v"(ACC) : "v"(W), "v"(X))
DEVI void d_stream(size_t tok, int s, int lane, char* slot, const int* IDX, const char* XB8) {
    const unsigned o1 = (unsigned)tok * 512u + 4u * (unsigned)lane;
    __builtin_amdgcn_global_load_lds((const unsigned*)((const char*)IDX + o1),        (unsigned*)(slot),       4, 0, 0);
    __builtin_amdgcn_global_load_lds((const unsigned*)((const char*)IDX + o1 + 256u), (unsigned*)(slot + 256), 4, 0, 0);
    __builtin_amdgcn_global_load_lds((const unsigned*)(XB8 + (unsigned)tok * 1024u + (unsigned)(128 * s + 4 * (lane & 31))), (unsigned*)(slot + 512), 4, 0, 0);
}
template <int HLF>
DEVI void d_dma(const char* slot, char* buf, int s, int lane, const char* ED) {
    const int grp = lane >> 3, sub = lane & 7;
    unsigned e[8];
#pragma unroll
    for (int i = 0; i < 8; ++i) e[i] = *(const unsigned*)(slot + 256 * HLF + 4 * (8 * i + grp));
#pragma unroll
    for (int i = 0; i < 8; ++i) {
        const int pl_ = 8 * i + grp;
        const unsigned src = ((unsigned)s * 16384u + e[i]) * 128u + (unsigned)(16 * (sub ^ ((pl_ >> 1) & 7)));
        __builtin_amdgcn_global_load_lds((const unsigned*)(ED + src), (unsigned*)(buf + i * 1024), 16, 0, 0);
    }
}
template <int HLF>
DEVI void d_mma(const char* buf, const char* slot, size_t tok, int s, int lane, float* PART) {
    const int r = lane & 15, q = lane >> 4;
    const long b0 = *(const long*)(slot + 512 + 32 * q), b1 = *(const long*)(slot + 512 + 32 * q + 8), b2 = *(const long*)(slot + 512 + 32 * q + 16), b3 = *(const long*)(slot + 512 + 32 * q + 24);
    float* dst = PART + ((size_t)s * 16384 + tok) * 128 + 64 * HLF;
    long a[4][4];
#pragma unroll
    for (int t = 0; t < 4; ++t) {
        const int row = 16 * t + r, key = (row >> 1) & 7;
        const char* rp = buf + row * 128;
#pragma unroll
        for (int kk = 0; kk < 4; ++kk) a[t][kk] = *(const long*)(rp + ((((4 * q + kk) >> 1) ^ key) << 4) + 8 * ((4 * q + kk) & 1));
    }
    f32x4 acc[4];
#pragma unroll
    for (int t = 0; t < 4; ++t) { acc[t] = f32x4{0.f, 0.f, 0.f, 0.f}; acc[t] = __builtin_amdgcn_mfma_f32_16x16x32_fp8_fp8(a[t][0], b0, acc[t], 0, 0, 0); }
#pragma unroll
    for (int t = 0; t < 4; ++t) acc[t] = __builtin_amdgcn_mfma_f32_16x16x32_fp8_fp8(a[t][1], b1, acc[t], 0, 0, 0);
#pragma unroll
    for (int t = 0; t < 4; ++t) acc[t] = __builtin_amdgcn_mfma_f32_16x16x32_fp8_fp8(a[t][2], b2, acc[t], 0, 0, 0);
#pragma unroll
    for (int t = 0; t < 4; ++t) acc[t] = __builtin_amdgcn_mfma_f32_16x16x32_fp8_fp8(a[t][3], b3, acc[t], 0, 0, 0);
    if (r == 0) {
#pragma unroll
        for (int t = 0; t < 4; ++t) *(float4*)(dst + 16 * t + 4 * q) = float4{acc[t][0] * (1.f / 32.f), acc[t][1] * (1.f / 32.f), acc[t][2] * (1.f / 32.f), acc[t][3] * (1.f / 32.f)};
    }
}
DEVI void peer_down_phase(const Params& p, const float* __restrict__ gain, int qbase, int s0, char* smem) {
    const int tid = threadIdx.x, lane = tid & 63;
    const int wave = __builtin_amdgcn_readfirstlane(tid >> 6);
    const char* ED = p.ws + OFF_ED; const char* XB8 = p.ws + OFF_XB8;
    const int* IDX = (const int*)(p.ws + OFF_IDX);
    float* PART = (float*)(p.ws + OFF_PART);
    (void)gain;
    char* const img = smem + wave * 16384;
    char* const tb0 = smem + 65536 + wave * 3072;
    unsigned live = 0xffu; int pending = 0;
#pragma unroll 1
    for (int sl = 0; sl < 8; ++sl) {
        const int s = (s0 + sl) & 7;
        if (sl == 1) live = queue_live(p, qbase, s0, smem);
        if (!((live >> sl) & 1u)) continue;
#pragma unroll 1
        for (int g = queue_pop(p, qbase + s, smem); g < PEER_ITEMS; g = queue_publish(pending, smem)) {
            if (threadIdx.x == 0) {
                const unsigned* qp_ = (const unsigned*)(p.ws + OFF_QCNT) + (qbase + s) * 16; const unsigned zo_ = 0u, one_ = 1u;
                asm volatile("global_atomic_add %0, %1, %2, %3 sc0" : "+v"(pending) : "v"(zo_), "v"(one_), "s"(qp_) : "memory");
            }
            const size_t t0 = (size_t)g * (4 * PEER_TPW) + wave * PEER_TPW;
            d_stream(t0, s, lane, tb0, IDX, XB8); d_stream(t0 + 1, s, lane, tb0 + 768, IDX, XB8);
            asm volatile("s_waitcnt vmcnt(0)" ::: "memory");
            d_dma<0>(tb0, img, s, lane, ED);
#pragma unroll 1
            for (int j = 0; j < PEER_TPW; ++j) {
                char* const slj = tb0 + 768 * (j & 3); char* const sln = tb0 + 768 * ((j + 1) & 3);
                if (j + 2 < PEER_TPW) d_stream(t0 + j + 2, s, lane, tb0 + 768 * ((j + 2) & 3), IDX, XB8);
                d_dma<1>(slj, img + 8192, s, lane, ED);
                if (j + 2 < PEER_TPW) asm volatile("s_waitcnt vmcnt(11)" ::: "memory"); else asm volatile("s_waitcnt vmcnt(8)" ::: "memory");
                if (!(PROBE_NOMMA && qbase >= 32)) d_mma<0>(img, slj, t0 + j, s, lane, PART);
                asm volatile("s_waitcnt lgkmcnt(0)" ::: "memory");
                if (j + 1 < PEER_TPW) { d_dma<0>(sln, img, s, lane, ED); asm volatile("s_waitcnt vmcnt(8)" ::: "memory"); }
                else asm volatile("s_waitcnt vmcnt(0)" ::: "memory");
                if (!(PROBE_NOMMA && qbase >= 32)) d_mma<1>(img + 8192, slj, t0 + j, s, lane, PART);
                asm volatile("s_waitcnt lgkmcnt(0)" ::: "memory");
            }
        }
    }
}
struct RedL { float sq, pa[8], pb[8], g0, g1, d0, d1; int i0, i1; };
DEVI void red_load(RedL& L, const Params& p, size_t tok, int lane) {
    const float* PART = (const float*)(p.ws + OFF_PART); const float* GATEU = (const float*)(p.ws + OFF_GATE); const float* SDN = (const float*)(p.ws + OFF_SDN);
    const float* SSQ16 = (const float*)(p.ws + OFF_SSQ16); const int* IDX = (const int*)(p.ws + OFF_IDX);
    L.sq = SSQ16[tok * 16 + (lane & 15)];
#pragma unroll
    for (int s = 0; s < 8; ++s) { L.pa[s] = PART[((size_t)s * 16384 + tok) * 128 + lane]; L.pb[s] = PART[((size_t)s * 16384 + tok) * 128 + 64 + lane]; }
    L.g0 = GATEU[tok * 128 + lane]; L.g1 = GATEU[tok * 128 + 64 + lane]; L.d0 = SDN[tok * 128 + lane]; L.d1 = SDN[tok * 128 + 64 + lane];
    L.i0 = IDX[tok * 128 + lane]; L.i1 = IDX[tok * 128 + 64 + lane];
}
DEVI void red_finish(const RedL& L, const Params& p, size_t tok, int lane) {
    float sq = L.sq;
    sq += DPP_F(sq, 0xB1); sq += DPP_F(sq, 0x4E); sq += DPP_F(sq, 0x141); sq += DPP_F(sq, 0x140);
    const float rstd = rsqrtf(sq * (1.f / 1024.f) + 1e-6f);
    float a0 = 0.f, a1 = 0.f;
#pragma unroll
    for (int s = 0; s < 8; ++s) { a0 += L.pa[s]; a1 += L.pb[s]; }
    const float w0 = L.g0 * gelu_tanh(a0 * rstd * L.d0);
    const float w1 = L.g1 * gelu_tanh(a1 * rstd * L.d1);
    float m = fmaxf(fabsf(w0), fabsf(w1));
    m = wave_max_dpp(m);
    const unsigned e = (__float_as_uint(m) >> 23) & 255u;
    const bool tiny = e < 16u;
    const float S = tiny ? 1.f : __uint_as_float((261u - e) << 23), invS = tiny ? 1.f : __uint_as_float((e - 7u) << 23);
    const float s0 = w0 * S, s1 = w1 * S;
    const int hi = __builtin_amdgcn_cvt_pk_fp8_f32(s0, s1, 0, false);
    const float r0 = s0 - __builtin_amdgcn_cvt_f32_fp8(hi, 0), r1 = s1 - __builtin_amdgcn_cvt_f32_fp8(hi, 1);
    const int lo = __builtin_amdgcn_cvt_pk_fp8_f32(r0, r1, 0, false);
    char* rec = p.ws + OFF_UREC + tok * 768;
    *(unsigned short*)(rec + 2 * lane) = (unsigned short)L.i0;
    *(unsigned short*)(rec + 128 + 2 * lane) = (unsigned short)L.i1;
    *(unsigned char*)(rec + 256 + lane) = (unsigned char)(hi & 255);       *(unsigned char*)(rec + 320 + lane) = (unsigned char)((hi >> 8) & 255);
    *(unsigned char*)(rec + 384 + lane) = (unsigned char)(lo & 255);       *(unsigned char*)(rec + 448 + lane) = (unsigned char)((lo >> 8) & 255);
    *(float*)(rec + 512 + 4 * lane) = invS;
}
DEVI void peer_reduce_phase(const Params& p) {
    const int lane = threadIdx.x & 63, wave = threadIdx.x >> 6;
    const int G = gridDim.x;
    for (int it = blockIdx.x; it < 4096; it += 2 * G) {
        const bool two = it + G < 4096;
        const size_t tokA = (size_t)it * 4 + wave, tokB = (size_t)(two ? it + G : it) * 4 + wave;
        RedL A, B;
        red_load(A, p, tokA, lane); red_load(B, p, tokB, lane);
        red_finish(A, p, tokA, lane);
        if (two) red_finish(B, p, tokB, lane);
    }
}
DEVI void u_stream(size_t tok, int s, int lane, char* slot, const char* UREC, const char* XB) {
    const unsigned o1 = (unsigned)tok * 768u + 4u * (unsigned)lane;
    __builtin_amdgcn_global_load_lds((const unsigned*)(UREC + o1),        (unsigned*)(slot),       4, 0, 0);
    __builtin_amdgcn_global_load_lds((const unsigned*)(UREC + o1 + 256u), (unsigned*)(slot + 256), 4, 0, 0);
    __builtin_amdgcn_global_load_lds((const unsigned*)(UREC + o1 + 512u), (unsigned*)(slot + 512), 4, 0, 0);
    __builtin_amdgcn_global_load_lds((const unsigned*)(XB + (unsigned)tok * 2048u + (unsigned)(256 * s + 4 * lane)), (unsigned*)(slot + 768), 4, 0, 0);
}
template <int HLF>
DEVI void u_dma(const char* slot, char* buf, int s, int lane, const char* EU) {
    const int grp = lane >> 3, sub = lane & 7;
    unsigned e[8];
#pragma unroll
    for (int i = 0; i < 8; ++i) e[i] = *(const unsigned short*)(slot + 128 * HLF + 2 * (8 * i + grp));
#pragma unroll
    for (int i = 0; i < 8; ++i) {
        const int pl_ = 8 * i + grp;
        const unsigned src = ((unsigned)s * 16384u + e[i]) * 128u + (unsigned)(16 * (sub ^ ((pl_ >> 1) & 7)));
        __builtin_amdgcn_global_load_lds((const unsigned*)(EU + src), (unsigned*)(buf + i * 1024), 16, 0, 0);
    }
}
#define TR8(DST, ADDR, OFF) asm volatile("ds_read_b64_tr_b8 %0, %1 offset:%2" : "=v"(DST) : "v"(ADDR), "i"(OFF))
#define TR8_WAIT4(N, A, B, C, D) asm volatile("s_waitcnt lgkmcnt(" #N ")" : "+v"(A), "+v"(B), "+v"(C), "+v"(D))
template <int HLF>
DEVI void u_mma(const char* buf, const char* slot, int lane, f32x4 (&acc)[8]) {
    const int i16 = lane & 15, g = lane >> 4;
    const int row0 = 8 * g + (i16 >> 1), key = (row0 >> 1) & 7;
    const unsigned ab = (unsigned)(size_t)(__attribute__((address_space(3))) const char*)(buf + row0 * 128 + 8 * (i16 & 1));
    const long b0 = *(const long*)(slot + 256 + 128 * (i16 & 1) + 64 * HLF + 8 * g), b1 = *(const long*)(slot + 256 + 128 * (i16 & 1) + 64 * HLF + 32 + 8 * g);
    long a0[8], a1[8];
#pragma unroll
    for (int ct = 0; ct < 8; ++ct) { const unsigned ad = ab + (unsigned)((ct ^ key) << 4); TR8(a0[ct], ad, 0); }
#pragma unroll
    for (int ct = 0; ct < 8; ++ct) { const unsigned ad = ab + (unsigned)((ct ^ key) << 4); TR8(a1[ct], ad, 4096); }
    TR8_WAIT4(12, a0[0], a0[1], a0[2], a0[3]);
#pragma unroll
    for (int ct = 0; ct < 4; ++ct) acc[ct] = __builtin_amdgcn_mfma_f32_16x16x32_fp8_fp8(a0[ct], b0, acc[ct], 0, 0, 0);
    TR8_WAIT4(8, a0[4], a0[5], a0[6], a0[7]);
#pragma unroll
    for (int ct = 4; ct < 8; ++ct) acc[ct] = __builtin_amdgcn_mfma_f32_16x16x32_fp8_fp8(a0[ct], b0, acc[ct], 0, 0, 0);
    TR8_WAIT4(4, a1[0], a1[1], a1[2], a1[3]);
#pragma unroll
    for (int ct = 0; ct < 4; ++ct) acc[ct] = __builtin_amdgcn_mfma_f32_16x16x32_fp8_fp8(a1[ct], b1, acc[ct], 0, 0, 0);
    TR8_WAIT4(0, a1[4], a1[5], a1[6], a1[7]);
#pragma unroll
    for (int ct = 4; ct < 8; ++ct) acc[ct] = __builtin_amdgcn_mfma_f32_16x16x32_fp8_fp8(a1[ct], b1, acc[ct], 0, 0, 0);
}
DEVI void u_finish(f32x4 (&acc)[8], const char* slot, char* ex, size_t tok, int s, int lane, float alpha, float* X, bf16_t* XB, float* SSQ8) {
    const int i16 = lane & 15, g = lane >> 4;
    if (i16 < 2) {
#pragma unroll
        for (int ct = 0; ct < 8; ++ct) *(f32x4*)(ex + 576 * i16 + 4 * (16 * ct + 4 * g)) = acc[ct];
    }
    const float2 vh = *(const float2*)(ex + 8 * lane), vl = *(const float2*)(ex + 576 + 8 * lane);
    const float sc = alpha * *(const float*)(slot + 512);
    const unsigned xb2 = *(const unsigned*)(slot + 768 + 4 * lane);
    const float y0 = bflo(xb2) + sc * (vh.x + vl.x), y1 = bfhi(xb2) + sc * (vh.y + vl.y);
    const unsigned col = (unsigned)tok * 1024u + (unsigned)(128 * s + 2 * lane);
    if (X) *(f32x2v*)((char*)X + 4u * col) = f32x2v{y0, y1};
    const unsigned yb = pack2(y0, y1);
    *(unsigned*)((char*)XB + 2u * col) = yb;
    float sq = bflo(yb) * bflo(yb) + bfhi(yb) * bfhi(yb);
    sq = wave_sum_dpp(sq);
    if (lane == 0) *(float*)((char*)SSQ8 + ((unsigned)tok * 32u + 4u * (unsigned)s)) = sq;
#pragma unroll
    for (int ct = 0; ct < 8; ++ct) acc[ct] = f32x4{0.f, 0.f, 0.f, 0.f};
}
DEVI void peer_up_phase(const Params& p, int qbase, int s0, float alpha, float* X, char* smem) {
    const int tid = threadIdx.x, lane = tid & 63;
    const int wave = __builtin_amdgcn_readfirstlane(tid >> 6);
    const char* EU = p.ws + OFF_EU; const char* UREC = p.ws + OFF_UREC;
    bf16_t* XB = (bf16_t*)(p.ws + OFF_XB); float* SSQ8 = (float*)(p.ws + OFF_SSQ8);
    char* const img = smem + wave * 16384;
    char* const tb0 = smem + 65536 + wave * 3072;
    unsigned live = 0xffu; int pending = 0;
#pragma unroll 1
    for (int sl = 0; sl < 8; ++sl) {
        const int s = (s0 + sl) & 7;
        if (sl == 1) live = queue_live(p, qbase, s0, smem);
        if (!((live >> sl) & 1u)) continue;
#pragma unroll 1
        for (int g = queue_pop(p, qbase + s, smem); g < PEER_ITEMS; g = queue_publish(pending, smem)) {
            if (threadIdx.x == 0) {
                const unsigned* qp_ = (const unsigned*)(p.ws + OFF_QCNT) + (qbase + s) * 16; const unsigned zo_ = 0u, one_ = 1u;
                asm volatile("global_atomic_add %0, %1, %2, %3 sc0" : "+v"(pending) : "v"(zo_), "v"(one_), "s"(qp_) : "memory");
            }
            const size_t t0 = (size_t)g * (4 * PEER_TPW) + wave * PEER_TPW;
            f32x4 acc[8];
#pragma unroll
            for (int ct = 0; ct < 8; ++ct) acc[ct] = f32x4{0.f, 0.f, 0.f, 0.f};
            char* slj = tb0; char* sln = tb0 + 1024; char* slf = tb0 + 2048;
            u_stream(t0, s, lane, slj, UREC, (const char*)XB); u_stream(t0 + 1, s, lane, sln, UREC, (const char*)XB);
            asm volatile("s_waitcnt vmcnt(0)" ::: "memory");
            u_dma<0>(slj, img, s, lane, EU);
#pragma unroll 1
            for (int j = 0; j < PEER_TPW; ++j) {
                if (j + 2 < PEER_TPW) u_stream(t0 + j + 2, s, lane, slf, UREC, (const char*)XB);
                u_dma<1>(slj, img + 8192, s, lane, EU);
                if (j + 2 < PEER_TPW) asm volatile("s_waitcnt vmcnt(12)" ::: "memory"); else asm volatile("s_waitcnt vmcnt(8)" ::: "memory");
                u_mma<0>(img, slj, lane, acc);
                asm volatile("s_waitcnt lgkmcnt(0)" ::: "memory");
                if (j + 1 < PEER_TPW) { u_dma<0>(sln, img, s, lane, EU); asm volatile("s_waitcnt vmcnt(8)" ::: "memory"); }
                else asm volatile("s_waitcnt vmcnt(0)" ::: "memory");
                u_mma<1>(img + 8192, slj, lane, acc);
                asm volatile("s_waitcnt lgkmcnt(0)" ::: "memory");
                u_finish(acc, slj, img + 8192, t0 + j, s, lane, alpha, X, XB, SSQ8);
                asm volatile("s_waitcnt lgkmcnt(0)" ::: "memory");
                char* const t_ = slj; slj = sln; sln = slf; slf = t_;
            }
        }
    }
}

DEVI void rope_cs(float pos, int i, float& c, float& s) {
    const float inv = exp2f(-(float)i * (13.287712379549449f / 32.f));
    const float ang = pos * inv;
    const float kf = rintf(ang * 0.15915494309189535f);
    float rr = fmaf(-kf, 6.2831854820251465f, ang);
    rr = fmaf(-kf, -1.7484555e-7f, rr);
    c = __cosf(rr); s = __sinf(rr);
}
#define QSCALE_MLA  (0.07216878364870322f * 1.4426950408889634f)
#define QSCALE_MOBA (0.08838834764831845f * 1.4426950408889634f)

DEVI void moba_prep_item(const Params& p, int item, char* smem) {
    const int tid = threadIdx.x;
    const int h = item & 3, tt = item >> 2;
    const size_t m0 = (size_t)tt * 64;
    const int b = (int)(m0 >> 13), s0 = (int)(m0 & 8191), bh = b * 4 + h;
    const bf16_t* Z1 = (const bf16_t*)(p.ws + OFF_Z1);
    bf16_t* Qd = (bf16_t*)(p.ws + OFF_QD); bf16_t* Kd = (bf16_t*)(p.ws + OFF_KD); bf16_t* VdT = (bf16_t*)(p.ws + OFF_VDT);
    const int row = tid >> 2, j = tid & 3;
    const bf16_t* zr = Z1 + (m0 + row) * 1984;
#pragma unroll
    for (int which = 0; which < 2; ++which) {
        const bf16_t* src = zr + (which ? 960 : 448) + h * 128 + 32 * j;
        const float* gn = (which ? p.l1_mk_norm : p.l1_mq_norm) + 32 * j;
        float v[32]; float ss = 0.f;
#pragma unroll
        for (int i = 0; i < 4; ++i) {
            uint4 u = *(const uint4*)(src + 8 * i);
            v[8 * i] = bflo(u.x); v[8 * i + 1] = bfhi(u.x); v[8 * i + 2] = bflo(u.y); v[8 * i + 3] = bfhi(u.y);
            v[8 * i + 4] = bflo(u.z); v[8 * i + 5] = bfhi(u.z); v[8 * i + 6] = bflo(u.w); v[8 * i + 7] = bfhi(u.w);
        }
#pragma unroll
        for (int i = 0; i < 32; ++i) ss += v[i] * v[i];
        ss += DPP_F(ss, 0xB1); ss += DPP_F(ss, 0x4E);
        const float sc = rsqrtf(ss * (1.f / 128.f) + 1e-6f) * (which ? 1.f : QSCALE_MOBA);
        bf16_t* dst = (which ? Kd : Qd) + ((size_t)bh * 8192 + s0 + row) * 128 + 32 * j;
#pragma unroll
        for (int i = 0; i < 4; ++i) {
            uint4 o;
            o.x = pack2(v[8 * i] * sc * gn[8 * i], v[8 * i + 1] * sc * gn[8 * i + 1]); o.y = pack2(v[8 * i + 2] * sc * gn[8 * i + 2], v[8 * i + 3] * sc * gn[8 * i + 3]);
            o.z = pack2(v[8 * i + 4] * sc * gn[8 * i + 4], v[8 * i + 5] * sc * gn[8 * i + 5]); o.w = pack2(v[8 * i + 6] * sc * gn[8 * i + 6], v[8 * i + 7] * sc * gn[8 * i + 7]);
            *(uint4*)(dst + 8 * i) = o;
        }
    }
    bf16_t* sT = (bf16_t*)smem;
    {
        const bf16_t* src = zr + 1472 + h * 128 + 32 * j;
#pragma unroll
        for (int i = 0; i < 4; ++i) {
            uint4 u = *(const uint4*)(src + 8 * i);
            const int d0 = 32 * j + 8 * i;
            sT[(d0 + 0) * 66 + row] = (bf16_t)(u.x & 0xffff); sT[(d0 + 1) * 66 + row] = (bf16_t)(u.x >> 16);
            sT[(d0 + 2) * 66 + row] = (bf16_t)(u.y & 0xffff); sT[(d0 + 3) * 66 + row] = (bf16_t)(u.y >> 16);
            sT[(d0 + 4) * 66 + row] = (bf16_t)(u.z & 0xffff); sT[(d0 + 5) * 66 + row] = (bf16_t)(u.z >> 16);
            sT[(d0 + 6) * 66 + row] = (bf16_t)(u.w & 0xffff); sT[(d0 + 7) * 66 + row] = (bf16_t)(u.w >> 16);
        }
    }
    __syncthreads();
    for (int e = tid; e < 128 * 32; e += NTHREADS) {
        const int d = e >> 5, tp = e & 31;
        const unsigned v = (unsigned)sT[d * 66 + 2 * tp] | ((unsigned)sT[d * 66 + 2 * tp + 1] << 16);
        *(unsigned*)(VdT + ((size_t)bh * 128 + d) * 8192 + s0 + (((2 * tp) & ~12) | (((2 * tp) & 4) << 1) | (((2 * tp) & 8) >> 1))) = v;
    }
    __syncthreads();
}

DEVI void moba_kmean_item(const Params& p, int item, char* smem) {
    const int tid = threadIdx.x;
    const int bh = item >> 5, blk = item & 31, b = bh >> 2, h = bh & 3;
    const bf16_t* Z1 = (const bf16_t*)(p.ws + OFF_Z1) + ((size_t)b * 8192 + blk * 256) * 1984 + 960 + h * 128;
    const int cc = tid & 15, rg = tid >> 4;
    float col[8];
#pragma unroll
    for (int i = 0; i < 8; ++i) col[i] = 0.f;
    for (int i = 0; i < 16; ++i) {
        const int row = rg * 16 + i;
        uint4 u = *(const uint4*)(Z1 + (size_t)row * 1984 + cc * 8);
        float v[8] = {bflo(u.x), bfhi(u.x), bflo(u.y), bfhi(u.y), bflo(u.z), bfhi(u.z), bflo(u.w), bfhi(u.w)};
        float ss = 0.f;
#pragma unroll
        for (int e = 0; e < 8; ++e) ss += v[e] * v[e];
        ss += DPP_F(ss, 0xB1); ss += DPP_F(ss, 0x4E); ss += DPP_F(ss, 0x141); ss += DPP_F(ss, 0x140);
        const float rstd = rsqrtf(ss * (1.f / 128.f) + 1e-6f);
#pragma unroll
        for (int e = 0; e < 8; ++e) col[e] += v[e] * rstd;
    }
    float* sR = (float*)smem;
#pragma unroll
    for (int e = 0; e < 8; ++e) sR[rg * 128 + cc * 8 + e] = col[e];
    __syncthreads();
    if (tid < 128) {
        float s = 0.f;
#pragma unroll
        for (int g = 0; g < 16; ++g) s += sR[g * 128 + tid];
        ((float*)(p.ws + OFF_KMEAN))[((size_t)bh * 32 + blk) * 128 + tid] = s * (1.f / 256.f) * p.l1_mk_norm[tid];
    }
    __syncthreads();
}

DEVI void mla_prep_item(const Params& p, int item, char* smem) {
    const int tid = threadIdx.x;
    const int h = item & 3, tt = item >> 2;
    const size_t m0 = (size_t)tt * 64;
    const int b = (int)(m0 >> 13), s0 = (int)(m0 & 8191), bh = b * 4 + h;
    const bf16_t* Z1 = (const bf16_t*)(p.ws + OFF_Z1);
    const bf16_t* QC = (const bf16_t*)(p.ws + OFF_QC);
    const bf16_t* KV = (const bf16_t*)(p.ws + OFF_KV);
    bf16_t* Q = (bf16_t*)(p.ws + OFF_Q); bf16_t* K = (bf16_t*)(p.ws + OFF_K); bf16_t* VT = (bf16_t*)(p.ws + OFF_VT);
    const int row = tid >> 2, j = tid & 3;
    const size_t m = m0 + row;
    const float pos = (float)p.pos[m];
#pragma unroll
    for (int which = 0; which < 2; ++which) {
        const bf16_t* nsrc = which ? (KV + m * 1024 + h * 256 + 32 * j) : (QC + m * 768 + h * 192 + 32 * j);
        const bf16_t* r1 = which ? (Z1 + m * 1984 + 384 + 8 * j) : (QC + m * 768 + h * 192 + 128 + 8 * j);
        const bf16_t* r2 = r1 + 32;
        const float* gn = which ? p.l1_k_norm : p.l1_q_norm;
        float v[32], a1[8], a2[8]; float ss = 0.f;
#pragma unroll
        for (int i = 0; i < 4; ++i) {
            uint4 u = *(const uint4*)(nsrc + 8 * i);
            v[8 * i] = bflo(u.x); v[8 * i + 1] = bfhi(u.x); v[8 * i + 2] = bflo(u.y); v[8 * i + 3] = bfhi(u.y);
            v[8 * i + 4] = bflo(u.z); v[8 * i + 5] = bfhi(u.z); v[8 * i + 6] = bflo(u.w); v[8 * i + 7] = bfhi(u.w);
        }
        { uint4 u = *(const uint4*)r1; a1[0] = bflo(u.x); a1[1] = bfhi(u.x); a1[2] = bflo(u.y); a1[3] = bfhi(u.y); a1[4] = bflo(u.z); a1[5] = bfhi(u.z); a1[6] = bflo(u.w); a1[7] = bfhi(u.w); }
        { uint4 u = *(const uint4*)r2; a2[0] = bflo(u.x); a2[1] = bfhi(u.x); a2[2] = bflo(u.y); a2[3] = bfhi(u.y); a2[4] = bflo(u.z); a2[5] = bfhi(u.z); a2[6] = bflo(u.w); a2[7] = bfhi(u.w); }
#pragma unroll
        for (int i = 0; i < 32; ++i) ss += v[i] * v[i];
#pragma unroll
        for (int i = 0; i < 8; ++i) ss += a1[i] * a1[i] + a2[i] * a2[i];
        ss += DPP_F(ss, 0xB1); ss += DPP_F(ss, 0x4E);
        const float rstd = rsqrtf(ss * (1.f / 192.f) + 1e-6f);
        const float sc = which ? 1.f : QSCALE_MLA;
        bf16_t* dst = (which ? K : Q) + ((size_t)bh * 8192 + s0 + row) * 192;
#pragma unroll
        for (int i = 0; i < 4; ++i) {
            const float* g = gn + 32 * j + 8 * i;
            uint4 o;
            o.x = pack2(v[8 * i] * rstd * g[0] * sc, v[8 * i + 1] * rstd * g[1] * sc); o.y = pack2(v[8 * i + 2] * rstd * g[2] * sc, v[8 * i + 3] * rstd * g[3] * sc);
            o.z = pack2(v[8 * i + 4] * rstd * g[4] * sc, v[8 * i + 5] * rstd * g[5] * sc); o.w = pack2(v[8 * i + 6] * rstd * g[6] * sc, v[8 * i + 7] * rstd * g[7] * sc);
            *(uint4*)(dst + 32 * j + 8 * i) = o;
        }
        float o1[8], o2[8];
#pragma unroll
        for (int i = 0; i < 8; ++i) {
            float c, s; rope_cs(pos, 8 * j + i, c, s);
            const float y1 = a1[i] * rstd * gn[128 + 8 * j + i], y2 = a2[i] * rstd * gn[160 + 8 * j + i];
            o1[i] = (y1 * c - y2 * s) * sc; o2[i] = (y2 * c + y1 * s) * sc;
        }
        uint4 w1, w2;
        w1.x = pack2(o1[0], o1[1]); w1.y = pack2(o1[2], o1[3]); w1.z = pack2(o1[4], o1[5]); w1.w = pack2(o1[6], o1[7]);
        w2.x = pack2(o2[0], o2[1]); w2.y = pack2(o2[2], o2[3]); w2.z = pack2(o2[4], o2[5]); w2.w = pack2(o2[6], o2[7]);
        *(uint4*)(dst + 128 + 8 * j) = w1; *(uint4*)(dst + 160 + 8 * j) = w2;
    }
    bf16_t* sT = (bf16_t*)smem;
    {
        const bf16_t* src = KV + m * 1024 + h * 256 + 128 + 32 * j;
#pragma unroll
        for (int i = 0; i < 4; ++i) {
            uint4 u = *(const uint4*)(src + 8 * i);
            const int d0 = 32 * j + 8 * i;
            sT[(d0 + 0) * 66 + row] = (bf16_t)(u.x & 0xffff); sT[(d0 + 1) * 66 + row] = (bf16_t)(u.x >> 16);
            sT[(d0 + 2) * 66 + row] = (bf16_t)(u.y & 0xffff); sT[(d0 + 3) * 66 + row] = (bf16_t)(u.y >> 16);
            sT[(d0 + 4) * 66 + row] = (bf16_t)(u.z & 0xffff); sT[(d0 + 5) * 66 + row] = (bf16_t)(u.z >> 16);
            sT[(d0 + 6) * 66 + row] = (bf16_t)(u.w & 0xffff); sT[(d0 + 7) * 66 + row] = (bf16_t)(u.w >> 16);
        }
    }
    __syncthreads();
    for (int e = tid; e < 128 * 32; e += NTHREADS) {
        const int d = e >> 5, tp = e & 31;
        const unsigned v = (unsigned)sT[d * 66 + 2 * tp] | ((unsigned)sT[d * 66 + 2 * tp + 1] << 16);
        *(unsigned*)(VT + ((size_t)bh * 128 + d) * 8192 + s0 + (((2 * tp) & ~12) | (((2 * tp) & 4) << 1) | (((2 * tp) & 8) >> 1))) = v;
    }
    __syncthreads();
}

template <int DQK, bool MOBA>
DEVI void attn_item(const Params& p, int bh, int qt, char* smem) {
    constexpr int NKS = DQK / 16, KCH = DQK / 8;
    const int tid = threadIdx.x, lane = tid & 63, wave = tid >> 6;
    const int r = lane & 31, hh = lane >> 5;
    char* const ws = opaque_ptr(p.ws);
    const bf16_t* Q  = (const bf16_t*)(ws + (MOBA ? OFF_QD : OFF_Q)) + (size_t)bh * 8192 * DQK;
    const bf16_t* Kg = (const bf16_t*)(ws + (MOBA ? OFF_KD : OFF_K)) + (size_t)bh * 8192 * DQK;
    const bf16_t* Vg = (const bf16_t*)(ws + (MOBA ? OFF_VDT : OFF_VT)) + (size_t)bh * 128 * 8192;
    const int q0 = qt * 128;
    const int qpos = q0 + wave * 32 + r;
    constexpr int KB = 32 * DQK * 2, VB = 8192, STG = KB + VB;
    constexpr int KI = KB / 4096;
    int*  sList = (int*)(smem + 61440);
    unsigned* sSel = (unsigned*)(smem + 62464);
    float* sTop = (float*)(smem + 63232);
    int ntiles;
    unsigned mysel = 0xffffffffu;
    if constexpr (MOBA) {
        const int jblk = q0 >> 8;
        float* sKm = (float*)smem;
        const float* km = (const float*)(ws + OFF_KMEAN) + (size_t)bh * 32 * 128;
        for (int e = tid; e < 1024; e += NTHREADS) ((float4*)sKm)[e] = ((const float4*)km)[e];
        unsigned* sAny = (unsigned*)(smem + 62976);
        if (tid < 32) sAny[tid] = 0u;
        __syncthreads();
        const int qq = tid & 127, par = tid >> 7;
        float ga[16];
#pragma unroll
        for (int i = 0; i < 16; ++i) ga[i] = 0.f;
        const bf16_t* qrow = Q + (size_t)(q0 + qq) * 128;
#pragma unroll 1
        for (int d0 = 0; d0 < 128; d0 += 8) {
            uint4 u = *(const uint4*)(qrow + d0);
            float qv[8] = {bflo(u.x), bfhi(u.x), bflo(u.y), bfhi(u.y), bflo(u.z), bfhi(u.z), bflo(u.w), bfhi(u.w)};
#pragma unroll
            for (int i = 0; i < 16; ++i) {
                const float4 ka = *(const float4*)(sKm + (2 * i + par) * 128 + d0), kb = *(const float4*)(sKm + (2 * i + par) * 128 + d0 + 4);
                ga[i] += qv[0] * ka.x + qv[1] * ka.y + qv[2] * ka.z + qv[3] * ka.w + qv[4] * kb.x + qv[5] * kb.y + qv[6] * kb.z + qv[7] * kb.w;
            }
        }
        float tv[3] = {-3e38f, -3e38f, -3e38f}; int ti[3] = {-1, -1, -1};
#pragma unroll
        for (int i = 0; i < 16; ++i) {
            const int n = 2 * i + par;
            if (n < jblk) {
                const float v = ga[i];
                if (v > tv[0]) { tv[2] = tv[1]; ti[2] = ti[1]; tv[1] = tv[0]; ti[1] = ti[0]; tv[0] = v; ti[0] = n; }
                else if (v > tv[1]) { tv[2] = tv[1]; ti[2] = ti[1]; tv[1] = v; ti[1] = n; }
                else if (v > tv[2]) { tv[2] = v; ti[2] = n; }
            }
        }
#pragma unroll
        for (int i = 0; i < 3; ++i) { sTop[tid * 6 + 2 * i] = tv[i]; sTop[tid * 6 + 2 * i + 1] = __int_as_float(ti[i]); }
        __syncthreads();
        if (par == 0) {
#pragma unroll
            for (int i = 0; i < 3; ++i) {
                const float v = sTop[(tid + 128) * 6 + 2 * i]; const int n = __float_as_int(sTop[(tid + 128) * 6 + 2 * i + 1]);
                if (n >= 0) {
                    if (v > tv[0]) { tv[2] = tv[1]; ti[2] = ti[1]; tv[1] = tv[0]; ti[1] = ti[0]; tv[0] = v; ti[0] = n; }
                    else if (v > tv[1]) { tv[2] = tv[1]; ti[2] = ti[1]; tv[1] = v; ti[1] = n; }
                    else if (v > tv[2]) { tv[2] = v; ti[2] = n; }
                }
            }
            unsigned m = 1u << jblk;
#pragma unroll
            for (int i = 0; i < 3; ++i) if (ti[i] >= 0) { m |= 1u << ti[i]; sAny[ti[i]] = 1u; }
            sSel[qq] = m;
        }
        __syncthreads();
        if (tid == 0) {
            int n = 0;
            for (int blk = 0; blk < jblk; ++blk) if (sAny[blk]) { for (int t = 0; t < 8; ++t) sList[n++] = blk * 8 + t; }
            for (int t = jblk * 8; t < (q0 + 128) / 32; ++t) sList[n++] = t;
            sSel[160] = (unsigned)n;
        }
        __syncthreads();
        ntiles = (int)sSel[160];
        mysel = sSel[wave * 32 + r];
        __syncthreads();
    } else {
        ntiles = 4 * qt + 4;
    }
    bf16x8 qf[NKS];
#pragma unroll
    for (int ks = 0; ks < NKS; ++ks) qf[ks] = *(const bf16x8*)(Q + (size_t)qpos * DQK + ks * 16 + hh * 8);
    f32x16 o[4];
#pragma unroll
    for (int dt = 0; dt < 4; ++dt)
#pragma unroll
        for (int e = 0; e < 16; ++e) o[dt][e] = 0.f;
    float lsum = 0.f;
    int koff[KI], voff[2];
#pragma unroll
    for (int i = 0; i < KI; ++i) {
        const int L = (wave * KI + i) * 64 + lane, row = L / KCH, cp = L % KCH;
        const int f = (DQK == 128) ? (row & 15) : ((row >> 1) & 7);
        koff[i] = row * DQK + (cp ^ f) * 8;
    }
#pragma unroll
    for (int i = 0; i < 2; ++i) {
        const int L = (wave * 2 + i) * 64 + lane, dv = L >> 2, cp = L & 3;
        voff[i] = dv * 8192 + (cp ^ ((dv >> 2) & 3)) * 8;
    }
    const int wv = __builtin_amdgcn_readfirstlane(wave);
#define ATT_ISSUE(LI) { const int u_ = tile_id(LI); char* st_ = smem + ((LI) % 3) * STG; \
        _Pragma("unroll") for (int i = 0; i < KI; ++i) __builtin_amdgcn_global_load_lds((const unsigned*)(Kg + (size_t)u_ * 32 * DQK + koff[i]), (unsigned*)(st_ + (wv * KI + i) * 1024), 16, 0, 0); \
        _Pragma("unroll") for (int i = 0; i < 2; ++i)  __builtin_amdgcn_global_load_lds((const unsigned*)(Vg + (size_t)u_ * 32 + voff[i]),       (unsigned*)(st_ + KB + (wv * 2 + i) * 1024), 16, 0, 0); }
    auto tile_id = [&](int li) -> int { if constexpr (MOBA) return sList[li]; else return li; };
    if (ntiles > 0) ATT_ISSUE(0)
    if (ntiles > 1) ATT_ISSUE(1)
    const int xk = ((DQK == 128) ? (r & 15) : ((r >> 1) & 7)) ^ hh;
    const int xv = (r >> 2) & 3;
#pragma unroll 1
    for (int li = 0; li < ntiles; ++li) {
        if (li + 1 < ntiles) asm volatile("s_waitcnt vmcnt(%0)" :: "n"(KI + 2) : "memory");
        else asm volatile("s_waitcnt vmcnt(0)" ::: "memory");
        G2_RAW_BARRIER();
        if (li + 2 < ntiles) ATT_ISSUE(li + 2)
        const int unit = tile_id(li);
        const int kbase = unit * 32;
        bool allowed = true;
        if constexpr (MOBA) allowed = (mysel >> (unit >> 3)) & 1u;
        const char* sK = smem + (li % 3) * STG;
        const char* sV = sK + KB;
        if (kbase <= q0 + wave * 32 + 31) {
            const char* kbase_l = sK + r * (DQK * 2);
            const char* vbase_l = sV + r * 64;
            f32x16 s;
#pragma unroll
            for (int e = 0; e < 16; ++e) s[e] = 0.f;
#pragma unroll
            for (int ks = 0; ks < NKS; ++ks) {
                const bf16x8 a = *(const bf16x8*)(kbase_l + (((2 * ks) ^ xk) << 4));
                s = mfma32(a, qf[ks], s);
            }
            const bool need_mask = (kbase + 31 > q0 + wave * 32);
            float pr[16];
            if (need_mask) {
                const int kofs = qpos - kbase - 4 * hh;
#pragma unroll
                for (int e = 0; e < 16; ++e) pr[e] = ((e & 3) + 8 * (e >> 2) <= kofs) ? __builtin_amdgcn_exp2f(s[e]) : 0.f;
            } else {
#pragma unroll
                for (int e = 0; e < 16; ++e) pr[e] = __builtin_amdgcn_exp2f(s[e]);
            }
            if constexpr (MOBA) {
                const float am = allowed ? 1.f : 0.f;
#pragma unroll
                for (int e = 0; e < 16; ++e) pr[e] *= am;
            }
            lsum += ((pr[0] + pr[1]) + (pr[2] + pr[3])) + ((pr[4] + pr[5]) + (pr[6] + pr[7])) + ((pr[8] + pr[9]) + (pr[10] + pr[11])) + ((pr[12] + pr[13]) + (pr[14] + pr[15]));
#pragma unroll
            for (int s2 = 0; s2 < 2; ++s2) {
                const u32x4 pbu = {pack2(pr[8 * s2 + 0], pr[8 * s2 + 1]), pack2(pr[8 * s2 + 2], pr[8 * s2 + 3]),
                                   pack2(pr[8 * s2 + 4], pr[8 * s2 + 5]), pack2(pr[8 * s2 + 6], pr[8 * s2 + 7])};
                const bf16x8 pbv = __builtin_bit_cast(bf16x8, pbu);
#pragma unroll
                for (int dt = 0; dt < 4; ++dt) {
                    const char* vb = vbase_l + dt * (32 * 64);
                    const u32x4 vau = *(const u32x4*)(vb + (((2 * s2 + hh) ^ xv) << 4));
                    o[dt] = mfma32(__builtin_bit_cast(bf16x8, vau), pbv, o[dt]);
                }
            }
        }
    }
#undef ATT_ISSUE
    G2_RAW_BARRIER();
    lsum += __shfl_xor(lsum, 32);
    const float inv = 1.f / lsum;
    char* sO = smem + wave * 8704;
#pragma unroll
    for (int dt = 0; dt < 4; ++dt)
#pragma unroll
        for (int e = 0; e < 16; e += 2) {
            const int dv = 32 * dt + (e & 3) + 8 * (e >> 2) + 4 * hh;
            *(unsigned*)(sO + r * 272 + dv * 2) = pack2(o[dt][e] * inv, o[dt][e + 1] * inv);
        }
    __builtin_amdgcn_s_waitcnt(0xc07f);
    __builtin_amdgcn_wave_barrier();
    bf16_t* MIX = (bf16_t*)(ws + OFF_MIX1);
    const int b = bh >> 2, h = bh & 3;
#pragma unroll
    for (int i = 0; i < 8; ++i) {
        const int id = lane + 64 * i, row = id >> 4, cc = id & 15;
        const uint4 v = *(const uint4*)(sO + row * 272 + cc * 16);
        *(uint4*)(MIX + ((size_t)b * 8192 + q0 + wave * 32 + row) * 1024 + (MOBA ? 512 : 0) + h * 128 + cc * 8) = v;
    }
    __syncthreads();
}

DEVI void attn_phase_all(const Params& p, char* smem) {
    const int G = gridDim.x;
#pragma unroll 1
    for (int v = blockIdx.x; v < 512; v += G) attn_item<192, false>(p, v & 7, 63 - (v >> 3), smem);
    __builtin_amdgcn_sched_barrier(0);
#pragma unroll 1
    for (int v = blockIdx.x; v < 512; v += G) attn_item<128, true>(p, v & 7, (v >> 3), smem);
}

#define XB_TMO      128
#define XB_XCNT(j)  (256  + 64 * (j))
#define XB_XSUB(j)  (1280 + 64 * (j))
#define XB_XGEN(j)  (2304 + 64 * (j))
#define XB_TOP      3328
#define XB_TOPGEN   3392
#define XCD_BAR_WORDS 3456
#define XB_SPIN_CAP (1u << 23)
#define LAS __attribute__((address_space(3)))
DEVI unsigned xb_ld(unsigned* p)              { return __hip_atomic_load(p, __ATOMIC_RELAXED, __HIP_MEMORY_SCOPE_AGENT); }
DEVI unsigned xb_add(unsigned* p, unsigned v) { return __hip_atomic_fetch_add(p, v, __ATOMIC_RELAXED, __HIP_MEMORY_SCOPE_AGENT); }
DEVI unsigned xb_xcc_id() { return (unsigned)__builtin_amdgcn_s_getreg((3 << 11) | 20) & 0xFu; }
#define XB_SPIN(cond, bar) do { unsigned _sp = 0; while (cond) { __builtin_amdgcn_s_sleep(1); \
    if ((++_sp & 255u) == 0u) { if (xb_ld(&(bar)[XB_TMO])) break; if (_sp > XB_SPIN_CAP) { atomicAdd(&(bar)[XB_TMO], 1u); break; } } } } while (0)
struct XcdBarrier { unsigned* bar; unsigned x; volatile LAS unsigned* st; };
DEVI XcdBarrier xcd_barrier_post(unsigned* bar, volatile LAS unsigned* st) {
    XcdBarrier b; b.bar = bar; b.x = xb_xcc_id(); b.st = st;
    if (threadIdx.x == 0) st[2] = xb_add(&bar[XB_XCNT(b.x)], 1u);
    return b;
}
DEVI void xcd_barrier_complete(unsigned* bar, unsigned x, unsigned& nloc, unsigned& nx, unsigned& dense) {
    const unsigned G = gridDim.x * gridDim.y * gridDim.z;
    unsigned sum, cnt, mine, sp = 0u;
    for (;;) {
        sum = 0u; cnt = 0u; mine = 0u; dense = 0u;
#pragma unroll
        for (unsigned j = 0; j < 16; ++j) { const unsigned c = xb_ld(&bar[XB_XCNT(j)]); sum += c; cnt += (c > 0u) ? 1u : 0u; mine = (j == x) ? c : mine; dense += (j < x && c > 0u) ? 1u : 0u; }
        if (sum == G) break;
        __builtin_amdgcn_s_sleep(1);
        if ((++sp & 255u) == 0u) { if (xb_ld(&bar[XB_TMO])) break; if (sp > XB_SPIN_CAP) { atomicAdd(&bar[XB_TMO], 1u); break; } }
    }
    nloc = mine > 0u ? mine : 1u; nx = cnt > 0u ? cnt : 1u;
}
DEVI void xcd_barrier(const XcdBarrier& b) {
    asm volatile("s_waitcnt vmcnt(0)" ::: "memory");
    __syncthreads();
    if (threadIdx.x == 0) {
        unsigned* bar = b.bar;
        __builtin_amdgcn_s_waitcnt(0);
        unsigned nloc = b.st[0], nx = b.st[1];
        if (nloc == 0u) { unsigned dense = 0u; xcd_barrier_complete(bar, b.x, nloc, nx, dense); b.st[0] = nloc; b.st[1] = nx; b.st[3] = dense; }
        const unsigned old = xb_add(&bar[XB_XSUB(b.x)], 1u);
        const unsigned gen = old / nloc;
        if (old + 1u == (gen + 1u) * nloc) {
            __builtin_amdgcn_fence(__ATOMIC_RELEASE, "agent");
            asm volatile("s_waitcnt vmcnt(0)" ::: "memory");
            const unsigned og = xb_add(&bar[XB_TOP], 1u);
            const unsigned tg = og / nx;
            if (og + 1u == (tg + 1u) * nx) xb_add(&bar[XB_TOPGEN], 1u);
            else XB_SPIN(xb_ld(&bar[XB_TOPGEN]) == tg, bar);
            __builtin_amdgcn_fence(__ATOMIC_ACQUIRE, "agent");
            xb_add(&bar[XB_XGEN(b.x)], 1u);
            asm volatile("s_waitcnt vmcnt(0)" ::: "memory");
        } else {
            XB_SPIN(xb_ld(&bar[XB_XGEN(b.x)]) == gen, bar);
            __builtin_amdgcn_fence(__ATOMIC_ACQUIRE, "agent");
            asm volatile("s_waitcnt vmcnt(0)" ::: "memory");
        }
    }
    __syncthreads();
}

enum { PH_CONV, PH_INPROJ0, PH_LOCAL, PH_SCAN, PH_HOUT, PH_OUTPROJ0, PH_Q0, PH_TOPK0, PH_PD0, PH_PR0, PH_PU0, PH_INPROJ1, PH_SMALL, PH_MLAPREP, PH_MLA,
       PH_OUTPROJ1, PH_Q1, PH_TOPK1, PH_PD1, PH_PR1, PH_PU1, N_PHASES };
DEVI void run_phase(const Params& p, int ph_in, char* smem, Placement pl) {
    const bool dup = ph_in >= 100; const int ph = dup ? ph_in - 100 : ph_in;
#ifdef ONLY_PHASE
    if (ph != ONLY_PHASE) return;
#endif
    char* ws = p.ws;
    const int bid = blockIdx.x, nb = gridDim.x;
    const int myslice = (pl.nloc > 0) ? (pl.xcc & 7) : (bid & 7);
    switch (ph) {
    case PH_CONV: phase_convert(p, smem); break;
    case PH_INPROJ0: gemm2_phase((const bf16_t*)(ws + OFF_XB), 1024, (const bf16_t*)(ws + OFF_W_IN0T), 128, 12, 1024, (const float*)(ws + OFF_SSQ1), 1,
                        Epi2In0{(bf16_t*)(ws + OFF_Z0), (float*)(ws + OFF_G), (const float*)(ws + OFF_LB), (bf16_t*)(ws + OFF_Z0), 3072, 3072, nullptr, nullptr}, smem, pl); break;
    case PH_LOCAL: for (int it = bid; it < 1024; it += nb) hgrn_local_item(p, it, smem);
            for (int it = nb - 1 - bid; it < 512; it += nb) gmlp_item(p, it, smem);
            break;
    case PH_SCAN: hgrn_scan_phase(p); break;
    case PH_HOUT: for (int it = bid; it < 1024; it += nb) hgrn_out_item(p, it, smem); break;
    case PH_OUTPROJ0: case PH_OUTPROJ1: {
        const bool l1 = (ph == PH_OUTPROJ1);
        gemm2_phase((const bf16_t*)(ws + (l1 ? OFF_MIX1 : OFF_MIX0)), 1024, (const bf16_t*)(ws + (l1 ? OFF_W_OUT1T : OFF_W_OUT0T)), 128, 4, 1024, nullptr, 0,
                    Epi2Resid{(bf16_t*)(ws + OFF_XB), (float*)(ws + OFF_SSQ16), dup ? 0.f : (l1 ? ALPHA_M1 : ALPHA_M0), nullptr, 0, 0, nullptr, nullptr}, smem, pl);
    } break;
    case PH_Q0: case PH_Q1: {
        const bool l1 = (ph == PH_Q1);
        gemm2_phase((const bf16_t*)(ws + OFF_XB), 1024, (const bf16_t*)(ws + (l1 ? OFF_W_Q1T : OFF_W_Q0T)), 128, 8, 1024, (const float*)(ws + OFF_SSQ16), 16,
                    Epi2Bf16{dup ? (bf16_t*)nullptr : (bf16_t*)(ws + OFF_QP), 2048, 2048, nullptr, nullptr}, smem, pl);
    } break;
    case PH_TOPK0: case PH_TOPK1: peer_topk_phase(p, (const bf16_t*)(ws + (ph == PH_TOPK1 ? OFF_SK1 : OFF_SK0)), bid, nb, smem); break;
    case PH_PD0: case PH_PD1: peer_down_phase(p, (ph == PH_PD1) ? p.l1_norm_ffn : p.l0_norm_ffn, ((ph == PH_PD1) ? 16 : 0) + (dup ? 32 : 0), myslice, smem); break;
    case PH_PR0: case PH_PR1: peer_reduce_phase(p); break;
    case PH_PU0: case PH_PU1: peer_up_phase(p, ((ph == PH_PU1) ? 24 : 8) + (dup ? 32 : 0), myslice, dup ? 0.f : ((ph == PH_PU1) ? ALPHA_P1 : ALPHA_P0), (ph == PH_PU1 && !dup) ? p.out : nullptr, smem); break;
    case PH_INPROJ1: gemm2_phase((const bf16_t*)(ws + OFF_XB), 1024, (const bf16_t*)(ws + OFF_W_IN1T), 128, 8, 1024, (const float*)(ws + OFF_SSQ8), 8, Epi2Bf16{(bf16_t*)(ws + OFF_Z1), 1984, 1984, (float*)(ws + OFF_SSQCQ), (float*)(ws + OFF_SSQCKV)}, smem, pl);
            for (int it = bid; it < 8192; it += nb) conv_experts(p.l1_exp_down, p.l1_exp_up, p.l1_norm_ffn, ws, it);
            break;
    case PH_SMALL: {
        gemm2_phase((const bf16_t*)(ws + OFF_Z1), 1984, (const bf16_t*)(ws + OFF_W_UQT), 128, 3, 256, (const float*)(ws + OFF_SSQCQ), 1, Epi2Bf16{(bf16_t*)(ws + OFF_QC), 768, 768, nullptr, nullptr}, smem, pl);
        gemm2_phase((const bf16_t*)(ws + OFF_Z1) + 256, 1984, (const bf16_t*)(ws + OFF_W_UKVT), 128, 4, 128, (const float*)(ws + OFF_SSQCKV), 1, Epi2Bf16{(bf16_t*)(ws + OFF_KV), 1024, 1024, nullptr, nullptr}, smem, pl);
        for (int it = (bid + nb / 2) % nb; it < 1024 + 256; it += nb) { if (it < 1024) moba_prep_item(p, it, smem); else moba_kmean_item(p, it - 1024, smem); }
    } break;
    case PH_MLAPREP: for (int it = bid; it < 1024; it += nb) mla_prep_item(p, it, smem); break;
    case PH_MLA: attn_phase_all(p, smem); break;
    default: break;
    }
}

extern "C" __global__ void __launch_bounds__(NTHREADS, 2) fwd_kernel(Params p) {
    extern __shared__ __attribute__((aligned(16))) char smem[];
    __shared__ uint4 xb_words;
    XcdBarrier xb; xb.bar = nullptr; xb.x = 0; xb.st = (volatile LAS unsigned*)&xb_words;
    if (p.coop) {
        if (threadIdx.x == 0) xb_words = make_uint4(0u, 0u, 0u, 0u);
        __syncthreads();
        xb = xcd_barrier_post((unsigned*)(p.ws + OFF_BAR), (volatile LAS unsigned*)&xb_words);
    }
    if (p.coop == 2) cg::this_grid().sync();
    long long tp0 = 0, tp1 = 0;
#define RUN_PH(PH) if (p.ph_lo <= PH && PH < p.ph_hi) { \
        Placement pl_; pl_.xcc = p.coop ? (int)xb.st[3] : 0; pl_.rank = p.coop ? (int)xb.st[2] : 0; pl_.nloc = p.coop ? (int)xb.st[0] : 0; pl_.nx = p.coop ? (int)xb.st[1] : 0; \
        if (PROBE_DUP == PH) { run_phase(p, PH + 100, smem, pl_); if (p.coop) xcd_barrier(xb); } \
        if (PROBE_TIME == PH) tp0 = wall_clock64(); \
        run_phase(p, PH, smem, pl_); if (p.coop && PH + 1 < p.ph_hi) xcd_barrier(xb); \
        if (PROBE_TIME == PH) tp1 = wall_clock64(); }
    RUN_PH(0) RUN_PH(1) RUN_PH(2) RUN_PH(3) RUN_PH(4) RUN_PH(5) RUN_PH(6) RUN_PH(7) RUN_PH(8) RUN_PH(9)
    RUN_PH(10) RUN_PH(11) RUN_PH(12) RUN_PH(13) RUN_PH(14) RUN_PH(15) RUN_PH(16) RUN_PH(17) RUN_PH(18) RUN_PH(19) RUN_PH(20)
    if (PROBE_TIME >= 0) { const long long te = wall_clock64(), dt = (tp1 - tp0) * PROBE_TIME_K; while (wall_clock64() - te < dt) __builtin_amdgcn_s_sleep(20); }
}

extern "C" void kernel_launch(void* const* d_in, const int* in_sizes, int n_in, void* d_out, int out_size, void* d_ws, size_t ws_size, hipStream_t stream) {
    static int grid = 0;
    if (grid == 0) {
        if (n_in != 31 || out_size != 16384 * 1024 || ws_size < WS_NEED) { fprintf(stderr, "kernel_launch: unexpected shapes (n_in %d out %d ws %zu need %zu)\n", n_in, out_size, ws_size, (size_t)WS_NEED); grid = -1; return; }
        int dev = 0, cus = 0, per_cu = 0;
        hipGetDevice(&dev);
        hipDeviceGetAttribute(&cus, hipDeviceAttributeMultiprocessorCount, dev);
        if (hipFuncSetAttribute((const void*)fwd_kernel, hipFuncAttributeMaxDynamicSharedMemorySize, LDS_BYTES) != hipSuccess) { fprintf(stderr, "kernel_launch: hipFuncSetAttribute failed\n"); grid = -1; return; }
        if (hipOccupancyMaxActiveBlocksPerMultiprocessor(&per_cu, (const void*)fwd_kernel, NTHREADS, LDS_BYTES) != hipSuccess || per_cu < 1) { fprintf(stderr, "kernel_launch: occupancy query failed (%d)\n", per_cu); per_cu = 1; }
        (void)hipGetLastError();
        if (per_cu > 2) per_cu = 2;
        grid = cus * per_cu;
        fprintf(stderr, "kernel_launch: grid %d (%d CUs x %d)\n", grid, cus, per_cu);
    }
    if (grid < 0) return;
    Params p; memset(&p, 0, sizeof(p));
    const float* const* f = (const float* const*)d_in;
    p.x = f[0]; p.pos = (const int*)d_in[1]; p.lb_logits = f[2];
    p.l0_norm_mix = f[3]; p.l0_w_in = f[4]; p.l0_hgrn_out_norm = f[5]; p.l0_gmlp_v_norm = f[6]; p.l0_gmlp_w_s = f[7]; p.l0_gmlp_b_s = f[8]; p.l0_w_out = f[9];
    p.l0_norm_ffn = f[10]; p.l0_w_query = f[11]; p.l0_sub_keys = f[12]; p.l0_exp_down = f[13]; p.l0_exp_up = f[14];
    p.l1_norm_mix = f[15]; p.l1_w_in = f[16]; p.l1_cq_norm = f[17]; p.l1_ckv_norm = f[18]; p.l1_w_uq = f[19]; p.l1_w_ukv = f[20];
    p.l1_q_norm = f[21]; p.l1_k_norm = f[22]; p.l1_mq_norm = f[23]; p.l1_mk_norm = f[24]; p.l1_w_out = f[25];
    p.l1_norm_ffn = f[26]; p.l1_w_query = f[27]; p.l1_sub_keys = f[28]; p.l1_exp_down = f[29]; p.l1_exp_up = f[30];
    p.out = (float*)d_out; p.ws = (char*)d_ws;
    if (hipMemsetAsync((char*)d_ws + OFF_BAR, 0, 16384 + 4096, stream) != hipSuccess) { fprintf(stderr, "kernel_launch: memset failed\n"); return; }
#if N_LAUNCH_MODE == 1
    p.ph_lo = 0; p.ph_hi = N_PHASES; p.coop = 1;
    void* args[] = {&p};
    hipError_t e = hipLaunchCooperativeKernel((const void*)fwd_kernel, dim3(grid), dim3(NTHREADS), args, LDS_BYTES, stream);
    if (e != hipSuccess) fprintf(stderr, "cooperative launch failed: %s (grid %d)\n", hipGetErrorString(e), grid);
#else
    for (int ph = 0; ph < N_PHASES; ++ph) {
#ifdef ABLATE_M1
        if (ph >= 10 && ph <= 14) continue;
#endif
        p.ph_lo = ph; p.ph_hi = ph + 1; p.coop = 0;
        hipLaunchKernelGGL(fwd_kernel, dim3(grid), dim3(NTHREADS), LDS_BYTES, stream, p);
    }
#endif
}
```

```cpp
#include <hip/hip_runtime.h>
#include <hip/hip_cooperative_groups.h>
#include <stdint.h>
#include <stdio.h>
#include <string.h>
namespace cg = cooperative_groups;

#ifndef ALPHA_P0
#define ALPHA_P0 1.0f
#endif
#ifndef ALPHA_P1
#define ALPHA_P1 1.0f
#endif
#ifndef ALPHA_M0
#define ALPHA_M0 1.0f
#endif
#ifndef ALPHA_M1
#define ALPHA_M1 1.0f
#endif
#define PROBE_TIME -1
#define PROBE_TIME_K 4
#ifndef PROBE_NOMMA
#define PROBE_NOMMA 0
#endif
#ifndef PROBE_DUP
#define PROBE_DUP -1
#endif
#ifndef N_LAUNCH_MODE
#define N_LAUNCH_MODE 1
#endif

typedef unsigned short bf16_t;
using bf16x8 = __attribute__((ext_vector_type(8))) short;
using f32x4  = __attribute__((ext_vector_type(4))) float;
using f32x16 = __attribute__((ext_vector_type(16))) float;
typedef float f32x4v __attribute__((ext_vector_type(4)));
typedef float f32x2_t __attribute__((ext_vector_type(2)));
typedef __bf16 bf16x2_t __attribute__((ext_vector_type(2)));
typedef unsigned u32x4 __attribute__((ext_vector_type(4)));

#define DEVI __device__ __forceinline__
#define NTHREADS 256
#define LDS_BYTES 80896

static constexpr size_t MB = 1024 * 1024;
static constexpr size_t OFF_W_IN0T  = 0;
static constexpr size_t OFF_W_OUT0T = OFF_W_IN0T  + 3072ull * 1024 * 2;
static constexpr size_t OFF_W_Q0T   = OFF_W_OUT0T + 1024ull * 1024 * 2;
static constexpr size_t OFF_SK0     = OFF_W_Q0T   + 2048ull * 1024 * 2;
static constexpr size_t OFF_WS0     = OFF_SK0     + 262144ull * 2;
static constexpr size_t OFF_W_IN1T  = OFF_WS0     + 65536ull * 2;
static constexpr size_t OFF_W_UQT   = OFF_W_IN1T  + 2048ull * 1024 * 2;
static constexpr size_t OFF_W_UKVT  = OFF_W_UQT   + 768ull * 256 * 2;
static constexpr size_t OFF_W_OUT1T = OFF_W_UKVT  + 1024ull * 128 * 2;
static constexpr size_t OFF_W_Q1T   = OFF_W_OUT1T + 1024ull * 1024 * 2;
static constexpr size_t OFF_SK1     = OFF_W_Q1T   + 2048ull * 1024 * 2;
static constexpr size_t OFF_LB      = OFF_SK1     + 262144ull * 2;
static constexpr size_t OFF_INVD    = OFF_LB + 4096;
static constexpr size_t OFF_INVU    = OFF_INVD + 65536;
static constexpr size_t OFF_BAR     = OFF_INVU + 65536;
static constexpr size_t OFF_QCNT    = OFF_BAR + 14336;
static constexpr size_t OFF_ED      = 26 * MB;
static constexpr size_t OFF_EU      = OFF_ED + 32 * MB;
static constexpr size_t OFF_ACT     = OFF_EU + 32 * MB;
static constexpr size_t OFF_Z0   = OFF_ACT;
static constexpr size_t OFF_G    = OFF_Z0  + 16384ull * 3072 * 2;
static constexpr size_t OFF_HST  = OFF_G   + 16384ull * 512 * 4;
static constexpr size_t OFF_DEC  = OFF_HST + 1024ull * 16384 * 4;
static constexpr size_t OFF_MIX0 = OFF_DEC + 1024ull * 128 * 4;
static constexpr size_t OFF_QP   = OFF_ACT;
static constexpr size_t OFF_IDX  = OFF_QP  + 16384ull * 2048 * 2;
static constexpr size_t OFF_GATE = OFF_IDX + 16384ull * 128 * 4;
static constexpr size_t OFF_ACTW = OFF_GATE + 16384ull * 128 * 4;
static constexpr size_t OFF_PART = OFF_QP;
static constexpr size_t OFF_SDN  = OFF_ACTW + 16384ull * 128 * 4;
static constexpr size_t OFF_UREC = OFF_SDN + 16384ull * 128 * 4;
static constexpr size_t OFF_Z1   = OFF_ACT;
static constexpr size_t OFF_MIX1 = OFF_ACT;
static constexpr size_t OFF_QC   = OFF_Z1  + 16384ull * 1984 * 2;
static constexpr size_t OFF_KV   = OFF_QC  + 16384ull * 768 * 2;
static constexpr size_t OFF_QD   = OFF_KV  + 16384ull * 1024 * 2;
static constexpr size_t OFF_KD   = OFF_QD  + 16384ull * 512 * 2;
static constexpr size_t OFF_VDT  = OFF_KD  + 16384ull * 512 * 2;
static constexpr size_t OFF_Q    = OFF_VDT + 16384ull * 512 * 2;
static constexpr size_t OFF_K    = OFF_Q   + 16384ull * 768 * 2;
static constexpr size_t OFF_VT   = OFF_K   + 16384ull * 768 * 2;
static constexpr size_t OFF_KMEAN= OFF_VT  + 16384ull * 512 * 2;
static constexpr size_t WS_END_L1 = OFF_KMEAN + 8ull * 32 * 128 * 4;
static constexpr size_t WS_END_L0 = OFF_MIX0 + 16384ull * 1024 * 2;
static constexpr size_t WS_END_ACT = (WS_END_L1 > WS_END_L0 ? WS_END_L1 : WS_END_L0);
static constexpr size_t OFF_XB    = (WS_END_ACT + 255) / 256 * 256;
static constexpr size_t OFF_SSQ1  = OFF_XB + 16384ull * 1024 * 2;
static constexpr size_t OFF_SSQ16 = OFF_SSQ1 + 16384ull * 4;
static constexpr size_t OFF_SSQ8  = OFF_SSQ16 + 16384ull * 16 * 4;
static constexpr size_t OFF_XB8   = OFF_ED + 16 * MB;
static constexpr size_t OFF_SSQCQ = OFF_SSQ8 + 16384ull * 8 * 4;
static constexpr size_t OFF_SSQCKV = OFF_SSQCQ + 16384ull * 4;
static constexpr size_t WS_NEED = OFF_SSQCKV + 16384ull * 4;
static_assert(OFF_BAR + 16384 + 4096 <= OFF_ED, "weights overflow");

struct Params {
    const float* x; const int* pos; const float* lb_logits;
    const float *l0_norm_mix, *l0_w_in, *l0_hgrn_out_norm, *l0_gmlp_v_norm, *l0_gmlp_w_s, *l0_gmlp_b_s, *l0_w_out,
                *l0_norm_ffn, *l0_w_query, *l0_sub_keys, *l0_exp_down, *l0_exp_up;
    const float *l1_norm_mix, *l1_w_in, *l1_cq_norm, *l1_ckv_norm, *l1_w_uq, *l1_w_ukv, *l1_q_norm, *l1_k_norm,
                *l1_mq_norm, *l1_mk_norm, *l1_w_out, *l1_norm_ffn, *l1_w_query, *l1_sub_keys, *l1_exp_down, *l1_exp_up;
    float* out;
    char* ws;
    int ph_lo, ph_hi, coop, pad0;
};

DEVI unsigned pack2(float lo, float hi) { f32x2_t v = {lo, hi}; bf16x2_t b = __builtin_convertvector(v, bf16x2_t); return __builtin_bit_cast(unsigned, b); }
DEVI bf16_t f2bf(float f) { return (bf16_t)(pack2(f, 0.f) & 0xffffu); }
DEVI float bf2f(bf16_t h) { return __uint_as_float(((unsigned)h) << 16); }
DEVI float bflo(unsigned u) { return __uint_as_float(u << 16); }
DEVI float bfhi(unsigned u) { return __uint_as_float(u & 0xffff0000u); }
#define DPP_F(V, CTRL) __builtin_bit_cast(float, __builtin_amdgcn_update_dpp(0, __builtin_bit_cast(int, (V)), (CTRL), 0xF, 0xF, true))
DEVI float wave_sum_dpp(float v) {
    v += DPP_F(v, 0xB1);
    v += DPP_F(v, 0x4E);
    v += DPP_F(v, 0x141);
    v += DPP_F(v, 0x140);
    return __builtin_bit_cast(float, __builtin_amdgcn_readlane(__builtin_bit_cast(int, v), 0)) + __builtin_bit_cast(float, __builtin_amdgcn_readlane(__builtin_bit_cast(int, v), 16))
         + __builtin_bit_cast(float, __builtin_amdgcn_readlane(__builtin_bit_cast(int, v), 32)) + __builtin_bit_cast(float, __builtin_amdgcn_readlane(__builtin_bit_cast(int, v), 48));
}
DEVI float wave_max_dpp(float v) {
    v = fmaxf(v, DPP_F(v, 0xB1)); v = fmaxf(v, DPP_F(v, 0x4E)); v = fmaxf(v, DPP_F(v, 0x141)); v = fmaxf(v, DPP_F(v, 0x140));
    return fmaxf(fmaxf(__builtin_bit_cast(float, __builtin_amdgcn_readlane(__builtin_bit_cast(int, v), 0)), __builtin_bit_cast(float, __builtin_amdgcn_readlane(__builtin_bit_cast(int, v), 16))),
                 fmaxf(__builtin_bit_cast(float, __builtin_amdgcn_readlane(__builtin_bit_cast(int, v), 32)), __builtin_bit_cast(float, __builtin_amdgcn_readlane(__builtin_bit_cast(int, v), 48))));
}
DEVI float sigm(float x) { return 1.f / (1.f + __expf(-x)); }
DEVI float gelu_tanh(float x) {
    float y = 0.7978845608028654f * (x + 0.044715f * x * x * x);
    float e = __expf(2.f * y);
    float t = 1.f - 2.f / (1.f + e);
    return 0.5f * x * (1.f + t);
}
DEVI char* opaque_ptr(char* q) { asm volatile("" : "+s"(q)); return q; }
DEVI f32x4  mfma16(bf16x8 a, bf16x8 b, f32x4 c)  { return __builtin_amdgcn_mfma_f32_16x16x32_bf16(a, b, c, 0, 0, 0); }
DEVI f32x16 mfma32(bf16x8 a, bf16x8 b, f32x16 c) { return __builtin_amdgcn_mfma_f32_32x32x16_bf16(a, b, c, 0, 0, 0); }

template <int KW> DEVI int swz_off(int row, int c) {
    if constexpr (KW == 128) return row * 256 + ((c ^ (row & 15)) << 4);
    else return row * (KW * 2) + ((c ^ ((row >> 1) & 7)) << 4);
}
template <int KW> DEVI int swz_elem(int row, int k) { return swz_off<KW>(row, k >> 3) + ((k & 7) << 1); }

template <int MT, int NT, int KWA, int KWB>
DEVI void mma_nt(f32x4 (&acc)[MT][NT], const char* A, int a_row0, const char* B, int b_row0, int kc0, int nks, int lane) {
    const int r = lane & 15, q = lane >> 4;
#pragma unroll 1
    for (int ks = 0; ks < nks; ++ks) {
        bf16x8 a[MT], b[NT];
#pragma unroll
        for (int i = 0; i < MT; ++i) a[i] = *(const bf16x8*)(A + swz_off<KWA>(a_row0 + 16 * i + r, kc0 + ks * 4 + q));
#pragma unroll
        for (int j = 0; j < NT; ++j) b[j] = *(const bf16x8*)(B + swz_off<KWB>(b_row0 + 16 * j + r, kc0 + ks * 4 + q));
#pragma unroll
        for (int i = 0; i < MT; ++i)
#pragma unroll
            for (int j = 0; j < NT; ++j) acc[i][j] = mfma16(a[i], b[j], acc[i][j]);
    }
}

DEVI void conv_transpose_tile(const float* __restrict__ src, int K, int N, bf16_t* __restrict__ dst, int kt, int nt, char* smem, const float* __restrict__ kgain = nullptr) {
    float* s = (float*)smem;
    const int tid = threadIdx.x;
    for (int e = tid; e < 4096; e += NTHREADS) {
        int kk = e >> 6, nn = e & 63;
        int n = nt * 64 + nn;
        const float gk = kgain ? kgain[kt * 64 + kk] : 1.f;
        s[kk * 65 + nn] = (n < N) ? src[(size_t)(kt * 64 + kk) * N + n] * gk : 0.f;
    }
    __syncthreads();
    for (int e = tid; e < 2048; e += NTHREADS) {
        int nn = e >> 5, kp = e & 31;
        unsigned v = pack2(s[(2 * kp) * 65 + nn], s[(2 * kp + 1) * 65 + nn]);
        *(unsigned*)(dst + (size_t)(nt * 64 + nn) * K + kt * 64 + 2 * kp) = v;
    }
    __syncthreads();
}
DEVI void conv_plain_chunk(const float* __restrict__ src, bf16_t* __restrict__ dst, size_t chunk) {
    const int tid = threadIdx.x;
    size_t base = chunk * 4096 + (size_t)tid * 16;
    const float4* s4 = (const float4*)(src + base);
    float4 a = s4[0], b = s4[1], c = s4[2], d = s4[3];
    uint4 o0, o1;
    o0.x = pack2(a.x, a.y); o0.y = pack2(a.z, a.w); o0.z = pack2(b.x, b.y); o0.w = pack2(b.z, b.w);
    o1.x = pack2(c.x, c.y); o1.y = pack2(c.z, c.w); o1.z = pack2(d.x, d.y); o1.w = pack2(d.z, d.w);
    uint4* d4 = (uint4*)(dst + base);
    d4[0] = o0; d4[1] = o1;
}
DEVI void conv_experts(const float* down, const float* up, const float* __restrict__ dgain, char* ws, int it  ) {
    const int lane = threadIdx.x & 63, wave = threadIdx.x >> 6;
    const bool isup = it >= 4096;
    const int row = (isup ? it - 4096 : it) * 4 + wave;
    const float* src = (isup ? up : down) + (size_t)row * 1024 + 16 * lane;
    float4 a = *(const float4*)src, b = *(const float4*)(src + 4), c = *(const float4*)(src + 8), d = *(const float4*)(src + 12);
    if (!isup) {
        const float4 ga = *(const float4*)(dgain + 16 * lane), gb = *(const float4*)(dgain + 16 * lane + 4), gc = *(const float4*)(dgain + 16 * lane + 8), gd = *(const float4*)(dgain + 16 * lane + 12);
        a.x *= ga.x; a.y *= ga.y; a.z *= ga.z; a.w *= ga.w; b.x *= gb.x; b.y *= gb.y; b.z *= gb.z; b.w *= gb.w;
        c.x *= gc.x; c.y *= gc.y; c.z *= gc.z; c.w *= gc.w; d.x *= gd.x; d.y *= gd.y; d.z *= gd.z; d.w *= gd.w;
    }
    float mx = fmaxf(fmaxf(fmaxf(fabsf(a.x), fabsf(a.y)), fmaxf(fabsf(a.z), fabsf(a.w))), fmaxf(fmaxf(fabsf(b.x), fabsf(b.y)), fmaxf(fabsf(b.z), fabsf(b.w))));
    mx = fmaxf(mx, fmaxf(fmaxf(fmaxf(fabsf(c.x), fabsf(c.y)), fmaxf(fabsf(c.z), fabsf(c.w))), fmaxf(fmaxf(fabsf(d.x), fabsf(d.y)), fmaxf(fabsf(d.z), fabsf(d.w)))));
    mx = wave_max_dpp(mx);
    const float sc = (mx > 0.f) ? 416.f / mx : 1.f;
    const float inv = (mx > 0.f) ? mx / 416.f : 1.f;
    int w0 = 0, w1 = 0, w2 = 0, w3 = 0;
    w0 = __builtin_amdgcn_cvt_pk_fp8_f32(a.x * sc, a.y * sc, w0, false); w0 = __builtin_amdgcn_cvt_pk_fp8_f32(a.z * sc, a.w * sc, w0, true);
    w1 = __builtin_amdgcn_cvt_pk_fp8_f32(b.x * sc, b.y * sc, w1, false); w1 = __builtin_amdgcn_cvt_pk_fp8_f32(b.z * sc, b.w * sc, w1, true);
    w2 = __builtin_amdgcn_cvt_pk_fp8_f32(c.x * sc, c.y * sc, w2, false); w2 = __builtin_amdgcn_cvt_pk_fp8_f32(c.z * sc, c.w * sc, w2, true);
    w3 = __builtin_amdgcn_cvt_pk_fp8_f32(d.x * sc, d.y * sc, w3, false); w3 = __builtin_amdgcn_cvt_pk_fp8_f32(d.z * sc, d.w * sc, w3, true);
    *(int4*)(ws + (isup ? OFF_EU : OFF_ED) + ((size_t)(lane >> 3) * 16384 + row) * 128 + 16 * (lane & 7)) = int4{w0, w1, w2, w3};
    if (lane == 0) ((float*)(ws + (isup ? OFF_INVU : OFF_INVD)))[row] = inv;
}

DEVI void phase_convert(const Params& p, char* smem) {
    char* ws = p.ws;
    const int bid = blockIdx.x, nb = gridDim.x;
    for (int t = bid; t < 768; t += nb) conv_transpose_tile(p.l0_w_in,    1024, 3072, (bf16_t*)(ws + OFF_W_IN0T),  t / 48, t % 48, smem, p.l0_norm_mix);
    for (int t = (bid + nb - 256 % nb) % nb; t < 256; t += nb) conv_transpose_tile(p.l0_w_out,   1024, 1024, (bf16_t*)(ws + OFF_W_OUT0T), t / 16, t % 16, smem);
    for (int t = bid; t < 512; t += nb) conv_transpose_tile(p.l0_w_query, 1024, 2048, (bf16_t*)(ws + OFF_W_Q0T),   t / 32, t % 32, smem, p.l0_norm_ffn);
    for (int t = bid; t < 512; t += nb) conv_transpose_tile(p.l1_w_in,    1024, 1984, (bf16_t*)(ws + OFF_W_IN1T),  t / 32, t % 32, smem, p.l1_norm_mix);
    for (int t = bid; t < 48; t += nb)  conv_transpose_tile(p.l1_w_uq,     256,  768, (bf16_t*)(ws + OFF_W_UQT),   t / 12, t % 12, smem, p.l1_cq_norm);
    for (int t = nb - 1 - bid; t < 32; t += nb)  conv_transpose_tile(p.l1_w_ukv,    128, 1024, (bf16_t*)(ws + OFF_W_UKVT),  t / 16, t % 16, smem, p.l1_ckv_norm);
    for (int t = (bid + nb - 256 % nb) % nb; t < 256; t += nb) conv_transpose_tile(p.l1_w_out,   1024, 1024, (bf16_t*)(ws + OFF_W_OUT1T), t / 16, t % 16, smem);
    for (int t = bid; t < 512; t += nb) conv_transpose_tile(p.l1_w_query, 1024, 2048, (bf16_t*)(ws + OFF_W_Q1T),   t / 32, t % 32, smem, p.l1_norm_ffn);
    for (int t = bid - 64; t < 64; t += nb) if (t >= 0) conv_plain_chunk(p.l0_sub_keys, (bf16_t*)(ws + OFF_SK0), t);
    for (int t = bid - 128; t < 64; t += nb) if (t >= 0) conv_plain_chunk(p.l1_sub_keys, (bf16_t*)(ws + OFF_SK1), t);
    for (int chunk = bid - 192; chunk < 16; chunk += nb) if (chunk >= 0) {
        bf16_t* dst = (bf16_t*)(ws + OFF_WS0);
        for (int e = threadIdx.x; e < 4096; e += NTHREADS) {
            int idx = chunk * 4096 + e; int t = (idx >> 7) & 127, sI = idx & 127;
            dst[idx] = f2bf(sI <= t ? p.l0_gmlp_w_s[idx] : 0.f);
        }
    }
    if (bid == nb - 1) {
        float* lb = (float*)(ws + OFF_LB);
        for (int c = threadIdx.x; c < 512; c += NTHREADS) {
            float a0 = p.lb_logits[c], a1 = p.lb_logits[512 + c], a2 = p.lb_logits[1024 + c];
            float m = fmaxf(a0, fmaxf(a1, a2));
            float e0 = __expf(a0 - m), e1 = __expf(a1 - m), e2 = __expf(a2 - m);
            lb[c] = e0 / (e0 + e1 + e2);
        }
    }
    for (int it = bid; it < 8192; it += nb) conv_experts(p.l0_exp_down, p.l0_exp_up, p.l0_norm_ffn, ws, it);
    {
        const int lane = threadIdx.x & 63, wave = threadIdx.x >> 6;
        for (int it = bid; it < 4096; it += nb) {
            const size_t row = (size_t)it * 4 + wave;
            const float* xr = p.x + row * 1024 + 16 * lane;
            const float4 a = *(const float4*)xr, b = *(const float4*)(xr + 4), c = *(const float4*)(xr + 8), d = *(const float4*)(xr + 12);
            float ss = a.x * a.x + a.y * a.y + a.z * a.z + a.w * a.w + b.x * b.x + b.y * b.y + b.z * b.z + b.w * b.w
                     + c.x * c.x + c.y * c.y + c.z * c.z + c.w * c.w + d.x * d.x + d.y * d.y + d.z * d.z + d.w * d.w;
            ss = wave_sum_dpp(ss);
            uint4 o0, o1;
            o0.x = pack2(a.x, a.y); o0.y = pack2(a.z, a.w); o0.z = pack2(b.x, b.y); o0.w = pack2(b.z, b.w);
            o1.x = pack2(c.x, c.y); o1.y = pack2(c.z, c.w); o1.z = pack2(d.x, d.y); o1.w = pack2(d.z, d.w);
            bf16_t* xb = (bf16_t*)(ws + OFF_XB) + row * 1024 + 16 * lane;
            *(uint4*)xb = o0; *(uint4*)(xb + 8) = o1;
            if (lane == 0) ((float*)(ws + OFF_SSQ1))[row] = ss;
        }
    }
}

template <int AMODE, class Epi>
DEVI void gemm_phase(const void* __restrict__ Aptr, int lda, const float* __restrict__ gain, const bf16_t* __restrict__ Bt,
                           int M, int Npad, int K, Epi epi, char* smem, int blk0, int nblk) {
    const int tid = threadIdx.x, lane = tid & 63, wave = tid >> 6;
    const int wm = wave >> 1, wn = wave & 1;
    const int tn = Npad / 128, tm = M / 128, nkt = K / 64;
    float* sRstd = (float*)(smem + 65536);
    const int crow = tid >> 3, cc = tid & 7;
    for (int tile = blk0; tile < tm * tn; tile += nblk) {
        const int m0 = (tile / tn) * 128, n0 = (tile % tn) * 128;
        f32x4 acc[4][4];
#pragma unroll
        for (int i = 0; i < 4; ++i)
#pragma unroll
            for (int j = 0; j < 4; ++j) acc[i][j] = f32x4{0.f, 0.f, 0.f, 0.f};
        float ss[4] = {0.f, 0.f, 0.f, 0.f};
        f32x4v ra[4][2]; u32x4 rab[4]; u32x4 rb[4]; f32x4v g0, g1;
        auto gload = [&](int kt) {
            const int k0 = kt * 64 + cc * 8;
#pragma unroll
            for (int i = 0; i < 4; ++i) {
                const int row = crow + 32 * i;
                if constexpr (AMODE == 0) {
                    const float* pa = (const float*)Aptr + (size_t)(m0 + row) * lda + k0;
                    ra[i][0] = *(const f32x4v*)pa; ra[i][1] = *(const f32x4v*)(pa + 4);
                } else {
                    const bf16_t* pa = (const bf16_t*)Aptr + (size_t)(m0 + row) * lda + k0;
                    rab[i] = *(const u32x4*)pa;
                }
                rb[i] = *(const u32x4*)(Bt + (size_t)(n0 + row) * K + k0);
            }
            if constexpr (AMODE != 1) { g0 = *(const f32x4v*)(gain + k0); g1 = *(const f32x4v*)(gain + k0 + 4); }
        };
        auto lstore = [&](int buf) {
            char* sA = smem + buf * 32768; char* sB = sA + 16384;
#pragma unroll
            for (int i = 0; i < 4; ++i) {
                const int row = crow + 32 * i;
                u32x4 o;
                if constexpr (AMODE == 0) {
                    f32x4v a = ra[i][0], b = ra[i][1];
                    ss[i] += a.x * a.x + a.y * a.y + a.z * a.z + a.w * a.w + b.x * b.x + b.y * b.y + b.z * b.z + b.w * b.w;
                    o.x = pack2(a.x * g0.x, a.y * g0.y); o.y = pack2(a.z * g0.z, a.w * g0.w);
                    o.z = pack2(b.x * g1.x, b.y * g1.y); o.w = pack2(b.z * g1.z, b.w * g1.w);
                } else if constexpr (AMODE == 2) {
                    u32x4 u = rab[i];
                    float a0 = bflo(u.x), a1 = bfhi(u.x), a2 = bflo(u.y), a3 = bfhi(u.y), a4 = bflo(u.z), a5 = bfhi(u.z), a6 = bflo(u.w), a7 = bfhi(u.w);
                    ss[i] += a0 * a0 + a1 * a1 + a2 * a2 + a3 * a3 + a4 * a4 + a5 * a5 + a6 * a6 + a7 * a7;
                    o.x = pack2(a0 * g0.x, a1 * g0.y); o.y = pack2(a2 * g0.z, a3 * g0.w);
                    o.z = pack2(a4 * g1.x, a5 * g1.y); o.w = pack2(a6 * g1.z, a7 * g1.w);
                } else o = rab[i];
                *(u32x4*)(sA + swz_off<64>(row, cc)) = o;
                *(u32x4*)(sB + swz_off<64>(row, cc)) = rb[i];
            }
        };
        gload(0); lstore(0); __syncthreads();
#pragma unroll 1
        for (int kt = 0; kt < nkt; ++kt) {
            if (kt + 1 < nkt) gload(kt + 1);
            const char* sA = smem + (kt & 1) * 32768; const char* sB = sA + 16384;
            mma_nt<4, 4, 64, 64>(acc, sA, wm * 64, sB, wn * 64, 0, 2, lane);
            if (kt + 1 < nkt) lstore((kt + 1) & 1);
            __syncthreads();
        }
        if constexpr (AMODE != 1) {
#pragma unroll
            for (int i = 0; i < 4; ++i) {
                float s = ss[i];
                s += __shfl_xor(s, 1); s += __shfl_xor(s, 2); s += __shfl_xor(s, 4);
                if (cc == 0) sRstd[crow + 32 * i] = rsqrtf(s / (float)K + 1e-6f);
            }
            __syncthreads();
        }
#pragma unroll
        for (int i = 0; i < 4; ++i)
#pragma unroll
            for (int r = 0; r < 4; ++r) {
                const int rl = wm * 64 + i * 16 + (lane >> 4) * 4 + r;
                const float rs = (AMODE != 1) ? sRstd[rl] : 1.f;
#pragma unroll
                for (int j = 0; j < 4; ++j) epi(m0 + rl, n0 + wn * 64 + j * 16 + (lane & 15), acc[i][j][r] * rs);
                __builtin_amdgcn_sched_barrier(0);
            }
    }
}

struct Placement { int xcc, rank, nloc, nx; };
#define G2_RAW_BARRIER() do { asm volatile("s_waitcnt lgkmcnt(0)" ::: "memory"); __builtin_amdgcn_s_barrier(); } while (0)
struct NoAfter { DEVI void operator()(int, int) const {} };
template <class Epi, class After = NoAfter>
DEVI void gemm2_phase(const bf16_t* __restrict__ A, int lda, const bf16_t* __restrict__ Bt, int tm, int tn, int K,
                      const float* __restrict__ ssq, int nss, Epi epi, char* smem, Placement pl, After after = After(), int tsel = -1) {
    const int tid = threadIdx.x, lane = tid & 63;
    const int wave = __builtin_amdgcn_readfirstlane(tid >> 6);
    const int wm = wave >> 1, wn = wave & 1;
    const int nkt = K / 32;
    constexpr int STG = 24576;
    float* sRstd = (float*)(smem + 3 * STG);
    int xcd = blockIdx.x & 7, slot = blockIdx.x >> 3, nslots = gridDim.x >> 3, nxc = 8;
    if (pl.nloc > 0) { xcd = pl.xcc; slot = pl.rank; nslots = pl.nloc; nxc = pl.nx; }
    const int np = (tm + nxc - 1) / nxc;
    const int per_xcd = ((np + 7) >> 3) * tn * 8;
    for (int t = slot; t < per_xcd; t += nslots) {
        const int mi = t & 7, rest = t >> 3, nt_ = rest % tn, mg = rest / tn;
        const int pidx = mg * 8 + mi, panel = xcd + nxc * pidx;
        if (pidx >= np || panel >= tm) continue;
        if (tsel >= 0 && (t - slot) / nslots != tsel) continue;
        int ln_ = lane; asm volatile("" : "+v"(ln_));
        const int Rl = (ln_ >> 4) & 3, gl = (((Rl ^ (Rl >> 1)) & 1) << 1) | (Rl >> 1);
        const int Rr = (ln_ >> 2) & 3, gr = (((Rr ^ (Rr >> 1)) & 1) << 1) | (Rr >> 1);
        const int ld_row = ln_ >> 2, ld_c = (ln_ & 3) ^ gl;
        const int rd_off = (ln_ & 15) * 64 + (((ln_ >> 4) ^ gr) << 4);
        const int m0 = panel * 128, n0 = nt_ * 256;
        if (ssq) { if (tid < 128) { float sacc = 0.f; for (int i = 0; i < nss; ++i) sacc += ssq[(size_t)(m0 + tid) * nss + i]; sRstd[tid] = rsqrtf(sacc / (float)K + 1e-6f); } }
        else if (tid < 128) sRstd[tid] = 1.f;
        const bf16_t* ga = A  + (size_t)(m0 + 32 * wave + ld_row) * lda + ld_c * 8;
        const bf16_t* gb = Bt + (size_t)(n0 + 64 * wave + ld_row) * K   + ld_c * 8;
        f32x4 acc[4][8];
#pragma unroll
        for (int i = 0; i < 4; ++i)
#pragma unroll
            for (int j = 0; j < 8; ++j) acc[i][j] = f32x4{0.f, 0.f, 0.f, 0.f};
#define G2_ISSUE(KT) { char* st_ = smem + ((KT) % 3) * STG; const int ko_ = (KT) * 32; \
            __builtin_amdgcn_global_load_lds((const unsigned*)(ga + ko_),                    (unsigned*)(st_ + wave * 2048),               16, 0, 0); \
            __builtin_amdgcn_global_load_lds((const unsigned*)(ga + (size_t)16 * lda + ko_), (unsigned*)(st_ + wave * 2048 + 1024),        16, 0, 0); \
            __builtin_amdgcn_global_load_lds((const unsigned*)(gb + ko_),                    (unsigned*)(st_ + 8192 + wave * 4096),        16, 0, 0); \
            __builtin_amdgcn_global_load_lds((const unsigned*)(gb + (size_t)16 * K + ko_),   (unsigned*)(st_ + 8192 + wave * 4096 + 1024), 16, 0, 0); \
            __builtin_amdgcn_global_load_lds((const unsigned*)(gb + (size_t)32 * K + ko_),   (unsigned*)(st_ + 8192 + wave * 4096 + 2048), 16, 0, 0); \
            __builtin_amdgcn_global_load_lds((const unsigned*)(gb + (size_t)48 * K + ko_),   (unsigned*)(st_ + 8192 + wave * 4096 + 3072), 16, 0, 0); }
        G2_ISSUE(0) G2_ISSUE(1)
#pragma unroll 1
        for (int kt = 0; kt < nkt; ++kt) {
            if (kt + 1 < nkt) asm volatile("s_waitcnt vmcnt(6)" ::: "memory");
            else asm volatile("s_waitcnt vmcnt(0)" ::: "memory");
            G2_RAW_BARRIER();
            if (kt + 2 < nkt) G2_ISSUE(kt + 2)
            const char* sA = smem + (kt % 3) * STG + rd_off; const char* sB = sA + 8192;
            bf16x8 a[4], b[8];
#pragma unroll
            for (int i = 0; i < 4; ++i) a[i] = *(const bf16x8*)(sA + (wm * 64 + 16 * i) * 64);
#pragma unroll
            for (int j = 0; j < 8; ++j) b[j] = *(const bf16x8*)(sB + (wn * 128 + 16 * j) * 64);
#pragma unroll
            for (int i = 0; i < 4; ++i)
#pragma unroll
                for (int j = 0; j < 8; ++j) acc[i][j] = mfma16(b[j], a[i], acc[i][j]);
        }
#undef G2_ISSUE
        if (epi.staged(n0)) {
            G2_RAW_BARRIER();
#pragma unroll
            for (int i = 0; i < 4; ++i) {
                const int rl = wm * 64 + i * 16 + (lane & 15);
                const float rs = sRstd[rl];
                char* trow = smem + rl * 528 + (wn * 128 + 4 * (lane >> 4)) * 2;
#pragma unroll
                for (int j = 0; j < 8; ++j) {
                    const int nc = n0 + wn * 128 + 16 * j + 4 * (lane >> 4);
                    *(uint2*)(trow + 32 * j) = uint2{pack2(epi.map(nc, acc[i][j][0] * rs), epi.map(nc + 1, acc[i][j][1] * rs)), pack2(epi.map(nc + 2, acc[i][j][2] * rs), epi.map(nc + 3, acc[i][j][3] * rs))};
                }
            }
            __syncthreads();
            float* const sqp = (n0 == 0) ? epi.SQ0 : ((n0 == 256) ? epi.SQ1 : nullptr);
#pragma unroll 4
            for (int i = 0; i < 16; ++i) {
                const int e = tid + 256 * i, row = e >> 5, cc = e & 31;
                const uint4 v = *(const uint4*)(smem + row * 528 + cc * 16);
                if constexpr (Epi::kResid) {
                    bf16_t* px = epi.XB + (size_t)(m0 + row) * 1024 + n0 + cc * 8;
                    const uint4 od = *(const uint4*)px;
                    const float al = epi.alpha;
                    uint4 w;
                    w.x = pack2(bflo(od.x) + al * bflo(v.x), bfhi(od.x) + al * bfhi(v.x)); w.y = pack2(bflo(od.y) + al * bflo(v.y), bfhi(od.y) + al * bfhi(v.y));
                    w.z = pack2(bflo(od.z) + al * bflo(v.z), bfhi(od.z) + al * bfhi(v.z)); w.w = pack2(bflo(od.w) + al * bflo(v.w), bfhi(od.w) + al * bfhi(v.w));
                    *(uint4*)px = w;
                    float q = bflo(w.x) * bflo(w.x) + bfhi(w.x) * bfhi(w.x) + bflo(w.y) * bflo(w.y) + bfhi(w.y) * bfhi(w.y)
                            + bflo(w.z) * bflo(w.z) + bfhi(w.z) * bfhi(w.z) + bflo(w.w) * bflo(w.w) + bfhi(w.w) * bfhi(w.w);
                    q += DPP_F(q, 0xB1); q += DPP_F(q, 0x4E); q += DPP_F(q, 0x141);
                    if ((cc & 7) == 0) epi.SSQ16[(size_t)(m0 + row) * 16 + ((n0 + cc * 8) >> 6)] = q;
                } else
                if (epi.D && n0 + cc * 8 < epi.N) *(uint4*)(epi.D + (size_t)(m0 + row) * epi.ldd + n0 + cc * 8) = v;
                if (sqp) {
                    float q = bflo(v.x) * bflo(v.x) + bfhi(v.x) * bfhi(v.x) + bflo(v.y) * bflo(v.y) + bfhi(v.y) * bfhi(v.y)
                            + bflo(v.z) * bflo(v.z) + bfhi(v.z) * bfhi(v.z) + bflo(v.w) * bflo(v.w) + bfhi(v.w) * bfhi(v.w);
                    if (n0 == 256 && cc >= 16) q = 0.f;
                    q += DPP_F(q, 0xB1); q += DPP_F(q, 0x4E); q += DPP_F(q, 0x141); q += DPP_F(q, 0x140); q += __shfl_xor(q, 16);
                    if (cc == 0) sqp[m0 + row] = q;
                }
            }
        } else {
#pragma unroll
            for (int i = 0; i < 4; ++i) {
                const int rl = wm * 64 + i * 16 + (lane & 15);
                const float rs = sRstd[rl];
                epi.row(m0 + rl, n0 + wn * 128 + 4 * (lane >> 4), acc[i], rs, lane);
                __builtin_amdgcn_sched_barrier(0);
            }
        }
        __syncthreads();
        after(panel, nt_);
    }
}

struct Epi2In0 {
    static constexpr bool kResid = false;
    bf16_t* Z0; float* G; const float* lb; bf16_t* D; int ldd; int N; float* SQ0; float* SQ1;
    DEVI bool staged(int n0) const { return (n0 >> 9) != 1; }
    DEVI float map(int n, float v) const { const int blk = n >> 9; return (blk == 0) ? v : ((blk <= 3) ? v * sigm(v) : gelu_tanh(v)); }
    DEVI void row(int m, int n, const f32x4 (&a)[8], float rs, int) const {
#pragma unroll
        for (int j = 0; j < 8; ++j) {
            const int c = n + 16 * j - 512;
            const float4 l4 = *(const float4*)(lb + c);
            float4 o;
            o.x = logf(l4.x + (1.f - l4.x) * sigm(a[j][0] * rs)); o.y = logf(l4.y + (1.f - l4.y) * sigm(a[j][1] * rs));
            o.z = logf(l4.z + (1.f - l4.z) * sigm(a[j][2] * rs)); o.w = logf(l4.w + (1.f - l4.w) * sigm(a[j][3] * rs));
            *(float4*)(G + (size_t)m * 512 + c) = o;
        }
    }
};
struct Epi2Bf16 {
    static constexpr bool kResid = false;
    bf16_t* D; int ldd; int N; float* SQ0; float* SQ1;
    DEVI bool staged(int) const { return true; }
    DEVI float map(int, float v) const { return v; }
    DEVI void row(int, int, const f32x4 (&)[8], float, int) const {}
};
struct Epi2Resid {
    static constexpr bool kResid = true;
    bf16_t* XB; float* SSQ16; float alpha; bf16_t* D; int ldd; int N; float* SQ0; float* SQ1;
    DEVI bool staged(int) const { return true; }
    DEVI float map(int, float v) const { return v; }
    DEVI void row(int m, int n, const f32x4 (&a)[8], float, int lane) const {
        float sq[2] = {0.f, 0.f};
#pragma unroll
        for (int j = 0; j < 8; ++j) {
            bf16_t* px = XB + (size_t)m * 1024 + n + 16 * j;
            const uint2 r = *(const uint2*)px;
            const unsigned w0 = pack2(bflo(r.x) + alpha * a[j][0], bfhi(r.x) + alpha * a[j][1]), w1 = pack2(bflo(r.y) + alpha * a[j][2], bfhi(r.y) + alpha * a[j][3]);
            *(uint2*)px = uint2{w0, w1};
            sq[j >> 2] += bflo(w0) * bflo(w0) + bfhi(w0) * bfhi(w0) + bflo(w1) * bflo(w1) + bfhi(w1) * bfhi(w1);
        }
#pragma unroll
        for (int g = 0; g < 2; ++g) {
            float v = sq[g];
            v += __shfl_xor(v, 16); v += __shfl_xor(v, 32);
            if ((lane >> 4) == 0) SSQ16[(size_t)m * 16 + ((n + 64 * g) >> 6)] = v;
        }
    }
};

struct EpiBf16 { bf16_t* D; int ldd; int N; DEVI void operator()(int m, int n, float v) const { if (n < N) D[(size_t)m * ldd + n] = f2bf(v); } };

DEVI void hgrn_local_item(const Params& p, int item, char* smem) {
    const int tid = threadIdx.x, lane = tid & 63, wave = tid >> 6;
    const int bh = item >> 7, c = item & 127, b = bh >> 2, h = bh & 3;
    const size_t m0 = (size_t)b * 8192 + c * 64;
    const float* G = (const float*)(p.ws + OFF_G) + m0 * 512 + h * 128;
    const bf16_t* Zv = (const bf16_t*)(p.ws + OFF_Z0) + m0 * 3072 + 1024 + h * 128;
    char* sVT = smem; char* sKd = smem + 16384;
    const int k = tid & 127, hf = tid >> 7;
    float bl = 0.f, bmid = 0.f;
#pragma unroll 8
    for (int t = 0; t < 64; ++t) { bl += G[t * 512 + k]; if (t == 31) bmid = bl; }
    float bcur = hf ? bmid : 0.f;
#pragma unroll 1
    for (int ch = 0; ch < 4; ++ch) {
        float kd[8], vv[8];
#pragma unroll
        for (int j = 0; j < 8; ++j) {
            const int t = 32 * hf + 8 * ch + j;
            const float g = G[t * 512 + k];
            bcur += g;
            kd[j] = (1.f - __expf(g)) * __expf(bl - bcur);
            vv[j] = bf2f(Zv[(size_t)t * 3072 + k]);
        }
        uint4 o; o.x = pack2(kd[0], kd[1]); o.y = pack2(kd[2], kd[3]); o.z = pack2(kd[4], kd[5]); o.w = pack2(kd[6], kd[7]);
        *(uint4*)(sKd + swz_off<64>(k, 4 * hf + ch)) = o;
        uint4 w; w.x = pack2(vv[0], vv[1]); w.y = pack2(vv[2], vv[3]); w.z = pack2(vv[4], vv[5]); w.w = pack2(vv[6], vv[7]);
        *(uint4*)(sVT + swz_off<64>(k, 4 * hf + ch)) = w;
    }
    if (hf == 0) ((float*)(p.ws + OFF_DEC))[item * 128 + k] = __expf(bl);
    __syncthreads();
    f32x4 acc[2][8];
#pragma unroll
    for (int i = 0; i < 2; ++i)
#pragma unroll
        for (int j = 0; j < 8; ++j) acc[i][j] = f32x4{0.f, 0.f, 0.f, 0.f};
    mma_nt<2, 8, 64, 64>(acc, sVT, 32 * wave, sKd, 0, 0, 2, lane);
    float* H = (float*)(p.ws + OFF_HST) + (size_t)item * 16384;
#pragma unroll
    for (int i = 0; i < 2; ++i)
#pragma unroll
        for (int j = 0; j < 8; ++j)
#pragma unroll
            for (int r = 0; r < 4; ++r) {
                const int v = 32 * wave + 16 * i + (lane >> 4) * 4 + r, kk = 16 * j + (lane & 15);
                H[v * 128 + kk] = acc[i][j][r];
                if (r == 3) __builtin_amdgcn_sched_barrier(0);
            }
    __syncthreads();
}

DEVI void gmlp_item(const Params& p, int item, char* smem) {
    const int tid = threadIdx.x, lane = tid & 63, wave = tid >> 6;
    const int g = item & 3, chunk = item >> 2;
    const size_t m0 = (size_t)chunk * 128;
    const bf16_t* Z0 = (const bf16_t*)(p.ws + OFF_Z0);
    const bf16_t* Wc = (const bf16_t*)(p.ws + OFF_WS0) + g * 16384;
    char* sW = smem; char* sV = smem + 32768;
#pragma unroll
    for (int i = 0; i < 8; ++i) {
        const int e = tid + 256 * i, row = e >> 4, cc = e & 15;
        *(uint4*)(sW + swz_off<128>(row, cc)) = *(const uint4*)(Wc + row * 128 + cc * 8);
    }
    {
        const int t = tid >> 1, hf = tid & 1;
        const bf16_t* src = Z0 + (m0 + t) * 3072 + 2560 + g * 128 + 64 * hf;
        float vals[64]; float ss = 0.f;
#pragma unroll
        for (int i = 0; i < 8; ++i) {
            uint4 u = *(const uint4*)(src + 8 * i);
            vals[8 * i + 0] = bflo(u.x); vals[8 * i + 1] = bfhi(u.x); vals[8 * i + 2] = bflo(u.y); vals[8 * i + 3] = bfhi(u.y);
            vals[8 * i + 4] = bflo(u.z); vals[8 * i + 5] = bfhi(u.z); vals[8 * i + 6] = bflo(u.w); vals[8 * i + 7] = bfhi(u.w);
        }
#pragma unroll
        for (int i = 0; i < 64; ++i) ss += vals[i] * vals[i];
        ss += DPP_F(ss, 0xB1);
        const float rstd = rsqrtf(ss * (1.f / 128.f) + 1e-6f);
        const float* gn = p.l0_gmlp_v_norm + g * 128 + 64 * hf;
#pragma unroll
        for (int i = 0; i < 64; ++i) {
            const int d = 64 * hf + i;
            *(bf16_t*)(sV + swz_elem<128>(d, t)) = f2bf(vals[i] * rstd * gn[i]);
        }
    }
    __syncthreads();
    const int wm = wave >> 1, wn = wave & 1;
    f32x4 acc[4][4];
#pragma unroll
    for (int i = 0; i < 4; ++i)
#pragma unroll
        for (int j = 0; j < 4; ++j) acc[i][j] = f32x4{0.f, 0.f, 0.f, 0.f};
    mma_nt<4, 4, 128, 128>(acc, sW, wm * 64, sV, wn * 64, 0, 4, lane);
    bf16_t* MIX = (bf16_t*)(p.ws + OFF_MIX0);
#pragma unroll
    for (int i = 0; i < 4; ++i)
#pragma unroll
        for (int r = 0; r < 4; ++r) {
            const int t = wm * 64 + i * 16 + (lane >> 4) * 4 + r;
            const float bias = p.l0_gmlp_b_s[g * 128 + t];
#pragma unroll
            for (int j = 0; j < 4; ++j) {
                const int d = wn * 64 + j * 16 + (lane & 15);
                const float u = bf2f(Z0[(m0 + t) * 3072 + 2048 + g * 128 + d]);
                MIX[(m0 + t) * 1024 + 512 + g * 128 + d] = f2bf(u * (acc[i][j][r] + bias));
            }
        }
    __syncthreads();
}

DEVI void hgrn_scan_phase(const Params& p) {
    float* H = (float*)(p.ws + OFF_HST);
    const float* D = (const float*)(p.ws + OFF_DEC);
#define SCAN_LD(L, d, C0) { _Pragma("unroll") for (int u = 0; u < 16; ++u) { L[u] = H[((size_t)(bh * 128 + (C0) + u)) * 16384 + idx]; d[u] = D[(bh * 128 + (C0) + u) * 128 + k]; } }
#define SCAN_DO(L, d, C0) { _Pragma("unroll") for (int u = 0; u < 16; ++u) { H[((size_t)(bh * 128 + (C0) + u)) * 16384 + idx] = run; run = d[u] * run + L[u]; } }
    for (int e = blockIdx.x * NTHREADS + threadIdx.x; e < 8 * 16384; e += gridDim.x * NTHREADS) {
        const int bh = e >> 14, idx = e & 16383, k = idx & 127;
        float run = 0.f;
        float La[16], da[16], Lb[16], db[16];
        SCAN_LD(La, da, 0)
#pragma unroll 1
        for (int c0 = 0; c0 < 128; c0 += 32) {
            SCAN_LD(Lb, db, c0 + 16)
            SCAN_DO(La, da, c0)
            if (c0 + 32 < 128) SCAN_LD(La, da, c0 + 32)
            SCAN_DO(Lb, db, c0 + 16)
        }
    }
#undef SCAN_LD
#undef SCAN_DO
}

DEVI void hgrn_out_item(const Params& p, int item, char* smem) {
    const int tid = threadIdx.x, lane = tid & 63, wave = tid >> 6;
    const int bh = item >> 7, c = item & 127, b = bh >> 2, h = bh & 3;
    const size_t m0 = (size_t)b * 8192 + c * 64;
    const float* G = (const float*)(p.ws + OFF_G) + m0 * 512 + h * 128;
    const bf16_t* Z0 = (const bf16_t*)(p.ws + OFF_Z0) + m0 * 3072;
    float* sB  = (float*)smem;
    char*  sHT = smem;
    char*  sQe = smem + 32768;
    char*  sP  = smem + 49152;
    char*  sU  = smem + 57344;
    char*  sQs = sU; char* sKh = sU + 4096; char* sVT = sU;
    float* sRed = (float*)(smem + 77824);
    const int k = tid & 127, hf = tid >> 7;
    if (hf == 0) { float bc = 0.f;
#pragma unroll 8
        for (int t = 0; t < 64; ++t) { bc += G[t * 512 + k]; sB[t * 128 + k] = bc; } }
    __syncthreads();
#pragma unroll 4
    for (int t = 32 * hf; t < 32 * hf + 32; ++t) {
        const float q = bf2f(Z0[(size_t)t * 3072 + h * 128 + k]);
        *(bf16_t*)(sQe + swz_elem<128>(t, k)) = f2bf(q * __expf(sB[t * 128 + k]));
    }
#pragma unroll 1
    for (int i = 0; i < 4; ++i) {
        const float ri = (i == 0) ? 0.f : sB[(16 * i - 1) * 128 + k];
#pragma unroll 4
        for (int tt = 8 * hf; tt < 8 * hf + 8; ++tt) {
            const int t = 16 * i + tt;
            const float q = bf2f(Z0[(size_t)t * 3072 + h * 128 + k]);
            *(bf16_t*)(sQs + swz_elem<128>(tt, k)) = f2bf(q * __expf(sB[t * 128 + k] - ri));
        }
        const int ns = 16 * (i + 1), half = ns >> 1;
#pragma unroll 4
        for (int s = hf * half; s < hf * half + half; ++s) {
            const float bs = sB[s * 128 + k];
            const float gs = bs - (s ? sB[(s - 1) * 128 + k] : 0.f);
            const float kk = 1.f - __expf(gs);
            *(bf16_t*)(sKh + swz_elem<128>(s, k)) = f2bf(kk * __expf(fminf(ri - bs, 80.f)));
        }
        __syncthreads();
        {
            f32x4 acc[1][1]; acc[0][0] = f32x4{0.f, 0.f, 0.f, 0.f};
            if (wave <= i) mma_nt<1, 1, 128, 128>(acc, sQs, 0, sKh, 16 * wave, 0, 4, lane);
#pragma unroll
            for (int r = 0; r < 4; ++r) {
                const int row = (lane >> 4) * 4 + r, col = lane & 15;
                float v = acc[0][0][r];
                if (wave > i || (wave == i && col > row)) v = 0.f;
                *(bf16_t*)(sP + swz_elem<64>(16 * i + row, 16 * wave + col)) = f2bf(v);
            }
        }
        __syncthreads();
    }
    {
        const bf16_t* Zv = Z0 + 1024 + h * 128;
#pragma unroll 1
        for (int ch = 0; ch < 4; ++ch) {
            float vv[8];
#pragma unroll
            for (int j = 0; j < 8; ++j) vv[j] = bf2f(Zv[(size_t)(32 * hf + 8 * ch + j) * 3072 + k]);
            uint4 w; w.x = pack2(vv[0], vv[1]); w.y = pack2(vv[2], vv[3]); w.z = pack2(vv[4], vv[5]); w.w = pack2(vv[6], vv[7]);
            *(uint4*)(sVT + swz_off<64>(k, 4 * hf + ch)) = w;
        }
        const float* H = (const float*)(p.ws + OFF_HST) + (size_t)item * 16384;
#pragma unroll 2
        for (int i = 0; i < 8; ++i) {
            const int e = tid + 256 * i, row = e >> 4, cc = e & 15;
            const float4 a = *(const float4*)(H + row * 128 + cc * 8), bq = *(const float4*)(H + row * 128 + cc * 8 + 4);
            uint4 o; o.x = pack2(a.x, a.y); o.y = pack2(a.z, a.w); o.z = pack2(bq.x, bq.y); o.w = pack2(bq.z, bq.w);
            *(uint4*)(sHT + swz_off<128>(row, cc)) = o;
        }
    }
    __syncthreads();
    f32x4 acc[4][2];
#pragma unroll
    for (int i = 0; i < 4; ++i)
#pragma unroll
        for (int j = 0; j < 2; ++j) acc[i][j] = f32x4{0.f, 0.f, 0.f, 0.f};
    mma_nt<4, 2, 128, 128>(acc, sQe, 0, sHT, 32 * wave, 0, 4, lane);
    mma_nt<4, 2, 64, 64>(acc, sP, 0, sVT, 32 * wave, 0, 2, lane);
#pragma unroll
    for (int i = 0; i < 4; ++i)
#pragma unroll
        for (int r = 0; r < 4; ++r) {
            float s = acc[i][0][r] * acc[i][0][r] + acc[i][1][r] * acc[i][1][r];
            s += DPP_F(s, 0xB1); s += DPP_F(s, 0x4E); s += DPP_F(s, 0x141); s += DPP_F(s, 0x140);
            if ((lane & 15) == 0) sRed[wave * 64 + i * 16 + (lane >> 4) * 4 + r] = s;
        }
    __syncthreads();
    bf16_t* MIX = (bf16_t*)(p.ws + OFF_MIX0);
#pragma unroll
    for (int i = 0; i < 4; ++i)
#pragma unroll
        for (int r = 0; r < 4; ++r) {
            const int t = i * 16 + (lane >> 4) * 4 + r;
            const float tot = sRed[t] + sRed[64 + t] + sRed[128 + t] + sRed[192 + t];
            const float rstd = rsqrtf(tot * (1.f / 128.f) + 1e-6f);
#pragma unroll
            for (int j = 0; j < 2; ++j) {
                const int v = 32 * wave + 16 * j + (lane & 15);
                const float og = bf2f(Z0[(size_t)t * 3072 + 1536 + h * 128 + v]);
                MIX[(m0 + t) * 1024 + h * 128 + v] = f2bf(acc[i][j][r] * rstd * p.l0_hgrn_out_norm[h * 128 + v] * og);
            }
        }
    __syncthreads();
}

DEVI unsigned f2key(float f) { unsigned u = __float_as_uint(f); return (u & 0x80000000u) ? ~u : (u | 0x80000000u); }
DEVI float key2f(unsigned k) { unsigned u = (k & 0x80000000u) ? (k ^ 0x80000000u) : ~k; return __uint_as_float(u); }
#define CE_DESC(a, b) { unsigned _x = max(a, b), _y = min(a, b); a = _x; b = _y; }
DEVI void sort16_desc(unsigned (&a)[16]) {
#pragma unroll
    for (int k = 2; k <= 16; k <<= 1)
#pragma unroll
        for (int j = k >> 1; j > 0; j >>= 1)
#pragma unroll
            for (int i = 0; i < 16; ++i) {
                const int l = i ^ j;
                if (l > i) {
                    if ((i & k) == 0) { CE_DESC(a[i], a[l]); } else { CE_DESC(a[l], a[i]); }
                }
            }
}
DEVI void merge16_desc(unsigned (&a)[16], const unsigned (&b)[16]) {
#pragma unroll
    for (int i = 0; i < 16; ++i) a[i] = max(a[i], b[15 - i]);
#pragma unroll
    for (int j = 8; j > 0; j >>= 1)
#pragma unroll
        for (int i = 0; i < 16; ++i) { const int l = i ^ j; if (l > i) { CE_DESC(a[i], a[l]); } }
}

DEVI void peer_topk_item(const Params& p, const bf16_t* __restrict__ SK, int item, char* smem) {
    const int tid = threadIdx.x, lane = tid & 63, wave = tid >> 6;
    const int r = lane & 31, hh = lane >> 5;
    const bf16_t* QP = (const bf16_t*)(p.ws + OFF_QP);
    int* IDX = (int*)(p.ws + OFF_IDX); float* GATE = (float*)(p.ws + OFF_GATE);
    char* sKey = smem;
    char* sQ = smem + 32768 + wave * 8192;
    {
        const int h = item & 7, tile = (item >> 3) * 4 + wave;
        const size_t tok = (size_t)tile * 32 + r;
        unsigned top[2][16];
#pragma unroll
        for (int ph = 0; ph < 2; ++ph) {
            __syncthreads();
            {
                const bf16_t* ksrc = SK + (size_t)(h * 2 + ph) * 128 * 128;
#pragma unroll
                for (int i = 0; i < 8; ++i) { const int e = tid + 256 * i, row = e >> 4, cc = e & 15; *(uint4*)(sKey + swz_off<128>(row, cc)) = *(const uint4*)(ksrc + row * 128 + cc * 8); }
                const bf16_t* qsrc = QP + (size_t)tile * 32 * 2048 + h * 256 + ph * 128;
#pragma unroll
                for (int i = 0; i < 8; ++i) { const int e = lane + 64 * i, row = e >> 4, cc = e & 15; *(uint4*)(sQ + swz_off<128>(row, cc)) = *(const uint4*)(qsrc + (size_t)row * 2048 + cc * 8); }
            }
            __syncthreads();
            bf16x8 qf[8];
#pragma unroll
            for (int ks = 0; ks < 8; ++ks) qf[ks] = *(const bf16x8*)(sQ + swz_off<128>(r, 2 * ks + hh));
#pragma unroll 1
            for (int rt = 0; rt < 4; ++rt) {
                f32x16 acc;
#pragma unroll
                for (int e = 0; e < 16; ++e) acc[e] = 0.f;
#pragma unroll
                for (int ks = 0; ks < 8; ++ks) {
                    const bf16x8 kf = *(const bf16x8*)(sKey + swz_off<128>(32 * rt + r, 2 * ks + hh));
                    acc = mfma32(kf, qf[ks], acc);
                }
                unsigned kk[16];
#pragma unroll
                for (int e = 0; e < 16; ++e) {
                    const unsigned n = 32 * rt + (e & 3) + 8 * (e >> 2) + 4 * hh;
                    kk[e] = (f2key(acc[e]) & ~127u) | n;
                }
                sort16_desc(kk);
                if (rt == 0) {
#pragma unroll
                    for (int e = 0; e < 16; ++e) top[ph][e] = kk[e];
                } else merge16_desc(top[ph], kk);
            }
            unsigned other[16];
#pragma unroll
            for (int e = 0; e < 16; ++e) { const auto sw_ = __builtin_amdgcn_permlane32_swap(top[ph][e], top[ph][e], false, false); other[e] = hh ? sw_[0] : sw_[1]; }
            merge16_desc(top[ph], other);
        }
        unsigned best[16];
        {
            float s1[16], s2[16];
#pragma unroll
            for (int e = 0; e < 16; ++e) { s1[e] = key2f(top[0][e] & ~127u); s2[e] = key2f(top[1][e] & ~127u); }
            unsigned cand[64];
            unsigned ia[16], ib[16];
#pragma unroll
            for (int e = 0; e < 16; ++e) { ia[e] = (top[0][e] & 127u) << 7; ib[e] = top[1][e] & 127u; }
            int n = 0;
#pragma unroll
            for (int i = 0; i < 16; ++i)
#pragma unroll
                for (int j = 0; j < 16; ++j)
                    if ((i + 1) * (j + 1) <= 16) { cand[n] = (f2key(s1[i] + s2[j]) & ~0x3fffu) | ia[i] | ib[j]; ++n; }
#pragma unroll
            for (int e = 50; e < 64; ++e) cand[e] = 0u;
#pragma unroll
            for (int g = 0; g < 4; ++g) {
                unsigned kk[16];
#pragma unroll
                for (int e = 0; e < 16; ++e) kk[e] = cand[16 * g + e];
                sort16_desc(kk);
                if (g == 0) {
#pragma unroll
                    for (int e = 0; e < 16; ++e) best[e] = kk[e];
                } else merge16_desc(best, kk);
            }
        }
        float sv[16]; int id[16];
#pragma unroll
        for (int e = 0; e < 16; ++e) {
            sv[e] = key2f(best[e] & ~0x3fffu);
            id[e] = (int)(best[e] & 0x3fffu);
        }
        float den = 0.f; const float smax = sv[0];
#pragma unroll
        for (int e = 0; e < 16; ++e) { sv[e] = __expf(sv[e] - smax); den += sv[e]; }
        const float inv = 1.f / den;
        {
            const float* INVT = (const float*)(p.ws + (hh ? OFF_INVU : OFF_INVD));
            float sc[16];
#pragma unroll
            for (int e = 0; e < 16; ++e) sc[e] = INVT[id[e]];
            if (hh == 0) {
                int4* dst = (int4*)(IDX + tok * 128 + h * 16);
                float4* dst2 = (float4*)((float*)(p.ws + OFF_SDN) + tok * 128 + h * 16);
#pragma unroll
                for (int e = 0; e < 4; ++e) { dst[e] = int4{id[4 * e], id[4 * e + 1], id[4 * e + 2], id[4 * e + 3]}; dst2[e] = float4{sc[4 * e], sc[4 * e + 1], sc[4 * e + 2], sc[4 * e + 3]}; }
            } else {
                float4* dst = (float4*)(GATE + tok * 128 + h * 16);
#pragma unroll
                for (int e = 0; e < 4; ++e) dst[e] = float4{sv[4 * e] * inv * sc[4 * e], sv[4 * e + 1] * inv * sc[4 * e + 1], sv[4 * e + 2] * inv * sc[4 * e + 2], sv[4 * e + 3] * inv * sc[4 * e + 3]};
            }
        }
    }
}
DEVI void peer_xb8_convert(const Params& p, int blk0, int nblk) {
    const int tid = threadIdx.x, lane = tid & 63, wave = tid >> 6;
    for (int it0 = blk0; it0 < 4096; it0 += 4 * nblk) {
        uint4 ra[4], rb[4];
#pragma unroll
        for (int u = 0; u < 4; ++u) {
            const int it = it0 + u * nblk;
            const bf16_t* xb = (const bf16_t*)(p.ws + OFF_XB) + ((size_t)(it < 4096 ? it : it0) * 4 + wave) * 1024 + 16 * lane;
            ra[u] = *(const uint4*)xb; rb[u] = *(const uint4*)(xb + 8);
        }
#pragma unroll
        for (int u = 0; u < 4; ++u) {
            const int it = it0 + u * nblk;
            const uint4 a = ra[u], b = rb[u];
            float v[16] = {bflo(a.x), bfhi(a.x), bflo(a.y), bfhi(a.y), bflo(a.z), bfhi(a.z), bflo(a.w), bfhi(a.w),
                           bflo(b.x), bfhi(b.x), bflo(b.y), bfhi(b.y), bflo(b.z), bfhi(b.z), bflo(b.w), bfhi(b.w)};
#pragma unroll
            for (int i = 0; i < 16; ++i) v[i] = fminf(fmaxf(v[i] * 32.f, -400.f), 400.f);
            int w0 = 0, w1 = 0, w2 = 0, w3 = 0;
            w0 = __builtin_amdgcn_cvt_pk_fp8_f32(v[0], v[1], w0, false);   w0 = __builtin_amdgcn_cvt_pk_fp8_f32(v[2], v[3], w0, true);
            w1 = __builtin_amdgcn_cvt_pk_fp8_f32(v[4], v[5], w1, false);   w1 = __builtin_amdgcn_cvt_pk_fp8_f32(v[6], v[7], w1, true);
            w2 = __builtin_amdgcn_cvt_pk_fp8_f32(v[8], v[9], w2, false);   w2 = __builtin_amdgcn_cvt_pk_fp8_f32(v[10], v[11], w2, true);
            w3 = __builtin_amdgcn_cvt_pk_fp8_f32(v[12], v[13], w3, false); w3 = __builtin_amdgcn_cvt_pk_fp8_f32(v[14], v[15], w3, true);
            if (it < 4096) *(int4*)(p.ws + OFF_XB8 + ((size_t)it * 4 + wave) * 1024 + 16 * lane) = int4{w0, w1, w2, w3};
        }
    }
}

typedef float f32x2v __attribute__((ext_vector_type(2)));
#define PEER_QWORD 80000
#define PEER_TPW 32
#define PEER_ITEMS (16384 / (4 * PEER_TPW))
DEVI int queue_pop(const Params& p, int q, char* smem) {
    int* sw = (int*)(smem + PEER_QWORD);
    __syncthreads();
    if (threadIdx.x == 0) *sw = (int)__hip_atomic_fetch_add((unsigned*)(p.ws + OFF_QCNT) + q * 16, 1u, __ATOMIC_RELAXED, __HIP_MEMORY_SCOPE_AGENT);
    __syncthreads();
    return *sw;
}
DEVI int queue_publish(int pending, char* smem) {
    int* sw = (int*)(smem + PEER_QWORD);
    __syncthreads();
    if (threadIdx.x == 0) *sw = pending;
    __syncthreads();
    return *sw;
}
DEVI unsigned queue_live(const Params& p, int qbase, int s0, char* smem) {
    unsigned* sw = (unsigned*)(smem + PEER_QWORD + 4);
    __syncthreads();
    if (threadIdx.x < 64) {
        unsigned c = 0xffffffffu;
        if (threadIdx.x < 8) c = __hip_atomic_load((unsigned*)(p.ws + OFF_QCNT) + (qbase + ((s0 + (int)threadIdx.x) & 7)) * 16, __ATOMIC_RELAXED, __HIP_MEMORY_SCOPE_AGENT);
        const unsigned long long m = __ballot(c < (unsigned)PEER_ITEMS);
        if (threadIdx.x == 0) *sw = (unsigned)m;
    }
    __syncthreads();
    return *sw;
}
#define UFMA(ACC, W, X) asm volatile("v_fmac_f32 %0, %1, %2" : "+v"(ACC) : "v"(W), "v"(X))
DEVI void d_stream(size_t tok, int s, int lane, char* slot, const int* IDX, const char* XB8) {
    const unsigned o1 = (unsigned)tok * 512u + 4u * (unsigned)lane;
    __builtin_amdgcn_global_load_lds((const unsigned*)((const char*)IDX + o1),        (unsigned*)(slot),       4, 0, 0);
    __builtin_amdgcn_global_load_lds((const unsigned*)((const char*)IDX + o1 + 256u), (unsigned*)(slot + 256), 4, 0, 0);
    __builtin_amdgcn_global_load_lds((const unsigned*)(XB8 + (unsigned)tok * 1024u + (unsigned)(128 * s + 4 * (lane & 31))), (unsigned*)(slot + 512), 4, 0, 0);
}
template <int HLF>
DEVI void d_dma(const char* slot, char* buf, int s, int lane, const char* ED) {
    const int grp = lane >> 3, sub = lane & 7;
    unsigned e[8];
#pragma unroll
    for (int i = 0; i < 8; ++i) e[i] = *(const unsigned*)(slot + 256 * HLF + 4 * (8 * i + grp));
#pragma unroll
    for (int i = 0; i < 8; ++i) {
        const int pl_ = 8 * i + grp;
        const unsigned src = ((unsigned)s * 16384u + e[i]) * 128u + (unsigned)(16 * (sub ^ ((pl_ >> 1) & 7)));
        __builtin_amdgcn_global_load_lds((const unsigned*)(ED + src), (unsigned*)(buf + i * 1024), 16, 0, 0);
    }
}
template <int HLF>
DEVI void d_mma(const char* buf, const char* slot, size_t tok, int s, int lane, float* PART) {
    const int r = lane & 15, q = lane >> 4;
    const long b0 = *(const long*)(slot + 512 + 32 * q), b1 = *(const long*)(slot + 512 + 32 * q + 8), b2 = *(const long*)(slot + 512 + 32 * q + 16), b3 = *(const long*)(slot + 512 + 32 * q + 24);
    float* dst = PART + ((size_t)s * 16384 + tok) * 128 + 64 * HLF;
    long a[4][4];
#pragma unroll
    for (int t = 0; t < 4; ++t) {
        const int row = 16 * t + r, key = (row >> 1) & 7;
        const char* rp = buf + row * 128;
#pragma unroll
        for (int kk = 0; kk < 4; ++kk) a[t][kk] = *(const long*)(rp + ((((4 * q + kk) >> 1) ^ key) << 4) + 8 * ((4 * q + kk) & 1));
    }
    f32x4 acc[4];
#pragma unroll
    for (int t = 0; t < 4; ++t) { acc[t] = f32x4{0.f, 0.f, 0.f, 0.f}; acc[t] = __builtin_amdgcn_mfma_f32_16x16x32_fp8_fp8(a[t][0], b0, acc[t], 0, 0, 0); }
#pragma unroll
    for (int t = 0; t < 4; ++t) acc[t] = __builtin_amdgcn_mfma_f32_16x16x32_fp8_fp8(a[t][1], b1, acc[t], 0, 0, 0);
#pragma unroll
    for (int t = 0; t < 4; ++t) acc[t] = __builtin_amdgcn_mfma_f32_16x16x32_fp8_fp8(a[t][2], b2, acc[t], 0, 0, 0);
#pragma unroll
    for (int t = 0; t < 4; ++t) acc[t] = __builtin_amdgcn_mfma_f32_16x16x32_fp8_fp8(a[t][3], b3, acc[t], 0, 0, 0);
    const bool i0 = (r & 1) != 0, i1 = (r & 2) != 0, t0_ = (r & 4) != 0, t1_ = (r & 8) != 0;
#define D_SEL(C, A, B) ((C) ? (B) : (A))
    const float e0 = D_SEL(i1, D_SEL(i0, acc[0][0], acc[0][1]), D_SEL(i0, acc[0][2], acc[0][3]));
    const float e1 = D_SEL(i1, D_SEL(i0, acc[1][0], acc[1][1]), D_SEL(i0, acc[1][2], acc[1][3]));
    const float e2 = D_SEL(i1, D_SEL(i0, acc[2][0], acc[2][1]), D_SEL(i0, acc[2][2], acc[2][3]));
    const float e3 = D_SEL(i1, D_SEL(i0, acc[3][0], acc[3][1]), D_SEL(i0, acc[3][2], acc[3][3]));
    const float o = D_SEL(t1_, D_SEL(t0_, e0, e1), D_SEL(t0_, e2, e3)) * (1.f / 32.f);
#undef D_SEL
    dst[16 * (r >> 2) + 4 * q + (r & 3)] = o;
}
DEVI void peer_down_phase(const Params& p, const float* __restrict__ gain, int qbase, int s0, char* smem) {
    const int tid = threadIdx.x, lane = tid & 63;
    const int wave = __builtin_amdgcn_readfirstlane(tid >> 6);
    const char* ED = p.ws + OFF_ED; const char* XB8 = p.ws + OFF_XB8;
    const int* IDX = (const int*)(p.ws + OFF_IDX);
    float* PART = (float*)(p.ws + OFF_PART);
    (void)gain;
    char* const img = smem + wave * 16384;
    char* const tb0 = smem + 65536 + wave * 3072;
    unsigned live = 0xffu; int pending = 0;
#pragma unroll 1
    for (int sl = 0; sl < 8; ++sl) {
        const int s = (s0 + sl) & 7;
        if (sl == 1) live = queue_live(p, qbase, s0, smem);
        if (!((live >> sl) & 1u)) continue;
#pragma unroll 1
        for (int g = queue_pop(p, qbase + s, smem); g < PEER_ITEMS; g = queue_publish(pending, smem)) {
            if (threadIdx.x == 0) {
                const unsigned* qp_ = (const unsigned*)(p.ws + OFF_QCNT) + (qbase + s) * 16; const unsigned zo_ = 0u, one_ = 1u;
                asm volatile("global_atomic_add %0, %1, %2, %3 sc0" : "+v"(pending) : "v"(zo_), "v"(one_), "s"(qp_) : "memory");
            }
            const size_t t0 = (size_t)g * (4 * PEER_TPW) + wave * PEER_TPW;
            d_stream(t0, s, lane, tb0, IDX, XB8); d_stream(t0 + 1, s, lane, tb0 + 768, IDX, XB8);
            asm volatile("s_waitcnt vmcnt(0)" ::: "memory");
            d_dma<0>(tb0, img, s, lane, ED);
#pragma unroll 1
            for (int j = 0; j < PEER_TPW; ++j) {
                char* const slj = tb0 + 768 * (j & 3); char* const sln = tb0 + 768 * ((j + 1) & 3);
                if (j + 2 < PEER_TPW) d_stream(t0 + j + 2, s, lane, tb0 + 768 * ((j + 2) & 3), IDX, XB8);
                d_dma<1>(slj, img + 8192, s, lane, ED);
                if (j + 2 < PEER_TPW) asm volatile("s_waitcnt vmcnt(11)" ::: "memory"); else asm volatile("s_waitcnt vmcnt(8)" ::: "memory");
                if (!(PROBE_NOMMA && qbase >= 32)) d_mma<0>(img, slj, t0 + j, s, lane, PART);
                asm volatile("s_waitcnt lgkmcnt(0)" ::: "memory");
                if (j + 1 < PEER_TPW) { d_dma<0>(sln, img, s, lane, ED); asm volatile("s_waitcnt vmcnt(8)" ::: "memory"); }
                else asm volatile("s_waitcnt vmcnt(0)" ::: "memory");
                if (!(PROBE_NOMMA && qbase >= 32)) d_mma<1>(img + 8192, slj, t0 + j, s, lane, PART);
                asm volatile("s_waitcnt lgkmcnt(0)" ::: "memory");
            }
        }
    }
}
struct RedL { float sq, pa[8], pb[8], g0, g1, d0, d1; int i0, i1; };
DEVI void red_load(RedL& L, const Params& p, size_t tok, int lane) {
    const float* PART = (const float*)(p.ws + OFF_PART); const float* GATEU = (const float*)(p.ws + OFF_GATE); const float* SDN = (const float*)(p.ws + OFF_SDN);
    const float* SSQ16 = (const float*)(p.ws + OFF_SSQ16); const int* IDX = (const int*)(p.ws + OFF_IDX);
    L.sq = SSQ16[tok * 16 + (lane & 15)];
#pragma unroll
    for (int s = 0; s < 8; ++s) { L.pa[s] = PART[((size_t)s * 16384 + tok) * 128 + lane]; L.pb[s] = PART[((size_t)s * 16384 + tok) * 128 + 64 + lane]; }
    L.g0 = GATEU[tok * 128 + lane]; L.g1 = GATEU[tok * 128 + 64 + lane]; L.d0 = SDN[tok * 128 + lane]; L.d1 = SDN[tok * 128 + 64 + lane];
    L.i0 = IDX[tok * 128 + lane]; L.i1 = IDX[tok * 128 + 64 + lane];
}
DEVI void red_finish(const RedL& L, const Params& p, size_t tok, int lane) {
    float sq = L.sq;
    sq += DPP_F(sq, 0xB1); sq += DPP_F(sq, 0x4E); sq += DPP_F(sq, 0x141); sq += DPP_F(sq, 0x140);
    const float rstd = rsqrtf(sq * (1.f / 1024.f) + 1e-6f);
    float a0 = 0.f, a1 = 0.f;
#pragma unroll
    for (int s = 0; s < 8; ++s) { a0 += L.pa[s]; a1 += L.pb[s]; }
    const float w0 = L.g0 * gelu_tanh(a0 * rstd * L.d0);
    const float w1 = L.g1 * gelu_tanh(a1 * rstd * L.d1);
    float m = fmaxf(fabsf(w0), fabsf(w1));
    m = wave_max_dpp(m);
    const unsigned e = (__float_as_uint(m) >> 23) & 255u;
    const bool tiny = e < 16u;
    const float S = tiny ? 1.f : __uint_as_float((261u - e) << 23), invS = tiny ? 1.f : __uint_as_float((e - 7u) << 23);
    const float s0 = w0 * S, s1 = w1 * S;
    const int hi = __builtin_amdgcn_cvt_pk_fp8_f32(s0, s1, 0, false);
    const float r0 = s0 - __builtin_amdgcn_cvt_f32_fp8(hi, 0), r1 = s1 - __builtin_amdgcn_cvt_f32_fp8(hi, 1);
    const int lo = __builtin_amdgcn_cvt_pk_fp8_f32(r0, r1, 0, false);
    char* rec = p.ws + OFF_UREC + tok * 768;
    *(unsigned short*)(rec + 2 * lane) = (unsigned short)L.i0;
    *(unsigned short*)(rec + 128 + 2 * lane) = (unsigned short)L.i1;
    *(unsigned char*)(rec + 256 + lane) = (unsigned char)(hi & 255);       *(unsigned char*)(rec + 320 + lane) = (unsigned char)((hi >> 8) & 255);
    *(unsigned char*)(rec + 384 + lane) = (unsigned char)(lo & 255);       *(unsigned char*)(rec + 448 + lane) = (unsigned char)((lo >> 8) & 255);
    *(float*)(rec + 512 + 4 * lane) = invS;
}
DEVI void peer_reduce_phase(const Params& p) {
    const int lane = threadIdx.x & 63, wave = threadIdx.x >> 6;
    const int G = gridDim.x;
    for (int it = blockIdx.x; it < 4096; it += 2 * G) {
        const bool two = it + G < 4096;
        const size_t tokA = (size_t)it * 4 + wave, tokB = (size_t)(two ? it + G : it) * 4 + wave;
        RedL A, B;
        red_load(A, p, tokA, lane); red_load(B, p, tokB, lane);
        red_finish(A, p, tokA, lane);
        if (two) red_finish(B, p, tokB, lane);
    }
}
DEVI void u_stream(size_t tok, int s, int lane, char* slot, const char* UREC, const char* XB) {
    const unsigned o1 = (unsigned)tok * 768u + 4u * (unsigned)lane;
    __builtin_amdgcn_global_load_lds((const unsigned*)(UREC + o1),        (unsigned*)(slot),       4, 0, 0);
    __builtin_amdgcn_global_load_lds((const unsigned*)(UREC + o1 + 256u), (unsigned*)(slot + 256), 4, 0, 0);
    __builtin_amdgcn_global_load_lds((const unsigned*)(UREC + o1 + 512u), (unsigned*)(slot + 512), 4, 0, 0);
    __builtin_amdgcn_global_load_lds((const unsigned*)(XB + (unsigned)tok * 2048u + (unsigned)(256 * s + 4 * lane)), (unsigned*)(slot + 768), 4, 0, 0);
}
template <int HLF>
DEVI void u_dma(const char* slot, char* buf, int s, int lane, const char* EU) {
    const int grp = lane >> 3, sub = lane & 7;
    unsigned e[8];
#pragma unroll
    for (int i = 0; i < 8; ++i) e[i] = *(const unsigned short*)(slot + 128 * HLF + 2 * (8 * i + grp));
#pragma unroll
    for (int i = 0; i < 8; ++i) {
        const int pl_ = 8 * i + grp;
        const unsigned src = ((unsigned)s * 16384u + e[i]) * 128u + (unsigned)(16 * (sub ^ ((pl_ >> 1) & 7)));
        __builtin_amdgcn_global_load_lds((const unsigned*)(EU + src), (unsigned*)(buf + i * 1024), 16, 0, 0);
    }
}
#define TR8(DST, ADDR, OFF) asm volatile("ds_read_b64_tr_b8 %0, %1 offset:%2" : "=v"(DST) : "v"(ADDR), "i"(OFF))
#define TR8_WAIT4(N, A, B, C, D) asm volatile("s_waitcnt lgkmcnt(" #N ")" : "+v"(A), "+v"(B), "+v"(C), "+v"(D))
template <int HLF>
DEVI void u_mma(const char* buf, const char* slot, int lane, f32x4 (&acc)[8]) {
    const int i16 = lane & 15, g = lane >> 4;
    const int row0 = 8 * g + (i16 >> 1), key = (row0 >> 1) & 7;
    const unsigned ab = (unsigned)(size_t)(__attribute__((address_space(3))) const char*)(buf + row0 * 128 + 8 * (i16 & 1));
    const long b0 = *(const long*)(slot + 256 + 128 * (i16 & 1) + 64 * HLF + 8 * g), b1 = *(const long*)(slot + 256 + 128 * (i16 & 1) + 64 * HLF + 32 + 8 * g);
    long a0[8], a1[8];
#pragma unroll
    for (int ct = 0; ct < 8; ++ct) { const unsigned ad = ab + (unsigned)((ct ^ key) << 4); TR8(a0[ct], ad, 0); }
#pragma unroll
    for (int ct = 0; ct < 8; ++ct) { const unsigned ad = ab + (unsigned)((ct ^ key) << 4); TR8(a1[ct], ad, 4096); }
    TR8_WAIT4(12, a0[0], a0[1], a0[2], a0[3]);
#pragma unroll
    for (int ct = 0; ct < 4; ++ct) acc[ct] = __builtin_amdgcn_mfma_f32_16x16x32_fp8_fp8(a0[ct], b0, acc[ct], 0, 0, 0);
    TR8_WAIT4(8, a0[4], a0[5], a0[6], a0[7]);
#pragma unroll
    for (int ct = 4; ct < 8; ++ct) acc[ct] = __builtin_amdgcn_mfma_f32_16x16x32_fp8_fp8(a0[ct], b0, acc[ct], 0, 0, 0);
    TR8_WAIT4(4, a1[0], a1[1], a1[2], a1[3]);
#pragma unroll
    for (int ct = 0; ct < 4; ++ct) acc[ct] = __builtin_amdgcn_mfma_f32_16x16x32_fp8_fp8(a1[ct], b1, acc[ct], 0, 0, 0);
    TR8_WAIT4(0, a1[4], a1[5], a1[6], a1[7]);
#pragma unroll
    for (int ct = 4; ct < 8; ++ct) acc[ct] = __builtin_amdgcn_mfma_f32_16x16x32_fp8_fp8(a1[ct], b1, acc[ct], 0, 0, 0);
}
DEVI void u_finish(f32x4 (&acc)[8], const char* slot, char* ex, size_t tok, int s, int lane, float alpha, float* X, bf16_t* XB, float* SSQ8) {
    const int i16 = lane & 15, g = lane >> 4;
    if (i16 < 2) {
#pragma unroll
        for (int ct = 0; ct < 8; ++ct) *(f32x4*)(ex + 576 * i16 + 4 * (16 * ct + 4 * g)) = acc[ct];
    }
    const float2 vh = *(const float2*)(ex + 8 * lane), vl = *(const float2*)(ex + 576 + 8 * lane);
    const float sc = alpha * *(const float*)(slot + 512);
    const unsigned xb2 = *(const unsigned*)(slot + 768 + 4 * lane);
    const float y0 = bflo(xb2) + sc * (vh.x + vl.x), y1 = bfhi(xb2) + sc * (vh.y + vl.y);
    const unsigned col = (unsigned)tok * 1024u + (unsigned)(128 * s + 2 * lane);
    if (X) __builtin_nontemporal_store(f32x2v{y0, y1}, (f32x2v*)((char*)X + 4u * col));
    const unsigned yb = pack2(y0, y1);
    *(unsigned*)((char*)XB + 2u * col) = yb;
    if (!X) {
        float sq = bflo(yb) * bflo(yb) + bfhi(yb) * bfhi(yb);
        sq = wave_sum_dpp(sq);
        if (lane == 0) *(float*)((char*)SSQ8 + ((unsigned)tok * 32u + 4u * (unsigned)s)) = sq;
    }
#pragma unroll
    for (int ct = 0; ct < 8; ++ct) acc[ct] = f32x4{0.f, 0.f, 0.f, 0.f};
}
DEVI void peer_up_phase(const Params& p, int qbase, int s0, float alpha, float* X, char* smem) {
    const int tid = threadIdx.x, lane = tid & 63;
    const int wave = __builtin_amdgcn_readfirstlane(tid >> 6);
    const char* EU = p.ws + OFF_EU; const char* UREC = p.ws + OFF_UREC;
    bf16_t* XB = (bf16_t*)(p.ws + OFF_XB); float* SSQ8 = (float*)(p.ws + OFF_SSQ8);
    char* const img = smem + wave * 16384;
    char* const tb0 = smem + 65536 + wave * 3072;
    unsigned live = 0xffu; int pending = 0;
#pragma unroll 1
    for (int sl = 0; sl < 8; ++sl) {
        const int s = (s0 + sl) & 7;
        if (sl == 1) live = queue_live(p, qbase, s0, smem);
        if (!((live >> sl) & 1u)) continue;
#pragma unroll 1
        for (int g = queue_pop(p, qbase + s, smem); g < PEER_ITEMS; g = queue_publish(pending, smem)) {
            if (threadIdx.x == 0) {
                const unsigned* qp_ = (const unsigned*)(p.ws + OFF_QCNT) + (qbase + s) * 16; const unsigned zo_ = 0u, one_ = 1u;
                asm volatile("global_atomic_add %0, %1, %2, %3 sc0" : "+v"(pending) : "v"(zo_), "v"(one_), "s"(qp_) : "memory");
            }
            const size_t t0 = (size_t)g * (4 * PEER_TPW) + wave * PEER_TPW;
            f32x4 acc[8];
#pragma unroll
            for (int ct = 0; ct < 8; ++ct) acc[ct] = f32x4{0.f, 0.f, 0.f, 0.f};
            char* slj = tb0; char* sln = tb0 + 1024; char* slf = tb0 + 2048;
            u_stream(t0, s, lane, slj, UREC, (const char*)XB); u_stream(t0 + 1, s, lane, sln, UREC, (const char*)XB);
            asm volatile("s_waitcnt vmcnt(0)" ::: "memory");
            u_dma<0>(slj, img, s, lane, EU);
#pragma unroll 1
            for (int j = 0; j < PEER_TPW; ++j) {
                if (j + 2 < PEER_TPW) u_stream(t0 + j + 2, s, lane, slf, UREC, (const char*)XB);
                u_dma<1>(slj, img + 8192, s, lane, EU);
                if (j + 2 < PEER_TPW) asm volatile("s_waitcnt vmcnt(12)" ::: "memory"); else asm volatile("s_waitcnt vmcnt(8)" ::: "memory");
                u_mma<0>(img, slj, lane, acc);
                asm volatile("s_waitcnt lgkmcnt(0)" ::: "memory");
                if (j + 1 < PEER_TPW) { u_dma<0>(sln, img, s, lane, EU); asm volatile("s_waitcnt vmcnt(8)" ::: "memory"); }
                else asm volatile("s_waitcnt vmcnt(0)" ::: "memory");
                u_mma<1>(img + 8192, slj, lane, acc);
                asm volatile("s_waitcnt lgkmcnt(0)" ::: "memory");
                u_finish(acc, slj, img + 8192, t0 + j, s, lane, alpha, X, XB, SSQ8);
                asm volatile("s_waitcnt lgkmcnt(0)" ::: "memory");
                char* const t_ = slj; slj = sln; sln = slf; slf = t_;
            }
        }
    }
}

DEVI void rope_cs(float pos, int i, float& c, float& s) {
    const float inv = exp2f(-(float)i * (13.287712379549449f / 32.f));
    const float ang = pos * inv;
    const float kf = rintf(ang * 0.15915494309189535f);
    float rr = fmaf(-kf, 6.2831854820251465f, ang);
    rr = fmaf(-kf, -1.7484555e-7f, rr);
    c = __cosf(rr); s = __sinf(rr);
}
#define QSCALE_MLA  (0.07216878364870322f * 1.4426950408889634f)
#define QSCALE_MOBA (0.08838834764831845f * 1.4426950408889634f)

DEVI void moba_prep_item(const Params& p, int item, char* smem) {
    const int tid = threadIdx.x;
    const int h = item & 3, tt = item >> 2;
    const size_t m0 = (size_t)tt * 64;
    const int b = (int)(m0 >> 13), s0 = (int)(m0 & 8191), bh = b * 4 + h;
    const bf16_t* Z1 = (const bf16_t*)(p.ws + OFF_Z1);
    bf16_t* Qd = (bf16_t*)(p.ws + OFF_QD); bf16_t* Kd = (bf16_t*)(p.ws + OFF_KD); bf16_t* VdT = (bf16_t*)(p.ws + OFF_VDT);
    const int row = tid >> 2, j = tid & 3;
    const bf16_t* zr = Z1 + (m0 + row) * 1984;
#pragma unroll
    for (int which = 0; which < 2; ++which) {
        const bf16_t* src = zr + (which ? 960 : 448) + h * 128 + 8 * j;
        const float* gn = (which ? p.l1_mk_norm : p.l1_mq_norm) + 8 * j;
        float v[32]; float ss = 0.f;
#pragma unroll
        for (int i = 0; i < 4; ++i) {
            uint4 u = *(const uint4*)(src + 32 * i);
            v[8 * i] = bflo(u.x); v[8 * i + 1] = bfhi(u.x); v[8 * i + 2] = bflo(u.y); v[8 * i + 3] = bfhi(u.y);
            v[8 * i + 4] = bflo(u.z); v[8 * i + 5] = bfhi(u.z); v[8 * i + 6] = bflo(u.w); v[8 * i + 7] = bfhi(u.w);
        }
#pragma unroll
        for (int i = 0; i < 32; ++i) ss += v[i] * v[i];
        ss += DPP_F(ss, 0xB1); ss += DPP_F(ss, 0x4E);
        const float sc = rsqrtf(ss * (1.f / 128.f) + 1e-6f) * (which ? 1.f : QSCALE_MOBA);
        bf16_t* dst = (which ? Kd : Qd) + ((size_t)bh * 8192 + s0 + row) * 128 + 8 * j;
#pragma unroll
        for (int i = 0; i < 4; ++i) {
            uint4 o;
            o.x = pack2(v[8 * i] * sc * gn[32 * i], v[8 * i + 1] * sc * gn[32 * i + 1]); o.y = pack2(v[8 * i + 2] * sc * gn[32 * i + 2], v[8 * i + 3] * sc * gn[32 * i + 3]);
            o.z = pack2(v[8 * i + 4] * sc * gn[32 * i + 4], v[8 * i + 5] * sc * gn[32 * i + 5]); o.w = pack2(v[8 * i + 6] * sc * gn[32 * i + 6], v[8 * i + 7] * sc * gn[32 * i + 7]);
            *(uint4*)(dst + 32 * i) = o;
        }
    }
    bf16_t* sT = (bf16_t*)smem;
    {
        const bf16_t* src = zr + 1472 + h * 128 + 8 * j;
#pragma unroll
        for (int i = 0; i < 4; ++i) {
            uint4 u = *(const uint4*)(src + 32 * i);
            const int d0 = 8 * j + 32 * i;
            sT[(d0 + 0) * 66 + row] = (bf16_t)(u.x & 0xffff); sT[(d0 + 1) * 66 + row] = (bf16_t)(u.x >> 16);
            sT[(d0 + 2) * 66 + row] = (bf16_t)(u.y & 0xffff); sT[(d0 + 3) * 66 + row] = (bf16_t)(u.y >> 16);
            sT[(d0 + 4) * 66 + row] = (bf16_t)(u.z & 0xffff); sT[(d0 + 5) * 66 + row] = (bf16_t)(u.z >> 16);
            sT[(d0 + 6) * 66 + row] = (bf16_t)(u.w & 0xffff); sT[(d0 + 7) * 66 + row] = (bf16_t)(u.w >> 16);
        }
    }
    __syncthreads();
    for (int e = tid; e < 128 * 32; e += NTHREADS) {
        const int d = e >> 5, tp = e & 31;
        const unsigned v = (unsigned)sT[d * 66 + 2 * tp] | ((unsigned)sT[d * 66 + 2 * tp + 1] << 16);
        *(unsigned*)(VdT + ((size_t)bh * 128 + d) * 8192 + s0 + (((2 * tp) & ~12) | (((2 * tp) & 4) << 1) | (((2 * tp) & 8) >> 1))) = v;
    }
    __syncthreads();
}

DEVI void moba_kmean_item(const Params& p, int item, char* smem) {
    const int tid = threadIdx.x;
    const int bh = item >> 5, blk = item & 31, b = bh >> 2, h = bh & 3;
    const bf16_t* Z1 = (const bf16_t*)(p.ws + OFF_Z1) + ((size_t)b * 8192 + blk * 256) * 1984 + 960 + h * 128;
    const int cc = tid & 15, rg = tid >> 4;
    float col[8];
#pragma unroll
    for (int i = 0; i < 8; ++i) col[i] = 0.f;
    for (int i = 0; i < 16; ++i) {
        const int row = rg * 16 + i;
        uint4 u = *(const uint4*)(Z1 + (size_t)row * 1984 + cc * 8);
        float v[8] = {bflo(u.x), bfhi(u.x), bflo(u.y), bfhi(u.y), bflo(u.z), bfhi(u.z), bflo(u.w), bfhi(u.w)};
        float ss = 0.f;
#pragma unroll
        for (int e = 0; e < 8; ++e) ss += v[e] * v[e];
        ss += DPP_F(ss, 0xB1); ss += DPP_F(ss, 0x4E); ss += DPP_F(ss, 0x141); ss += DPP_F(ss, 0x140);
        const float rstd = rsqrtf(ss * (1.f / 128.f) + 1e-6f);
#pragma unroll
        for (int e = 0; e < 8; ++e) col[e] += v[e] * rstd;
    }
    float* sR = (float*)smem;
#pragma unroll
    for (int e = 0; e < 8; ++e) sR[rg * 128 + cc * 8 + e] = col[e];
    __syncthreads();
    if (tid < 128) {
        float s = 0.f;
#pragma unroll
        for (int g = 0; g < 16; ++g) s += sR[g * 128 + tid];
        ((float*)(p.ws + OFF_KMEAN))[((size_t)bh * 32 + blk) * 128 + tid] = s * (1.f / 256.f) * p.l1_mk_norm[tid];
    }
    __syncthreads();
}

DEVI void mla_prep_item(const Params& p, int item, char* smem) {
    const int tid = threadIdx.x;
    const int h = item & 3, tt = item >> 2;
    const size_t m0 = (size_t)tt * 64;
    const int b = (int)(m0 >> 13), s0 = (int)(m0 & 8191), bh = b * 4 + h;
    const bf16_t* Z1 = (const bf16_t*)(p.ws + OFF_Z1);
    const bf16_t* QC = (const bf16_t*)(p.ws + OFF_QC);
    const bf16_t* KV = (const bf16_t*)(p.ws + OFF_KV);
    bf16_t* Q = (bf16_t*)(p.ws + OFF_Q); bf16_t* K = (bf16_t*)(p.ws + OFF_K); bf16_t* VT = (bf16_t*)(p.ws + OFF_VT);
    const int row = tid >> 2, j = tid & 3;
    const size_t m = m0 + row;
    const float pos = (float)p.pos[m];
#pragma unroll
    for (int which = 0; which < 2; ++which) {
        const bf16_t* nsrc = which ? (KV + m * 1024 + h * 256 + 8 * j) : (QC + m * 768 + h * 192 + 8 * j);
        const bf16_t* r1 = which ? (Z1 + m * 1984 + 384 + 8 * j) : (QC + m * 768 + h * 192 + 128 + 8 * j);
        const bf16_t* r2 = r1 + 32;
        const float* gn = which ? p.l1_k_norm : p.l1_q_norm;
        float v[32], a1[8], a2[8]; float ss = 0.f;
#pragma unroll
        for (int i = 0; i < 4; ++i) {
            uint4 u = *(const uint4*)(nsrc + 32 * i);
            v[8 * i] = bflo(u.x); v[8 * i + 1] = bfhi(u.x); v[8 * i + 2] = bflo(u.y); v[8 * i + 3] = bfhi(u.y);
            v[8 * i + 4] = bflo(u.z); v[8 * i + 5] = bfhi(u.z); v[8 * i + 6] = bflo(u.w); v[8 * i + 7] = bfhi(u.w);
        }
        { uint4 u = *(const uint4*)r1; a1[0] = bflo(u.x); a1[1] = bfhi(u.x); a1[2] = bflo(u.y); a1[3] = bfhi(u.y); a1[4] = bflo(u.z); a1[5] = bfhi(u.z); a1[6] = bflo(u.w); a1[7] = bfhi(u.w); }
        { uint4 u = *(const uint4*)r2; a2[0] = bflo(u.x); a2[1] = bfhi(u.x); a2[2] = bflo(u.y); a2[3] = bfhi(u.y); a2[4] = bflo(u.z); a2[5] = bfhi(u.z); a2[6] = bflo(u.w); a2[7] = bfhi(u.w); }
#pragma unroll
        for (int i = 0; i < 32; ++i) ss += v[i] * v[i];
#pragma unroll
        for (int i = 0; i < 8; ++i) ss += a1[i] * a1[i] + a2[i] * a2[i];
        ss += DPP_F(ss, 0xB1); ss += DPP_F(ss, 0x4E);
        const float rstd = rsqrtf(ss * (1.f / 192.f) + 1e-6f);
        const float sc = which ? 1.f : QSCALE_MLA;
        bf16_t* dst = (which ? K : Q) + ((size_t)bh * 8192 + s0 + row) * 192;
#pragma unroll
        for (int i = 0; i < 4; ++i) {
            const float* g = gn + 8 * j + 32 * i;
            uint4 o;
            o.x = pack2(v[8 * i] * rstd * g[0] * sc, v[8 * i + 1] * rstd * g[1] * sc); o.y = pack2(v[8 * i + 2] * rstd * g[2] * sc, v[8 * i + 3] * rstd * g[3] * sc);
            o.z = pack2(v[8 * i + 4] * rstd * g[4] * sc, v[8 * i + 5] * rstd * g[5] * sc); o.w = pack2(v[8 * i + 6] * rstd * g[6] * sc, v[8 * i + 7] * rstd * g[7] * sc);
            *(uint4*)(dst + 8 * j + 32 * i) = o;
        }
        float o1[8], o2[8];
#pragma unroll
        for (int i = 0; i < 8; ++i) {
            float c, s; rope_cs(pos, 8 * j + i, c, s);
            const float y1 = a1[i] * rstd * gn[128 + 8 * j + i], y2 = a2[i] * rstd * gn[160 + 8 * j + i];
            o1[i] = (y1 * c - y2 * s) * sc; o2[i] = (y2 * c + y1 * s) * sc;
        }
        uint4 w1, w2;
        w1.x = pack2(o1[0], o1[1]); w1.y = pack2(o1[2], o1[3]); w1.z = pack2(o1[4], o1[5]); w1.w = pack2(o1[6], o1[7]);
        w2.x = pack2(o2[0], o2[1]); w2.y = pack2(o2[2], o2[3]); w2.z = pack2(o2[4], o2[5]); w2.w = pack2(o2[6], o2[7]);
        *(uint4*)(dst + 128 + 8 * j) = w1; *(uint4*)(dst + 160 + 8 * j) = w2;
    }
    bf16_t* sT = (bf16_t*)smem;
    {
        const bf16_t* src = KV + m * 1024 + h * 256 + 128 + 8 * j;
#pragma unroll
        for (int i = 0; i < 4; ++i) {
            uint4 u = *(const uint4*)(src + 32 * i);
            const int d0 = 8 * j + 32 * i;
            sT[(d0 + 0) * 66 + row] = (bf16_t)(u.x & 0xffff); sT[(d0 + 1) * 66 + row] = (bf16_t)(u.x >> 16);
            sT[(d0 + 2) * 66 + row] = (bf16_t)(u.y & 0xffff); sT[(d0 + 3) * 66 + row] = (bf16_t)(u.y >> 16);
            sT[(d0 + 4) * 66 + row] = (bf16_t)(u.z & 0xffff); sT[(d0 + 5) * 66 + row] = (bf16_t)(u.z >> 16);
            sT[(d0 + 6) * 66 + row] = (bf16_t)(u.w & 0xffff); sT[(d0 + 7) * 66 + row] = (bf16_t)(u.w >> 16);
        }
    }
    __syncthreads();
    for (int e = tid; e < 128 * 32; e += NTHREADS) {
        const int d = e >> 5, tp = e & 31;
        const unsigned v = (unsigned)sT[d * 66 + 2 * tp] | ((unsigned)sT[d * 66 + 2 * tp + 1] << 16);
        *(unsigned*)(VT + ((size_t)bh * 128 + d) * 8192 + s0 + (((2 * tp) & ~12) | (((2 * tp) & 4) << 1) | (((2 * tp) & 8) >> 1))) = v;
    }
    __syncthreads();
}

template <int DQK, bool MOBA>
DEVI void attn_item(const Params& p, int bh, int qt, char* smem) {
    constexpr int NKS = DQK / 16, KCH = DQK / 8;
    const int tid = threadIdx.x, lane = tid & 63, wave = tid >> 6;
    const int r = lane & 31, hh = lane >> 5;
    char* const ws = opaque_ptr(p.ws);
    const bf16_t* Q  = (const bf16_t*)(ws + (MOBA ? OFF_QD : OFF_Q)) + (size_t)bh * 8192 * DQK;
    const bf16_t* Kg = (const bf16_t*)(ws + (MOBA ? OFF_KD : OFF_K)) + (size_t)bh * 8192 * DQK;
    const bf16_t* Vg = (const bf16_t*)(ws + (MOBA ? OFF_VDT : OFF_VT)) + (size_t)bh * 128 * 8192;
    const int q0 = qt * 128;
    const int qpos = q0 + wave * 32 + r;
    constexpr int KB = 32 * DQK * 2, VB = 8192, STG = KB + VB;
    constexpr int KI = KB / 4096;
    constexpr int NST = MOBA ? 4 : 3;
    int*  sList = (int*)(smem + 65536);
    unsigned* sSel = (unsigned*)(smem + 66560);
    float* sTop = (float*)(smem + 67584);
    int ntiles;
    unsigned mysel = 0xffffffffu;
    if constexpr (MOBA) {
        const int jblk = q0 >> 8;
        float* sKm = (float*)smem;
        const float* km = (const float*)(ws + OFF_KMEAN) + (size_t)bh * 32 * 128;
        for (int e = tid; e < 1024; e += NTHREADS) ((float4*)sKm)[e] = ((const float4*)km)[e];
        unsigned* sAny = (unsigned*)(smem + 67328);
        if (tid < 32) sAny[tid] = 0u;
        __syncthreads();
        const int qq = tid & 127, par = tid >> 7;
        float ga[16];
#pragma unroll
        for (int i = 0; i < 16; ++i) ga[i] = 0.f;
        const bf16_t* qrow = Q + (size_t)(q0 + qq) * 128;
#pragma unroll 1
        for (int d0 = 0; d0 < 128; d0 += 8) {
            uint4 u = *(const uint4*)(qrow + d0);
            float qv[8] = {bflo(u.x), bfhi(u.x), bflo(u.y), bfhi(u.y), bflo(u.z), bfhi(u.z), bflo(u.w), bfhi(u.w)};
#pragma unroll
            for (int i = 0; i < 16; ++i) {
                const float4 ka = *(const float4*)(sKm + (2 * i + par) * 128 + d0), kb = *(const float4*)(sKm + (2 * i + par) * 128 + d0 + 4);
                ga[i] += qv[0] * ka.x + qv[1] * ka.y + qv[2] * ka.z + qv[3] * ka.w + qv[4] * kb.x + qv[5] * kb.y + qv[6] * kb.z + qv[7] * kb.w;
            }
        }
        float tv[3] = {-3e38f, -3e38f, -3e38f}; int ti[3] = {-1, -1, -1};
#pragma unroll
        for (int i = 0; i < 16; ++i) {
            const int n = 2 * i + par;
            if (n < jblk) {
                const float v = ga[i];
                if (v > tv[0]) { tv[2] = tv[1]; ti[2] = ti[1]; tv[1] = tv[0]; ti[1] = ti[0]; tv[0] = v; ti[0] = n; }
                else if (v > tv[1]) { tv[2] = tv[1]; ti[2] = ti[1]; tv[1] = v; ti[1] = n; }
                else if (v > tv[2]) { tv[2] = v; ti[2] = n; }
            }
        }
#pragma unroll
        for (int i = 0; i < 3; ++i) { sTop[tid * 6 + 2 * i] = tv[i]; sTop[tid * 6 + 2 * i + 1] = __int_as_float(ti[i]); }
        __syncthreads();
        if (par == 0) {
#pragma unroll
            for (int i = 0; i < 3; ++i) {
                const float v = sTop[(tid + 128) * 6 + 2 * i]; const int n = __float_as_int(sTop[(tid + 128) * 6 + 2 * i + 1]);
                if (n >= 0) {
                    if (v > tv[0]) { tv[2] = tv[1]; ti[2] = ti[1]; tv[1] = tv[0]; ti[1] = ti[0]; tv[0] = v; ti[0] = n; }
                    else if (v > tv[1]) { tv[2] = tv[1]; ti[2] = ti[1]; tv[1] = v; ti[1] = n; }
                    else if (v > tv[2]) { tv[2] = v; ti[2] = n; }
                }
            }
            unsigned m = 1u << jblk;
#pragma unroll
            for (int i = 0; i < 3; ++i) if (ti[i] >= 0) { m |= 1u << ti[i]; sAny[ti[i]] = 1u; }
            sSel[qq] = m;
        }
        __syncthreads();
        if (tid == 0) {
            int n = 0;
            for (int blk = 0; blk < jblk; ++blk) if (sAny[blk]) { for (int t = 0; t < 8; ++t) sList[n++] = blk * 8 + t; }
            for (int t = jblk * 8; t < (q0 + 128) / 32; ++t) sList[n++] = t;
            sSel[160] = (unsigned)n;
        }
        __syncthreads();
        ntiles = (int)sSel[160];
        mysel = sSel[wave * 32 + r];
        __syncthreads();
    } else {
        ntiles = 4 * qt + 4;
    }
    bf16x8 qf[NKS];
#pragma unroll
    for (int ks = 0; ks < NKS; ++ks) qf[ks] = *(const bf16x8*)(Q + (size_t)qpos * DQK + ks * 16 + hh * 8);
    f32x16 o[4];
#pragma unroll
    for (int dt = 0; dt < 4; ++dt)
#pragma unroll
        for (int e = 0; e < 16; ++e) o[dt][e] = 0.f;
    float lsum = 0.f;
    int koff[KI], voff[2];
#pragma unroll
    for (int i = 0; i < KI; ++i) {
        const int L = (wave * KI + i) * 64 + lane, row = L / KCH, cp = L % KCH;
        const int f = (DQK == 128) ? (row & 15) : ((row >> 1) & 7);
        koff[i] = row * DQK + (cp ^ f) * 8;
    }
#pragma unroll
    for (int i = 0; i < 2; ++i) {
        const int L = (wave * 2 + i) * 64 + lane, dv = L >> 2, cp = L & 3;
        voff[i] = dv * 8192 + (cp ^ ((dv >> 2) & 3)) * 8;
    }
    const int wv = __builtin_amdgcn_readfirstlane(wave);
#define ATT_ISSUE(LI) { const int u_ = tile_id(LI); char* st_ = smem + ((LI) % NST) * STG; \
        _Pragma("unroll") for (int i = 0; i < KI; ++i) __builtin_amdgcn_global_load_lds((const unsigned*)(Kg + (size_t)u_ * 32 * DQK + koff[i]), (unsigned*)(st_ + (wv * KI + i) * 1024), 16, 0, 0); \
        _Pragma("unroll") for (int i = 0; i < 2; ++i)  __builtin_amdgcn_global_load_lds((const unsigned*)(Vg + (size_t)u_ * 32 + voff[i]),       (unsigned*)(st_ + KB + (wv * 2 + i) * 1024), 16, 0, 0); }
    auto tile_id = [&](int li) -> int { if constexpr (MOBA) return sList[li]; else return li; };
    if (ntiles > 0) ATT_ISSUE(0)
    if (ntiles > 1) ATT_ISSUE(1)
    if (NST == 4 && ntiles > 2) ATT_ISSUE(2)
    const int xk = ((DQK == 128) ? (r & 15) : ((r >> 1) & 7)) ^ hh;
    const int xv = (r >> 2) & 3;
#pragma unroll 1
    for (int li = 0; li < ntiles; ++li) {
        if (NST == 4 && li + 2 < ntiles) asm volatile("s_waitcnt vmcnt(%0)" :: "n"(2 * (KI + 2)) : "memory");
        else if (li + 1 < ntiles) asm volatile("s_waitcnt vmcnt(%0)" :: "n"(KI + 2) : "memory");
        else asm volatile("s_waitcnt vmcnt(0)" ::: "memory");
        G2_RAW_BARRIER();
        if (li + NST - 1 < ntiles) ATT_ISSUE(li + NST - 1)
        const int unit = tile_id(li);
        const int kbase = unit * 32;
        bool allowed = true;
        if constexpr (MOBA) allowed = (mysel >> (unit >> 3)) & 1u;
        const char* sK = smem + (li % NST) * STG;
        const char* sV = sK + KB;
        if (kbase <= q0 + wave * 32 + 31) {
            const char* kbase_l = sK + r * (DQK * 2);
            const char* vbase_l = sV + r * 64;
            f32x16 s;
#pragma unroll
            for (int e = 0; e < 16; ++e) s[e] = 0.f;
#pragma unroll
            for (int ks = 0; ks < NKS; ++ks) {
                const bf16x8 a = *(const bf16x8*)(kbase_l + (((2 * ks) ^ xk) << 4));
                s = mfma32(a, qf[ks], s);
            }
            const bool need_mask = (kbase + 31 > q0 + wave * 32);
            float pr[16];
            if (need_mask) {
                const int kofs = qpos - kbase - 4 * hh;
#pragma unroll
                for (int e = 0; e < 16; ++e) pr[e] = ((e & 3) + 8 * (e >> 2) <= kofs) ? __builtin_amdgcn_exp2f(s[e]) : 0.f;
            } else {
#pragma unroll
                for (int e = 0; e < 16; ++e) pr[e] = __builtin_amdgcn_exp2f(s[e]);
            }
            if constexpr (MOBA) {
                const float am = allowed ? 1.f : 0.f;
#pragma unroll
                for (int e = 0; e < 16; ++e) pr[e] *= am;
            }
            lsum += ((pr[0] + pr[1]) + (pr[2] + pr[3])) + ((pr[4] + pr[5]) + (pr[6] + pr[7])) + ((pr[8] + pr[9]) + (pr[10] + pr[11])) + ((pr[12] + pr[13]) + (pr[14] + pr[15]));
#pragma unroll
            for (int s2 = 0; s2 < 2; ++s2) {
                const u32x4 pbu = {pack2(pr[8 * s2 + 0], pr[8 * s2 + 1]), pack2(pr[8 * s2 + 2], pr[8 * s2 + 3]),
                                   pack2(pr[8 * s2 + 4], pr[8 * s2 + 5]), pack2(pr[8 * s2 + 6], pr[8 * s2 + 7])};
                const bf16x8 pbv = __builtin_bit_cast(bf16x8, pbu);
#pragma unroll
                for (int dt = 0; dt < 4; ++dt) {
                    const char* vb = vbase_l + dt * (32 * 64);
                    const u32x4 vau = *(const u32x4*)(vb + (((2 * s2 + hh) ^ xv) << 4));
                    o[dt] = mfma32(__builtin_bit_cast(bf16x8, vau), pbv, o[dt]);
                }
            }
        }
    }
#undef ATT_ISSUE
    G2_RAW_BARRIER();
    lsum += __shfl_xor(lsum, 32);
    const float inv = 1.f / lsum;
    char* sO = smem + wave * 8704;
#pragma unroll
    for (int dt = 0; dt < 4; ++dt)
#pragma unroll
        for (int e = 0; e < 16; e += 2) {
            const int dv = 32 * dt + (e & 3) + 8 * (e >> 2) + 4 * hh;
            *(unsigned*)(sO + r * 272 + dv * 2) = pack2(o[dt][e] * inv, o[dt][e + 1] * inv);
        }
    __builtin_amdgcn_s_waitcnt(0xc07f);
    __builtin_amdgcn_wave_barrier();
    bf16_t* MIX = (bf16_t*)(ws + OFF_MIX1);
    const int b = bh >> 2, h = bh & 3;
#pragma unroll
    for (int i = 0; i < 8; ++i) {
        const int id = lane + 64 * i, row = id >> 4, cc = id & 15;
        const uint4 v = *(const uint4*)(sO + row * 272 + cc * 16);
        *(uint4*)(MIX + ((size_t)b * 8192 + q0 + wave * 32 + row) * 1024 + (MOBA ? 512 : 0) + h * 128 + cc * 8) = v;
    }
    __syncthreads();
}

DEVI void attn_phase_all(const Params& p, char* smem) {
    const int G = gridDim.x;
#pragma unroll 1
    for (int v = blockIdx.x; v < 512; v += G) attn_item<192, false>(p, v & 7, 63 - (v >> 3), smem);
    __builtin_amdgcn_sched_barrier(0);
#pragma unroll 1
    for (int v = blockIdx.x; v < 512; v += G) attn_item<128, true>(p, v & 7, (v >> 3), smem);
}

#define XB_TMO      128
#define XB_XCNT(j)  (256  + 64 * (j))
#define XB_XSUB(j)  (1280 + 64 * (j))
#define XB_XGEN(j)  (2304 + 64 * (j))
#define XB_TOP      3328
#define XB_TOPGEN   3392
#define XCD_BAR_WORDS 3456
#define XB_SPIN_CAP (1u << 23)
#define LAS __attribute__((address_space(3)))
DEVI unsigned xb_ld(unsigned* p)              { return __hip_atomic_load(p, __ATOMIC_RELAXED, __HIP_MEMORY_SCOPE_AGENT); }
DEVI unsigned xb_add(unsigned* p, unsigned v) { return __hip_atomic_fetch_add(p, v, __ATOMIC_RELAXED, __HIP_MEMORY_SCOPE_AGENT); }
DEVI unsigned xb_xcc_id() { return (unsigned)__builtin_amdgcn_s_getreg((3 << 11) | 20) & 0xFu; }
#define XB_SPIN(cond, bar) do { unsigned _sp = 0; while (cond) { __builtin_amdgcn_s_sleep(1); \
    if ((++_sp & 255u) == 0u) { if (xb_ld(&(bar)[XB_TMO])) break; if (_sp > XB_SPIN_CAP) { atomicAdd(&(bar)[XB_TMO], 1u); break; } } } } while (0)
struct XcdBarrier { unsigned* bar; unsigned x; volatile LAS unsigned* st; };
DEVI XcdBarrier xcd_barrier_post(unsigned* bar, volatile LAS unsigned* st) {
    XcdBarrier b; b.bar = bar; b.x = xb_xcc_id(); b.st = st;
    if (threadIdx.x == 0) st[2] = xb_add(&bar[XB_XCNT(b.x)], 1u);
    return b;
}
DEVI void xcd_barrier_complete(unsigned* bar, unsigned x, unsigned& nloc, unsigned& nx, unsigned& dense) {
    const unsigned G = gridDim.x * gridDim.y * gridDim.z;
    unsigned sum, cnt, mine, sp = 0u;
    for (;;) {
        sum = 0u; cnt = 0u; mine = 0u; dense = 0u;
#pragma unroll
        for (unsigned j = 0; j < 16; ++j) { const unsigned c = xb_ld(&bar[XB_XCNT(j)]); sum += c; cnt += (c > 0u) ? 1u : 0u; mine = (j == x) ? c : mine; dense += (j < x && c > 0u) ? 1u : 0u; }
        if (sum == G) break;
        __builtin_amdgcn_s_sleep(1);
        if ((++sp & 255u) == 0u) { if (xb_ld(&bar[XB_TMO])) break; if (sp > XB_SPIN_CAP) { atomicAdd(&bar[XB_TMO], 1u); break; } }
    }
    nloc = mine > 0u ? mine : 1u; nx = cnt > 0u ? cnt : 1u;
}
DEVI void xcd_barrier(const XcdBarrier& b) {
    asm volatile("s_waitcnt vmcnt(0)" ::: "memory");
    __syncthreads();
    if (threadIdx.x == 0) {
        unsigned* bar = b.bar;
        __builtin_amdgcn_s_waitcnt(0);
        unsigned nloc = b.st[0], nx = b.st[1];
        if (nloc == 0u) { unsigned dense = 0u; xcd_barrier_complete(bar, b.x, nloc, nx, dense); b.st[0] = nloc; b.st[1] = nx; b.st[3] = dense; }
        const unsigned old = xb_add(&bar[XB_XSUB(b.x)], 1u);
        const unsigned gen = old / nloc;
        if (old + 1u == (gen + 1u) * nloc) {
            __builtin_amdgcn_fence(__ATOMIC_RELEASE, "agent");
            asm volatile("s_waitcnt vmcnt(0)" ::: "memory");
            const unsigned og = xb_add(&bar[XB_TOP], 1u);
            const unsigned tg = og / nx;
            if (og + 1u == (tg + 1u) * nx) xb_add(&bar[XB_TOPGEN], 1u);
            else XB_SPIN(xb_ld(&bar[XB_TOPGEN]) == tg, bar);
            __builtin_amdgcn_fence(__ATOMIC_ACQUIRE, "agent");
            asm volatile("s_waitcnt vmcnt(0)" ::: "memory");
            xb_add(&bar[XB_XGEN(b.x)], 1u);
            asm volatile("s_waitcnt vmcnt(0)" ::: "memory");
        } else {
            XB_SPIN(xb_ld(&bar[XB_XGEN(b.x)]) == gen, bar);
            asm volatile("buffer_inv sc0" ::: "memory");
            asm volatile("s_waitcnt vmcnt(0)" ::: "memory");
        }
    }
    __syncthreads();
}

struct TopkAfter {
    const Params* p; const bf16_t* SK; char* smem;
    DEVI void operator()(int panel, int h) const { peer_topk_item(*p, SK, panel * 8 + h, smem); __syncthreads(); }
};
enum { PH_CONV, PH_INPROJ0, PH_LOCAL, PH_SCAN, PH_HOUT, PH_OUTPROJ0, PH_Q0, PH_PD0, PH_PR0, PH_PU0, PH_INPROJ1, PH_SMALL, PH_MLAPREP, PH_MLA,
       PH_OUTPROJ1, PH_Q1, PH_PD1, PH_PR1, PH_PU1, N_PHASES };
DEVI void run_phase(const Params& p, int ph_in, char* smem, Placement pl) {
    const bool dup = ph_in >= 100; const int ph = dup ? ph_in - 100 : ph_in;
#ifdef ONLY_PHASE
    if (ph != ONLY_PHASE) return;
#endif
    char* ws = p.ws;
    const int bid = blockIdx.x, nb = gridDim.x;
    const int myslice = (pl.nloc > 0) ? (pl.xcc & 7) : (bid & 7);
    switch (ph) {
    case PH_CONV: phase_convert(p, smem); break;
    case PH_INPROJ0: gemm2_phase((const bf16_t*)(ws + OFF_XB), 1024, (const bf16_t*)(ws + OFF_W_IN0T), 128, 12, 1024, (const float*)(ws + OFF_SSQ1), 1,
                        Epi2In0{(bf16_t*)(ws + OFF_Z0), (float*)(ws + OFF_G), (const float*)(ws + OFF_LB), (bf16_t*)(ws + OFF_Z0), 3072, 3072, nullptr, nullptr}, smem, pl); break;
    case PH_LOCAL: for (int it = bid; it < 1024; it += nb) hgrn_local_item(p, it, smem);
            for (int it = nb - 1 - bid; it < 512; it += nb) gmlp_item(p, it, smem);
            break;
    case PH_SCAN: hgrn_scan_phase(p); break;
    case PH_HOUT: for (int it = bid; it < 1024; it += nb) hgrn_out_item(p, it, smem); break;
    case PH_OUTPROJ0: case PH_OUTPROJ1: {
        const bool l1 = (ph == PH_OUTPROJ1);
        gemm2_phase((const bf16_t*)(ws + (l1 ? OFF_MIX1 : OFF_MIX0)), 1024, (const bf16_t*)(ws + (l1 ? OFF_W_OUT1T : OFF_W_OUT0T)), 128, 4, 1024, nullptr, 0,
                    Epi2Resid{(bf16_t*)(ws + OFF_XB), (float*)(ws + OFF_SSQ16), dup ? 0.f : (l1 ? ALPHA_M1 : ALPHA_M0), nullptr, 0, 0, nullptr, nullptr}, smem, pl);
    } break;
    case PH_Q0: case PH_Q1: {
        const bool l1 = (ph == PH_Q1);
        {
            const bf16_t* SK = (const bf16_t*)(ws + (l1 ? OFF_SK1 : OFF_SK0));
            int xcd = blockIdx.x & 7, slot = blockIdx.x >> 3, nslots = gridDim.x >> 3, nxc = 8;
            if (pl.nloc > 0) { xcd = pl.xcc; slot = pl.rank; nslots = pl.nloc; nxc = pl.nx; }
            const int tm_ = 128, tn_ = 8, np = (tm_ + nxc - 1) / nxc, per_xcd = ((np + 7) >> 3) * tn_ * 8;
            const bool alt = (slot & 1) != 0;
            if (!alt) gemm2_phase((const bf16_t*)(ws + OFF_XB), 1024, (const bf16_t*)(ws + (l1 ? OFF_W_Q1T : OFF_W_Q0T)), 128, 8, 1024, (const float*)(ws + OFF_SSQ16), 16,
                                  Epi2Bf16{(bf16_t*)(ws + OFF_QP), 2048, 2048, nullptr, nullptr}, smem, pl);
#pragma unroll 1
            for (int t = slot; t < per_xcd; t += nslots) {
                if (alt) gemm2_phase((const bf16_t*)(ws + OFF_XB), 1024, (const bf16_t*)(ws + (l1 ? OFF_W_Q1T : OFF_W_Q0T)), 128, 8, 1024, (const float*)(ws + OFF_SSQ16), 16,
                                     Epi2Bf16{(bf16_t*)(ws + OFF_QP), 2048, 2048, nullptr, nullptr}, smem, pl, NoAfter(), (t - slot) / nslots);
                const int mi = t & 7, rest = t >> 3, nt_ = rest % tn_, mg = rest / tn_;
                const int pidx = mg * 8 + mi, panel = xcd + nxc * pidx;
                if (pidx >= np || panel >= tm_) continue;
                peer_topk_item(p, SK, panel * 8 + nt_, smem);
                __syncthreads();
            }
        }
        peer_xb8_convert(p, bid, nb);
    } break;
    case PH_PD0: case PH_PD1: peer_down_phase(p, (ph == PH_PD1) ? p.l1_norm_ffn : p.l0_norm_ffn, ((ph == PH_PD1) ? 16 : 0) + (dup ? 32 : 0), myslice, smem); break;
    case PH_PR0: case PH_PR1: peer_reduce_phase(p); break;
    case PH_PU0: case PH_PU1: peer_up_phase(p, ((ph == PH_PU1) ? 24 : 8) + (dup ? 32 : 0), myslice, dup ? 0.f : ((ph == PH_PU1) ? ALPHA_P1 : ALPHA_P0), (ph == PH_PU1 && !dup) ? p.out : nullptr, smem); break;
    case PH_INPROJ1: gemm2_phase((const bf16_t*)(ws + OFF_XB), 1024, (const bf16_t*)(ws + OFF_W_IN1T), 128, 8, 1024, (const float*)(ws + OFF_SSQ8), 8, Epi2Bf16{(bf16_t*)(ws + OFF_Z1), 1984, 1984, (float*)(ws + OFF_SSQCQ), (float*)(ws + OFF_SSQCKV)}, smem, pl);
            for (int it = bid; it < 8192; it += nb) conv_experts(p.l1_exp_down, p.l1_exp_up, p.l1_norm_ffn, ws, it);
            break;
    case PH_SMALL: {
        gemm2_phase((const bf16_t*)(ws + OFF_Z1), 1984, (const bf16_t*)(ws + OFF_W_UQT), 128, 3, 256, (const float*)(ws + OFF_SSQCQ), 1, Epi2Bf16{(bf16_t*)(ws + OFF_QC), 768, 768, nullptr, nullptr}, smem, pl);
        gemm2_phase((const bf16_t*)(ws + OFF_Z1) + 256, 1984, (const bf16_t*)(ws + OFF_W_UKVT), 128, 4, 128, (const float*)(ws + OFF_SSQCKV), 1, Epi2Bf16{(bf16_t*)(ws + OFF_KV), 1024, 1024, nullptr, nullptr}, smem, pl);
        for (int it = (bid + nb / 2) % nb; it < 1024 + 256; it += nb) { if (it < 1024) moba_prep_item(p, it, smem); else moba_kmean_item(p, it - 1024, smem); }
    } break;
    case PH_MLAPREP: for (int it = bid; it < 1024; it += nb) mla_prep_item(p, it, smem); break;
    case PH_MLA: attn_phase_all(p, smem); break;
    default: break;
    }
}

extern "C" __global__ void __launch_bounds__(NTHREADS, 2) fwd_kernel(Params p) {
    extern __shared__ __attribute__((aligned(16))) char smem[];
    __shared__ uint4 xb_words;
    XcdBarrier xb; xb.bar = nullptr; xb.x = 0; xb.st = (volatile LAS unsigned*)&xb_words;
    if (p.coop) {
        if (threadIdx.x == 0) xb_words = make_uint4(0u, 0u, 0u, 0u);
        __syncthreads();
        xb = xcd_barrier_post((unsigned*)(p.ws + OFF_BAR), (volatile LAS unsigned*)&xb_words);
    }
    if (p.coop == 2) cg::this_grid().sync();
    long long tp0 = 0, tp1 = 0;
#define RUN_PH(PH) if (p.ph_lo <= PH && PH < p.ph_hi) { \
        Placement pl_; pl_.xcc = p.coop ? (int)xb.st[3] : 0; pl_.rank = p.coop ? (int)xb.st[2] : 0; pl_.nloc = p.coop ? (int)xb.st[0] : 0; pl_.nx = p.coop ? (int)xb.st[1] : 0; \
        if (PROBE_DUP == PH) { run_phase(p, PH + 100, smem, pl_); if (p.coop) xcd_barrier(xb); } \
        if (PROBE_TIME == PH) tp0 = wall_clock64(); \
        run_phase(p, PH, smem, pl_); if (p.coop && PH + 1 < p.ph_hi) xcd_barrier(xb); \
        if (PROBE_TIME == PH) tp1 = wall_clock64(); }
    RUN_PH(0) RUN_PH(1) RUN_PH(2) RUN_PH(3) RUN_PH(4) RUN_PH(5) RUN_PH(6) RUN_PH(7) RUN_PH(8) RUN_PH(9)
    RUN_PH(10) RUN_PH(11) RUN_PH(12) RUN_PH(13) RUN_PH(14) RUN_PH(15) RUN_PH(16) RUN_PH(17) RUN_PH(18)
    static_assert(N_PHASES == 19, "phase list");
    if (PROBE_TIME >= 0) { const long long te = wall_clock64(), dt = (tp1 - tp0) * PROBE_TIME_K; while (wall_clock64() - te < dt) __builtin_amdgcn_s_sleep(20); }
}

extern "C" void kernel_launch(void* const* d_in, const int* in_sizes, int n_in, void* d_out, int out_size, void* d_ws, size_t ws_size, hipStream_t stream) {
    static int grid = 0;
    if (grid == 0) {
        if (n_in != 31 || out_size != 16384 * 1024 || ws_size < WS_NEED) { fprintf(stderr, "kernel_launch: unexpected shapes (n_in %d out %d ws %zu need %zu)\n", n_in, out_size, ws_size, (size_t)WS_NEED); grid = -1; return; }
        int dev = 0, cus = 0, per_cu = 0;
        hipGetDevice(&dev);
        hipDeviceGetAttribute(&cus, hipDeviceAttributeMultiprocessorCount, dev);
        if (hipFuncSetAttribute((const void*)fwd_kernel, hipFuncAttributeMaxDynamicSharedMemorySize, LDS_BYTES) != hipSuccess) { fprintf(stderr, "kernel_launch: hipFuncSetAttribute failed\n"); grid = -1; return; }
        if (hipOccupancyMaxActiveBlocksPerMultiprocessor(&per_cu, (const void*)fwd_kernel, NTHREADS, LDS_BYTES) != hipSuccess || per_cu < 1) { fprintf(stderr, "kernel_launch: occupancy query failed (%d)\n", per_cu); per_cu = 1; }
        (void)hipGetLastError();
        if (per_cu > 2) per_cu = 2;
        grid = cus * per_cu;
        fprintf(stderr, "kernel_launch: grid %d (%d CUs x %d)\n", grid, cus, per_cu);
    }
    if (grid < 0) return;
    Params p; memset(&p, 0, sizeof(p));
    const float* const* f = (const float* const*)d_in;
    p.x = f[0]; p.pos = (const int*)d_in[1]; p.lb_logits = f[2];
    p.l0_norm_mix = f[3]; p.l0_w_in = f[4]; p.l0_hgrn_out_norm = f[5]; p.l0_gmlp_v_norm = f[6]; p.l0_gmlp_w_s = f[7]; p.l0_gmlp_b_s = f[8]; p.l0_w_out = f[9];
    p.l0_norm_ffn = f[10]; p.l0_w_query = f[11]; p.l0_sub_keys = f[12]; p.l0_exp_down = f[13]; p.l0_exp_up = f[14];
    p.l1_norm_mix = f[15]; p.l1_w_in = f[16]; p.l1_cq_norm = f[17]; p.l1_ckv_norm = f[18]; p.l1_w_uq = f[19]; p.l1_w_ukv = f[20];
    p.l1_q_norm = f[21]; p.l1_k_norm = f[22]; p.l1_mq_norm = f[23]; p.l1_mk_norm = f[24]; p.l1_w_out = f[25];
    p.l1_norm_ffn = f[26]; p.l1_w_query = f[27]; p.l1_sub_keys = f[28]; p.l1_exp_down = f[29]; p.l1_exp_up = f[30];
    p.out = (float*)d_out; p.ws = (char*)d_ws;
    if (hipMemsetAsync((char*)d_ws + OFF_BAR, 0, 16384 + 4096, stream) != hipSuccess) { fprintf(stderr, "kernel_launch: memset failed\n"); return; }
#if N_LAUNCH_MODE == 1
    p.ph_lo = 0; p.ph_hi = N_PHASES; p.coop = 1;
    void* args[] = {&p};
    hipError_t e = hipLaunchCooperativeKernel((const void*)fwd_kernel, dim3(grid), dim3(NTHREADS), args, LDS_BYTES, stream);
    if (e != hipSuccess) fprintf(stderr, "cooperative launch failed: %s (grid %d)\n", hipGetErrorString(e), grid);
#else
    for (int ph = 0; ph < N_PHASES; ++ph) {
#ifdef ABLATE_M1
        if (ph >= 10 && ph <= 14) continue;
#endif
        p.ph_lo = ph; p.ph_hi = ph + 1; p.coop = 0;
        hipLaunchKernelGGL(fwd_kernel, dim3(grid), dim3(NTHREADS), LDS_BYTES, stream, p);
    }
#endif
}
```
